# Optimizing an MI355X kernel written in HIP

```python
import jax, jax.numpy as jnp
from jax import lax
import numpy as np

D_MODEL = 1024
BATCH = 8
SEQ = 2048
DEPTH = 1
DEC_BATCH = 2
DEC_SEQ = 16384
PAST_LEN = 128

EXPAND = 2
D_MIX = EXPAND * D_MODEL
D_CONV = D_MIX // 2
D_RWKV = D_MIX - D_CONV
HEAD_DIM = 64
N_HEADS = D_RWKV // HEAD_DIM
CONV_WIDTH = 3
R_DECAY = 64
R_ICLR = 64
N_DIRS = 2
N_CONV_IN = 4 * D_CONV
N_RWKV_IN = 4 * D_RWKV + N_DIRS * R_DECAY + N_DIRS * R_ICLR
N_IN = N_CONV_IN + N_RWKV_IN
LN_EPS = 1e-5
LNX_EPS = 64e-5
DN_ALPHA = (2.0 * DEPTH) ** 0.25
DN_BETA = (8.0 * DEPTH) ** -0.25

kernel_name = "hybrid_conv_rwkv7_bidir_encoder"


def layer_norm(x, g, b, eps=LN_EPS):
    xf = x.astype(jnp.float32)
    mu = jnp.mean(xf, -1, keepdims=True)
    var = jnp.mean(jnp.square(xf - mu), -1, keepdims=True)
    return ((xf - mu) * lax.rsqrt(var + eps) * g.astype(jnp.float32) + b.astype(jnp.float32)).astype(x.dtype)


def shift_prev(u):
    return jnp.pad(u, ((0, 0), (1, 0), (0, 0)))[:, :-1]


def shift_next(u):
    return jnp.pad(u, ((0, 0), (0, 1), (0, 0)))[:, 1:]


def short_conv_branch(u, conv_w, conv_b):
    h, bg, cg, z = jnp.split(u, 4, axis=-1)
    p = cg * h
    q = conv_w[0] * shift_prev(p) + conv_w[1] * p + conv_w[2] * shift_next(p) + conv_b
    return bg * q * jax.nn.silu(z)


def rwkv7_scan(r, w, k, v, kk, a):
    xs = tuple(jnp.moveaxis(t, 2, 0) for t in (r, w, k, v, kk, a))
    d, b, _, h, n = r.shape

    def step(S, inp):
        r_t, w_t, k_t, v_t, kk_t, a_t = inp
        sa = jnp.einsum('dbhvk,dbhk->dbhv', S, kk_t)
        S = (S * w_t[..., None, :]
             - sa[..., :, None] * (kk_t * a_t)[..., None, :]
             + v_t[..., :, None] * k_t[..., None, :])
        return S, jnp.einsum('dbhvk,dbhk->dbhv', S, r_t)

    S0 = jnp.zeros((d, b, h, n, n), jnp.float32)
    _, ys = lax.scan(step, S0, xs)
    return jnp.moveaxis(ys, 0, 2)


def rwkv7_branch(u, mu, w0, w_up, a0, a_up, k_k, k_a, r_k, lnx_g, lnx_b):
    out_dtype = u.dtype
    u = u.astype(jnp.float32)
    B, T, _ = u.shape
    c = 0.5 * (shift_prev(u) + shift_next(u))
    m = u + mu.astype(jnp.float32) * (c - u)
    r, k, v, z, lw, la = jnp.split(
        m, [D_RWKV, 2 * D_RWKV, 3 * D_RWKV, 4 * D_RWKV, 4 * D_RWKV + N_DIRS * R_DECAY], axis=-1)
    lw = lw.reshape(B, T, N_DIRS, R_DECAY)
    la = la.reshape(B, T, N_DIRS, R_ICLR)
    wlog = -jax.nn.softplus(-(w0.astype(jnp.float32)
                              + jnp.einsum('btdr,drc->btdc', jnp.tanh(lw), w_up.astype(jnp.float32)))) - 0.5
    decay = jnp.exp(-jnp.exp(wlog))
    a = jax.nn.sigmoid(a0.astype(jnp.float32) + jnp.einsum('btdr,drc->btdc', la, a_up.astype(jnp.float32)))
    kk = (k * k_k.astype(jnp.float32)).reshape(B, T, N_HEADS, HEAD_DIM)
    kk = kk / jnp.maximum(jnp.sqrt(jnp.sum(kk * kk, -1, keepdims=True)), 1e-12)
    kd = k[:, :, None, :] * (1.0 + (a - 1.0) * k_a.astype(jnp.float32))

    def dir_stack(t):
        t = jnp.moveaxis(t, 2, 0).reshape(N_DIRS, B, T, N_HEADS, HEAD_DIM)
        return jnp.stack([t[0], t[1, :, ::-1]])

    def shared(t):
        return jnp.broadcast_to(t.reshape(B, T, 1, -1), (B, T, N_DIRS, t.shape[-1] if t.ndim == 3 else -1))

    kk_flat = kk.reshape(B, T, D_RWKV)
    ys = rwkv7_scan(dir_stack(shared(r)), dir_stack(decay), dir_stack(kd),
                    dir_stack(shared(v)), dir_stack(shared(kk_flat)), dir_stack(a))
    y = ys[0] + ys[1, :, ::-1]
    mean = jnp.mean(y, -1, keepdims=True)
    var = jnp.mean(jnp.square(y - mean), -1, keepdims=True)
    yn = (y - mean) * lax.rsqrt(var + LNX_EPS)
    yn = yn * lnx_g.astype(jnp.float32).reshape(N_HEADS, HEAD_DIM) + lnx_b.astype(jnp.float32).reshape(N_HEADS, HEAD_DIM)
    rh = r.reshape(B, T, N_HEADS, HEAD_DIM)
    kbar = (0.5 * (kd[:, :, 0] + kd[:, :, 1])).reshape(B, T, N_HEADS, HEAD_DIM)
    vh = v.reshape(B, T, N_HEADS, HEAD_DIM)
    bonus = jnp.sum(rh * kbar * r_k.astype(jnp.float32), -1, keepdims=True) * vh
    out = (yn + bonus).reshape(B, T, D_RWKV) * jax.nn.silu(z)
    return out.astype(out_dtype)


def encoder_layer(x, w_in, conv_w, conv_b, shift_mu, w0, w_up, a0, a_up, k_k, k_a, r_k,
                  lnx_g, lnx_b, w_out, ln_g, ln_b):
    u = jnp.einsum('btd,dn->btn', x, w_in)
    y_conv = short_conv_branch(u[..., :N_CONV_IN], conv_w, conv_b)
    y_rwkv = rwkv7_branch(u[..., N_CONV_IN:], shift_mu, w0, w_up, a0, a_up, k_k, k_a, r_k, lnx_g, lnx_b)
    y = jnp.einsum('btm,md->btd', jnp.concatenate([y_conv, y_rwkv], -1), w_out)
    return layer_norm(DN_ALPHA * x + y, ln_g, ln_b)


def trunk(x, emb_ln_g, emb_ln_b, w_in, conv_w, conv_b, shift_mu, w0, w_up, a0, a_up, k_k, k_a, r_k,
          lnx_g, lnx_b, w_out, ln_g, ln_b):
    x = layer_norm(x, emb_ln_g, emb_ln_b)
    for l in range(DEPTH):
        x = encoder_layer(x, w_in[l], conv_w[l], conv_b[l], shift_mu[l], w0[l], w_up[l], a0[l], a_up[l],
                          k_k[l], k_a[l], r_k[l], lnx_g[l], lnx_b[l], w_out[l], ln_g[l], ln_b[l])
    return x


def setup_inputs(seed: int = 0) -> dict:
    key = jax.random.key(seed)
    ks = jax.random.split(key, 20)
    nrm = jax.random.normal
    L = DEPTH
    f32 = jnp.float32
    return {
        "x_prompt": nrm(ks[0], (BATCH, SEQ, D_MODEL), f32),
        "x_sample": nrm(ks[1], (DEC_BATCH, DEC_SEQ, D_MODEL), f32),
        "emb_ln_g": 1.0 + 0.02 * nrm(ks[2], (D_MODEL,), f32),
        "emb_ln_b": 0.02 * nrm(ks[3], (D_MODEL,), f32),
        "w_in": nrm(ks[4], (L, D_MODEL, N_IN), f32) * D_MODEL ** -0.5,
        "conv_w": nrm(ks[5], (L, CONV_WIDTH, D_CONV), f32) * CONV_WIDTH ** -0.5,
        "conv_b": 0.02 * nrm(ks[6], (L, D_CONV), f32),
        "shift_mu": jax.random.uniform(ks[7], (L, N_RWKV_IN), f32, 0.0, 1.0),
        "w0": jax.random.uniform(ks[8], (L, N_DIRS, D_RWKV), f32, -6.5, -1.5),
        "w_up": nrm(ks[9], (L, N_DIRS, R_DECAY, D_RWKV), f32) * 0.1 * R_DECAY ** -0.5,
        "a0": 0.1 * nrm(ks[10], (L, N_DIRS, D_RWKV), f32),
        "a_up": nrm(ks[11], (L, N_DIRS, R_ICLR, D_RWKV), f32) * R_ICLR ** -0.5,
        "k_k": 0.85 + 0.02 * nrm(ks[12], (L, D_RWKV), f32),
        "k_a": 1.0 + 0.02 * nrm(ks[13], (L, D_RWKV), f32),
        "r_k": 0.1 * nrm(ks[14], (L, N_HEADS, HEAD_DIM), f32),
        "lnx_g": 1.0 + 0.02 * nrm(ks[15], (L, D_RWKV), f32),
        "lnx_b": 0.02 * nrm(ks[16], (L, D_RWKV), f32),
        "w_out": nrm(ks[17], (L, D_MIX, D_MODEL), f32) * (D_MIX ** -0.5) * DN_BETA,
        "ln_g": 1.0 + 0.02 * nrm(ks[18], (L, D_MODEL), f32),
        "ln_b": 0.02 * nrm(ks[19], (L, D_MODEL), f32),
    }


def reference(x_prompt, x_sample, emb_ln_g, emb_ln_b, w_in, conv_w, conv_b, shift_mu, w0, w_up, a0, a_up,
              k_k, k_a, r_k, lnx_g, lnx_b, w_out, ln_g, ln_b):
    y_prompt = trunk(x_prompt, emb_ln_g, emb_ln_b, w_in, conv_w, conv_b, shift_mu, w0, w_up, a0, a_up,
                     k_k, k_a, r_k, lnx_g, lnx_b, w_out, ln_g, ln_b)
    y_sample = trunk(x_sample, emb_ln_g, emb_ln_b, w_in, conv_w, conv_b, shift_mu, w0, w_up, a0, a_up,
                     k_k, k_a, r_k, lnx_g, lnx_b, w_out, ln_g, ln_b)
    return (y_prompt, y_sample)
```

```cpp
#include <hip/hip_runtime.h>
#include <hip/hip_cooperative_groups.h>
#include <cstdio>
#include <cstdint>
namespace cg = cooperative_groups;
namespace pg8 {
#define PG8_LAS __attribute__((address_space(3)))
typedef unsigned short bf16_t;
typedef short bf16x8 __attribute__((ext_vector_type(8)));
typedef float f32x4 __attribute__((ext_vector_type(4)));
typedef unsigned u32x4 __attribute__((ext_vector_type(4)));
constexpr int BM = 256, BK = 64, HALF = 128, HTB = HALF * BK * 2  , STAGE_BYTES = 8 * HTB, NXCD = 8, WGM = 8;

__host__ __device__ __forceinline__ int lds_byte(int r, int c) { const int st = (r >> 4) * 2 + (c >> 5), rr = r & 15, cc = c & 31, ob = rr * 64 + cc * 2; return st * 1024 + (ob ^ (((ob >> 9) & 1) << 5)); }
__host__ __device__ __forceinline__ void stage_rc(int b, int& R, int& C) { const int st = b / 1024, sb = b % 1024, swz = sb ^ (((sb >> 9) & 1) << 5); R = (st >> 1) * 16 + swz / 64; C = (st & 1) * 32 + (swz % 64) / 2; }
__host__ __device__ __forceinline__ int perm32(int rho) { const int n = rho >> 4, i = rho & 15; return 8 * (i >> 2) + 4 * n + (i & 3); }

struct Unit { int pm, pn; };
struct Gemm { const bf16_t* A; const bf16_t* Bt; int M, N, K; };

struct StaticOrder {
    int nM, nN, nwg, G, c;
    __host__ __device__ void init(int M, int N, int G_, int c_) { nM = M / BM; nN = N / BM; nwg = nM * nN; G = G_; c = c_; }
    __host__ __device__ bool next(int i, Unit& u) const {
        const long L = (long)i * G + c; if (L >= nwg) return false;
        int wgid = (int)L; { const int q = nwg / NXCD, r = nwg % NXCD, xcd = wgid % NXCD, off = wgid / NXCD; wgid = (xcd < r ? xcd * (q + 1) : r * (q + 1) + (xcd - r) * q) + off; }
        const int nig = WGM * nN, gid = wgid / nig, fm = gid * WGM, gsz = (nM - fm) < WGM ? (nM - fm) : WGM;
        u.pm = fm + ((wgid % nig) % gsz); u.pn = (wgid % nig) / gsz; return true;
    }
    __device__ __forceinline__ void a_ready(const Unit&) const {}
    __device__ __forceinline__ void done(const Unit&) const {}
};

template <class Epi, class Sched, bool ALIGN_EPI = false, bool SP2 = false>
__device__ __forceinline__ void gemm_phase(PG8_LAS unsigned char* lds, const Gemm g, const Sched& S, const Epi& E, int wid0) {
    int tid_; asm volatile("v_mbcnt_lo_u32_b32 %0, -1, 0\n\tv_mbcnt_hi_u32_b32 %0, -1, %0" : "=v"(tid_)); tid_ += wid0 * 64; const int tid = tid_, wid = __builtin_amdgcn_readfirstlane(tid >> 6), lane = tid & 63, wr = wid >> 2, wc = wid & 3, fr = lane & 15, fq = lane >> 4;
    const int K = g.K, nt = K / BK;
    unsigned voffA[2], voffB[2];
#pragma unroll
    for (int i = 0; i < 2; ++i) { int R, C; stage_rc(tid * 16 + i * 8192, R, C); const int Rb = Epi::PERM ? ((R & ~31) + perm32(R & 31)) : R;
        voffA[i] = (unsigned)(R * K + C) * 2u; voffB[i] = (unsigned)(Rb * K + C) * 2u; }
    const size_t kstep = (size_t)(BK * 2);
    const size_t hstep = (size_t)HALF * K * 2;
    const size_t tstep = 2 * hstep;
    const unsigned ldsw = (unsigned)wid * 1024u;
    const int aoff = lds_byte(wr * 64 + fr, fq * 8), boff = lds_byte(wc * 32 + fr, fq * 8);
#define PG8_SA(b, h) (((b) * 2 + (h)) * HTB)
#define PG8_SB(b, h) ((4 + (b) * 2 + (h)) * HTB)
#define PG8_STAGE(bufoff, gbase, voff) do { _Pragma("unroll") for (int _i = 0; _i < 2; ++_i) \
        __builtin_amdgcn_global_load_lds((const unsigned*)((const char*)(gbase) + (voff)[_i]), (PG8_LAS unsigned*)(lds + (bufoff) + ldsw + _i * 8192), 16, 0, 0); } while (0)
#define PG8_LDA(dst, b, h) do { _Pragma("unroll") for (int m = 0; m < 4; ++m) _Pragma("unroll") for (int k = 0; k < 2; ++k) dst[m][k] = *(const PG8_LAS bf16x8*)(lds + PG8_SA(b, h) + aoff + m * 2048 + k * 1024); } while (0)
#define PG8_LDB(dst, b, h) do { _Pragma("unroll") for (int n = 0; n < 2; ++n) _Pragma("unroll") for (int k = 0; k < 2; ++k) dst[n][k] = *(const PG8_LAS bf16x8*)(lds + PG8_SB(b, h) + boff + n * 2048 + k * 1024); } while (0)
#define PG8_MMA(ai, bj, At, Bt) do { __builtin_amdgcn_s_setprio(1); _Pragma("unroll") for (int m = 0; m < 4; ++m) _Pragma("unroll") for (int n = 0; n < 2; ++n) _Pragma("unroll") for (int k = 0; k < 2; ++k) \
        acc[ai][bj][m][n] = __builtin_amdgcn_mfma_f32_16x16x32_bf16(Bt[n][k], At[m][k], acc[ai][bj][m][n], 0, 0, 0); __builtin_amdgcn_s_setprio(0); } while (0)
#define PG8_WAIT_V(n) asm volatile("s_waitcnt vmcnt(" #n ")" ::: "memory")
#define PG8_WAIT_L(n) asm volatile("s_waitcnt lgkmcnt(" #n ")" ::: "memory")
#define PG8_BAR __builtin_amdgcn_s_barrier()
#define PG8_SCHED __builtin_amdgcn_sched_barrier(0)
    Unit cur, nxt; int ui = 0;
    if (!S.next(0, cur)) return;
    f32x4 acc[2][2][4][2];
#pragma unroll
    for (int a = 0; a < 2; ++a)
#pragma unroll
        for (int b = 0; b < 2; ++b)
#pragma unroll
            for (int m = 0; m < 4; ++m)
#pragma unroll
                for (int n = 0; n < 2; ++n) acc[a][b][m][n] = (f32x4){0.f, 0.f, 0.f, 0.f};
    bf16x8 At[4][2], B0[2][2], B1[2][2];
    const char* cA = (const char*)g.A + (size_t)cur.pm * tstep; const char* cB = (const char*)g.Bt + (size_t)cur.pn * tstep;
    S.a_ready(cur);
    if constexpr (SP2) {
        PG8_STAGE(PG8_SB(0, 0), cB, voffB); PG8_STAGE(PG8_SB(0, 1), cB + hstep, voffB); PG8_STAGE(PG8_SA(0, 0), cA, voffA); PG8_STAGE(PG8_SA(0, 1), cA + hstep, voffA);
        if (wr == 1) PG8_BAR;
        PG8_WAIT_V(2); PG8_BAR;
        PG8_STAGE(PG8_SB(1, 0), cB + kstep, voffB); PG8_STAGE(PG8_SA(1, 0), cA + kstep, voffA); PG8_STAGE(PG8_SB(1, 1), cB + hstep + kstep, voffB);
        PG8_WAIT_V(6); PG8_BAR;
    } else {
        PG8_STAGE(PG8_SB(0, 0), cB, voffB); PG8_STAGE(PG8_SA(0, 0), cA, voffA); PG8_STAGE(PG8_SB(0, 1), cB + hstep, voffB); PG8_STAGE(PG8_SA(0, 1), cA + hstep, voffA);
        if (wr == 1) PG8_BAR;
        PG8_WAIT_V(4); PG8_BAR;
        PG8_STAGE(PG8_SB(1, 0), cB + kstep, voffB); PG8_STAGE(PG8_SA(1, 0), cA + kstep, voffA); PG8_STAGE(PG8_SB(1, 1), cB + hstep + kstep, voffB);
        PG8_WAIT_V(6); PG8_BAR;
    }
    for (;;) {
        const bool has_next = S.next(ui + 1, nxt);
        const char* nA = has_next ? (const char*)g.A + (size_t)nxt.pm * tstep : cA; const char* nB = has_next ? (const char*)g.Bt + (size_t)nxt.pn * tstep : cB;
        for (int t = 0; t < nt; t += 2) {
            const bool last = (t == nt - 2);
            const char* a1 = cA + (size_t)(t + 1) * kstep;
            const char* a2 = last ? nA : cA + (size_t)(t + 2) * kstep; const char* b2 = last ? nB : cB + (size_t)(t + 2) * kstep;
            const char* a3 = a2 + kstep; const char* b3 = b2 + kstep;
            if (last && has_next) S.a_ready(nxt);
            if constexpr (SP2) {
            PG8_LDB(B0, 0, 0); PG8_LDB(B1, 0, 1); PG8_SCHED; PG8_LDA(At, 0, 0); PG8_STAGE(PG8_SA(1, 1), a1 + hstep, voffA);
            PG8_WAIT_V(8); PG8_WAIT_L(0); PG8_BAR; PG8_MMA(0, 0, At, B0); PG8_MMA(0, 1, At, B1); PG8_BAR; PG8_SCHED;
            PG8_LDA(At, 0, 1); PG8_STAGE(PG8_SB(0, 0), b2, voffB); PG8_STAGE(PG8_SB(0, 1), b2 + hstep, voffB); PG8_STAGE(PG8_SA(0, 0), a2, voffA);
            PG8_WAIT_V(8); PG8_WAIT_L(0); PG8_BAR; PG8_MMA(1, 0, At, B0); PG8_MMA(1, 1, At, B1); PG8_BAR; PG8_SCHED;
            PG8_LDB(B0, 1, 0); PG8_LDB(B1, 1, 1); PG8_SCHED; PG8_LDA(At, 1, 0); PG8_STAGE(PG8_SA(0, 1), a2 + hstep, voffA);
            PG8_WAIT_V(8); PG8_WAIT_L(0); PG8_BAR; PG8_MMA(0, 0, At, B0); PG8_MMA(0, 1, At, B1); PG8_BAR; PG8_SCHED;
            PG8_LDA(At, 1, 1); PG8_STAGE(PG8_SB(1, 0), b3, voffB); PG8_STAGE(PG8_SB(1, 1), b3 + hstep, voffB); PG8_STAGE(PG8_SA(1, 0), a3, voffA);
            PG8_WAIT_V(8); PG8_WAIT_L(0); PG8_BAR; PG8_MMA(1, 0, At, B0); PG8_MMA(1, 1, At, B1); PG8_BAR; PG8_SCHED;
            } else {
            PG8_LDB(B0, 0, 0); PG8_SCHED; PG8_LDA(At, 0, 0); PG8_STAGE(PG8_SA(1, 1), a1 + hstep, voffA);
            PG8_WAIT_L(8); PG8_BAR; PG8_WAIT_L(0); PG8_MMA(0, 0, At, B0); PG8_BAR; PG8_SCHED;
            PG8_LDB(B1, 0, 1); PG8_STAGE(PG8_SB(0, 0), b2, voffB);
            PG8_BAR; PG8_WAIT_L(0); PG8_MMA(0, 1, At, B1); PG8_BAR;
            PG8_LDA(At, 0, 1); PG8_STAGE(PG8_SA(0, 0), a2, voffA);
            PG8_BAR; PG8_WAIT_L(0); PG8_MMA(1, 0, At, B0); PG8_BAR; PG8_SCHED;
            PG8_STAGE(PG8_SB(0, 1), b2 + hstep, voffB);
            PG8_WAIT_V(6); PG8_BAR; PG8_MMA(1, 1, At, B1); PG8_BAR;
            PG8_LDB(B0, 1, 0); PG8_SCHED; PG8_LDA(At, 1, 0); PG8_STAGE(PG8_SA(0, 1), a2 + hstep, voffA);
            PG8_WAIT_L(8); PG8_BAR; PG8_WAIT_L(0); PG8_MMA(0, 0, At, B0); PG8_BAR; PG8_SCHED;
            PG8_LDB(B1, 1, 1); PG8_STAGE(PG8_SB(1, 0), b3, voffB);
            PG8_BAR; PG8_WAIT_L(0); PG8_MMA(0, 1, At, B1); PG8_BAR;
            PG8_LDA(At, 1, 1); PG8_STAGE(PG8_SA(1, 0), a3, voffA);
            PG8_BAR; PG8_WAIT_L(0); PG8_MMA(1, 0, At, B0); PG8_BAR; PG8_SCHED;
            PG8_STAGE(PG8_SB(1, 1), b3 + hstep, voffB);
            PG8_WAIT_V(6); PG8_BAR; PG8_MMA(1, 1, At, B1); PG8_BAR;
            }
        }
        if constexpr (ALIGN_EPI) { if (wr == 0) PG8_BAR; }
        if constexpr (!Epi::AFTER_DRAIN) { E(acc, cur, wr, wc, fr, fq); S.done(cur); }
        if (!has_next) break;
#pragma unroll
        for (int a = 0; a < 2; ++a)
#pragma unroll
            for (int b = 0; b < 2; ++b)
#pragma unroll
                for (int m = 0; m < 4; ++m)
#pragma unroll
                    for (int n = 0; n < 2; ++n) acc[a][b][m][n] = (f32x4){0.f, 0.f, 0.f, 0.f};
        cur = nxt; cA = nA; cB = nB; ++ui;
        if constexpr (ALIGN_EPI) { if (wr == 1) PG8_BAR; }
    }
    PG8_WAIT_V(0);
    if constexpr (!ALIGN_EPI) { if (wr == 0) PG8_BAR; }
    PG8_BAR;
    if constexpr (Epi::AFTER_DRAIN) { E.fused(acc, cur, wr, wc, fr, fq, lds, wid, lane); S.done(cur); }
#undef PG8_SA
#undef PG8_SB
#undef PG8_STAGE
#undef PG8_LDA
#undef PG8_LDB
#undef PG8_MMA
#undef PG8_WAIT_V
#undef PG8_WAIT_L
#undef PG8_BAR
#undef PG8_SCHED
}
}

typedef unsigned short bf16_t;
typedef float f32x4 __attribute__((ext_vector_type(4)));
typedef unsigned u32x4 __attribute__((ext_vector_type(4)));
typedef unsigned u32x2 __attribute__((ext_vector_type(2)));

constexpr int D = 1024, NIN = 8448, DR = 1024, UW = 6400  , URW = 2048  ;
constexpr int SLAB = 16384, NTOK = 49152;
constexpr float DN_ALPHA = 1.189207115002721f;
constexpr size_t WS_WIN = 0;
constexpr size_t WS_WOUT = WS_WIN + (size_t)NIN * D * 2;
constexpr size_t WS_STATS = WS_WOUT + (size_t)D * 2048 * 2;
constexpr size_t WS_XN = WS_STATS + (size_t)NTOK * 2 * 4;
constexpr size_t WS_U = WS_XN + (size_t)SLAB * D * 2;
constexpr size_t WS_YS = WS_U + (size_t)SLAB * UW * 2;
constexpr size_t WS_BON = WS_YS + (size_t)2 * SLAB * DR * 4;
constexpr size_t WS_YMIX = WS_BON + (size_t)2 * SLAB * 16 * 4;
constexpr size_t WS_TMP = WS_YS;
constexpr size_t WS_PQ = WS_YMIX;
constexpr size_t WS_SST = WS_YMIX + (size_t)SLAB * 2048 * 2;
constexpr size_t WS_BAR = WS_SST + (size_t)2048 * 4096 * 4;
constexpr size_t WS_END = WS_BAR + 16384;
static_assert(WS_END <= (size_t)512 * 1024 * 1024, "ws map");
constexpr int LDS_BYTES = 147456;

struct Params { const float* in[20]; float* out; unsigned char* ws; };
typedef const Params __attribute__((address_space(4)))* KP;
#define KP_FRESH(p) asm volatile("" : "+s"(p))
__device__ __forceinline__ int hw_tid(int wid0) { int l; asm volatile("v_mbcnt_lo_u32_b32 %0, -1, 0\n\tv_mbcnt_hi_u32_b32 %0, -1, %0" : "=v"(l)); return wid0 * 64 + l; }
enum { I_XP = 0, I_XS, I_EG, I_EB, I_WIN, I_CW, I_CB, I_MU, I_W0, I_WUP, I_A0, I_AUP, I_KK, I_KA, I_RK, I_LXG, I_LXB, I_WOUT, I_LG, I_LB };

__device__ __forceinline__ float bf2f(unsigned short h) { return __uint_as_float((unsigned)h << 16); }
__device__ __forceinline__ unsigned f2bf(float f) { unsigned u = __float_as_uint(f); return (u + 0x7fffu + ((u >> 16) & 1u)) >> 16; }
__device__ __forceinline__ unsigned pk2(float lo, float hi) { return f2bf(lo) | (f2bf(hi) << 16); }
typedef __bf16 bf16x2e_t __attribute__((ext_vector_type(2)));
typedef float f32x2e __attribute__((ext_vector_type(2)));
__device__ __forceinline__ unsigned cvtpk_(float lo, float hi) { f32x2e v = {lo, hi}; bf16x2e_t b = __builtin_convertvector(v, bf16x2e_t); return __builtin_bit_cast(unsigned, b); }
__device__ __forceinline__ float shx(float v, int lane, int o) { return __int_as_float(__builtin_amdgcn_ds_bpermute((lane ^ o) << 2, __float_as_int(v))); }
__device__ __forceinline__ float wsum(float v, int lane) {
#pragma unroll
    for (int o = 32; o; o >>= 1) v += shx(v, lane, o);
    return v;
}
__device__ __forceinline__ float sigmoidf_(float x) { return 1.f / (1.f + __expf(-x)); }
__device__ __forceinline__ float siluf_(float x) { return x * sigmoidf_(x); }
__device__ __forceinline__ float rl(float v, int l) { return __int_as_float(__builtin_amdgcn_readlane(__float_as_int(v), l)); }

__device__ __forceinline__ void slab_info(int s, int& tok0, int& nseq, int& T) { if (s == 0) { tok0 = 0; nseq = 8; T = 2048; } else { tok0 = SLAB * s; nseq = 1; T = 16384; } }
__device__ __forceinline__ const float* slab_x(KP p, int s) { return s == 0 ? p->in[I_XP] : p->in[I_XS] + (size_t)(s - 1) * SLAB * D; }

__device__ __forceinline__ int orig_col(int jv) {
    if (jv >= 4096) return jv;
    const int pn = jv >> 8, bj = (jv >> 7) & 1, wc = (jv >> 5) & 3, fq = (jv >> 3) & 3, n = (jv >> 2) & 1, j = jv & 3;
    return (2 * bj + n) * 1024 + 64 * pn + 16 * wc + 4 * fq + j;
}

__device__ void phase_weights(KP p, int wid0) {
    KP_FRESH(p);
    int gt = blockIdx.x * 512 + hw_tid(wid0); asm volatile("" : "+v"(gt)); const int nt = gridDim.x * 512;
    bf16_t* win = (bf16_t*)(p->ws + WS_WIN); bf16_t* wout = (bf16_t*)(p->ws + WS_WOUT);
    const float* w_in = p->in[I_WIN]; const float* w_out = p->in[I_WOUT];
    for (int idx = gt; idx < NIN * 128; idx += nt) {
        const int jv = idx % NIN, kg = idx / NIN, oc = orig_col(jv);
        float v[8];
#pragma unroll
        for (int i = 0; i < 8; ++i) v[i] = w_in[(size_t)(kg * 8 + i) * NIN + oc];
        u32x4 w; w.x = pk2(v[0], v[1]); w.y = pk2(v[2], v[3]); w.z = pk2(v[4], v[5]); w.w = pk2(v[6], v[7]);
        *(u32x4*)(win + (size_t)jv * D + kg * 8) = w;
    }
    for (int idx = gt; idx < D * 256; idx += nt) {
        const int n = idx % D, kg = idx / D;
        float v[8];
#pragma unroll
        for (int i = 0; i < 8; ++i) v[i] = w_out[(size_t)(kg * 8 + i) * D + n];
        u32x4 w; w.x = pk2(v[0], v[1]); w.y = pk2(v[2], v[3]); w.z = pk2(v[4], v[5]); w.w = pk2(v[6], v[7]);
        *(u32x4*)(wout + (size_t)n * 2048 + kg * 8) = w;
    }
}

__device__ __forceinline__ bf16_t* xn_buf(KP p, int s) { return s == 1 ? (bf16_t*)(p->out + (size_t)2 * SLAB * D) : (bf16_t*)(p->ws + WS_XN); }
__device__ __forceinline__ void phase_ln(KP p, int s, int wid0, int wg0) {
    KP_FRESH(p);
    int tid_ = hw_tid(wid0); asm volatile("" : "+v"(tid_)); int lane = tid_ & 63; const int gw = ((int)blockIdx.x - wg0) * 8 + (tid_ >> 6), nw = ((int)gridDim.x - wg0) * 8;
    const float* x = slab_x(p, s); bf16_t* xn = xn_buf(p, s); float* stats = (float*)(p->ws + WS_STATS) + (size_t)s * SLAB * 2;
    const float4* g4 = (const float4*)p->in[I_EG]; const float4* b4 = (const float4*)p->in[I_EB];
    for (int gi = gw; gi < SLAB / 4; gi += nw) {
        const int r0 = gi * 4;
        asm volatile("" : "+v"(lane));
        float4 v[4][4];
#pragma unroll
        for (int k = 0; k < 4; ++k)
#pragma unroll
            for (int i = 0; i < 4; ++i) v[k][i] = ((const float4*)(x + (size_t)(r0 + k) * D))[lane + 64 * i];
#pragma unroll
        for (int k = 0; k < 4; ++k) {
            const int r = r0 + k;
            float sum = 0.f;
#pragma unroll
            for (int i = 0; i < 4; ++i) sum += v[k][i].x + v[k][i].y + v[k][i].z + v[k][i].w;
            const float mean = wsum(sum, lane) * (1.f / 1024.f);
            float sq = 0.f;
#pragma unroll
            for (int i = 0; i < 4; ++i) { float a = v[k][i].x - mean, b = v[k][i].y - mean, c = v[k][i].z - mean, d = v[k][i].w - mean; sq += a * a + b * b + c * c + d * d; }
            const float rstd = rsqrtf(wsum(sq, lane) * (1.f / 1024.f) + 1e-5f);
            if (lane == 0) { stats[r * 2] = mean; stats[r * 2 + 1] = rstd; }
#pragma unroll
            for (int i = 0; i < 4; ++i) {
                const float4 g = g4[lane + 64 * i], b = b4[lane + 64 * i];
                u32x2 w; w.x = cvtpk_((v[k][i].x - mean) * rstd * g.x + b.x, (v[k][i].y - mean) * rstd * g.y + b.y);
                w.y = cvtpk_((v[k][i].z - mean) * rstd * g.z + b.z, (v[k][i].w - mean) * rstd * g.w + b.w);
                *(u32x2*)(xn + (size_t)r * D + (lane + 64 * i) * 4) = w;
            }
        }
    }
}

struct EpiU {
    static constexpr bool PERM = true, AFTER_DRAIN = false;
    bf16_t* U; bf16_t* TMP;
    __device__ __forceinline__ void operator()(const f32x4 (&acc)[2][2][4][2], const pg8::Unit& u, int wr, int wc, int fr, int fq) const {
        const int row0 = u.pm * 256 + wr * 64 + fr;
        if (u.pn < 16) {
            const int ch0 = 64 * u.pn + 16 * wc + 4 * fq;
#pragma unroll
            for (int ai = 0; ai < 2; ++ai)
#pragma unroll
                for (int m = 0; m < 4; ++m) {
                    bf16_t* rowp = U + (size_t)(row0 + ai * 128 + m * 16) * UW + ch0;
                    const f32x4 h = acc[ai][0][m][0], B = acc[ai][0][m][1], C = acc[ai][1][m][0], z = acc[ai][1][m][1];
                    float pp[4], gg[4];
#pragma unroll
                    for (int j = 0; j < 4; ++j) { pp[j] = C[j] * h[j]; gg[j] = B[j] * siluf_(z[j]); }
                    u32x2 w0; w0.x = pk2(pp[0], pp[1]); w0.y = pk2(pp[2], pp[3]);
                    u32x2 w1; w1.x = pk2(gg[0], gg[1]); w1.y = pk2(gg[2], gg[3]);
                    *(u32x2*)rowp = w0; *(u32x2*)(rowp + 1024) = w1;
                }
        } else {
            const int col0 = 256 * (u.pn - 16) + 32 * wc + 8 * fq; const bool zt = (u.pn >= 28) && (u.pn < 32);
#pragma unroll
            for (int ai = 0; ai < 2; ++ai)
#pragma unroll
                for (int m = 0; m < 4; ++m) {
                    bf16_t* rowp = zt ? U + (size_t)(row0 + ai * 128 + m * 16) * UW + URW + col0 : TMP + (size_t)(row0 + ai * 128 + m * 16) * 4352 + col0;
#pragma unroll
                    for (int bj = 0; bj < 2; ++bj) {
                        const f32x4 v0 = acc[ai][bj][m][0], v1 = acc[ai][bj][m][1];
                        u32x4 w; w.x = pk2(v0[0], v0[1]); w.y = pk2(v0[2], v0[3]); w.z = pk2(v1[0], v1[1]); w.w = pk2(v1[2], v1[3]);
                        *(u32x4*)(rowp + bj * 128) = w;
                    }
                }
        }
    }
};

struct EpiOut {
    static constexpr bool PERM = true, AFTER_DRAIN = false;
    float* out; const float* x; const float* stats; const float* eg; const float* eb;
    __device__ __forceinline__ void operator()(const f32x4 (&acc)[2][2][4][2], const pg8::Unit& u, int wr, int wc, int fr, int fq) const {
        const int row0 = u.pm * 256 + wr * 64 + fr, col0 = u.pn * 256 + wc * 32 + 8 * fq;
#pragma unroll
        for (int ai = 0; ai < 2; ++ai)
#pragma unroll
            for (int m = 0; m < 4; ++m) {
                const int row = row0 + ai * 128 + m * 16;
                const float mean = stats[row * 2], rstd = stats[row * 2 + 1];
#pragma unroll
                for (int bj = 0; bj < 2; ++bj)
#pragma unroll
                    for (int n = 0; n < 2; ++n) {
                        const int c = col0 + bj * 128 + 4 * n;
                        const float4 xv = *(const float4*)(x + (size_t)row * D + c), g = *(const float4*)(eg + c), b = *(const float4*)(eb + c);
                        const f32x4 a = acc[ai][bj][m][n];
                        float4 o;
                        o.x = DN_ALPHA * ((xv.x - mean) * rstd * g.x + b.x) + a[0]; o.y = DN_ALPHA * ((xv.y - mean) * rstd * g.y + b.y) + a[1];
                        o.z = DN_ALPHA * ((xv.z - mean) * rstd * g.z + b.z) + a[2]; o.w = DN_ALPHA * ((xv.w - mean) * rstd * g.w + b.w) + a[3];
                        *(float4*)(out + (size_t)row * D + c) = o;
                    }
            }
    }
};

typedef short bf16x8 __attribute__((ext_vector_type(8)));
typedef short s16x4 __attribute__((ext_vector_type(4)));
typedef __bf16 bf16x2_t __attribute__((ext_vector_type(2)));
typedef float f32x2 __attribute__((ext_vector_type(2)));
#define MFMA16(a, b, c) __builtin_amdgcn_mfma_f32_16x16x32_bf16((a), (b), (c), 0, 0, 0)
#define DI __device__ __forceinline__
constexpr int IMG_STRIDE = 144;
constexpr int WG_FRAG = 0;
constexpr int WG_CONST = 16384;
constexpr int WV_BASE = 16384 + 2560;
constexpr int WV_BYTES = 3 * 16 * IMG_STRIDE + 256;
static_assert(WV_BASE + 8 * WV_BYTES <= LDS_BYTES, "scan LDS map");

DI unsigned cvtpk(float lo, float hi) { f32x2 v = {lo, hi}; bf16x2_t b = __builtin_convertvector(v, bf16x2_t); return __builtin_bit_cast(unsigned, b); }
DI bf16x8 mkfrag(unsigned a, unsigned b, unsigned c, unsigned d) { u32x4 w = {a, b, c, d}; return __builtin_bit_cast(bf16x8, w); }
DI bf16x8 frag_f4(f32x4 a, f32x4 b) { return mkfrag(cvtpk(a[0], a[1]), cvtpk(a[2], a[3]), cvtpk(b[0], b[1]), cvtpk(b[2], b[3])); }
DI float bperm(float v, int srclane) { return __int_as_float(__builtin_amdgcn_ds_bpermute(srclane << 2, __float_as_int(v))); }
DI float lo16(unsigned w) { return __uint_as_float(w << 16); }
DI float hi16(unsigned w) { return __uint_as_float(w & 0xffff0000u); }
template <int CTRL> DI float dpp0(float x) { return __int_as_float(__builtin_amdgcn_update_dpp(0, __float_as_int(x), CTRL, 0xf, 0xf, true)); }
template <int CTRL> DI float dpp1(float x) { return __int_as_float(__builtin_amdgcn_update_dpp(0x3f800000, __float_as_int(x), CTRL, 0xf, 0xf, false)); }
DI float fsig(float x) { return __builtin_amdgcn_rcpf(1.f + __expf(-x)); }
DI f32x4 ld4(const bf16_t* ur) { const u32x2 c = *(const u32x2*)ur; return (f32x4){lo16(c.x), hi16(c.x), lo16(c.y), hi16(c.y)}; }

DI void split_frag(f32x4 a, f32x4 b, bf16x8& hi, bf16x8& lo) {
    f32x4 ah, bh;
    unsigned w[4] = {cvtpk(a[0], a[1]), cvtpk(a[2], a[3]), cvtpk(b[0], b[1]), cvtpk(b[2], b[3])};
    ah[0] = lo16(w[0]); ah[1] = hi16(w[0]); ah[2] = lo16(w[1]); ah[3] = hi16(w[1]); bh[0] = lo16(w[2]); bh[1] = hi16(w[2]); bh[2] = lo16(w[3]); bh[3] = hi16(w[3]);
    hi = mkfrag(w[0], w[1], w[2], w[3]); lo = frag_f4(a - ah, b - bh);
}
struct ChunkIn { u32x2 k[4], r[4], v[4]; bf16x8 tl[2], la[2]; };
template <int PASS> DI void chunk_load(ChunkIn& c, const bf16_t* ur, int h, int d, int q) {
#pragma unroll
    for (int n = 0; n < 4; ++n) {
        c.k[n] = *(const u32x2*)(ur + 1024 + h * 64 + 16 * n + 4 * q);
        if (PASS == 2) { c.v[n] = *(const u32x2*)(ur + 2048 + h * 64 + 16 * n + 4 * q); c.r[n] = *(const u32x2*)(ur + h * 64 + 16 * n + 4 * q); }
    }
#pragma unroll
    for (int ks = 0; ks < 2; ++ks) { const bf16_t* ul = ur + 4096 + d * 64 + 32 * ks + 8 * q; c.tl[ks] = *(const bf16x8*)ul; c.la[ks] = *(const bf16x8*)(ul + 128); }
}
DI f32x4 up4(u32x2 c) { return (f32x4){lo16(c.x), hi16(c.x), lo16(c.y), hi16(c.y)}; }
template <int PASS>
__device__ void phase_scan(KP p, int s, unsigned char* ldsg, int wid0) {
    KP_FRESH(p);
    const int wid = wid0;
    int tok0, nseq, T; slab_info(s, tok0, nseq, T);
    const int LS = 256, lgseg = (s == 0) ? 3 : 6, nseg = 1 << lgseg, nblk = (nseq * 32 << lgseg) >> 3;
    const bf16_t* U = (const bf16_t*)(p->ws + WS_U);
    bf16_t* YS = (bf16_t*)(p->ws + WS_YS); float* BON = (float*)(p->ws + WS_BON);
    float* PQ = (float*)(p->ws + WS_PQ); const float* SST = (const float*)(p->ws + WS_SST);
    float* cst = (float*)(ldsg + WG_CONST);
    const int wo = WV_BASE + wid * WV_BYTES;
    for (int ib = blockIdx.x; ib < nblk; ib += gridDim.x) {
        const int item = ib * 8 + wid, g = item & (nseg - 1), chain = item >> lgseg, h = chain & 15, d = (chain >> 4) & 1, b = chain >> 5;
        const int tid = hw_tid(wid0), lane = tid & 63, fr = lane & 15, q = lane >> 4;
        __syncthreads();
        if (tid < 64) {
            const float* mu = p->in[I_MU]; const int c = h * 64 + tid;
            cst[tid] = mu[c]; cst[64 + tid] = mu[1024 + c]; cst[128 + tid] = mu[2048 + c];
            cst[192 + tid] = -1.44269504f * p->in[I_W0][d * 1024 + c]; cst[256 + tid] = -1.44269504f * p->in[I_A0][d * 1024 + c];
            cst[320 + tid] = p->in[I_KK][c]; cst[384 + tid] = p->in[I_KA][c]; cst[448 + tid] = p->in[I_RK][c];
            cst[512 + tid] = mu[4096 + d * 64 + tid]; cst[576 + tid] = mu[4096 + 128 + d * 64 + tid];
        }
        for (int e = tid; e < 1024; e += 512) {
            const int l2 = e & 63, ks = (e >> 6) & 1, mt = (e >> 7) & 3, mat = e >> 9, fr2 = l2 & 15, q2 = l2 >> 4;
            const float* src = (mat ? p->in[I_AUP] : p->in[I_WUP]) + ((size_t)d * 64 + 32 * ks + 8 * q2) * 1024 + h * 64 + 16 * mt + fr2;
            float v8[8];
#pragma unroll
            for (int jj = 0; jj < 8; ++jj) v8[jj] = -1.44269504f * src[(size_t)jj * 1024];
            u32x4 w = {cvtpk(v8[0], v8[1]), cvtpk(v8[2], v8[3]), cvtpk(v8[4], v8[5]), cvtpk(v8[6], v8[7])};
            *(u32x4*)(ldsg + WG_FRAG + e * 16) = w;
        }
        __syncthreads();
        f32x4 St[4][4];
        f32x4 Pa[PASS == 1 ? 4 : 1][PASS == 1 ? 4 : 1];
        int l3 = lane; asm volatile("" : "+v"(l3));
        const float* sstl = SST + (size_t)item * 4096 + l3 * 4;
#pragma unroll
        for (int mt = 0; mt < 4; ++mt)
#pragma unroll
            for (int nt = 0; nt < 4; ++nt) {
                if (PASS == 1) {
#pragma unroll
                    for (int j = 0; j < 4; ++j) { St[mt][nt][j] = 0.f; Pa[PASS == 1 ? mt : 0][PASS == 1 ? nt : 0][j] = (16 * mt + 4 * q + j == 16 * nt + fr) ? 1.f : 0.f; }
                } else {
                    St[mt][nt] = *(const f32x4*)(sstl + (mt * 4 + nt) * 256);
                }
            }
        ChunkIn cin;
        { const int p0 = g * LS, t0 = d ? T - 1 - (p0 + fr) : p0 + fr; chunk_load<PASS>(cin, U + (size_t)(b * T + t0) * UW + URW, h, d, q); }
        for (int ck = 0; ck < LS / 16; ++ck) {
            const int pos0 = g * LS + ck * 16;
            const int lane_c = hw_tid(wid0) & 63;
            const int lane = lane_c, fr = lane_c & 15, q = lane_c >> 4;
            const int ti = d ? T - 1 - (pos0 + fr) : pos0 + fr, row = b * T + ti;
            ChunkIn cc = cin;
            if (PASS == 1) {
#pragma unroll
                for (int n = 0; n < 4; ++n) cc.v[n] = *(const u32x2*)(U + (size_t)row * UW + URW + 2048 + h * 64 + 16 * n + 4 * q);
            }
            {
                const int pn = g * LS + (ck + 1 < LS / 16 ? ck + 1 : ck) * 16, tn = d ? T - 1 - (pn + fr) : pn + fr;
                chunk_load<PASS>(cin, U + (size_t)(b * T + tn) * UW + URW, h, d, q);
            }
            const int lq16 = 16 * q, ll16 = 16 * lane, limg = fr * IMG_STRIDE + 8 * q, ltr = (4 * q + (fr >> 2)) * IMG_STRIDE + 8 * (fr & 3);
            f32x4 ow[4], oa[4];
            {
                const bf16x8 tlf[2] = {cc.tl[0], cc.tl[1]}, laf[2] = {cc.la[0], cc.la[1]};
#pragma unroll
                for (int mt = 0; mt < 4; ++mt) {
                    const bf16x8 w0f = *(const bf16x8*)(ldsg + WG_FRAG + ((0 * 4 + mt) * 2 + 0) * 1024 + ll16), w1f = *(const bf16x8*)(ldsg + WG_FRAG + ((0 * 4 + mt) * 2 + 1) * 1024 + ll16);
                    const bf16x8 a0f = *(const bf16x8*)(ldsg + WG_FRAG + ((1 * 4 + mt) * 2 + 0) * 1024 + ll16), a1f = *(const bf16x8*)(ldsg + WG_FRAG + ((1 * 4 + mt) * 2 + 1) * 1024 + ll16);
                    f32x4 z = {0.f, 0.f, 0.f, 0.f};
                    ow[mt] = MFMA16(w1f, tlf[1], MFMA16(w0f, tlf[0], z));
                    oa[mt] = MFMA16(a1f, laf[1], MFMA16(a0f, laf[0], z));
                }
            }
            f32x4 km[4]; float ss = 0.f;
#pragma unroll
            for (int n = 0; n < 4; ++n) {
                km[n] = up4(cc.k[n]);
                const f32x4 kr = km[n] * *(const f32x4*)(ldsg + WG_CONST + (320 + 16 * n) * 4 + lq16);
                ss += kr[0] * kr[0] + kr[1] * kr[1] + kr[2] * kr[2] + kr[3] * kr[3];
            }
            ss += bperm(ss, lane ^ 16); ss += bperm(ss, lane ^ 32);
            const float kinv = 1.f / fmaxf(sqrtf(ss), 1e-12f);
            u32x2 kapP[4], ktP[4], btP[4], rtP[4]; float bon = 0.f;
#pragma unroll
            for (int n = 0; n < 4; ++n) {
                const int co = 16 * n + 4 * q;
                const f32x4 w0v = *(const f32x4*)(ldsg + WG_CONST + (192 + 16 * n) * 4 + lq16), a0v = *(const f32x4*)(ldsg + WG_CONST + (256 + 16 * n) * 4 + lq16), kkw = *(const f32x4*)(ldsg + WG_CONST + (320 + 16 * n) * 4 + lq16), kav = *(const f32x4*)(ldsg + WG_CONST + (384 + 16 * n) * 4 + lq16);
                f32x4 lw, av, L, gmv;
#pragma unroll
                for (int j = 0; j < 4; ++j) { lw[j] = -0.87503877f * __builtin_amdgcn_rcpf(1.f + __builtin_amdgcn_exp2f(w0v[j] + ow[n][j])); av[j] = __builtin_amdgcn_rcpf(1.f + __builtin_amdgcn_exp2f(a0v[j] + oa[n][j])); }
#pragma unroll
                for (int j = 0; j < 4; ++j) {
                    float x = __builtin_amdgcn_exp2f(lw[j]);
                    x *= dpp1<0x111>(x); x *= dpp1<0x112>(x); x *= dpp1<0x114>(x); x *= dpp1<0x118>(x);
                    L[j] = x; lw[j] = dpp1<0x111>(x); gmv[j] = bperm(x, lane | 15);
                }
                f32x4 kap, kt, bt;
#pragma unroll
                for (int j = 0; j < 4; ++j) {
                    const float eL = L[j], emL = __builtin_amdgcn_rcpf(L[j]), eLm = lw[j];
                    const float kk = km[n][j] * kkw[j] * kinv, kd = km[n][j] * (1.f + (av[j] - 1.f) * kav[j]);
                    kap[j] = kk * eLm; bt[j] = kk * av[j] * emL; kt[j] = kd * emL;
                    if (PASS == 2) { lw[j] = eL; av[j] = kd; }
                }
                if (fr == 0) *(f32x4*)(ldsg + wo + 48 * IMG_STRIDE + 64 * n + lq16) = gmv;
                kapP[n] = (u32x2){cvtpk(kap[0], kap[1]), cvtpk(kap[2], kap[3])};
                ktP[n] = (u32x2){cvtpk(kt[0], kt[1]), cvtpk(kt[2], kt[3])};
                btP[n] = (u32x2){cvtpk(bt[0], bt[1]), cvtpk(bt[2], bt[3])};
                *(u32x2*)(ldsg + wo + 16 * IMG_STRIDE + 32 * n + limg) = ktP[n];
                *(u32x2*)(ldsg + wo + 32 * IMG_STRIDE + 32 * n + limg) = btP[n];
                if (PASS == 2) {
                    const f32x4 rm = up4(cc.r[n]), rk = *(const f32x4*)(ldsg + WG_CONST + (448 + 16 * n) * 4 + lq16);
                    rtP[n] = (u32x2){cvtpk(rm[0] * lw[0], rm[1] * lw[1]), cvtpk(rm[2] * lw[2], rm[3] * lw[3])};
                    bon += rm[0] * av[0] * rk[0] + rm[1] * av[1] * rk[1] + rm[2] * av[2] * rk[2] + rm[3] * av[3] * rk[3];
                }
                *(u32x2*)(ldsg + wo + 32 * n + limg) = cc.v[n];
            }
            if (PASS == 2) {
                bon += bperm(bon, lane ^ 16); bon += bperm(bon, lane ^ 32);
                if (q == 0) BON[((size_t)d * SLAB + row) * 16 + h] = 0.5f * bon;
            }
            const bf16x8 kapF0 = mkfrag(kapP[0].x, kapP[0].y, kapP[1].x, kapP[1].y), kapF1 = mkfrag(kapP[2].x, kapP[2].y, kapP[3].x, kapP[3].y);
            bf16x8 akkA, tA, aryA;
            {
                const bf16x8 ktF0 = mkfrag(ktP[0].x, ktP[0].y, ktP[1].x, ktP[1].y), ktF1 = mkfrag(ktP[2].x, ktP[2].y, ktP[3].x, ktP[3].y);
                const bf16x8 btF0 = mkfrag(btP[0].x, btP[0].y, btP[1].x, btP[1].y), btF1 = mkfrag(btP[2].x, btP[2].y, btP[3].x, btP[3].y);
                const f32x4 z = {0.f, 0.f, 0.f, 0.f};
                f32x4 akk = MFMA16(ktF1, kapF1, MFMA16(ktF0, kapF0, z));
                f32x4 nn = MFMA16(kapF1, btF1, MFMA16(kapF0, btF0, z));
                f32x4 na = MFMA16(btF1, kapF1, MFMA16(btF0, kapF0, z));
                f32x4 idv;
#pragma unroll
                for (int jj = 0; jj < 4; ++jj) {
                    akk[jj] = (4 * q + jj < fr) ? akk[jj] : 0.f; nn[jj] = (fr < 4 * q + jj) ? nn[jj] : 0.f; na[jj] = (4 * q + jj < fr) ? na[jj] : 0.f;
                    idv[jj] = (4 * q + jj == fr) ? 1.f : 0.f;
                }
                akkA = mkfrag(cvtpk(akk[0], akk[1]), cvtpk(akk[2], akk[3]), 0u, 0u);
                if (PASS == 2) {
                    const bf16x8 rtF0 = mkfrag(rtP[0].x, rtP[0].y, rtP[1].x, rtP[1].y), rtF1 = mkfrag(rtP[2].x, rtP[2].y, rtP[3].x, rtP[3].y);
                    f32x4 ark = MFMA16(ktF1, rtF1, MFMA16(ktF0, rtF0, z));
                    f32x4 arb = MFMA16(btF1, rtF1, MFMA16(btF0, rtF0, z));
#pragma unroll
                    for (int jj = 0; jj < 4; ++jj) { ark[jj] = (4 * q + jj <= fr) ? ark[jj] : 0.f; arb[jj] = (4 * q + jj <= fr) ? arb[jj] : 0.f; }
                    aryA = mkfrag(cvtpk(ark[0], ark[1]), cvtpk(ark[2], ark[3]), cvtpk(arb[0], arb[1]), cvtpk(arb[2], arb[3]));
                }
#define TF(x) mkfrag(cvtpk((x)[0], (x)[1]), cvtpk((x)[2], (x)[3]), 0u, 0u)
                const bf16x8 nF = TF(nn), aF = TF(na);
                const f32x4 n2 = MFMA16(aF, nF, z), a2 = MFMA16(nF, aF, z);
                const bf16x8 n2F = TF(n2), a2F = TF(a2);
                const f32x4 n4 = MFMA16(a2F, n2F, z), a4 = MFMA16(n2F, a2F, z);
                const bf16x8 n4F = TF(n4), a4F = TF(a4);
                const f32x4 n8 = MFMA16(a4F, n4F, z);
                const f32x4 t21 = MFMA16(n2F, aF, z);
                f32x4 R = idv - na + a2 - t21;
                R = MFMA16(n4F, TF(R), R);
                R = MFMA16(TF(n8), TF(R), R);
                tA = TF(R);
#undef TF
            }
            s16x4 Vc[4], Kc[4], Bc[4];
            {
                typedef s16x4 __attribute__((address_space(3)))* lp;
#pragma unroll
                for (int t4 = 0; t4 < 4; ++t4) {
                    Vc[t4] = __builtin_amdgcn_ds_read_tr16_b64_v4i16((lp)(ldsg + wo + ltr + 32 * t4));
                    Kc[t4] = __builtin_amdgcn_ds_read_tr16_b64_v4i16((lp)(ldsg + wo + 16 * IMG_STRIDE + ltr + 32 * t4));
                    Bc[t4] = __builtin_amdgcn_ds_read_tr16_b64_v4i16((lp)(ldsg + wo + 32 * IMG_STRIDE + ltr + 32 * t4));
                }
            }
            bf16x8 kbA[4];
#pragma unroll
            for (int mt = 0; mt < 4; ++mt) kbA[mt] = __builtin_shufflevector(Kc[mt], Bc[mt], 0, 1, 2, 3, 4, 5, 6, 7);
#pragma unroll
            for (int nt = 0; nt < 4; ++nt) {
                const f32x4 z = {0.f, 0.f, 0.f, 0.f};
                const bf16x8 stf0 = frag_f4(St[0][nt], St[1][nt]), stf1 = frag_f4(St[2][nt], St[3][nt]);
                const u32x2 vcu = __builtin_bit_cast(u32x2, Vc[nt]);
                f32x4 X = MFMA16(kapF1, stf1, MFMA16(kapF0, stf0, z));
                X = MFMA16(akkA, mkfrag(vcu.x, vcu.y, 0u, 0u), X);
                const f32x4 Uu = MFMA16(tA, mkfrag(cvtpk(X[0], X[1]), cvtpk(X[2], X[3]), 0u, 0u), z);
                const bf16x8 bvu = mkfrag(vcu.x, vcu.y, cvtpk(-Uu[0], -Uu[1]), cvtpk(-Uu[2], -Uu[3]));
                if (PASS == 2) {
                    const bf16x8 rtF0 = mkfrag(rtP[0].x, rtP[0].y, rtP[1].x, rtP[1].y), rtF1 = mkfrag(rtP[2].x, rtP[2].y, rtP[3].x, rtP[3].y);
                    f32x4 Y = MFMA16(rtF1, stf1, MFMA16(rtF0, stf0, z));
                    Y = MFMA16(aryA, bvu, Y);
#pragma unroll
                    for (int jj = 0; jj < 4; ++jj) {
                        const int i = 4 * q + jj, t2 = d ? T - 1 - (pos0 + i) : pos0 + i;
                        YS[((size_t)d * SLAB + b * T + t2) * DR + h * 64 + 16 * nt + fr] = (bf16_t)(cvtpk(Y[jj], 0.f) & 0xffffu);
                    }
                }
#pragma unroll
                for (int mt = 0; mt < 4; ++mt) St[mt][nt] = MFMA16(kbA[mt], bvu, St[mt][nt]) * *(const f32x4*)(ldsg + wo + 48 * IMG_STRIDE + 64 * mt + lq16);
            }
            if (PASS == 1) {
#pragma unroll
                for (int ct = 0; ct < 4; ++ct) {
                    const f32x4 z = {0.f, 0.f, 0.f, 0.f};
                    const bf16x8 pf0 = frag_f4(Pa[0][PASS == 1 ? ct : 0], Pa[PASS == 1 ? 1 : 0][PASS == 1 ? ct : 0]), pf1 = frag_f4(Pa[PASS == 1 ? 2 : 0][PASS == 1 ? ct : 0], Pa[PASS == 1 ? 3 : 0][PASS == 1 ? ct : 0]);
                    const f32x4 X = MFMA16(kapF1, pf1, MFMA16(kapF0, pf0, z));
                    const f32x4 Uu = MFMA16(tA, mkfrag(cvtpk(X[0], X[1]), cvtpk(X[2], X[3]), 0u, 0u), z);
                    const bf16x8 bvu = mkfrag(0u, 0u, cvtpk(-Uu[0], -Uu[1]), cvtpk(-Uu[2], -Uu[3]));
#pragma unroll
                    for (int mt = 0; mt < 4; ++mt) Pa[PASS == 1 ? mt : 0][PASS == 1 ? ct : 0] = MFMA16(kbA[mt], bvu, Pa[PASS == 1 ? mt : 0][PASS == 1 ? ct : 0]) * *(const f32x4*)(ldsg + wo + 48 * IMG_STRIDE + 64 * mt + lq16);
                }
            }
        }
        if (PASS == 1) {
            const int l2 = hw_tid(wid0) & 63, fr2 = l2 & 15, q2 = l2 >> 4;
            unsigned char* pqb = (unsigned char*)(PQ + (size_t)item * 8192);
            float* tl = (float*)(ldsg + wo);
#pragma unroll
            for (int mt = 0; mt < 4; ++mt)
#pragma unroll
                for (int ks = 0; ks < 2; ++ks) {
#pragma unroll
                    for (int e = 0; e < 2; ++e)
#pragma unroll
                        for (int j2 = 0; j2 < 4; ++j2) tl[e * 256 + (4 * q2 + j2) * 16 + fr2] = Pa[PASS == 1 ? mt : 0][PASS == 1 ? 2 * ks + e : 0][j2];
                    __builtin_amdgcn_wave_barrier();
                    const f32x4 pa = *(const f32x4*)(tl + fr2 * 16 + 4 * q2), pb = *(const f32x4*)(tl + 256 + fr2 * 16 + 4 * q2);
                    __builtin_amdgcn_wave_barrier();
                    bf16x8 ah, al; split_frag(pa, pb, ah, al);
                    *(bf16x8*)(pqb + (((mt * 2 + ks) * 2 + 0) * 64 + l2) * 16) = ah;
                }
            float* pq = PQ + (size_t)item * 8192 + 4096 + l2 * 4;
#pragma unroll
            for (int mt = 0; mt < 4; ++mt)
#pragma unroll
                for (int nt = 0; nt < 4; ++nt) *(f32x4*)(pq + (mt * 4 + nt) * 256) = St[mt][nt];
        }
    }
}

constexpr int CR_SLOTS = 10, CR_SLOT_BYTES = 12288, CR_FLAGS = CR_SLOTS * CR_SLOT_BYTES;
__device__ __forceinline__ void phase_combine_ring(KP p, int s, int wid0, unsigned char* ldsg) {
    KP_FRESH(p);
    int tid_ = hw_tid(wid0); asm volatile("" : "+v"(tid_));
    const int lane = tid_ & 63, wid = wid0;
    const int nseg = 64, nsteps = nseg - 1;
    const float* PQ = (const float*)(p->ws + WS_PQ); float* SST = (float*)(p->ws + WS_SST);
    volatile unsigned* flags = (volatile unsigned*)(ldsg + CR_FLAGS);
    __syncthreads();
    if (tid_ < CR_SLOTS) flags[tid_] = 0u;
    __syncthreads();
    if ((int)blockIdx.x >= 128) return;
    const int nt = blockIdx.x & 3, chain = blockIdx.x >> 2;
    if (wid != 0) {
        u32x4 ra[12], rb[12];
#define CR_ISSUE(r, gg) do { const unsigned char* b_ = (const unsigned char*)(PQ + ((size_t)chain * nseg + (gg)) * 8192); \
        _Pragma("unroll") for (int f = 0; f < 8; ++f) (r)[f] = *(const u32x4*)(b_ + ((f * 2 + 0) * 64 + lane) * 16); \
        _Pragma("unroll") for (int mt = 0; mt < 4; ++mt) (r)[8 + mt] = *(const u32x4*)(b_ + 16384 + ((mt * 4 + nt) * 64 + lane) * 16); } while (0)
#define CR_PUT(r, gg) do { const int slot_ = (gg) % CR_SLOTS; const unsigned gen_ = 2u * (unsigned)((gg) / CR_SLOTS); unsigned sp_ = 0;     \
        while (flags[slot_] != gen_ && ++sp_ < (1u << 20)) __builtin_amdgcn_s_sleep(1); \
        _Pragma("unroll") for (int f = 0; f < 12; ++f) *(u32x4*)(ldsg + slot_ * CR_SLOT_BYTES + f * 1024 + lane * 16) = (r)[f]; \
        asm volatile("s_waitcnt lgkmcnt(0)" ::: "memory"); __builtin_amdgcn_wave_barrier(); \
        if (lane == 0) flags[slot_] = gen_ + 1u; } while (0)
        int g = wid - 1;
        if (g < nsteps) CR_ISSUE(ra, g);
        for (; g < nsteps; g += 14) {
            if (g + 7 < nsteps) CR_ISSUE(rb, g + 7);
            CR_PUT(ra, g);
            if (g + 14 < nsteps) CR_ISSUE(ra, g + 14);
            if (g + 7 < nsteps) CR_PUT(rb, g + 7);
        }
#undef CR_ISSUE
#undef CR_PUT
    } else {
        f32x4 S[4];
#pragma unroll
        for (int mt = 0; mt < 4; ++mt) S[mt] = (f32x4){0.f, 0.f, 0.f, 0.f};
        for (int g = 0; g < nseg; ++g) {
            const size_t item = (size_t)chain * nseg + g;
#pragma unroll
            for (int mt = 0; mt < 4; ++mt) *(f32x4*)(SST + item * 4096 + ((mt * 4 + nt) * 64 + lane) * 4) = S[mt];
            if (g == nsteps) break;
            const int slot = g % CR_SLOTS; const unsigned gen = 2u * (unsigned)(g / CR_SLOTS); unsigned sp = 0;
            while (flags[slot] != gen + 1u && ++sp < (1u << 20)) __builtin_amdgcn_s_sleep(1);
            bf16x8 ah[4][2]; f32x4 qv[4];
#pragma unroll
            for (int mt = 0; mt < 4; ++mt) {
                qv[mt] = *(const f32x4*)(ldsg + slot * CR_SLOT_BYTES + (8 + mt) * 1024 + lane * 16);
#pragma unroll
                for (int ks = 0; ks < 2; ++ks) ah[mt][ks] = *(const bf16x8*)(ldsg + slot * CR_SLOT_BYTES + (mt * 2 + ks) * 1024 + lane * 16);
            }
            asm volatile("s_waitcnt lgkmcnt(0)" ::: "memory"); __builtin_amdgcn_wave_barrier();
            if (lane == 0) flags[slot] = gen + 2u;
            bf16x8 bh[2], bl[2];
            split_frag(S[0], S[1], bh[0], bl[0]); split_frag(S[2], S[3], bh[1], bl[1]);
#pragma unroll
            for (int mt = 0; mt < 4; ++mt) {
                f32x4 acc = qv[mt];
#pragma unroll
                for (int ks = 0; ks < 2; ++ks) { acc = MFMA16(ah[mt][ks], bh[ks], acc); acc = MFMA16(ah[mt][ks], bl[ks], acc); }
                S[mt] = acc;
            }
        }
    }
}

__device__ void phase_combine(KP p, int s, int wid0) {
    KP_FRESH(p);
    int tid_ = hw_tid(wid0); asm volatile("" : "+v"(tid_));
    const int lane = tid_ & 63, wid = tid_ >> 6, fr = lane & 15, q = lane >> 4;
    int tok0, nseq, T; slab_info(s, tok0, nseq, T);
    const int lgseg = (s == 0) ? 3 : 6, nseg = 1 << lgseg, nwork = nseq * 32 * 4;
    const float* PQ = (const float*)(p->ws + WS_PQ); float* SST = (float*)(p->ws + WS_SST);
    for (int wk = blockIdx.x * 8 + wid; wk < nwork; wk += gridDim.x * 8) {
        const int nt = wk & 3, chain = wk >> 2;
        f32x4 S[4];
#pragma unroll
        for (int mt = 0; mt < 4; ++mt) S[mt] = (f32x4){0.f, 0.f, 0.f, 0.f};
        struct CStep { bf16x8 ah[4][2]; f32x4 q[4]; };
#define CMB_LOAD(c, gg) do { const int g_ = (gg) < nseg - 1 ? (gg) : nseg - 2; const unsigned char* b_ = (const unsigned char*)(PQ + ((size_t)chain * nseg + g_) * 8192); \
        _Pragma("unroll") for (int mt = 0; mt < 4; ++mt) { (c).q[mt] = *(const f32x4*)(b_ + 16384 + ((mt * 4 + nt) * 64 + lane) * 16); \
            _Pragma("unroll") for (int ks = 0; ks < 2; ++ks) (c).ah[mt][ks] = *(const bf16x8*)(b_ + (((mt * 2 + ks) * 2 + 0) * 64 + lane) * 16); } } while (0)
        CStep c0, c1, c2;
        CMB_LOAD(c0, 0); CMB_LOAD(c1, 1); CMB_LOAD(c2, 2);
        for (int g = 0; g < nseg; ++g) {
            const size_t item = (size_t)chain * nseg + g;
#pragma unroll
            for (int mt = 0; mt < 4; ++mt) *(f32x4*)(SST + item * 4096 + ((mt * 4 + nt) * 64 + lane) * 4) = S[mt];
            if (g == nseg - 1) break;
            const CStep cc = c0; c0 = c1; c1 = c2;
            CMB_LOAD(c2, g + 3);
            bf16x8 bh[2], bl[2];
            split_frag(S[0], S[1], bh[0], bl[0]); split_frag(S[2], S[3], bh[1], bl[1]);
#pragma unroll
            for (int mt = 0; mt < 4; ++mt) {
                f32x4 acc = cc.q[mt];
#pragma unroll
                for (int ks = 0; ks < 2; ++ks) { acc = MFMA16(cc.ah[mt][ks], bh[ks], acc); acc = MFMA16(cc.ah[mt][ks], bl[ks], acc); }
                S[mt] = acc;
            }
        }
#undef CMB_LOAD
    }
}

DI void unpack8(u32x4 w, float (&f)[8]) { f[0] = lo16(w.x); f[1] = hi16(w.x); f[2] = lo16(w.y); f[3] = hi16(w.y); f[4] = lo16(w.z); f[5] = hi16(w.z); f[6] = lo16(w.w); f[7] = hi16(w.w); }
__device__ void phase_shift(KP p, int s, int wid0) {
    KP_FRESH(p);
    int tid_ = hw_tid(wid0); asm volatile("" : "+v"(tid_));
    int tok0, nseq, T; slab_info(s, tok0, nseq, T);
    const bf16_t* TMP = (const bf16_t*)(p->ws + WS_TMP); bf16_t* U = (bf16_t*)(p->ws + WS_U);
    const float* mu = p->in[I_MU];
    const int gt = blockIdx.x * 512 + tid_, nt = gridDim.x * 512;
    for (int unit = gt; unit < 416 * (SLAB / 16); unit += nt) {
        const int cg0 = unit % 416, cg = cg0 < 384 ? cg0 : cg0 + 128, rb = unit / 416, c0 = cg * 8, r0 = rb * 16;
        const bool tanh_cols = (c0 >= 4096) && (c0 < 4096 + 128);
        float m[8];
        { const f32x4 a = *(const f32x4*)(mu + c0), b = *(const f32x4*)(mu + c0 + 4); m[0] = a[0]; m[1] = a[1]; m[2] = a[2]; m[3] = a[3]; m[4] = b[0]; m[5] = b[1]; m[6] = b[2]; m[7] = b[3]; }
        const bf16_t* src = TMP + (size_t)r0 * 4352 + c0; bf16_t* dst = U + (size_t)r0 * UW + URW + c0;
        const int t0 = r0 & (T - 1);
        u32x4 raw[18];
        raw[0] = (t0 > 0) ? *(const u32x4*)(src - 4352) : (u32x4){0u, 0u, 0u, 0u};
#pragma unroll
        for (int i = 0; i < 16; ++i) raw[i + 1] = *(const u32x4*)(src + (size_t)i * 4352);
        raw[17] = (t0 + 16 < T) ? *(const u32x4*)(src + (size_t)16 * 4352) : (u32x4){0u, 0u, 0u, 0u};
        float prev[8], cur[8], nxt[8];
        unpack8(raw[0], prev); unpack8(raw[1], cur);
#pragma unroll
        for (int i = 0; i < 16; ++i) {
            unpack8(raw[i + 2], nxt);
            float o[8];
#pragma unroll
            for (int e = 0; e < 8; ++e) {
                float v = cur[e] + m[e] * (0.5f * (prev[e] + nxt[e]) - cur[e]);
                if (tanh_cols) v = 1.f - 2.f * __builtin_amdgcn_rcpf(1.f + __expf(2.f * v));
                o[e] = v; prev[e] = cur[e]; cur[e] = nxt[e];
            }
            *(u32x4*)(dst + (size_t)i * UW) = (u32x4){cvtpk(o[0], o[1]), cvtpk(o[2], o[3]), cvtpk(o[4], o[5]), cvtpk(o[6], o[7])};
        }
    }
}

__device__ void phase_post(KP p, int s, int wid0) {
    KP_FRESH(p);
    int tid_ = hw_tid(wid0); asm volatile("" : "+v"(tid_));
    const int lane = tid_ & 63, gw = blockIdx.x * 8 + (tid_ >> 6), nw = gridDim.x * 8;
    int tok0, nseq, T; slab_info(s, tok0, nseq, T);
    const bf16_t* U = (const bf16_t*)(p->ws + WS_U);
    const bf16_t* YS = (const bf16_t*)(p->ws + WS_YS); const float* BON = (const float*)(p->ws + WS_BON);
    bf16_t* ymix = (bf16_t*)(p->ws + WS_YMIX);
    for (int unit = gw; unit < (SLAB / 16) * 2; unit += nw) {
        const int half = unit & 1, r0 = (unit >> 1) * 16, c0 = half * 512 + lane * 8, h = c0 >> 6;
        float cw0[8], cw1[8], cw2[8], cbv[8], lg[8], lb[8];
        {
            const float* cw = p->in[I_CW]; const float* cb = p->in[I_CB]; const float* g = p->in[I_LXG]; const float* b = p->in[I_LXB];
#pragma unroll
            for (int e = 0; e < 8; ++e) { cw0[e] = cw[c0 + e]; cw1[e] = cw[1024 + c0 + e]; cw2[e] = cw[2048 + c0 + e]; cbv[e] = cb[c0 + e]; lg[e] = g[c0 + e]; lb[e] = b[c0 + e]; }
        }
        const int t0 = r0 & (T - 1);
        const bf16_t* up = U + (size_t)r0 * UW + c0;
        float pprev[8], pcur[8], pnxt[8], zprev[8], zcur[8], znxt[8], muz[8];
        if (t0 > 0) { unpack8(*(const u32x4*)(up - UW), pprev); unpack8(*(const u32x4*)(up - UW + URW + 3072), zprev); } else { for (int e = 0; e < 8; ++e) { pprev[e] = 0.f; zprev[e] = 0.f; } }
        unpack8(*(const u32x4*)up, pcur); unpack8(*(const u32x4*)(up + URW + 3072), zcur);
        { const float* mu = p->in[I_MU];
#pragma unroll
          for (int e = 0; e < 8; ++e) muz[e] = mu[3072 + c0 + e]; }
        for (int ib = 0; ib < 16; ib += 4) {
            u32x4 rp[4], rg[4], rv[4], rz[4], ry0[4], ry1[4]; float bonv[4];
#pragma unroll
            for (int r = 0; r < 4; ++r) {
                const int i = ib + r, row = r0 + i;
                const bf16_t* ur = up + (size_t)i * UW;
                rp[r] = (t0 + i < T - 1) ? *(const u32x4*)(ur + UW) : (u32x4){0u, 0u, 0u, 0u};
                rz[r] = (t0 + i < T - 1) ? *(const u32x4*)(ur + UW + URW + 3072) : (u32x4){0u, 0u, 0u, 0u};
                rg[r] = *(const u32x4*)(ur + 1024); rv[r] = *(const u32x4*)(ur + URW + 2048);
                ry0[r] = *(const u32x4*)(YS + (size_t)row * DR + c0); ry1[r] = *(const u32x4*)(YS + ((size_t)SLAB + row) * DR + c0);
                bonv[r] = BON[(size_t)row * 16 + h] + BON[((size_t)SLAB + row) * 16 + h];
            }
#pragma unroll
            for (int r = 0; r < 4; ++r) {
                const int row = r0 + ib + r;
                float gg[8], vv[8], zz[8], y[8], y1[8];
                unpack8(rp[r], pnxt); unpack8(rg[r], gg); unpack8(rv[r], vv); unpack8(rz[r], znxt); unpack8(ry0[r], y); unpack8(ry1[r], y1);
#pragma unroll
                for (int e = 0; e < 8; ++e) { zz[e] = zcur[e] + muz[e] * (0.5f * (zprev[e] + znxt[e]) - zcur[e]); zprev[e] = zcur[e]; zcur[e] = znxt[e]; }
                const float bon = bonv[r];
#pragma unroll
                for (int e = 0; e < 8; ++e) y[e] += y1[e];
                float sum = 0.f;
#pragma unroll
                for (int e = 0; e < 8; ++e) sum += y[e];
                sum += shx(sum, lane, 1); sum += shx(sum, lane, 2); sum += shx(sum, lane, 4);
                const float mean = sum * (1.f / 64.f);
                float sq = 0.f;
#pragma unroll
                for (int e = 0; e < 8; ++e) { const float dl = y[e] - mean; sq += dl * dl; }
                sq += shx(sq, lane, 1); sq += shx(sq, lane, 2); sq += shx(sq, lane, 4);
                const float rstd = rsqrtf(sq * (1.f / 64.f) + 64e-5f);
                float oc[8], orw[8];
#pragma unroll
                for (int e = 0; e < 8; ++e) {
                    oc[e] = gg[e] * (cw0[e] * pprev[e] + cw1[e] * pcur[e] + cw2[e] * pnxt[e] + cbv[e]);
                    orw[e] = ((y[e] - mean) * rstd * lg[e] + lb[e] + bon * vv[e]) * (zz[e] * fsig(zz[e]));
                    pprev[e] = pcur[e]; pcur[e] = pnxt[e];
                }
                *(u32x4*)(ymix + (size_t)row * 2048 + c0) = (u32x4){cvtpk(oc[0], oc[1]), cvtpk(oc[2], oc[3]), cvtpk(oc[4], oc[5]), cvtpk(oc[6], oc[7])};
                *(u32x4*)(ymix + (size_t)row * 2048 + 1024 + c0) = (u32x4){cvtpk(orw[0], orw[1]), cvtpk(orw[2], orw[3]), cvtpk(orw[4], orw[5]), cvtpk(orw[6], orw[7])};
            }
        }
    }
}

__device__ void phase_lnout(KP p, int s, int wid0) {
    KP_FRESH(p);
    int tid_ = hw_tid(wid0); asm volatile("" : "+v"(tid_)); int lane = tid_ & 63; const int gw = blockIdx.x * 8 + (tid_ >> 6), nw = gridDim.x * 8;
    float* out = p->out + (size_t)s * SLAB * D;
    const float4* g4 = (const float4*)p->in[I_LG]; const float4* b4 = (const float4*)p->in[I_LB];
    for (int r0 = gw; r0 < SLAB; r0 += 4 * nw) {
        asm volatile("" : "+v"(lane));
        float4 v[4][4];
#pragma unroll
        for (int k = 0; k < 4; ++k)
#pragma unroll
            for (int i = 0; i < 4; ++i) v[k][i] = ((const float4*)(out + (size_t)(r0 + k * nw) * D))[lane + 64 * i];
#pragma unroll
        for (int k = 0; k < 4; ++k) {
            float4* xp = (float4*)(out + (size_t)(r0 + k * nw) * D);
            float sum = 0.f;
#pragma unroll
            for (int i = 0; i < 4; ++i) sum += v[k][i].x + v[k][i].y + v[k][i].z + v[k][i].w;
            const float mean = wsum(sum, lane) * (1.f / 1024.f);
            float sq = 0.f;
#pragma unroll
            for (int i = 0; i < 4; ++i) { float a = v[k][i].x - mean, b = v[k][i].y - mean, c = v[k][i].z - mean, d = v[k][i].w - mean; sq += a * a + b * b + c * c + d * d; }
            const float rstd = rsqrtf(wsum(sq, lane) * (1.f / 1024.f) + 1e-5f);
#pragma unroll
            for (int i = 0; i < 4; ++i) {
                const float4 g = g4[lane + 64 * i], b = b4[lane + 64 * i];
                float4 o; o.x = (v[k][i].x - mean) * rstd * g.x + b.x; o.y = (v[k][i].y - mean) * rstd * g.y + b.y; o.z = (v[k][i].z - mean) * rstd * g.z + b.z; o.w = (v[k][i].w - mean) * rstd * g.w + b.w;
                xp[lane + 64 * i] = o;
            }
        }
    }
}

#define LAS __attribute__((address_space(3)))
#define XB_TMO      128
#define XB_XCNT(j)  (256  + 64 * (j))
#define XB_XSUB(j)  (1280 + 64 * (j))
#define XB_XGEN(j)  (2304 + 64 * (j))
#define XB_TOP      3328
#define XB_TOPGEN   3392
#define XCD_BAR_WORDS 3456
#define XB_SPIN_CAP (1u << 18)

__device__ __forceinline__ unsigned xb_ld(unsigned* p)              { return __hip_atomic_load(p, __ATOMIC_RELAXED, __HIP_MEMORY_SCOPE_AGENT); }
__device__ __forceinline__ unsigned xb_add(unsigned* p, unsigned v) { return __hip_atomic_fetch_add(p, v, __ATOMIC_RELAXED, __HIP_MEMORY_SCOPE_AGENT); }
__device__ __forceinline__ unsigned xb_xcc_id() { return (unsigned)__builtin_amdgcn_s_getreg((3 << 11) | 20) & 0xFu; }
#define XB_SPIN(cond, bar) do { unsigned _sp = 0; while (cond) { __builtin_amdgcn_s_sleep(1); \
    if ((++_sp & 255u) == 0u) { if (xb_ld(&(bar)[XB_TMO])) break; if (_sp > XB_SPIN_CAP) { atomicAdd(&(bar)[XB_TMO], 1u); break; } } } } while (0)

struct XcdBarrier {
    unsigned* bar; unsigned x;
    volatile LAS unsigned* st;
};

__device__ __forceinline__ XcdBarrier xcd_barrier_post(unsigned* bar, volatile LAS unsigned* st) {
    XcdBarrier b; b.bar = bar; b.x = xb_xcc_id(); b.st = st;
    if (threadIdx.x == 0) (void)xb_add(&bar[XB_XCNT(b.x)], 1u);
    return b;
}
__device__ __forceinline__ void xcd_barrier_complete(unsigned* bar, unsigned x, unsigned& nloc, unsigned& nx) {
    const unsigned G = gridDim.x * gridDim.y * gridDim.z;
    unsigned sum, cnt, mine, sp = 0u;
    for (;;) {
        sum = 0u; cnt = 0u; mine = 0u;
#pragma unroll
        for (unsigned j = 0; j < 16; ++j) { const unsigned c = xb_ld(&bar[XB_XCNT(j)]); sum += c; cnt += (c > 0u) ? 1u : 0u; mine = (j == x) ? c : mine; }
        if (sum == G) break;
        __builtin_amdgcn_s_sleep(1);
        if ((++sp & 255u) == 0u) { if (xb_ld(&bar[XB_TMO])) break; if (sp > XB_SPIN_CAP) { atomicAdd(&bar[XB_TMO], 1u); break; } }
    }
    nloc = mine > 0u ? mine : 1u; nx = cnt > 0u ? cnt : 1u;
}

__device__ __forceinline__ void xcd_barrier(const XcdBarrier& b) {
    asm volatile("s_waitcnt vmcnt(0)" ::: "memory");
    __syncthreads();
    if (threadIdx.x == 0) {
        unsigned* bar = b.bar;
        __builtin_amdgcn_s_waitcnt(0);
        unsigned nloc = b.st[0], nx = b.st[1];
        if (nloc == 0u) { xcd_barrier_complete(bar, b.x, nloc, nx); b.st[0] = nloc; b.st[1] = nx; }
        const unsigned old = xb_add(&bar[XB_XSUB(b.x)], 1u);
        const unsigned gen = old / nloc;
        if (old + 1u == (gen + 1u) * nloc) {
            __builtin_amdgcn_fence(__ATOMIC_RELEASE, "agent");
            asm volatile("s_waitcnt vmcnt(0)" ::: "memory");
            const unsigned og = xb_add(&bar[XB_TOP], 1u);
            const unsigned tg = og / nx;
            if (og + 1u == (tg + 1u) * nx) xb_add(&bar[XB_TOPGEN], 1u);
            else XB_SPIN(xb_ld(&bar[XB_TOPGEN]) == tg, bar);
            __builtin_amdgcn_fence(__ATOMIC_ACQUIRE, "agent");
            xb_add(&bar[XB_XGEN(b.x)], 1u);
            asm volatile("s_waitcnt vmcnt(0)" ::: "memory");
        } else {
            XB_SPIN(xb_ld(&bar[XB_XGEN(b.x)]) == gen, bar);
            __builtin_amdgcn_fence(__ATOMIC_ACQUIRE, "agent");
            asm volatile("s_waitcnt vmcnt(0)" ::: "memory");
        }
    }
    __syncthreads();
}

#ifndef REP_SHIFT
#define REP_SHIFT 1
#endif
#ifndef REP_G2
#define REP_G2 1
#endif
#ifndef REP_SCAN
#define REP_SCAN 1
#endif
#ifndef REP_POST
#define REP_POST 1
#endif
#ifndef REP_G1
#define REP_G1 1
#endif
#define GBAR() xcd_barrier(bar)
__global__ void __launch_bounds__(512, 2) fwd_megakernel(Params p_unused) {
    extern __shared__ __attribute__((aligned(16))) unsigned char lds_raw[];
    PG8_LAS unsigned char* lds = (PG8_LAS unsigned char*)lds_raw;
    cg::grid_group grid = cg::this_grid();
    KP p = (KP)__builtin_amdgcn_kernarg_segment_ptr();
    if (threadIdx.x < 2) ((volatile LAS unsigned*)(lds + LDS_BYTES - 64))[threadIdx.x] = 0u;
    __syncthreads();
    XcdBarrier bar = xcd_barrier_post((unsigned*)(((const Params __attribute__((address_space(4)))*)__builtin_amdgcn_kernarg_segment_ptr())->ws + WS_BAR), (volatile LAS unsigned*)(lds + LDS_BYTES - 64));
    const int wid0 = __builtin_amdgcn_readfirstlane((int)threadIdx.x >> 6);
    phase_weights(p, wid0);
    for (int s = -1; s < 3; ++s) {
        if (s == 0) grid.sync();
        if (s >= 0)
        for (int rep = 0; rep < REP_G1; ++rep) {
            if (rep) GBAR();
            KP_FRESH(p);
            pg8::Gemm g; g.A = xn_buf(p, s); g.Bt = (const bf16_t*)(p->ws + WS_WIN); g.M = SLAB; g.N = NIN; g.K = D;
            pg8::StaticOrder S; S.init(g.M, g.N, gridDim.x, blockIdx.x);
            EpiU E; E.U = (bf16_t*)(p->ws + WS_U); E.TMP = (bf16_t*)(p->ws + WS_TMP);
            pg8::gemm_phase<EpiU, pg8::StaticOrder, true, true>(lds, g, S, E, wid0);
        }
        {
            const int wg0 = (s >= 0 && gridDim.x > 64) ? 64 : 0;
            if (s < 2 && (int)blockIdx.x >= wg0) phase_ln(p, s + 1, wid0, wg0);
        }
        if (s < 0) continue;
        GBAR();
        for (int rep = 0; rep < REP_SHIFT; ++rep) {
        phase_shift(p, s, wid0);
        GBAR();
        }
        for (int rep = 0; rep < REP_SCAN; ++rep) {
        phase_scan<1>(p, s, lds_raw, wid0);
        GBAR();
        if (s > 0 && gridDim.x >= 128) phase_combine_ring(p, s, wid0, lds_raw); else phase_combine(p, s, wid0);
        GBAR();
        phase_scan<2>(p, s, lds_raw, wid0);
        GBAR();
        }
        for (int rep = 0; rep < REP_POST; ++rep) {
        phase_post(p, s, wid0);
        GBAR();
        }
        for (int rep = 0; rep < REP_G2; ++rep) {
            if (rep) GBAR();
            KP_FRESH(p);
            pg8::Gemm g; g.A = (const bf16_t*)(p->ws + WS_YMIX); g.Bt = (const bf16_t*)(p->ws + WS_WOUT); g.M = SLAB; g.N = D; g.K = 2048;
            pg8::StaticOrder S; S.init(g.M, g.N, gridDim.x, blockIdx.x);
            EpiOut E; E.out = p->out + (size_t)s * SLAB * D; E.x = slab_x(p, s); E.stats = (const float*)(p->ws + WS_STATS) + (size_t)s * SLAB * 2; E.eg = p->in[I_EG]; E.eb = p->in[I_EB];
            pg8::gemm_phase<EpiOut, pg8::StaticOrder, true, true>(lds, g, S, E, wid0);
        }
        GBAR();
        phase_lnout(p, s, wid0);
    }
}

extern "C" void kernel_launch(void* const* d_in, const int* in_sizes, int n_in, void* d_out, int out_size, void* d_ws, size_t ws_size, hipStream_t stream) {
    static int grid_blocks = 0;
    if (!grid_blocks) {
        int dev = 0, cus = 0, per_cu = 0;
        hipGetDevice(&dev);
        hipDeviceGetAttribute(&cus, hipDeviceAttributeMultiprocessorCount, dev);
        hipFuncSetAttribute((const void*)fwd_megakernel, hipFuncAttributeMaxDynamicSharedMemorySize, LDS_BYTES);
        hipOccupancyMaxActiveBlocksPerMultiprocessor(&per_cu, (const void*)fwd_megakernel, 512, LDS_BYTES);
        if (per_cu < 1) per_cu = 1;
        if (per_cu > 1) per_cu = 1;
        grid_blocks = cus * per_cu;
    }
    Params p{};
    for (int i = 0; i < 20; ++i) p.in[i] = (const float*)d_in[i];
    p.out = (float*)d_out; p.ws = (unsigned char*)d_ws;
    hipMemsetAsync((unsigned char*)d_ws + WS_BAR, 0, 16384, stream);
    void* args[] = {&p};
    hipError_t e = hipLaunchCooperativeKernel((const void*)fwd_megakernel, dim3(grid_blocks), dim3(512), args, LDS_BYTES, stream);
    if (e != hipSuccess) fprintf(stderr, "cooperative launch failed: %s (grid %d)\n", hipGetErrorString(e), grid_blocks);
}
```

```cpp
#include <hip/hip_runtime.h>
#include <hip/hip_cooperative_groups.h>
#include <cstdio>
#include <cstdint>
namespace cg = cooperative_groups;
namespace pg8 {
#define PG8_LAS __attribute__((address_space(3)))
typedef unsigned short bf16_t;
typedef short bf16x8 __attribute__((ext_vector_type(8)));
typedef float f32x4 __attribute__((ext_vector_type(4)));
typedef unsigned u32x4 __attribute__((ext_vector_type(4)));
constexpr int BM = 256, BK = 64, HALF = 128, HTB = HALF * BK * 2  , STAGE_BYTES = 8 * HTB, NXCD = 8, WGM = 8;

__host__ __device__ __forceinline__ int lds_byte(int r, int c) { const int st = (r >> 4) * 2 + (c >> 5), rr = r & 15, cc = c & 31, ob = rr * 64 + cc * 2; return st * 1024 + (ob ^ (((ob >> 9) & 1) << 5)); }
__host__ __device__ __forceinline__ void stage_rc(int b, int& R, int& C) { const int st = b / 1024, sb = b % 1024, swz = sb ^ (((sb >> 9) & 1) << 5); R = (st >> 1) * 16 + swz / 64; C = (st & 1) * 32 + (swz % 64) / 2; }
__host__ __device__ __forceinline__ int perm32(int rho) { const int n = rho >> 4, i = rho & 15; return 8 * (i >> 2) + 4 * n + (i & 3); }

struct Unit { int pm, pn; };
struct Gemm { const bf16_t* A; const bf16_t* Bt; int M, N, K; };

struct StaticOrder {
    int nM, nN, nwg, G, c;
    __host__ __device__ void init(int M, int N, int G_, int c_) { nM = M / BM; nN = N / BM; nwg = nM * nN; G = G_; c = c_; }
    __host__ __device__ bool next(int i, Unit& u) const {
        const long L = (long)i * G + c; if (L >= nwg) return false;
        int wgid = (int)L; { const int q = nwg / NXCD, r = nwg % NXCD, xcd = wgid % NXCD, off = wgid / NXCD; wgid = (xcd < r ? xcd * (q + 1) : r * (q + 1) + (xcd - r) * q) + off; }
        const int nig = WGM * nN, gid = wgid / nig, fm = gid * WGM, gsz = (nM - fm) < WGM ? (nM - fm) : WGM;
        u.pm = fm + ((wgid % nig) % gsz); u.pn = (wgid % nig) / gsz; return true;
    }
    __device__ __forceinline__ void a_ready(const Unit&) const {}
    __device__ __forceinline__ void done(const Unit&) const {}
};

template <class Epi, class Sched, bool ALIGN_EPI = false, bool SP2 = false>
__device__ __forceinline__ void gemm_phase(PG8_LAS unsigned char* lds, const Gemm g, const Sched& S, const Epi& E, int wid0) {
    int tid_; asm volatile("v_mbcnt_lo_u32_b32 %0, -1, 0\n\tv_mbcnt_hi_u32_b32 %0, -1, %0" : "=v"(tid_)); tid_ += wid0 * 64; const int tid = tid_, wid = __builtin_amdgcn_readfirstlane(tid >> 6), lane = tid & 63, wr = wid >> 2, wc = wid & 3, fr = lane & 15, fq = lane >> 4;
    const int K = g.K, nt = K / BK;
    unsigned voffA[2], voffB[2];
#pragma unroll
    for (int i = 0; i < 2; ++i) { int R, C; stage_rc(tid * 16 + i * 8192, R, C); const int Rb = Epi::PERM ? ((R & ~31) + perm32(R & 31)) : R;
        voffA[i] = (unsigned)(R * K + C) * 2u; voffB[i] = (unsigned)(Rb * K + C) * 2u; }
    const size_t kstep = (size_t)(BK * 2);
    const size_t hstep = (size_t)HALF * K * 2;
    const size_t tstep = 2 * hstep;
    const unsigned ldsw = (unsigned)wid * 1024u;
    const int aoff = lds_byte(wr * 64 + fr, fq * 8), boff = lds_byte(wc * 32 + fr, fq * 8);
#define PG8_SA(b, h) (((b) * 2 + (h)) * HTB)
#define PG8_SB(b, h) ((4 + (b) * 2 + (h)) * HTB)
#define PG8_STAGE(bufoff, gbase, voff) do { _Pragma("unroll") for (int _i = 0; _i < 2; ++_i) \
        __builtin_amdgcn_global_load_lds((const unsigned*)((const char*)(gbase) + (voff)[_i]), (PG8_LAS unsigned*)(lds + (bufoff) + ldsw + _i * 8192), 16, 0, 0); } while (0)
#define PG8_LDA(dst, b, h) do { _Pragma("unroll") for (int m = 0; m < 4; ++m) _Pragma("unroll") for (int k = 0; k < 2; ++k) dst[m][k] = *(const PG8_LAS bf16x8*)(lds + PG8_SA(b, h) + aoff + m * 2048 + k * 1024); } while (0)
#define PG8_LDB(dst, b, h) do { _Pragma("unroll") for (int n = 0; n < 2; ++n) _Pragma("unroll") for (int k = 0; k < 2; ++k) dst[n][k] = *(const PG8_LAS bf16x8*)(lds + PG8_SB(b, h) + boff + n * 2048 + k * 1024); } while (0)
#define PG8_MMA(ai, bj, At, Bt) do { __builtin_amdgcn_s_setprio(1); _Pragma("unroll") for (int m = 0; m < 4; ++m) _Pragma("unroll") for (int n = 0; n < 2; ++n) _Pragma("unroll") for (int k = 0; k < 2; ++k) \
        acc[ai][bj][m][n] = __builtin_amdgcn_mfma_f32_16x16x32_bf16(Bt[n][k], At[m][k], acc[ai][bj][m][n], 0, 0, 0); __builtin_amdgcn_s_setprio(0); } while (0)
#define PG8_WAIT_V(n) asm volatile("s_waitcnt vmcnt(" #n ")" ::: "memory")
#define PG8_WAIT_L(n) asm volatile("s_waitcnt lgkmcnt(" #n ")" ::: "memory")
#define PG8_BAR __builtin_amdgcn_s_barrier()
#define PG8_SCHED __builtin_amdgcn_sched_barrier(0)
    Unit cur, nxt; int ui = 0;
    if (!S.next(0, cur)) return;
    f32x4 acc[2][2][4][2];
#pragma unroll
    for (int a = 0; a < 2; ++a)
#pragma unroll
        for (int b = 0; b < 2; ++b)
#pragma unroll
            for (int m = 0; m < 4; ++m)
#pragma unroll
                for (int n = 0; n < 2; ++n) acc[a][b][m][n] = (f32x4){0.f, 0.f, 0.f, 0.f};
    bf16x8 At[4][2], B0[2][2], B1[2][2];
    const char* cA = (const char*)g.A + (size_t)cur.pm * tstep; const char* cB = (const char*)g.Bt + (size_t)cur.pn * tstep;
    S.a_ready(cur);
    if constexpr (SP2) {
        PG8_STAGE(PG8_SB(0, 0), cB, voffB); PG8_STAGE(PG8_SB(0, 1), cB + hstep, voffB); PG8_STAGE(PG8_SA(0, 0), cA, voffA); PG8_STAGE(PG8_SA(0, 1), cA + hstep, voffA);
        if (wr == 1) PG8_BAR;
        PG8_WAIT_V(2); PG8_BAR;
        PG8_STAGE(PG8_SB(1, 0), cB + kstep, voffB); PG8_STAGE(PG8_SA(1, 0), cA + kstep, voffA); PG8_STAGE(PG8_SB(1, 1), cB + hstep + kstep, voffB);
        PG8_WAIT_V(6); PG8_BAR;
    } else {
        PG8_STAGE(PG8_SB(0, 0), cB, voffB); PG8_STAGE(PG8_SA(0, 0), cA, voffA); PG8_STAGE(PG8_SB(0, 1), cB + hstep, voffB); PG8_STAGE(PG8_SA(0, 1), cA + hstep, voffA);
        if (wr == 1) PG8_BAR;
        PG8_WAIT_V(4); PG8_BAR;
        PG8_STAGE(PG8_SB(1, 0), cB + kstep, voffB); PG8_STAGE(PG8_SA(1, 0), cA + kstep, voffA); PG8_STAGE(PG8_SB(1, 1), cB + hstep + kstep, voffB);
        PG8_WAIT_V(6); PG8_BAR;
    }
    for (;;) {
        const bool has_next = S.next(ui + 1, nxt);
        const char* nA = has_next ? (const char*)g.A + (size_t)nxt.pm * tstep : cA; const char* nB = has_next ? (const char*)g.Bt + (size_t)nxt.pn * tstep : cB;
        for (int t = 0; t < nt; t += 2) {
            const bool last = (t == nt - 2);
            const char* a1 = cA + (size_t)(t + 1) * kstep;
            const char* a2 = last ? nA : cA + (size_t)(t + 2) * kstep; const char* b2 = last ? nB : cB + (size_t)(t + 2) * kstep;
            const char* a3 = a2 + kstep; const char* b3 = b2 + kstep;
            if (last && has_next) S.a_ready(nxt);
            if constexpr (SP2) {
            PG8_LDB(B0, 0, 0); PG8_LDB(B1, 0, 1); PG8_SCHED; PG8_LDA(At, 0, 0); PG8_STAGE(PG8_SA(1, 1), a1 + hstep, voffA);
            PG8_WAIT_V(8); PG8_WAIT_L(0); PG8_BAR; PG8_MMA(0, 0, At, B0); PG8_MMA(0, 1, At, B1); PG8_BAR; PG8_SCHED;
            PG8_LDA(At, 0, 1); PG8_STAGE(PG8_SB(0, 0), b2, voffB); PG8_STAGE(PG8_SB(0, 1), b2 + hstep, voffB); PG8_STAGE(PG8_SA(0, 0), a2, voffA);
            PG8_WAIT_V(8); PG8_WAIT_L(0); PG8_BAR; PG8_MMA(1, 0, At, B0); PG8_MMA(1, 1, At, B1); PG8_BAR; PG8_SCHED;
            PG8_LDB(B0, 1, 0); PG8_LDB(B1, 1, 1); PG8_SCHED; PG8_LDA(At, 1, 0); PG8_STAGE(PG8_SA(0, 1), a2 + hstep, voffA);
            PG8_WAIT_V(8); PG8_WAIT_L(0); PG8_BAR; PG8_MMA(0, 0, At, B0); PG8_MMA(0, 1, At, B1); PG8_BAR; PG8_SCHED;
            PG8_LDA(At, 1, 1); PG8_STAGE(PG8_SB(1, 0), b3, voffB); PG8_STAGE(PG8_SB(1, 1), b3 + hstep, voffB); PG8_STAGE(PG8_SA(1, 0), a3, voffA);
            PG8_WAIT_V(8); PG8_WAIT_L(0); PG8_BAR; PG8_MMA(1, 0, At, B0); PG8_MMA(1, 1, At, B1); PG8_BAR; PG8_SCHED;
            } else {
            PG8_LDB(B0, 0, 0); PG8_SCHED; PG8_LDA(At, 0, 0); PG8_STAGE(PG8_SA(1, 1), a1 + hstep, voffA);
            PG8_WAIT_L(8); PG8_BAR; PG8_WAIT_L(0); PG8_MMA(0, 0, At, B0); PG8_BAR; PG8_SCHED;
            PG8_LDB(B1, 0, 1); PG8_STAGE(PG8_SB(0, 0), b2, voffB);
            PG8_BAR; PG8_WAIT_L(0); PG8_MMA(0, 1, At, B1); PG8_BAR;
            PG8_LDA(At, 0, 1); PG8_STAGE(PG8_SA(0, 0), a2, voffA);
            PG8_BAR; PG8_WAIT_L(0); PG8_MMA(1, 0, At, B0); PG8_BAR; PG8_SCHED;
            PG8_STAGE(PG8_SB(0, 1), b2 + hstep, voffB);
            PG8_WAIT_V(6); PG8_BAR; PG8_MMA(1, 1, At, B1); PG8_BAR;
            PG8_LDB(B0, 1, 0); PG8_SCHED; PG8_LDA(At, 1, 0); PG8_STAGE(PG8_SA(0, 1), a2 + hstep, voffA);
            PG8_WAIT_L(8); PG8_BAR; PG8_WAIT_L(0); PG8_MMA(0, 0, At, B0); PG8_BAR; PG8_SCHED;
            PG8_LDB(B1, 1, 1); PG8_STAGE(PG8_SB(1, 0), b3, voffB);
            PG8_BAR; PG8_WAIT_L(0); PG8_MMA(0, 1, At, B1); PG8_BAR;
            PG8_LDA(At, 1, 1); PG8_STAGE(PG8_SA(1, 0), a3, voffA);
            PG8_BAR; PG8_WAIT_L(0); PG8_MMA(1, 0, At, B0); PG8_BAR; PG8_SCHED;
            PG8_STAGE(PG8_SB(1, 1), b3 + hstep, voffB);
            PG8_WAIT_V(6); PG8_BAR; PG8_MMA(1, 1, At, B1); PG8_BAR;
            }
        }
        if constexpr (ALIGN_EPI) { if (wr == 0) PG8_BAR; }
        if constexpr (!Epi::AFTER_DRAIN) { E(acc, cur, wr, wc, fr, fq); S.done(cur); }
        if (!has_next) break;
#pragma unroll
        for (int a = 0; a < 2; ++a)
#pragma unroll
            for (int b = 0; b < 2; ++b)
#pragma unroll
                for (int m = 0; m < 4; ++m)
#pragma unroll
                    for (int n = 0; n < 2; ++n) acc[a][b][m][n] = (f32x4){0.f, 0.f, 0.f, 0.f};
        cur = nxt; cA = nA; cB = nB; ++ui;
        if constexpr (ALIGN_EPI) { if (wr == 1) PG8_BAR; }
    }
    PG8_WAIT_V(0);
    if constexpr (!ALIGN_EPI) { if (wr == 0) PG8_BAR; }
    PG8_BAR;
    if constexpr (Epi::AFTER_DRAIN) { E.fused(acc, cur, wr, wc, fr, fq, lds, wid, lane); S.done(cur); }
#undef PG8_SA
#undef PG8_SB
#undef PG8_STAGE
#undef PG8_LDA
#undef PG8_LDB
#undef PG8_MMA
#undef PG8_WAIT_V
#undef PG8_WAIT_L
#undef PG8_BAR
#undef PG8_SCHED
}
}

typedef unsigned short bf16_t;
typedef float f32x4 __attribute__((ext_vector_type(4)));
typedef unsigned u32x4 __attribute__((ext_vector_type(4)));
typedef unsigned u32x2 __attribute__((ext_vector_type(2)));

constexpr int D = 1024, NIN = 8448, DR = 1024, UW = 6400  , URW = 2048  ;
constexpr int SLAB = 16384, NTOK = 49152;
constexpr float DN_ALPHA = 1.189207115002721f;
constexpr size_t WS_WIN = 0;
constexpr size_t WS_WOUT = WS_WIN + (size_t)NIN * D * 2;
constexpr size_t WS_STATS = WS_WOUT + (size_t)D * 2048 * 2;
constexpr size_t WS_XN = WS_STATS + (size_t)NTOK * 2 * 4;
constexpr size_t WS_U = WS_XN + (size_t)SLAB * D * 2;
constexpr size_t WS_YS = WS_U + (size_t)SLAB * UW * 2;
constexpr size_t WS_BON = WS_YS + (size_t)2 * SLAB * DR * 4;
constexpr size_t WS_YMIX = WS_BON + (size_t)2 * SLAB * 16 * 4;
constexpr size_t WS_TMP = WS_YS;
constexpr size_t WS_PQ = WS_YMIX;
constexpr size_t WS_SST = WS_YMIX + (size_t)SLAB * 2048 * 2;
constexpr size_t WS_BAR = WS_SST + (size_t)2048 * 4096 * 4;
constexpr size_t WS_END = WS_BAR + 16384;
static_assert(WS_END <= (size_t)512 * 1024 * 1024, "ws map");
constexpr int LDS_BYTES = 147456;

struct Params { const float* in[20]; float* out; unsigned char* ws; };
typedef const Params __attribute__((address_space(4)))* KP;
#define KP_FRESH(p) asm volatile("" : "+s"(p))
__device__ __forceinline__ int hw_tid(int wid0) { int l; asm volatile("v_mbcnt_lo_u32_b32 %0, -1, 0\n\tv_mbcnt_hi_u32_b32 %0, -1, %0" : "=v"(l)); return wid0 * 64 + l; }
enum { I_XP = 0, I_XS, I_EG, I_EB, I_WIN, I_CW, I_CB, I_MU, I_W0, I_WUP, I_A0, I_AUP, I_KK, I_KA, I_RK, I_LXG, I_LXB, I_WOUT, I_LG, I_LB };

__device__ __forceinline__ float bf2f(unsigned short h) { return __uint_as_float((unsigned)h << 16); }
__device__ __forceinline__ unsigned f2bf(float f) { unsigned u = __float_as_uint(f); return (u + 0x7fffu + ((u >> 16) & 1u)) >> 16; }
__device__ __forceinline__ unsigned pk2(float lo, float hi) { return f2bf(lo) | (f2bf(hi) << 16); }
typedef __bf16 bf16x2e_t __attribute__((ext_vector_type(2)));
typedef float f32x2e __attribute__((ext_vector_type(2)));
__device__ __forceinline__ unsigned cvtpk_(float lo, float hi) { f32x2e v = {lo, hi}; bf16x2e_t b = __builtin_convertvector(v, bf16x2e_t); return __builtin_bit_cast(unsigned, b); }
__device__ __forceinline__ float shx(float v, int lane, int o) { return __int_as_float(__builtin_amdgcn_ds_bpermute((lane ^ o) << 2, __float_as_int(v))); }
__device__ __forceinline__ float wsum(float v, int lane) {
#pragma unroll
    for (int o = 32; o; o >>= 1) v += shx(v, lane, o);
    return v;
}
__device__ __forceinline__ float sigmoidf_(float x) { return 1.f / (1.f + __expf(-x)); }
__device__ __forceinline__ float siluf_(float x) { return x * sigmoidf_(x); }
__device__ __forceinline__ float rl(float v, int l) { return __int_as_float(__builtin_amdgcn_readlane(__float_as_int(v), l)); }

__device__ __forceinline__ void slab_info(int s, int& tok0, int& nseq, int& T) { if (s == 0) { tok0 = 0; nseq = 8; T = 2048; } else { tok0 = SLAB * s; nseq = 1; T = 16384; } }
__device__ __forceinline__ const float* slab_x(KP p, int s) { return s == 0 ? p->in[I_XP] : p->in[I_XS] + (size_t)(s - 1) * SLAB * D; }

__device__ __forceinline__ int orig_col(int jv) {
    if (jv >= 4096) return jv;
    const int pn = jv >> 8, bj = (jv >> 7) & 1, wc = (jv >> 5) & 3, fq = (jv >> 3) & 3, n = (jv >> 2) & 1, j = jv & 3;
    return (2 * bj + n) * 1024 + 64 * pn + 16 * wc + 4 * fq + j;
}

__device__ void phase_weights(KP p, int wid0) {
    KP_FRESH(p);
    int gt = blockIdx.x * 512 + hw_tid(wid0); asm volatile("" : "+v"(gt)); const int nt = gridDim.x * 512;
    bf16_t* win = (bf16_t*)(p->ws + WS_WIN); bf16_t* wout = (bf16_t*)(p->ws + WS_WOUT);
    const float* w_in = p->in[I_WIN]; const float* w_out = p->in[I_WOUT];
    for (int idx = gt; idx < NIN * 128; idx += nt) {
        const int jv = idx % NIN, kg = idx / NIN, oc = orig_col(jv);
        float v[8];
#pragma unroll
        for (int i = 0; i < 8; ++i) v[i] = w_in[(size_t)(kg * 8 + i) * NIN + oc];
        u32x4 w; w.x = pk2(v[0], v[1]); w.y = pk2(v[2], v[3]); w.z = pk2(v[4], v[5]); w.w = pk2(v[6], v[7]);
        *(u32x4*)(win + (size_t)jv * D + kg * 8) = w;
    }
    for (int idx = gt; idx < D * 256; idx += nt) {
        const int n = idx % D, kg = idx / D;
        float v[8];
#pragma unroll
        for (int i = 0; i < 8; ++i) v[i] = w_out[(size_t)(kg * 8 + i) * D + n];
        u32x4 w; w.x = pk2(v[0], v[1]); w.y = pk2(v[2], v[3]); w.z = pk2(v[4], v[5]); w.w = pk2(v[6], v[7]);
        *(u32x4*)(wout + (size_t)n * 2048 + kg * 8) = w;
    }
}

__device__ __forceinline__ bf16_t* xn_buf(KP p, int s) { return s == 1 ? (bf16_t*)(p->out + (size_t)2 * SLAB * D) : (bf16_t*)(p->ws + WS_XN); }
__device__ __forceinline__ void phase_ln(KP p, int s, int wid0, int wg0) {
    KP_FRESH(p);
    int tid_ = hw_tid(wid0); asm volatile("" : "+v"(tid_)); int lane = tid_ & 63; const int gw = ((int)blockIdx.x - wg0) * 8 + (tid_ >> 6), nw = ((int)gridDim.x - wg0) * 8;
    const float* x = slab_x(p, s); bf16_t* xn = xn_buf(p, s); float* stats = (float*)(p->ws + WS_STATS) + (size_t)s * SLAB * 2;
    const float4* g4 = (const float4*)p->in[I_EG]; const float4* b4 = (const float4*)p->in[I_EB];
    for (int gi = gw; gi < SLAB / 4; gi += nw) {
        const int r0 = gi * 4;
        asm volatile("" : "+v"(lane));
        float4 v[4][4];
#pragma unroll
        for (int k = 0; k < 4; ++k)
#pragma unroll
            for (int i = 0; i < 4; ++i) v[k][i] = ((const float4*)(x + (size_t)(r0 + k) * D))[lane + 64 * i];
#pragma unroll
        for (int k = 0; k < 4; ++k) {
            const int r = r0 + k;
            float sum = 0.f;
#pragma unroll
            for (int i = 0; i < 4; ++i) sum += v[k][i].x + v[k][i].y + v[k][i].z + v[k][i].w;
            const float mean = wsum(sum, lane) * (1.f / 1024.f);
            float sq = 0.f;
#pragma unroll
            for (int i = 0; i < 4; ++i) { float a = v[k][i].x - mean, b = v[k][i].y - mean, c = v[k][i].z - mean, d = v[k][i].w - mean; sq += a * a + b * b + c * c + d * d; }
            const float rstd = rsqrtf(wsum(sq, lane) * (1.f / 1024.f) + 1e-5f);
            if (lane == 0) { stats[r * 2] = mean; stats[r * 2 + 1] = rstd; }
#pragma unroll
            for (int i = 0; i < 4; ++i) {
                const float4 g = g4[lane + 64 * i], b = b4[lane + 64 * i];
                u32x2 w; w.x = cvtpk_((v[k][i].x - mean) * rstd * g.x + b.x, (v[k][i].y - mean) * rstd * g.y + b.y);
                w.y = cvtpk_((v[k][i].z - mean) * rstd * g.z + b.z, (v[k][i].w - mean) * rstd * g.w + b.w);
                *(u32x2*)(xn + (size_t)r * D + (lane + 64 * i) * 4) = w;
            }
        }
    }
}

struct EpiU {
    static constexpr bool PERM = true, AFTER_DRAIN = false;
    bf16_t* U; bf16_t* TMP;
    __device__ __forceinline__ void operator()(const f32x4 (&acc)[2][2][4][2], const pg8::Unit& u, int wr, int wc, int fr, int fq) const {
        const int row0 = u.pm * 256 + wr * 64 + fr;
        if (u.pn < 16) {
            const int ch0 = 64 * u.pn + 16 * wc + 4 * fq;
#pragma unroll
            for (int ai = 0; ai < 2; ++ai)
#pragma unroll
                for (int m = 0; m < 4; ++m) {
                    bf16_t* rowp = U + (size_t)(row0 + ai * 128 + m * 16) * UW + ch0;
                    const f32x4 h = acc[ai][0][m][0], B = acc[ai][0][m][1], C = acc[ai][1][m][0], z = acc[ai][1][m][1];
                    float pp[4], gg[4];
#pragma unroll
                    for (int j = 0; j < 4; ++j) { pp[j] = C[j] * h[j]; gg[j] = B[j] * siluf_(z[j]); }
                    u32x2 w0; w0.x = pk2(pp[0], pp[1]); w0.y = pk2(pp[2], pp[3]);
                    u32x2 w1; w1.x = pk2(gg[0], gg[1]); w1.y = pk2(gg[2], gg[3]);
                    *(u32x2*)rowp = w0; *(u32x2*)(rowp + 1024) = w1;
                }
        } else {
            const int col0 = 256 * (u.pn - 16) + 32 * wc + 8 * fq; const bool zt = (u.pn >= 28) && (u.pn < 32);
#pragma unroll
            for (int ai = 0; ai < 2; ++ai)
#pragma unroll
                for (int m = 0; m < 4; ++m) {
                    bf16_t* rowp = zt ? U + (size_t)(row0 + ai * 128 + m * 16) * UW + URW + col0 : TMP + (size_t)(row0 + ai * 128 + m * 16) * 4352 + col0;
#pragma unroll
                    for (int bj = 0; bj < 2; ++bj) {
                        const f32x4 v0 = acc[ai][bj][m][0], v1 = acc[ai][bj][m][1];
                        u32x4 w; w.x = pk2(v0[0], v0[1]); w.y = pk2(v0[2], v0[3]); w.z = pk2(v1[0], v1[1]); w.w = pk2(v1[2], v1[3]);
                        *(u32x4*)(rowp + bj * 128) = w;
                    }
                }
        }
    }
};

struct EpiOut {
    static constexpr bool PERM = true, AFTER_DRAIN = false;
    float* out; const float* x; const float* stats; const float* eg; const float* eb;
    __device__ __forceinline__ void operator()(const f32x4 (&acc)[2][2][4][2], const pg8::Unit& u, int wr, int wc, int fr, int fq) const {
        const int row0 = u.pm * 256 + wr * 64 + fr, col0 = u.pn * 256 + wc * 32 + 8 * fq;
#pragma unroll
        for (int ai = 0; ai < 2; ++ai)
#pragma unroll
            for (int m = 0; m < 4; ++m) {
                const int row = row0 + ai * 128 + m * 16;
                const float mean = stats[row * 2], rstd = stats[row * 2 + 1];
#pragma unroll
                for (int bj = 0; bj < 2; ++bj)
#pragma unroll
                    for (int n = 0; n < 2; ++n) {
                        const int c = col0 + bj * 128 + 4 * n;
                        const float4 xv = *(const float4*)(x + (size_t)row * D + c), g = *(const float4*)(eg + c), b = *(const float4*)(eb + c);
                        const f32x4 a = acc[ai][bj][m][n];
                        float4 o;
                        o.x = DN_ALPHA * ((xv.x - mean) * rstd * g.x + b.x) + a[0]; o.y = DN_ALPHA * ((xv.y - mean) * rstd * g.y + b.y) + a[1];
                        o.z = DN_ALPHA * ((xv.z - mean) * rstd * g.z + b.z) + a[2]; o.w = DN_ALPHA * ((xv.w - mean) * rstd * g.w + b.w) + a[3];
                        *(float4*)(out + (size_t)row * D + c) = o;
                    }
            }
    }
};

typedef short bf16x8 __attribute__((ext_vector_type(8)));
typedef short s16x4 __attribute__((ext_vector_type(4)));
typedef __bf16 bf16x2_t __attribute__((ext_vector_type(2)));
typedef float f32x2 __attribute__((ext_vector_type(2)));
#define MFMA16(a, b, c) __builtin_amdgcn_mfma_f32_16x16x32_bf16((a), (b), (c), 0, 0, 0)
#define DI __device__ __forceinline__
constexpr int IMG_STRIDE = 144;
constexpr int WG_FRAG = 0;
constexpr int WG_CONST = 16384;
constexpr int WV_BASE = 16384 + 2560;
constexpr int WV_BYTES = 3 * 16 * IMG_STRIDE + 256;
static_assert(WV_BASE + 8 * WV_BYTES <= LDS_BYTES, "scan LDS map");

DI unsigned cvtpk(float lo, float hi) { f32x2 v = {lo, hi}; bf16x2_t b = __builtin_convertvector(v, bf16x2_t); return __builtin_bit_cast(unsigned, b); }
DI bf16x8 mkfrag(unsigned a, unsigned b, unsigned c, unsigned d) { u32x4 w = {a, b, c, d}; return __builtin_bit_cast(bf16x8, w); }
DI bf16x8 frag_f4(f32x4 a, f32x4 b) { return mkfrag(cvtpk(a[0], a[1]), cvtpk(a[2], a[3]), cvtpk(b[0], b[1]), cvtpk(b[2], b[3])); }
DI float bperm(float v, int srclane) { return __int_as_float(__builtin_amdgcn_ds_bpermute(srclane << 2, __float_as_int(v))); }
DI float lo16(unsigned w) { return __uint_as_float(w << 16); }
DI float hi16(unsigned w) { return __uint_as_float(w & 0xffff0000u); }
template <int CTRL> DI float dpp0(float x) { return __int_as_float(__builtin_amdgcn_update_dpp(0, __float_as_int(x), CTRL, 0xf, 0xf, true)); }
template <int CTRL> DI float dpp1(float x) { return __int_as_float(__builtin_amdgcn_update_dpp(0x3f800000, __float_as_int(x), CTRL, 0xf, 0xf, false)); }
DI float fsig(float x) { return __builtin_amdgcn_rcpf(1.f + __expf(-x)); }
DI f32x4 ld4(const bf16_t* ur) { const u32x2 c = *(const u32x2*)ur; return (f32x4){lo16(c.x), hi16(c.x), lo16(c.y), hi16(c.y)}; }

DI void split_frag(f32x4 a, f32x4 b, bf16x8& hi, bf16x8& lo) {
    f32x4 ah, bh;
    unsigned w[4] = {cvtpk(a[0], a[1]), cvtpk(a[2], a[3]), cvtpk(b[0], b[1]), cvtpk(b[2], b[3])};
    ah[0] = lo16(w[0]); ah[1] = hi16(w[0]); ah[2] = lo16(w[1]); ah[3] = hi16(w[1]); bh[0] = lo16(w[2]); bh[1] = hi16(w[2]); bh[2] = lo16(w[3]); bh[3] = hi16(w[3]);
    hi = mkfrag(w[0], w[1], w[2], w[3]); lo = frag_f4(a - ah, b - bh);
}
struct ChunkIn { u32x2 k[4], r[4], v[4]; bf16x8 tl[2], la[2]; };
template <int PASS> DI void chunk_load(ChunkIn& c, const bf16_t* ur, int h, int d, int q) {
#pragma unroll
    for (int n = 0; n < 4; ++n) {
        c.k[n] = *(const u32x2*)(ur + 1024 + h * 64 + 16 * n + 4 * q);
        if (PASS == 2) { c.v[n] = *(const u32x2*)(ur + 2048 + h * 64 + 16 * n + 4 * q); c.r[n] = *(const u32x2*)(ur + h * 64 + 16 * n + 4 * q); }
    }
#pragma unroll
    for (int ks = 0; ks < 2; ++ks) { const bf16_t* ul = ur + 4096 + d * 64 + 32 * ks + 8 * q; c.tl[ks] = *(const bf16x8*)ul; c.la[ks] = *(const bf16x8*)(ul + 128); }
}
DI f32x4 up4(u32x2 c) { return (f32x4){lo16(c.x), hi16(c.x), lo16(c.y), hi16(c.y)}; }
template <int PASS>
__device__ void phase_scan(KP p, int s, unsigned char* ldsg, int wid0) {
    KP_FRESH(p);
    const int wid = wid0;
    int tok0, nseq, T; slab_info(s, tok0, nseq, T);
    const int LS = 256, lgseg = (s == 0) ? 3 : 6, nseg = 1 << lgseg, nblk = (nseq * 32 << lgseg) >> 3;
    const bf16_t* U = (const bf16_t*)(p->ws + WS_U);
    bf16_t* YS = (bf16_t*)(p->ws + WS_YS); float* BON = (float*)(p->ws + WS_BON);
    float* PQ = (float*)(p->ws + WS_PQ); const float* SST = (const float*)(p->ws + WS_SST);
    float* cst = (float*)(ldsg + WG_CONST);
    const int wo = WV_BASE + wid * WV_BYTES;
    for (int ib = blockIdx.x; ib < nblk; ib += gridDim.x) {
        const int item = ib * 8 + wid, g = item & (nseg - 1), chain = item >> lgseg, h = chain & 15, d = (chain >> 4) & 1, b = chain >> 5;
        const int tid = hw_tid(wid0), lane = tid & 63, fr = lane & 15, q = lane >> 4;
        __syncthreads();
        if (tid < 64) {
            const float* mu = p->in[I_MU]; const int c = h * 64 + tid;
            cst[tid] = mu[c]; cst[64 + tid] = mu[1024 + c]; cst[128 + tid] = mu[2048 + c];
            cst[192 + tid] = -1.44269504f * p->in[I_W0][d * 1024 + c]; cst[256 + tid] = -1.44269504f * p->in[I_A0][d * 1024 + c];
            cst[320 + tid] = p->in[I_KK][c]; cst[384 + tid] = p->in[I_KA][c]; cst[448 + tid] = p->in[I_RK][c];
            cst[512 + tid] = mu[4096 + d * 64 + tid]; cst[576 + tid] = mu[4096 + 128 + d * 64 + tid];
        }
        for (int e = tid; e < 1024; e += 512) {
            const int l2 = e & 63, ks = (e >> 6) & 1, mt = (e >> 7) & 3, mat = e >> 9, fr2 = l2 & 15, q2 = l2 >> 4;
            const float* src = (mat ? p->in[I_AUP] : p->in[I_WUP]) + ((size_t)d * 64 + 32 * ks + 8 * q2) * 1024 + h * 64 + 16 * mt + fr2;
            float v8[8];
#pragma unroll
            for (int jj = 0; jj < 8; ++jj) v8[jj] = -1.44269504f * src[(size_t)jj * 1024];
            u32x4 w = {cvtpk(v8[0], v8[1]), cvtpk(v8[2], v8[3]), cvtpk(v8[4], v8[5]), cvtpk(v8[6], v8[7])};
            *(u32x4*)(ldsg + WG_FRAG + e * 16) = w;
        }
        __syncthreads();
        f32x4 St[4][4];
        f32x4 Pa[PASS == 1 ? 4 : 1][PASS == 1 ? 4 : 1];
        int l3 = lane; asm volatile("" : "+v"(l3));
        const float* sstl = SST + (size_t)item * 4096 + l3 * 4;
#pragma unroll
        for (int mt = 0; mt < 4; ++mt)
#pragma unroll
            for (int nt = 0; nt < 4; ++nt) {
                if (PASS == 1) {
#pragma unroll
                    for (int j = 0; j < 4; ++j) { St[mt][nt][j] = 0.f; Pa[PASS == 1 ? mt : 0][PASS == 1 ? nt : 0][j] = (16 * mt + 4 * q + j == 16 * nt + fr) ? 1.f : 0.f; }
                } else {
                    St[mt][nt] = *(const f32x4*)(sstl + (mt * 4 + nt) * 256);
                }
            }
        ChunkIn cin;
        { const int p0 = g * LS, t0 = d ? T - 1 - (p0 + fr) : p0 + fr; chunk_load<PASS>(cin, U + (size_t)(b * T + t0) * UW + URW, h, d, q); }
        for (int ck = 0; ck < LS / 16; ++ck) {
            const int pos0 = g * LS + ck * 16;
            const int lane_c = hw_tid(wid0) & 63;
            const int lane = lane_c, fr = lane_c & 15, q = lane_c >> 4;
            const int ti = d ? T - 1 - (pos0 + fr) : pos0 + fr, row = b * T + ti;
            ChunkIn cc = cin;
            if (PASS == 1) {
#pragma unroll
                for (int n = 0; n < 4; ++n) cc.v[n] = *(const u32x2*)(U + (size_t)row * UW + URW + 2048 + h * 64 + 16 * n + 4 * q);
            }
            {
                const int pn = g * LS + (ck + 1 < LS / 16 ? ck + 1 : ck) * 16, tn = d ? T - 1 - (pn + fr) : pn + fr;
                chunk_load<PASS>(cin, U + (size_t)(b * T + tn) * UW + URW, h, d, q);
            }
            const int lq16 = 16 * q, ll16 = 16 * lane, limg = fr * IMG_STRIDE + 8 * q, ltr = (4 * q + (fr >> 2)) * IMG_STRIDE + 8 * (fr & 3);
            f32x4 ow[4], oa[4];
            {
                const bf16x8 tlf[2] = {cc.tl[0], cc.tl[1]}, laf[2] = {cc.la[0], cc.la[1]};
#pragma unroll
                for (int mt = 0; mt < 4; ++mt) {
                    const bf16x8 w0f = *(const bf16x8*)(ldsg + WG_FRAG + ((0 * 4 + mt) * 2 + 0) * 1024 + ll16), w1f = *(const bf16x8*)(ldsg + WG_FRAG + ((0 * 4 + mt) * 2 + 1) * 1024 + ll16);
                    const bf16x8 a0f = *(const bf16x8*)(ldsg + WG_FRAG + ((1 * 4 + mt) * 2 + 0) * 1024 + ll16), a1f = *(const bf16x8*)(ldsg + WG_FRAG + ((1 * 4 + mt) * 2 + 1) * 1024 + ll16);
                    f32x4 z = {0.f, 0.f, 0.f, 0.f};
                    ow[mt] = MFMA16(w1f, tlf[1], MFMA16(w0f, tlf[0], z));
                    oa[mt] = MFMA16(a1f, laf[1], MFMA16(a0f, laf[0], z));
                }
            }
            f32x4 km[4]; float ss = 0.f;
#pragma unroll
            for (int n = 0; n < 4; ++n) {
                km[n] = up4(cc.k[n]);
                const f32x4 kr = km[n] * *(const f32x4*)(ldsg + WG_CONST + (320 + 16 * n) * 4 + lq16);
                ss += kr[0] * kr[0] + kr[1] * kr[1] + kr[2] * kr[2] + kr[3] * kr[3];
            }
            ss += bperm(ss, lane ^ 16); ss += bperm(ss, lane ^ 32);
            const float kinv = 1.f / fmaxf(sqrtf(ss), 1e-12f);
            u32x2 kapP[4], ktP[4], btP[4], rtP[4]; float bon = 0.f;
#pragma unroll
            for (int n = 0; n < 4; ++n) {
                const int co = 16 * n + 4 * q;
                const f32x4 w0v = *(const f32x4*)(ldsg + WG_CONST + (192 + 16 * n) * 4 + lq16), a0v = *(const f32x4*)(ldsg + WG_CONST + (256 + 16 * n) * 4 + lq16), kkw = *(const f32x4*)(ldsg + WG_CONST + (320 + 16 * n) * 4 + lq16), kav = *(const f32x4*)(ldsg + WG_CONST + (384 + 16 * n) * 4 + lq16);
                f32x4 lw, av, L, gmv;
#pragma unroll
                for (int j = 0; j < 4; ++j) { lw[j] = -0.87503877f * __builtin_amdgcn_rcpf(1.f + __builtin_amdgcn_exp2f(w0v[j] + ow[n][j])); av[j] = __builtin_amdgcn_rcpf(1.f + __builtin_amdgcn_exp2f(a0v[j] + oa[n][j])); }
#pragma unroll
                for (int j = 0; j < 4; ++j) {
                    float x = __builtin_amdgcn_exp2f(lw[j]);
                    x *= dpp1<0x111>(x); x *= dpp1<0x112>(x); x *= dpp1<0x114>(x); x *= dpp1<0x118>(x);
                    L[j] = x; lw[j] = dpp1<0x111>(x); gmv[j] = dpp0<0x121>(x);
                }
                f32x4 kap, kt, bt;
#pragma unroll
                for (int j = 0; j < 4; ++j) {
                    const float eL = L[j], emL = __builtin_amdgcn_rcpf(L[j]), eLm = lw[j];
                    const float kk = km[n][j] * kkw[j] * kinv, kd = km[n][j] * (1.f + (av[j] - 1.f) * kav[j]);
                    kap[j] = kk * eLm; bt[j] = kk * av[j] * emL; kt[j] = kd * emL;
                    if (PASS == 2) { lw[j] = eL; av[j] = kd; }
                }
                if (fr == 0) *(f32x4*)(ldsg + wo + 48 * IMG_STRIDE + 64 * n + lq16) = gmv;
                kapP[n] = (u32x2){cvtpk(kap[0], kap[1]), cvtpk(kap[2], kap[3])};
                ktP[n] = (u32x2){cvtpk(kt[0], kt[1]), cvtpk(kt[2], kt[3])};
                btP[n] = (u32x2){cvtpk(bt[0], bt[1]), cvtpk(bt[2], bt[3])};
                *(u32x2*)(ldsg + wo + 16 * IMG_STRIDE + 32 * n + limg) = ktP[n];
                *(u32x2*)(ldsg + wo + 32 * IMG_STRIDE + 32 * n + limg) = btP[n];
                if (PASS == 2) {
                    const f32x4 rm = up4(cc.r[n]), rk = *(const f32x4*)(ldsg + WG_CONST + (448 + 16 * n) * 4 + lq16);
                    rtP[n] = (u32x2){cvtpk(rm[0] * lw[0], rm[1] * lw[1]), cvtpk(rm[2] * lw[2], rm[3] * lw[3])};
                    bon += rm[0] * av[0] * rk[0] + rm[1] * av[1] * rk[1] + rm[2] * av[2] * rk[2] + rm[3] * av[3] * rk[3];
                }
                *(u32x2*)(ldsg + wo + 32 * n + limg) = cc.v[n];
            }
            if (PASS == 2) {
                bon += bperm(bon, lane ^ 16); bon += bperm(bon, lane ^ 32);
                if (q == 0) BON[((size_t)d * SLAB + row) * 16 + h] = 0.5f * bon;
            }
            const bf16x8 kapF0 = mkfrag(kapP[0].x, kapP[0].y, kapP[1].x, kapP[1].y), kapF1 = mkfrag(kapP[2].x, kapP[2].y, kapP[3].x, kapP[3].y);
            bf16x8 akkA, tA, aryA;
            {
                const bf16x8 ktF0 = mkfrag(ktP[0].x, ktP[0].y, ktP[1].x, ktP[1].y), ktF1 = mkfrag(ktP[2].x, ktP[2].y, ktP[3].x, ktP[3].y);
                const bf16x8 btF0 = mkfrag(btP[0].x, btP[0].y, btP[1].x, btP[1].y), btF1 = mkfrag(btP[2].x, btP[2].y, btP[3].x, btP[3].y);
                const f32x4 z = {0.f, 0.f, 0.f, 0.f};
                f32x4 akk = MFMA16(ktF1, kapF1, MFMA16(ktF0, kapF0, z));
                f32x4 nn = MFMA16(kapF1, btF1, MFMA16(kapF0, btF0, z));
                f32x4 na = MFMA16(btF1, kapF1, MFMA16(btF0, kapF0, z));
                f32x4 idv;
#pragma unroll
                for (int jj = 0; jj < 4; ++jj) {
                    akk[jj] = (4 * q + jj < fr) ? akk[jj] : 0.f; nn[jj] = (fr < 4 * q + jj) ? nn[jj] : 0.f; na[jj] = (4 * q + jj < fr) ? na[jj] : 0.f;
                    idv[jj] = (4 * q + jj == fr) ? 1.f : 0.f;
                }
                akkA = mkfrag(cvtpk(akk[0], akk[1]), cvtpk(akk[2], akk[3]), 0u, 0u);
                if (PASS == 2) {
                    const bf16x8 rtF0 = mkfrag(rtP[0].x, rtP[0].y, rtP[1].x, rtP[1].y), rtF1 = mkfrag(rtP[2].x, rtP[2].y, rtP[3].x, rtP[3].y);
                    f32x4 ark = MFMA16(ktF1, rtF1, MFMA16(ktF0, rtF0, z));
                    f32x4 arb = MFMA16(btF1, rtF1, MFMA16(btF0, rtF0, z));
#pragma unroll
                    for (int jj = 0; jj < 4; ++jj) { ark[jj] = (4 * q + jj <= fr) ? ark[jj] : 0.f; arb[jj] = (4 * q + jj <= fr) ? arb[jj] : 0.f; }
                    aryA = mkfrag(cvtpk(ark[0], ark[1]), cvtpk(ark[2], ark[3]), cvtpk(arb[0], arb[1]), cvtpk(arb[2], arb[3]));
                }
#define TF(x) mkfrag(cvtpk((x)[0], (x)[1]), cvtpk((x)[2], (x)[3]), 0u, 0u)
                const bf16x8 nF = TF(nn), aF = TF(na);
                const f32x4 n2 = MFMA16(aF, nF, z), a2 = MFMA16(nF, aF, z);
                const bf16x8 n2F = TF(n2), a2F = TF(a2);
                const f32x4 n4 = MFMA16(a2F, n2F, z), a4 = MFMA16(n2F, a2F, z);
                const bf16x8 n4F = TF(n4), a4F = TF(a4);
                const f32x4 n8 = MFMA16(a4F, n4F, z);
                const f32x4 t21 = MFMA16(n2F, aF, z);
                f32x4 R = idv - na + a2 - t21;
                R = MFMA16(n4F, TF(R), R);
                R = MFMA16(TF(n8), TF(R), R);
                tA = TF(R);
#undef TF
            }
            s16x4 Vc[4], Kc[4], Bc[4];
            {
                typedef s16x4 __attribute__((address_space(3)))* lp;
#pragma unroll
                for (int t4 = 0; t4 < 4; ++t4) {
                    Vc[t4] = __builtin_amdgcn_ds_read_tr16_b64_v4i16((lp)(ldsg + wo + ltr + 32 * t4));
                    Kc[t4] = __builtin_amdgcn_ds_read_tr16_b64_v4i16((lp)(ldsg + wo + 16 * IMG_STRIDE + ltr + 32 * t4));
                    Bc[t4] = __builtin_amdgcn_ds_read_tr16_b64_v4i16((lp)(ldsg + wo + 32 * IMG_STRIDE + ltr + 32 * t4));
                }
            }
            bf16x8 kbA[4];
#pragma unroll
            for (int mt = 0; mt < 4; ++mt) kbA[mt] = __builtin_shufflevector(Kc[mt], Bc[mt], 0, 1, 2, 3, 4, 5, 6, 7);
#pragma unroll
            for (int nt = 0; nt < 4; ++nt) {
                const f32x4 z = {0.f, 0.f, 0.f, 0.f};
                const bf16x8 stf0 = frag_f4(St[0][nt], St[1][nt]), stf1 = frag_f4(St[2][nt], St[3][nt]);
                const u32x2 vcu = __builtin_bit_cast(u32x2, Vc[nt]);
                f32x4 X = MFMA16(kapF1, stf1, MFMA16(kapF0, stf0, z));
                X = MFMA16(akkA, mkfrag(vcu.x, vcu.y, 0u, 0u), X);
                const f32x4 Uu = MFMA16(tA, mkfrag(cvtpk(X[0], X[1]), cvtpk(X[2], X[3]), 0u, 0u), z);
                const bf16x8 bvu = mkfrag(vcu.x, vcu.y, cvtpk(-Uu[0], -Uu[1]), cvtpk(-Uu[2], -Uu[3]));
                if (PASS == 2) {
                    const bf16x8 rtF0 = mkfrag(rtP[0].x, rtP[0].y, rtP[1].x, rtP[1].y), rtF1 = mkfrag(rtP[2].x, rtP[2].y, rtP[3].x, rtP[3].y);
                    f32x4 Y = MFMA16(rtF1, stf1, MFMA16(rtF0, stf0, z));
                    Y = MFMA16(aryA, bvu, Y);
#pragma unroll
                    for (int jj = 0; jj < 4; ++jj) {
                        const int i = 4 * q + jj, t2 = d ? T - 1 - (pos0 + i) : pos0 + i;
                        YS[((size_t)d * SLAB + b * T + t2) * DR + h * 64 + 16 * nt + fr] = (bf16_t)(cvtpk(Y[jj], 0.f) & 0xffffu);
                    }
                }
#pragma unroll
                for (int mt = 0; mt < 4; ++mt) St[mt][nt] = MFMA16(kbA[mt], bvu, St[mt][nt]) * *(const f32x4*)(ldsg + wo + 48 * IMG_STRIDE + 64 * mt + lq16);
            }
            if (PASS == 1) {
#pragma unroll
                for (int ct = 0; ct < 4; ++ct) {
                    const f32x4 z = {0.f, 0.f, 0.f, 0.f};
                    const bf16x8 pf0 = frag_f4(Pa[0][PASS == 1 ? ct : 0], Pa[PASS == 1 ? 1 : 0][PASS == 1 ? ct : 0]), pf1 = frag_f4(Pa[PASS == 1 ? 2 : 0][PASS == 1 ? ct : 0], Pa[PASS == 1 ? 3 : 0][PASS == 1 ? ct : 0]);
                    const f32x4 X = MFMA16(kapF1, pf1, MFMA16(kapF0, pf0, z));
                    const f32x4 Uu = MFMA16(tA, mkfrag(cvtpk(X[0], X[1]), cvtpk(X[2], X[3]), 0u, 0u), z);
                    const bf16x8 bvu = mkfrag(0u, 0u, cvtpk(-Uu[0], -Uu[1]), cvtpk(-Uu[2], -Uu[3]));
#pragma unroll
                    for (int mt = 0; mt < 4; ++mt) Pa[PASS == 1 ? mt : 0][PASS == 1 ? ct : 0] = MFMA16(kbA[mt], bvu, Pa[PASS == 1 ? mt : 0][PASS == 1 ? ct : 0]) * *(const f32x4*)(ldsg + wo + 48 * IMG_STRIDE + 64 * mt + lq16);
                }
            }
        }
        if (PASS == 1) {
            const int l2 = hw_tid(wid0) & 63, fr2 = l2 & 15, q2 = l2 >> 4;
            unsigned char* pqb = (unsigned char*)(PQ + (size_t)item * 8192);
            float* tl = (float*)(ldsg + wo);
#pragma unroll
            for (int mt = 0; mt < 4; ++mt)
#pragma unroll
                for (int ks = 0; ks < 2; ++ks) {
#pragma unroll
                    for (int e = 0; e < 2; ++e)
#pragma unroll
                        for (int j2 = 0; j2 < 4; ++j2) tl[e * 256 + (4 * q2 + j2) * 16 + fr2] = Pa[PASS == 1 ? mt : 0][PASS == 1 ? 2 * ks + e : 0][j2];
                    __builtin_amdgcn_wave_barrier();
                    const f32x4 pa = *(const f32x4*)(tl + fr2 * 16 + 4 * q2), pb = *(const f32x4*)(tl + 256 + fr2 * 16 + 4 * q2);
                    __builtin_amdgcn_wave_barrier();
                    bf16x8 ah, al; split_frag(pa, pb, ah, al);
                    *(bf16x8*)(pqb + (((mt * 2 + ks) * 2 + 0) * 64 + l2) * 16) = ah;
                }
            float* pq = PQ + (size_t)item * 8192 + 4096 + l2 * 4;
#pragma unroll
            for (int mt = 0; mt < 4; ++mt)
#pragma unroll
                for (int nt = 0; nt < 4; ++nt) *(f32x4*)(pq + (mt * 4 + nt) * 256) = St[mt][nt];
        }
    }
}

constexpr int CR_SLOTS = 10, CR_SLOT_BYTES = 12288, CR_FLAGS = CR_SLOTS * CR_SLOT_BYTES;
__device__ __forceinline__ void phase_combine_ring(KP p, int s, int wid0, unsigned char* ldsg) {
    KP_FRESH(p);
    int tid_ = hw_tid(wid0); asm volatile("" : "+v"(tid_));
    const int lane = tid_ & 63, wid = wid0;
    const int nseg = 64, nsteps = nseg - 1;
    const float* PQ = (const float*)(p->ws + WS_PQ); float* SST = (float*)(p->ws + WS_SST);
    volatile unsigned* flags = (volatile unsigned*)(ldsg + CR_FLAGS);
    __syncthreads();
    if (tid_ < CR_SLOTS) flags[tid_] = 0u;
    __syncthreads();
    if ((int)blockIdx.x >= 128) return;
    const int nt = blockIdx.x & 3, chain = blockIdx.x >> 2;
    if (wid != 0) {
        u32x4 ra[12], rb[12];
#define CR_ISSUE(r, gg) do { const unsigned char* b_ = (const unsigned char*)(PQ + ((size_t)chain * nseg + (gg)) * 8192); \
        _Pragma("unroll") for (int f = 0; f < 8; ++f) (r)[f] = *(const u32x4*)(b_ + ((f * 2 + 0) * 64 + lane) * 16); \
        _Pragma("unroll") for (int mt = 0; mt < 4; ++mt) (r)[8 + mt] = *(const u32x4*)(b_ + 16384 + ((mt * 4 + nt) * 64 + lane) * 16); } while (0)
#define CR_PUT(r, gg) do { const int slot_ = (gg) % CR_SLOTS; const unsigned gen_ = 2u * (unsigned)((gg) / CR_SLOTS); unsigned sp_ = 0;     \
        while (flags[slot_] != gen_ && ++sp_ < (1u << 20)) __builtin_amdgcn_s_sleep(1); \
        _Pragma("unroll") for (int f = 0; f < 12; ++f) *(u32x4*)(ldsg + slot_ * CR_SLOT_BYTES + f * 1024 + lane * 16) = (r)[f]; \
        asm volatile("s_waitcnt lgkmcnt(0)" ::: "memory"); __builtin_amdgcn_wave_barrier(); \
        if (lane == 0) flags[slot_] = gen_ + 1u; } while (0)
        int g = wid - 1;
        if (g < nsteps) CR_ISSUE(ra, g);
        for (; g < nsteps; g += 14) {
            if (g + 7 < nsteps) CR_ISSUE(rb, g + 7);
            CR_PUT(ra, g);
            if (g + 14 < nsteps) CR_ISSUE(ra, g + 14);
            if (g + 7 < nsteps) CR_PUT(rb, g + 7);
        }
#undef CR_ISSUE
#undef CR_PUT
    } else {
        f32x4 S[4];
#pragma unroll
        for (int mt = 0; mt < 4; ++mt) S[mt] = (f32x4){0.f, 0.f, 0.f, 0.f};
        for (int g = 0; g < nseg; ++g) {
            const size_t item = (size_t)chain * nseg + g;
#pragma unroll
            for (int mt = 0; mt < 4; ++mt) *(f32x4*)(SST + item * 4096 + ((mt * 4 + nt) * 64 + lane) * 4) = S[mt];
            if (g == nsteps) break;
            const int slot = g % CR_SLOTS; const unsigned gen = 2u * (unsigned)(g / CR_SLOTS); unsigned sp = 0;
            while (flags[slot] != gen + 1u && ++sp < (1u << 20)) __builtin_amdgcn_s_sleep(1);
            bf16x8 ah[4][2]; f32x4 qv[4];
#pragma unroll
            for (int mt = 0; mt < 4; ++mt) {
                qv[mt] = *(const f32x4*)(ldsg + slot * CR_SLOT_BYTES + (8 + mt) * 1024 + lane * 16);
#pragma unroll
                for (int ks = 0; ks < 2; ++ks) ah[mt][ks] = *(const bf16x8*)(ldsg + slot * CR_SLOT_BYTES + (mt * 2 + ks) * 1024 + lane * 16);
            }
            asm volatile("s_waitcnt lgkmcnt(0)" ::: "memory"); __builtin_amdgcn_wave_barrier();
            if (lane == 0) flags[slot] = gen + 2u;
            bf16x8 bh[2], bl[2];
            split_frag(S[0], S[1], bh[0], bl[0]); split_frag(S[2], S[3], bh[1], bl[1]);
#pragma unroll
            for (int mt = 0; mt < 4; ++mt) {
                f32x4 acc = qv[mt];
#pragma unroll
                for (int ks = 0; ks < 2; ++ks) { acc = MFMA16(ah[mt][ks], bh[ks], acc); acc = MFMA16(ah[mt][ks], bl[ks], acc); }
                S[mt] = acc;
            }
        }
    }
}

__device__ void phase_combine(KP p, int s, int wid0) {
    KP_FRESH(p);
    int tid_ = hw_tid(wid0); asm volatile("" : "+v"(tid_));
    const int lane = tid_ & 63, wid = tid_ >> 6, fr = lane & 15, q = lane >> 4;
    int tok0, nseq, T; slab_info(s, tok0, nseq, T);
    const int lgseg = (s == 0) ? 3 : 6, nseg = 1 << lgseg, nwork = nseq * 32 * 4;
    const float* PQ = (const float*)(p->ws + WS_PQ); float* SST = (float*)(p->ws + WS_SST);
    for (int wk = blockIdx.x * 8 + wid; wk < nwork; wk += gridDim.x * 8) {
        const int nt = wk & 3, chain = wk >> 2;
        f32x4 S[4];
#pragma unroll
        for (int mt = 0; mt < 4; ++mt) S[mt] = (f32x4){0.f, 0.f, 0.f, 0.f};
        struct CStep { bf16x8 ah[4][2]; f32x4 q[4]; };
#define CMB_LOAD(c, gg) do { const int g_ = (gg) < nseg - 1 ? (gg) : nseg - 2; const unsigned char* b_ = (const unsigned char*)(PQ + ((size_t)chain * nseg + g_) * 8192); \
        _Pragma("unroll") for (int mt = 0; mt < 4; ++mt) { (c).q[mt] = *(const f32x4*)(b_ + 16384 + ((mt * 4 + nt) * 64 + lane) * 16); \
            _Pragma("unroll") for (int ks = 0; ks < 2; ++ks) (c).ah[mt][ks] = *(const bf16x8*)(b_ + (((mt * 2 + ks) * 2 + 0) * 64 + lane) * 16); } } while (0)
        CStep c0, c1, c2;
        CMB_LOAD(c0, 0); CMB_LOAD(c1, 1); CMB_LOAD(c2, 2);
        for (int g = 0; g < nseg; ++g) {
            const size_t item = (size_t)chain * nseg + g;
#pragma unroll
            for (int mt = 0; mt < 4; ++mt) *(f32x4*)(SST + item * 4096 + ((mt * 4 + nt) * 64 + lane) * 4) = S[mt];
            if (g == nseg - 1) break;
            const CStep cc = c0; c0 = c1; c1 = c2;
            CMB_LOAD(c2, g + 3);
            bf16x8 bh[2], bl[2];
            split_frag(S[0], S[1], bh[0], bl[0]); split_frag(S[2], S[3], bh[1], bl[1]);
#pragma unroll
            for (int mt = 0; mt < 4; ++mt) {
                f32x4 acc = cc.q[mt];
#pragma unroll
                for (int ks = 0; ks < 2; ++ks) { acc = MFMA16(cc.ah[mt][ks], bh[ks], acc); acc = MFMA16(cc.ah[mt][ks], bl[ks], acc); }
                S[mt] = acc;
            }
        }
#undef CMB_LOAD
    }
}

DI void unpack8(u32x4 w, float (&f)[8]) { f[0] = lo16(w.x); f[1] = hi16(w.x); f[2] = lo16(w.y); f[3] = hi16(w.y); f[4] = lo16(w.z); f[5] = hi16(w.z); f[6] = lo16(w.w); f[7] = hi16(w.w); }
__device__ void phase_shift(KP p, int s, int wid0) {
    KP_FRESH(p);
    int tid_ = hw_tid(wid0); asm volatile("" : "+v"(tid_));
    int tok0, nseq, T; slab_info(s, tok0, nseq, T);
    const bf16_t* TMP = (const bf16_t*)(p->ws + WS_TMP); bf16_t* U = (bf16_t*)(p->ws + WS_U);
    const float* mu = p->in[I_MU];
    const int gt = blockIdx.x * 512 + tid_, nt = gridDim.x * 512;
    for (int unit = gt; unit < 416 * (SLAB / 16); unit += nt) {
        const int cg0 = unit % 416, cg = cg0 < 384 ? cg0 : cg0 + 128, rb = unit / 416, c0 = cg * 8, r0 = rb * 16;
        const bool tanh_cols = (c0 >= 4096) && (c0 < 4096 + 128);
        float m[8];
        { const f32x4 a = *(const f32x4*)(mu + c0), b = *(const f32x4*)(mu + c0 + 4); m[0] = a[0]; m[1] = a[1]; m[2] = a[2]; m[3] = a[3]; m[4] = b[0]; m[5] = b[1]; m[6] = b[2]; m[7] = b[3]; }
        const bf16_t* src = TMP + (size_t)r0 * 4352 + c0; bf16_t* dst = U + (size_t)r0 * UW + URW + c0;
        const int t0 = r0 & (T - 1);
        u32x4 raw[18];
        raw[0] = (t0 > 0) ? *(const u32x4*)(src - 4352) : (u32x4){0u, 0u, 0u, 0u};
#pragma unroll
        for (int i = 0; i < 16; ++i) raw[i + 1] = *(const u32x4*)(src + (size_t)i * 4352);
        raw[17] = (t0 + 16 < T) ? *(const u32x4*)(src + (size_t)16 * 4352) : (u32x4){0u, 0u, 0u, 0u};
        float prev[8], cur[8], nxt[8];
        unpack8(raw[0], prev); unpack8(raw[1], cur);
#pragma unroll
        for (int i = 0; i < 16; ++i) {
            unpack8(raw[i + 2], nxt);
            float o[8];
#pragma unroll
            for (int e = 0; e < 8; ++e) {
                float v = cur[e] + m[e] * (0.5f * (prev[e] + nxt[e]) - cur[e]);
                if (tanh_cols) v = 1.f - 2.f * __builtin_amdgcn_rcpf(1.f + __expf(2.f * v));
                o[e] = v; prev[e] = cur[e]; cur[e] = nxt[e];
            }
            *(u32x4*)(dst + (size_t)i * UW) = (u32x4){cvtpk(o[0], o[1]), cvtpk(o[2], o[3]), cvtpk(o[4], o[5]), cvtpk(o[6], o[7])};
        }
    }
}

__device__ void phase_post(KP p, int s, int wid0) {
    KP_FRESH(p);
    int tid_ = hw_tid(wid0); asm volatile("" : "+v"(tid_));
    const int lane = tid_ & 63, gw = blockIdx.x * 8 + (tid_ >> 6), nw = gridDim.x * 8;
    int tok0, nseq, T; slab_info(s, tok0, nseq, T);
    const bf16_t* U = (const bf16_t*)(p->ws + WS_U);
    const bf16_t* YS = (const bf16_t*)(p->ws + WS_YS); const float* BON = (const float*)(p->ws + WS_BON);
    bf16_t* ymix = (bf16_t*)(p->ws + WS_YMIX);
    for (int unit = gw; unit < (SLAB / 16) * 2; unit += nw) {
        const int half = unit & 1, r0 = (unit >> 1) * 16, c0 = half * 512 + lane * 8, h = c0 >> 6;
        float cw0[8], cw1[8], cw2[8], cbv[8], lg[8], lb[8];
        {
            const float* cw = p->in[I_CW]; const float* cb = p->in[I_CB]; const float* g = p->in[I_LXG]; const float* b = p->in[I_LXB];
#pragma unroll
            for (int e = 0; e < 8; ++e) { cw0[e] = cw[c0 + e]; cw1[e] = cw[1024 + c0 + e]; cw2[e] = cw[2048 + c0 + e]; cbv[e] = cb[c0 + e]; lg[e] = g[c0 + e]; lb[e] = b[c0 + e]; }
        }
        const int t0 = r0 & (T - 1);
        const bf16_t* up = U + (size_t)r0 * UW + c0;
        float pprev[8], pcur[8], pnxt[8], zprev[8], zcur[8], znxt[8], muz[8];
        if (t0 > 0) { unpack8(*(const u32x4*)(up - UW), pprev); unpack8(*(const u32x4*)(up - UW + URW + 3072), zprev); } else { for (int e = 0; e < 8; ++e) { pprev[e] = 0.f; zprev[e] = 0.f; } }
        unpack8(*(const u32x4*)up, pcur); unpack8(*(const u32x4*)(up + URW + 3072), zcur);
        { const float* mu = p->in[I_MU];
#pragma unroll
          for (int e = 0; e < 8; ++e) muz[e] = mu[3072 + c0 + e]; }
        for (int ib = 0; ib < 16; ib += 4) {
            u32x4 rp[4], rg[4], rv[4], rz[4], ry0[4], ry1[4]; float bonv[4];
#pragma unroll
            for (int r = 0; r < 4; ++r) {
                const int i = ib + r, row = r0 + i;
                const bf16_t* ur = up + (size_t)i * UW;
                rp[r] = (t0 + i < T - 1) ? *(const u32x4*)(ur + UW) : (u32x4){0u, 0u, 0u, 0u};
                rz[r] = (t0 + i < T - 1) ? *(const u32x4*)(ur + UW + URW + 3072) : (u32x4){0u, 0u, 0u, 0u};
                rg[r] = *(const u32x4*)(ur + 1024); rv[r] = *(const u32x4*)(ur + URW + 2048);
                ry0[r] = *(const u32x4*)(YS + (size_t)row * DR + c0); ry1[r] = *(const u32x4*)(YS + ((size_t)SLAB + row) * DR + c0);
                bonv[r] = BON[(size_t)row * 16 + h] + BON[((size_t)SLAB + row) * 16 + h];
            }
#pragma unroll
            for (int r = 0; r < 4; ++r) {
                const int row = r0 + ib + r;
                float gg[8], vv[8], zz[8], y[8], y1[8];
                unpack8(rp[r], pnxt); unpack8(rg[r], gg); unpack8(rv[r], vv); unpack8(rz[r], znxt); unpack8(ry0[r], y); unpack8(ry1[r], y1);
#pragma unroll
                for (int e = 0; e < 8; ++e) { zz[e] = zcur[e] + muz[e] * (0.5f * (zprev[e] + znxt[e]) - zcur[e]); zprev[e] = zcur[e]; zcur[e] = znxt[e]; }
                const float bon = bonv[r];
#pragma unroll
                for (int e = 0; e < 8; ++e) y[e] += y1[e];
                float sum = 0.f;
#pragma unroll
                for (int e = 0; e < 8; ++e) sum += y[e];
                sum += shx(sum, lane, 1); sum += shx(sum, lane, 2); sum += shx(sum, lane, 4);
                const float mean = sum * (1.f / 64.f);
                float sq = 0.f;
#pragma unroll
                for (int e = 0; e < 8; ++e) { const float dl = y[e] - mean; sq += dl * dl; }
                sq += shx(sq, lane, 1); sq += shx(sq, lane, 2); sq += shx(sq, lane, 4);
                const float rstd = rsqrtf(sq * (1.f / 64.f) + 64e-5f);
                float oc[8], orw[8];
#pragma unroll
                for (int e = 0; e < 8; ++e) {
                    oc[e] = gg[e] * (cw0[e] * pprev[e] + cw1[e] * pcur[e] + cw2[e] * pnxt[e] + cbv[e]);
                    orw[e] = ((y[e] - mean) * rstd * lg[e] + lb[e] + bon * vv[e]) * (zz[e] * fsig(zz[e]));
                    pprev[e] = pcur[e]; pcur[e] = pnxt[e];
                }
                *(u32x4*)(ymix + (size_t)row * 2048 + c0) = (u32x4){cvtpk(oc[0], oc[1]), cvtpk(oc[2], oc[3]), cvtpk(oc[4], oc[5]), cvtpk(oc[6], oc[7])};
                *(u32x4*)(ymix + (size_t)row * 2048 + 1024 + c0) = (u32x4){cvtpk(orw[0], orw[1]), cvtpk(orw[2], orw[3]), cvtpk(orw[4], orw[5]), cvtpk(orw[6], orw[7])};
            }
        }
    }
}

__device__ void phase_lnout(KP p, int s, int wid0) {
    KP_FRESH(p);
    int tid_ = hw_tid(wid0); asm volatile("" : "+v"(tid_)); int lane = tid_ & 63; const int gw = blockIdx.x * 8 + (tid_ >> 6), nw = gridDim.x * 8;
    float* out = p->out + (size_t)s * SLAB * D;
    const float4* g4 = (const float4*)p->in[I_LG]; const float4* b4 = (const float4*)p->in[I_LB];
    for (int r0 = gw; r0 < SLAB; r0 += 4 * nw) {
        asm volatile("" : "+v"(lane));
        float4 v[4][4];
#pragma unroll
        for (int k = 0; k < 4; ++k)
#pragma unroll
            for (int i = 0; i < 4; ++i) v[k][i] = ((const float4*)(out + (size_t)(r0 + k * nw) * D))[lane + 64 * i];
#pragma unroll
        for (int k = 0; k < 4; ++k) {
            float4* xp = (float4*)(out + (size_t)(r0 + k * nw) * D);
            float sum = 0.f;
#pragma unroll
            for (int i = 0; i < 4; ++i) sum += v[k][i].x + v[k][i].y + v[k][i].z + v[k][i].w;
            const float mean = wsum(sum, lane) * (1.f / 1024.f);
            float sq = 0.f;
#pragma unroll
            for (int i = 0; i < 4; ++i) { float a = v[k][i].x - mean, b = v[k][i].y - mean, c = v[k][i].z - mean, d = v[k][i].w - mean; sq += a * a + b * b + c * c + d * d; }
            const float rstd = rsqrtf(wsum(sq, lane) * (1.f / 1024.f) + 1e-5f);
#pragma unroll
            for (int i = 0; i < 4; ++i) {
                const float4 g = g4[lane + 64 * i], b = b4[lane + 64 * i];
                float4 o; o.x = (v[k][i].x - mean) * rstd * g.x + b.x; o.y = (v[k][i].y - mean) * rstd * g.y + b.y; o.z = (v[k][i].z - mean) * rstd * g.z + b.z; o.w = (v[k][i].w - mean) * rstd * g.w + b.w;
                xp[lane + 64 * i] = o;
            }
        }
    }
}

#define LAS __attribute__((address_space(3)))
#define XB_TMO      128
#define XB_XCNT(j)  (256  + 64 * (j))
#define XB_XSUB(j)  (1280 + 64 * (j))
#define XB_XGEN(j)  (2304 + 64 * (j))
#define XB_TOP      3328
#define XB_TOPGEN   3392
#define XCD_BAR_WORDS 3456
#define XB_SPIN_CAP (1u << 18)

__device__ __forceinline__ unsigned xb_ld(unsigned* p)              { return __hip_atomic_load(p, __ATOMIC_RELAXED, __HIP_MEMORY_SCOPE_AGENT); }
__device__ __forceinline__ unsigned xb_add(unsigned* p, unsigned v) { return __hip_atomic_fetch_add(p, v, __ATOMIC_RELAXED, __HIP_MEMORY_SCOPE_AGENT); }
__device__ __forceinline__ unsigned xb_xcc_id() { return (unsigned)__builtin_amdgcn_s_getreg((3 << 11) | 20) & 0xFu; }
#define XB_SPIN(cond, bar) do { unsigned _sp = 0; while (cond) { __builtin_amdgcn_s_sleep(1); \
    if ((++_sp & 255u) == 0u) { if (xb_ld(&(bar)[XB_TMO])) break; if (_sp > XB_SPIN_CAP) { atomicAdd(&(bar)[XB_TMO], 1u); break; } } } } while (0)

struct XcdBarrier {
    unsigned* bar; unsigned x;
    volatile LAS unsigned* st;
};

__device__ __forceinline__ XcdBarrier xcd_barrier_post(unsigned* bar, volatile LAS unsigned* st) {
    XcdBarrier b; b.bar = bar; b.x = xb_xcc_id(); b.st = st;
    if (threadIdx.x == 0) (void)xb_add(&bar[XB_XCNT(b.x)], 1u);
    return b;
}
__device__ __forceinline__ void xcd_barrier_complete(unsigned* bar, unsigned x, unsigned& nloc, unsigned& nx) {
    const unsigned G = gridDim.x * gridDim.y * gridDim.z;
    unsigned sum, cnt, mine, sp = 0u;
    for (;;) {
        sum = 0u; cnt = 0u; mine = 0u;
#pragma unroll
        for (unsigned j = 0; j < 16; ++j) { const unsigned c = xb_ld(&bar[XB_XCNT(j)]); sum += c; cnt += (c > 0u) ? 1u : 0u; mine = (j == x) ? c : mine; }
        if (sum == G) break;
        __builtin_amdgcn_s_sleep(1);
        if ((++sp & 255u) == 0u) { if (xb_ld(&bar[XB_TMO])) break; if (sp > XB_SPIN_CAP) { atomicAdd(&bar[XB_TMO], 1u); break; } }
    }
    nloc = mine > 0u ? mine : 1u; nx = cnt > 0u ? cnt : 1u;
}

__device__ __forceinline__ void xcd_barrier(const XcdBarrier& b) {
    asm volatile("s_waitcnt vmcnt(0)" ::: "memory");
    __syncthreads();
    if (threadIdx.x == 0) {
        unsigned* bar = b.bar;
        __builtin_amdgcn_s_waitcnt(0);
        unsigned nloc = b.st[0], nx = b.st[1];
        if (nloc == 0u) { xcd_barrier_complete(bar, b.x, nloc, nx); b.st[0] = nloc; b.st[1] = nx; }
        const unsigned old = xb_add(&bar[XB_XSUB(b.x)], 1u);
        const unsigned gen = old / nloc;
        if (old + 1u == (gen + 1u) * nloc) {
            __builtin_amdgcn_fence(__ATOMIC_RELEASE, "agent");
            asm volatile("s_waitcnt vmcnt(0)" ::: "memory");
            const unsigned og = xb_add(&bar[XB_TOP], 1u);
            const unsigned tg = og / nx;
            if (og + 1u == (tg + 1u) * nx) xb_add(&bar[XB_TOPGEN], 1u);
            else XB_SPIN(xb_ld(&bar[XB_TOPGEN]) == tg, bar);
            __builtin_amdgcn_fence(__ATOMIC_ACQUIRE, "agent");
            xb_add(&bar[XB_XGEN(b.x)], 1u);
            asm volatile("s_waitcnt vmcnt(0)" ::: "memory");
        } else {
            XB_SPIN(xb_ld(&bar[XB_XGEN(b.x)]) == gen, bar);
            __builtin_amdgcn_fence(__ATOMIC_ACQUIRE, "agent");
            asm volatile("s_waitcnt vmcnt(0)" ::: "memory");
        }
    }
    __syncthreads();
}

#ifndef REP_SHIFT
#define REP_SHIFT 1
#endif
#ifndef REP_G2
#define REP_G2 1
#endif
#ifndef REP_SCAN
#define REP_SCAN 1
#endif
#ifndef REP_POST
#define REP_POST 1
#endif
#ifndef REP_G1
#define REP_G1 1
#endif
#define GBAR() xcd_barrier(bar)
__global__ void __launch_bounds__(512, 2) fwd_megakernel(Params p_unused) {
    extern __shared__ __attribute__((aligned(16))) unsigned char lds_raw[];
    PG8_LAS unsigned char* lds = (PG8_LAS unsigned char*)lds_raw;
    cg::grid_group grid = cg::this_grid();
    KP p = (KP)__builtin_amdgcn_kernarg_segment_ptr();
    if (threadIdx.x < 2) ((volatile LAS unsigned*)(lds + LDS_BYTES - 64))[threadIdx.x] = 0u;
    __syncthreads();
    XcdBarrier bar = xcd_barrier_post((unsigned*)(((const Params __attribute__((address_space(4)))*)__builtin_amdgcn_kernarg_segment_ptr())->ws + WS_BAR), (volatile LAS unsigned*)(lds + LDS_BYTES - 64));
    const int wid0 = __builtin_amdgcn_readfirstlane((int)threadIdx.x >> 6);
    phase_weights(p, wid0);
    for (int s = -1; s < 3; ++s) {
        if (s == 0) grid.sync();
        if (s >= 0)
        for (int rep = 0; rep < REP_G1; ++rep) {
            if (rep) GBAR();
            KP_FRESH(p);
            pg8::Gemm g; g.A = xn_buf(p, s); g.Bt = (const bf16_t*)(p->ws + WS_WIN); g.M = SLAB; g.N = NIN; g.K = D;
            pg8::StaticOrder S; S.init(g.M, g.N, gridDim.x, blockIdx.x);
            EpiU E; E.U = (bf16_t*)(p->ws + WS_U); E.TMP = (bf16_t*)(p->ws + WS_TMP);
            pg8::gemm_phase<EpiU, pg8::StaticOrder, true, true>(lds, g, S, E, wid0);
        }
        {
            const int wg0 = (s >= 0 && gridDim.x > 64) ? 64 : 0;
            if (s < 2 && (int)blockIdx.x >= wg0) phase_ln(p, s + 1, wid0, wg0);
        }
        if (s < 0) continue;
        GBAR();
        for (int rep = 0; rep < REP_SHIFT; ++rep) {
        phase_shift(p, s, wid0);
        GBAR();
        }
        for (int rep = 0; rep < REP_SCAN; ++rep) {
        phase_scan<1>(p, s, lds_raw, wid0);
        GBAR();
        if (s > 0 && gridDim.x >= 128) phase_combine_ring(p, s, wid0, lds_raw); else phase_combine(p, s, wid0);
        GBAR();
        phase_scan<2>(p, s, lds_raw, wid0);
        GBAR();
        }
        for (int rep = 0; rep < REP_POST; ++rep) {
        phase_post(p, s, wid0);
        GBAR();
        }
        for (int rep = 0; rep < REP_G2; ++rep) {
            if (rep) GBAR();
            KP_FRESH(p);
            pg8::Gemm g; g.A = (const bf16_t*)(p->ws + WS_YMIX); g.Bt = (const bf16_t*)(p->ws + WS_WOUT); g.M = SLAB; g.N = D; g.K = 2048;
            pg8::StaticOrder S; S.init(g.M, g.N, gridDim.x, blockIdx.x);
            EpiOut E; E.out = p->out + (size_t)s * SLAB * D; E.x = slab_x(p, s); E.stats = (const float*)(p->ws + WS_STATS) + (size_t)s * SLAB * 2; E.eg = p->in[I_EG]; E.eb = p->in[I_EB];
            pg8::gemm_phase<EpiOut, pg8::StaticOrder, true, true>(lds, g, S, E, wid0);
        }
        GBAR();
        phase_lnout(p, s, wid0);
    }
}

extern "C" void kernel_launch(void* const* d_in, const int* in_sizes, int n_in, void* d_out, int out_size, void* d_ws, size_t ws_size, hipStream_t stream) {
    static int grid_blocks = 0;
    if (!grid_blocks) {
        int dev = 0, cus = 0, per_cu = 0;
        hipGetDevice(&dev);
        hipDeviceGetAttribute(&cus, hipDeviceAttributeMultiprocessorCount, dev);
        hipFuncSetAttribute((const void*)fwd_megakernel, hipFuncAttributeMaxDynamicSharedMemorySize, LDS_BYTES);
        hipOccupancyMaxActiveBlocksPerMultiprocessor(&per_cu, (const void*)fwd_megakernel, 512, LDS_BYTES);
        if (per_cu < 1) per_cu = 1;
        if (per_cu > 1) per_cu = 1;
        grid_blocks = cus * per_cu;
    }
    Params p{};
    for (int i = 0; i < 20; ++i) p.in[i] = (const float*)d_in[i];
    p.out = (float*)d_out; p.ws = (unsigned char*)d_ws;
    hipMemsetAsync((unsigned char*)d_ws + WS_BAR, 0, 16384, stream);
    void* args[] = {&p};
    hipError_t e = hipLaunchCooperativeKernel((const void*)fwd_megakernel, dim3(grid_blocks), dim3(512), args, LDS_BYTES, stream);
    if (e != hipSuccess) fprintf(stderr, "cooperative launch failed: %s (grid %d)\n", hipGetErrorString(e), grid_blocks);
}
```

```cpp
#include <hip/hip_runtime.h>
#include <hip/hip_cooperative_groups.h>
#include <cstdio>
#include <cstdint>
namespace cg = cooperative_groups;
namespace pg8 {
#define PG8_LAS __attribute__((address_space(3)))
typedef unsigned short bf16_t;
typedef short bf16x8 __attribute__((ext_vector_type(8)));
typedef float f32x4 __attribute__((ext_vector_type(4)));
typedef unsigned u32x4 __attribute__((ext_vector_type(4)));
constexpr int BM = 256, BK = 64, HALF = 128, HTB = HALF * BK * 2  , STAGE_BYTES = 8 * HTB, NXCD = 8, WGM = 8;

__host__ __device__ __forceinline__ int lds_byte(int r, int c) { const int st = (r >> 4) * 2 + (c >> 5), rr = r & 15, cc = c & 31, ob = rr * 64 + cc * 2; return st * 1024 + (ob ^ (((ob >> 9) & 1) << 5)); }
__host__ __device__ __forceinline__ void stage_rc(int b, int& R, int& C) { const int st = b / 1024, sb = b % 1024, swz = sb ^ (((sb >> 9) & 1) << 5); R = (st >> 1) * 16 + swz / 64; C = (st & 1) * 32 + (swz % 64) / 2; }
__host__ __device__ __forceinline__ int perm32(int rho) { const int n = rho >> 4, i = rho & 15; return 8 * (i >> 2) + 4 * n + (i & 3); }

struct Unit { int pm, pn; };
struct Gemm { const bf16_t* A; const bf16_t* Bt; int M, N, K; };

struct StaticOrder {
    int nM, nN, nwg, G, c;
    __host__ __device__ void init(int M, int N, int G_, int c_) { nM = M / BM; nN = N / BM; nwg = nM * nN; G = G_; c = c_; }
    __host__ __device__ bool next(int i, Unit& u) const {
        const long L = (long)i * G + c; if (L >= nwg) return false;
        int wgid = (int)L; { const int q = nwg / NXCD, r = nwg % NXCD, xcd = wgid % NXCD, off = wgid / NXCD; wgid = (xcd < r ? xcd * (q + 1) : r * (q + 1) + (xcd - r) * q) + off; }
        const int nig = WGM * nN, gid = wgid / nig, fm = gid * WGM, gsz = (nM - fm) < WGM ? (nM - fm) : WGM;
        u.pm = fm + ((wgid % nig) % gsz); u.pn = (wgid % nig) / gsz; return true;
    }
    __device__ __forceinline__ void a_ready(const Unit&) const {}
    __device__ __forceinline__ void done(const Unit&) const {}
};

template <class Epi, class Sched, bool ALIGN_EPI = false, bool SP2 = false>
__device__ __forceinline__ void gemm_phase(PG8_LAS unsigned char* lds, const Gemm g, const Sched& S, const Epi& E, int wid0) {
    int tid_; asm volatile("v_mbcnt_lo_u32_b32 %0, -1, 0\n\tv_mbcnt_hi_u32_b32 %0, -1, %0" : "=v"(tid_)); tid_ += wid0 * 64; const int tid = tid_, wid = __builtin_amdgcn_readfirstlane(tid >> 6), lane = tid & 63, wr = wid >> 2, wc = wid & 3, fr = lane & 15, fq = lane >> 4;
    const int K = g.K, nt = K / BK;
    unsigned voffA[2], voffB[2];
#pragma unroll
    for (int i = 0; i < 2; ++i) { int R, C; stage_rc(tid * 16 + i * 8192, R, C); const int Rb = Epi::PERM ? ((R & ~31) + perm32(R & 31)) : R;
        voffA[i] = (unsigned)(R * K + C) * 2u; voffB[i] = (unsigned)(Rb * K + C) * 2u; }
    const size_t kstep = (size_t)(BK * 2);
    const size_t hstep = (size_t)HALF * K * 2;
    const size_t tstep = 2 * hstep;
    const unsigned ldsw = (unsigned)wid * 1024u;
    const int aoff = lds_byte(wr * 64 + fr, fq * 8), boff = lds_byte(wc * 32 + fr, fq * 8);
#define PG8_SA(b, h) (((b) * 2 + (h)) * HTB)
#define PG8_SB(b, h) ((4 + (b) * 2 + (h)) * HTB)
#define PG8_STAGE(bufoff, gbase, voff) do { _Pragma("unroll") for (int _i = 0; _i < 2; ++_i) \
        __builtin_amdgcn_global_load_lds((const unsigned*)((const char*)(gbase) + (voff)[_i]), (PG8_LAS unsigned*)(lds + (bufoff) + ldsw + _i * 8192), 16, 0, 0); } while (0)
#define PG8_LDA(dst, b, h) do { _Pragma("unroll") for (int m = 0; m < 4; ++m) _Pragma("unroll") for (int k = 0; k < 2; ++k) dst[m][k] = *(const PG8_LAS bf16x8*)(lds + PG8_SA(b, h) + aoff + m * 2048 + k * 1024); } while (0)
#define PG8_LDB(dst, b, h) do { _Pragma("unroll") for (int n = 0; n < 2; ++n) _Pragma("unroll") for (int k = 0; k < 2; ++k) dst[n][k] = *(const PG8_LAS bf16x8*)(lds + PG8_SB(b, h) + boff + n * 2048 + k * 1024); } while (0)
#define PG8_MMA(ai, bj, At, Bt) do { __builtin_amdgcn_s_setprio(1); _Pragma("unroll") for (int m = 0; m < 4; ++m) _Pragma("unroll") for (int n = 0; n < 2; ++n) _Pragma("unroll") for (int k = 0; k < 2; ++k) \
        acc[ai][bj][m][n] = __builtin_amdgcn_mfma_f32_16x16x32_bf16(Bt[n][k], At[m][k], acc[ai][bj][m][n], 0, 0, 0); __builtin_amdgcn_s_setprio(0); } while (0)
#define PG8_WAIT_V(n) asm volatile("s_waitcnt vmcnt(" #n ")" ::: "memory")
#define PG8_WAIT_L(n) asm volatile("s_waitcnt lgkmcnt(" #n ")" ::: "memory")
#define PG8_BAR __builtin_amdgcn_s_barrier()
#define PG8_SCHED __builtin_amdgcn_sched_barrier(0)
    Unit cur, nxt; int ui = 0;
    if (!S.next(0, cur)) return;
    f32x4 acc[2][2][4][2];
#pragma unroll
    for (int a = 0; a < 2; ++a)
#pragma unroll
        for (int b = 0; b < 2; ++b)
#pragma unroll
            for (int m = 0; m < 4; ++m)
#pragma unroll
                for (int n = 0; n < 2; ++n) acc[a][b][m][n] = (f32x4){0.f, 0.f, 0.f, 0.f};
    bf16x8 At[4][2], B0[2][2], B1[2][2];
    const char* cA = (const char*)g.A + (size_t)cur.pm * tstep; const char* cB = (const char*)g.Bt + (size_t)cur.pn * tstep;
    S.a_ready(cur);
    if constexpr (SP2) {
        PG8_STAGE(PG8_SB(0, 0), cB, voffB); PG8_STAGE(PG8_SB(0, 1), cB + hstep, voffB); PG8_STAGE(PG8_SA(0, 0), cA, voffA); PG8_STAGE(PG8_SA(0, 1), cA + hstep, voffA);
        if (wr == 1) PG8_BAR;
        PG8_WAIT_V(2); PG8_BAR;
        PG8_STAGE(PG8_SB(1, 0), cB + kstep, voffB); PG8_STAGE(PG8_SA(1, 0), cA + kstep, voffA); PG8_STAGE(PG8_SB(1, 1), cB + hstep + kstep, voffB);
        PG8_WAIT_V(6); PG8_BAR;
    } else {
        PG8_STAGE(PG8_SB(0, 0), cB, voffB); PG8_STAGE(PG8_SA(0, 0), cA, voffA); PG8_STAGE(PG8_SB(0, 1), cB + hstep, voffB); PG8_STAGE(PG8_SA(0, 1), cA + hstep, voffA);
        if (wr == 1) PG8_BAR;
        PG8_WAIT_V(4); PG8_BAR;
        PG8_STAGE(PG8_SB(1, 0), cB + kstep, voffB); PG8_STAGE(PG8_SA(1, 0), cA + kstep, voffA); PG8_STAGE(PG8_SB(1, 1), cB + hstep + kstep, voffB);
        PG8_WAIT_V(6); PG8_BAR;
    }
    for (;;) {
        const bool has_next = S.next(ui + 1, nxt);
        const char* nA = has_next ? (const char*)g.A + (size_t)nxt.pm * tstep : cA; const char* nB = has_next ? (const char*)g.Bt + (size_t)nxt.pn * tstep : cB;
        for (int t = 0; t < nt; t += 2) {
            const bool last = (t == nt - 2);
            const char* a1 = cA + (size_t)(t + 1) * kstep;
            const char* a2 = last ? nA : cA + (size_t)(t + 2) * kstep; const char* b2 = last ? nB : cB + (size_t)(t + 2) * kstep;
            const char* a3 = a2 + kstep; const char* b3 = b2 + kstep;
            if (last && has_next) S.a_ready(nxt);
            if constexpr (SP2) {
            PG8_LDB(B0, 0, 0); PG8_LDB(B1, 0, 1); PG8_SCHED; PG8_LDA(At, 0, 0); PG8_STAGE(PG8_SA(1, 1), a1 + hstep, voffA);
            PG8_WAIT_V(8); PG8_WAIT_L(0); PG8_BAR; PG8_MMA(0, 0, At, B0); PG8_MMA(0, 1, At, B1); PG8_BAR; PG8_SCHED;
            PG8_LDA(At, 0, 1); PG8_STAGE(PG8_SB(0, 0), b2, voffB); PG8_STAGE(PG8_SB(0, 1), b2 + hstep, voffB); PG8_STAGE(PG8_SA(0, 0), a2, voffA);
            PG8_WAIT_V(8); PG8_WAIT_L(0); PG8_BAR; PG8_MMA(1, 0, At, B0); PG8_MMA(1, 1, At, B1); PG8_BAR; PG8_SCHED;
            PG8_LDB(B0, 1, 0); PG8_LDB(B1, 1, 1); PG8_SCHED; PG8_LDA(At, 1, 0); PG8_STAGE(PG8_SA(0, 1), a2 + hstep, voffA);
            PG8_WAIT_V(8); PG8_WAIT_L(0); PG8_BAR; PG8_MMA(0, 0, At, B0); PG8_MMA(0, 1, At, B1); PG8_BAR; PG8_SCHED;
            PG8_LDA(At, 1, 1); PG8_STAGE(PG8_SB(1, 0), b3, voffB); PG8_STAGE(PG8_SB(1, 1), b3 + hstep, voffB); PG8_STAGE(PG8_SA(1, 0), a3, voffA);
            PG8_WAIT_V(8); PG8_WAIT_L(0); PG8_BAR; PG8_MMA(1, 0, At, B0); PG8_MMA(1, 1, At, B1); PG8_BAR; PG8_SCHED;
            } else {
            PG8_LDB(B0, 0, 0); PG8_SCHED; PG8_LDA(At, 0, 0); PG8_STAGE(PG8_SA(1, 1), a1 + hstep, voffA);
            PG8_WAIT_L(8); PG8_BAR; PG8_WAIT_L(0); PG8_MMA(0, 0, At, B0); PG8_BAR; PG8_SCHED;
            PG8_LDB(B1, 0, 1); PG8_STAGE(PG8_SB(0, 0), b2, voffB);
            PG8_BAR; PG8_WAIT_L(0); PG8_MMA(0, 1, At, B1); PG8_BAR;
            PG8_LDA(At, 0, 1); PG8_STAGE(PG8_SA(0, 0), a2, voffA);
            PG8_BAR; PG8_WAIT_L(0); PG8_MMA(1, 0, At, B0); PG8_BAR; PG8_SCHED;
            PG8_STAGE(PG8_SB(0, 1), b2 + hstep, voffB);
            PG8_WAIT_V(6); PG8_BAR; PG8_MMA(1, 1, At, B1); PG8_BAR;
            PG8_LDB(B0, 1, 0); PG8_SCHED; PG8_LDA(At, 1, 0); PG8_STAGE(PG8_SA(0, 1), a2 + hstep, voffA);
            PG8_WAIT_L(8); PG8_BAR; PG8_WAIT_L(0); PG8_MMA(0, 0, At, B0); PG8_BAR; PG8_SCHED;
            PG8_LDB(B1, 1, 1); PG8_STAGE(PG8_SB(1, 0), b3, voffB);
            PG8_BAR; PG8_WAIT_L(0); PG8_MMA(0, 1, At, B1); PG8_BAR;
            PG8_LDA(At, 1, 1); PG8_STAGE(PG8_SA(1, 0), a3, voffA);
            PG8_BAR; PG8_WAIT_L(0); PG8_MMA(1, 0, At, B0); PG8_BAR; PG8_SCHED;
            PG8_STAGE(PG8_SB(1, 1), b3 + hstep, voffB);
            PG8_WAIT_V(6); PG8_BAR; PG8_MMA(1, 1, At, B1); PG8_BAR;
            }
        }
        if constexpr (ALIGN_EPI) { if (wr == 0) PG8_BAR; }
        if constexpr (!Epi::AFTER_DRAIN) { E(acc, cur, wr, wc, fr, fq); S.done(cur); }
        if (!has_next) break;
#pragma unroll
        for (int a = 0; a < 2; ++a)
#pragma unroll
            for (int b = 0; b < 2; ++b)
#pragma unroll
                for (int m = 0; m < 4; ++m)
#pragma unroll
                    for (int n = 0; n < 2; ++n) acc[a][b][m][n] = (f32x4){0.f, 0.f, 0.f, 0.f};
        cur = nxt; cA = nA; cB = nB; ++ui;
        if constexpr (ALIGN_EPI) { if (wr == 1) PG8_BAR; }
    }
    PG8_WAIT_V(0);
    if constexpr (!ALIGN_EPI) { if (wr == 0) PG8_BAR; }
    PG8_BAR;
    if constexpr (Epi::AFTER_DRAIN) { E.fused(acc, cur, wr, wc, fr, fq, lds, wid, lane); S.done(cur); }
#undef PG8_SA
#undef PG8_SB
#undef PG8_STAGE
#undef PG8_LDA
#undef PG8_LDB
#undef PG8_MMA
#undef PG8_WAIT_V
#undef PG8_WAIT_L
#undef PG8_BAR
#undef PG8_SCHED
}
}

typedef unsigned short bf16_t;
typedef float f32x4 __attribute__((ext_vector_type(4)));
typedef unsigned u32x4 __attribute__((ext_vector_type(4)));
typedef unsigned u32x2 __attribute__((ext_vector_type(2)));

constexpr int D = 1024, NIN = 8448, DR = 1024, UW = 6400  , URW = 2048  ;
constexpr int SLAB = 16384, NTOK = 49152;
constexpr float DN_ALPHA = 1.189207115002721f;
constexpr size_t WS_WIN = 0;
constexpr size_t WS_WOUT = WS_WIN + (size_t)NIN * D * 2;
constexpr size_t WS_STATS = WS_WOUT + (size_t)D * 2048 * 2;
constexpr size_t WS_XN = WS_STATS + (size_t)NTOK * 2 * 4;
constexpr size_t WS_U = WS_XN + (size_t)SLAB * D * 2;
constexpr size_t WS_YS = WS_U + (size_t)SLAB * UW * 2;
constexpr size_t WS_BON = WS_YS + (size_t)2 * SLAB * DR * 4;
constexpr size_t WS_YMIX = WS_BON + (size_t)2 * SLAB * 16 * 4;
constexpr size_t WS_TMP = WS_YS;
constexpr size_t WS_PQ = WS_YMIX;
constexpr size_t WS_SST = WS_YMIX + (size_t)SLAB * 2048 * 2;
constexpr size_t WS_BAR = WS_SST + (size_t)2048 * 4096 * 4;
constexpr size_t WS_END = WS_BAR + 16384;
static_assert(WS_END <= (size_t)512 * 1024 * 1024, "ws map");
constexpr int LDS_BYTES = 147456;

struct Params { const float* in[20]; float* out; unsigned char* ws; };
typedef const Params __attribute__((address_space(4)))* KP;
#define KP_FRESH(p) asm volatile("" : "+s"(p))
__device__ __forceinline__ int hw_tid(int wid0) { int l; asm volatile("v_mbcnt_lo_u32_b32 %0, -1, 0\n\tv_mbcnt_hi_u32_b32 %0, -1, %0" : "=v"(l)); return wid0 * 64 + l; }
enum { I_XP = 0, I_XS, I_EG, I_EB, I_WIN, I_CW, I_CB, I_MU, I_W0, I_WUP, I_A0, I_AUP, I_KK, I_KA, I_RK, I_LXG, I_LXB, I_WOUT, I_LG, I_LB };

__device__ __forceinline__ float bf2f(unsigned short h) { return __uint_as_float((unsigned)h << 16); }
__device__ __forceinline__ unsigned f2bf(float f) { unsigned u = __float_as_uint(f); return (u + 0x7fffu + ((u >> 16) & 1u)) >> 16; }
__device__ __forceinline__ unsigned pk2(float lo, float hi) { return f2bf(lo) | (f2bf(hi) << 16); }
typedef __bf16 bf16x2e_t __attribute__((ext_vector_type(2)));
typedef float f32x2e __attribute__((ext_vector_type(2)));
__device__ __forceinline__ unsigned cvtpk_(float lo, float hi) { f32x2e v = {lo, hi}; bf16x2e_t b = __builtin_convertvector(v, bf16x2e_t); return __builtin_bit_cast(unsigned, b); }
__device__ __forceinline__ float shx(float v, int lane, int o) { return __int_as_float(__builtin_amdgcn_ds_bpermute((lane ^ o) << 2, __float_as_int(v))); }
__device__ __forceinline__ float wsum(float v, int lane) {
#pragma unroll
    for (int o = 32; o; o >>= 1) v += shx(v, lane, o);
    return v;
}
__device__ __forceinline__ float sigmoidf_(float x) { return 1.f / (1.f + __expf(-x)); }
__device__ __forceinline__ float siluf_(float x) { return x * sigmoidf_(x); }
__device__ __forceinline__ float rl(float v, int l) { return __int_as_float(__builtin_amdgcn_readlane(__float_as_int(v), l)); }

__device__ __forceinline__ void slab_info(int s, int& tok0, int& nseq, int& T) { if (s == 0) { tok0 = 0; nseq = 8; T = 2048; } else { tok0 = SLAB * s; nseq = 1; T = 16384; } }
__device__ __forceinline__ const float* slab_x(KP p, int s) { return s == 0 ? p->in[I_XP] : p->in[I_XS] + (size_t)(s - 1) * SLAB * D; }

__device__ __forceinline__ int orig_col(int jv) {
    if (jv >= 4096) return jv;
    const int pn = jv >> 8, bj = (jv >> 7) & 1, wc = (jv >> 5) & 3, fq = (jv >> 3) & 3, n = (jv >> 2) & 1, j = jv & 3;
    return (2 * bj + n) * 1024 + 64 * pn + 16 * wc + 4 * fq + j;
}

__device__ void phase_weights(KP p, int wid0) {
    KP_FRESH(p);
    int gt = blockIdx.x * 512 + hw_tid(wid0); asm volatile("" : "+v"(gt)); const int nt = gridDim.x * 512;
    bf16_t* win = (bf16_t*)(p->ws + WS_WIN); bf16_t* wout = (bf16_t*)(p->ws + WS_WOUT);
    const float* w_in = p->in[I_WIN]; const float* w_out = p->in[I_WOUT];
    for (int idx = gt; idx < NIN * 128; idx += nt) {
        const int jv = idx % NIN, kg = idx / NIN, oc = orig_col(jv);
        float v[8];
#pragma unroll
        for (int i = 0; i < 8; ++i) v[i] = w_in[(size_t)(kg * 8 + i) * NIN + oc];
        u32x4 w; w.x = pk2(v[0], v[1]); w.y = pk2(v[2], v[3]); w.z = pk2(v[4], v[5]); w.w = pk2(v[6], v[7]);
        *(u32x4*)(win + (size_t)jv * D + kg * 8) = w;
    }
    for (int idx = gt; idx < D * 256; idx += nt) {
        const int n = idx % D, kg = idx / D;
        float v[8];
#pragma unroll
        for (int i = 0; i < 8; ++i) v[i] = w_out[(size_t)(kg * 8 + i) * D + n];
        u32x4 w; w.x = pk2(v[0], v[1]); w.y = pk2(v[2], v[3]); w.z = pk2(v[4], v[5]); w.w = pk2(v[6], v[7]);
        *(u32x4*)(wout + (size_t)n * 2048 + kg * 8) = w;
    }
}

__device__ __forceinline__ bf16_t* xn_buf(KP p, int s) { return s == 1 ? (bf16_t*)(p->out + (size_t)2 * SLAB * D) : (bf16_t*)(p->ws + WS_XN); }
__device__ __forceinline__ void phase_ln(KP p, int s, int wid0, int wg0) {
    KP_FRESH(p);
    int tid_ = hw_tid(wid0); asm volatile("" : "+v"(tid_)); int lane = tid_ & 63; const int gw = ((int)blockIdx.x - wg0) * 8 + (tid_ >> 6), nw = ((int)gridDim.x - wg0) * 8;
    const float* x = slab_x(p, s); bf16_t* xn = xn_buf(p, s); float* stats = (float*)(p->ws + WS_STATS) + (size_t)s * SLAB * 2;
    const float4* g4 = (const float4*)p->in[I_EG]; const float4* b4 = (const float4*)p->in[I_EB];
    for (int gi = gw; gi < SLAB / 4; gi += nw) {
        const int r0 = gi * 4;
        asm volatile("" : "+v"(lane));
        float4 v[4][4];
#pragma unroll
        for (int k = 0; k < 4; ++k)
#pragma unroll
            for (int i = 0; i < 4; ++i) v[k][i] = ((const float4*)(x + (size_t)(r0 + k) * D))[lane + 64 * i];
#pragma unroll
        for (int k = 0; k < 4; ++k) {
            const int r = r0 + k;
            float sum = 0.f;
#pragma unroll
            for (int i = 0; i < 4; ++i) sum += v[k][i].x + v[k][i].y + v[k][i].z + v[k][i].w;
            const float mean = wsum(sum, lane) * (1.f / 1024.f);
            float sq = 0.f;
#pragma unroll
            for (int i = 0; i < 4; ++i) { float a = v[k][i].x - mean, b = v[k][i].y - mean, c = v[k][i].z - mean, d = v[k][i].w - mean; sq += a * a + b * b + c * c + d * d; }
            const float rstd = rsqrtf(wsum(sq, lane) * (1.f / 1024.f) + 1e-5f);
            if (lane == 0) { stats[r * 2] = mean; stats[r * 2 + 1] = rstd; }
#pragma unroll
            for (int i = 0; i < 4; ++i) {
                const float4 g = g4[lane + 64 * i], b = b4[lane + 64 * i];
                u32x2 w; w.x = cvtpk_((v[k][i].x - mean) * rstd * g.x + b.x, (v[k][i].y - mean) * rstd * g.y + b.y);
                w.y = cvtpk_((v[k][i].z - mean) * rstd * g.z + b.z, (v[k][i].w - mean) * rstd * g.w + b.w);
                *(u32x2*)(xn + (size_t)r * D + (lane + 64 * i) * 4) = w;
            }
        }
    }
}

struct EpiU {
    static constexpr bool PERM = true, AFTER_DRAIN = false;
    bf16_t* U; bf16_t* TMP;
    __device__ __forceinline__ void operator()(const f32x4 (&acc)[2][2][4][2], const pg8::Unit& u, int wr, int wc, int fr, int fq) const {
        const int row0 = u.pm * 256 + wr * 64 + fr;
        if (u.pn < 16) {
            const int ch0 = 64 * u.pn + 16 * wc + 4 * fq;
#pragma unroll
            for (int ai = 0; ai < 2; ++ai)
#pragma unroll
                for (int m = 0; m < 4; ++m) {
                    bf16_t* rowp = U + (size_t)(row0 + ai * 128 + m * 16) * UW + ch0;
                    const f32x4 h = acc[ai][0][m][0], B = acc[ai][0][m][1], C = acc[ai][1][m][0], z = acc[ai][1][m][1];
                    float pp[4], gg[4];
#pragma unroll
                    for (int j = 0; j < 4; ++j) { pp[j] = C[j] * h[j]; gg[j] = B[j] * siluf_(z[j]); }
                    u32x2 w0; w0.x = pk2(pp[0], pp[1]); w0.y = pk2(pp[2], pp[3]);
                    u32x2 w1; w1.x = pk2(gg[0], gg[1]); w1.y = pk2(gg[2], gg[3]);
                    *(u32x2*)rowp = w0; *(u32x2*)(rowp + 1024) = w1;
                }
        } else {
            const int col0 = 256 * (u.pn - 16) + 32 * wc + 8 * fq; const bool zt = (u.pn >= 28) && (u.pn < 32);
#pragma unroll
            for (int ai = 0; ai < 2; ++ai)
#pragma unroll
                for (int m = 0; m < 4; ++m) {
                    bf16_t* rowp = zt ? U + (size_t)(row0 + ai * 128 + m * 16) * UW + URW + col0 : TMP + (size_t)(row0 + ai * 128 + m * 16) * 4352 + col0;
#pragma unroll
                    for (int bj = 0; bj < 2; ++bj) {
                        const f32x4 v0 = acc[ai][bj][m][0], v1 = acc[ai][bj][m][1];
                        u32x4 w; w.x = pk2(v0[0], v0[1]); w.y = pk2(v0[2], v0[3]); w.z = pk2(v1[0], v1[1]); w.w = pk2(v1[2], v1[3]);
                        *(u32x4*)(rowp + bj * 128) = w;
                    }
                }
        }
    }
};

struct EpiOut {
    static constexpr bool PERM = true, AFTER_DRAIN = false;
    float* out; const float* x; const float* stats; const float* eg; const float* eb;
    __device__ __forceinline__ void operator()(const f32x4 (&acc)[2][2][4][2], const pg8::Unit& u, int wr, int wc, int fr, int fq) const {
        const int row0 = u.pm * 256 + wr * 64 + fr, col0 = u.pn * 256 + wc * 32 + 8 * fq;
#pragma unroll
        for (int ai = 0; ai < 2; ++ai)
#pragma unroll
            for (int m = 0; m < 4; ++m) {
                const int row = row0 + ai * 128 + m * 16;
                const float mean = stats[row * 2], rstd = stats[row * 2 + 1];
#pragma unroll
                for (int bj = 0; bj < 2; ++bj)
#pragma unroll
                    for (int n = 0; n < 2; ++n) {
                        const int c = col0 + bj * 128 + 4 * n;
                        const float4 xv = *(const float4*)(x + (size_t)row * D + c), g = *(const float4*)(eg + c), b = *(const float4*)(eb + c);
                        const f32x4 a = acc[ai][bj][m][n];
                        float4 o;
                        o.x = DN_ALPHA * ((xv.x - mean) * rstd * g.x + b.x) + a[0]; o.y = DN_ALPHA * ((xv.y - mean) * rstd * g.y + b.y) + a[1];
                        o.z = DN_ALPHA * ((xv.z - mean) * rstd * g.z + b.z) + a[2]; o.w = DN_ALPHA * ((xv.w - mean) * rstd * g.w + b.w) + a[3];
                        *(float4*)(out + (size_t)row * D + c) = o;
                    }
            }
    }
};

typedef short bf16x8 __attribute__((ext_vector_type(8)));
typedef short s16x4 __attribute__((ext_vector_type(4)));
typedef __bf16 bf16x2_t __attribute__((ext_vector_type(2)));
typedef float f32x2 __attribute__((ext_vector_type(2)));
#define MFMA16(a, b, c) __builtin_amdgcn_mfma_f32_16x16x32_bf16((a), (b), (c), 0, 0, 0)
#define DI __device__ __forceinline__
constexpr int IMG_STRIDE = 144;
constexpr int WG_FRAG = 0;
constexpr int WG_CONST = 16384;
constexpr int WV_BASE = 16384 + 2560;
constexpr int WV_BYTES = 3 * 16 * IMG_STRIDE + 256;
static_assert(WV_BASE + 8 * WV_BYTES <= LDS_BYTES, "scan LDS map");

DI unsigned cvtpk(float lo, float hi) { f32x2 v = {lo, hi}; bf16x2_t b = __builtin_convertvector(v, bf16x2_t); return __builtin_bit_cast(unsigned, b); }
DI bf16x8 mkfrag(unsigned a, unsigned b, unsigned c, unsigned d) { u32x4 w = {a, b, c, d}; return __builtin_bit_cast(bf16x8, w); }
DI bf16x8 frag_f4(f32x4 a, f32x4 b) { return mkfrag(cvtpk(a[0], a[1]), cvtpk(a[2], a[3]), cvtpk(b[0], b[1]), cvtpk(b[2], b[3])); }
DI float bperm(float v, int srclane) { return __int_as_float(__builtin_amdgcn_ds_bpermute(srclane << 2, __float_as_int(v))); }
DI float lo16(unsigned w) { return __uint_as_float(w << 16); }
DI float hi16(unsigned w) { return __uint_as_float(w & 0xffff0000u); }
template <int CTRL> DI float dpp0(float x) { return __int_as_float(__builtin_amdgcn_update_dpp(0, __float_as_int(x), CTRL, 0xf, 0xf, true)); }
template <int CTRL> DI float dpp1(float x) { return __int_as_float(__builtin_amdgcn_update_dpp(0x3f800000, __float_as_int(x), CTRL, 0xf, 0xf, false)); }
DI float fsig(float x) { return __builtin_amdgcn_rcpf(1.f + __expf(-x)); }
DI f32x4 ld4(const bf16_t* ur) { const u32x2 c = *(const u32x2*)ur; return (f32x4){lo16(c.x), hi16(c.x), lo16(c.y), hi16(c.y)}; }

DI void split_frag(f32x4 a, f32x4 b, bf16x8& hi, bf16x8& lo) {
    f32x4 ah, bh;
    unsigned w[4] = {cvtpk(a[0], a[1]), cvtpk(a[2], a[3]), cvtpk(b[0], b[1]), cvtpk(b[2], b[3])};
    ah[0] = lo16(w[0]); ah[1] = hi16(w[0]); ah[2] = lo16(w[1]); ah[3] = hi16(w[1]); bh[0] = lo16(w[2]); bh[1] = hi16(w[2]); bh[2] = lo16(w[3]); bh[3] = hi16(w[3]);
    hi = mkfrag(w[0], w[1], w[2], w[3]); lo = frag_f4(a - ah, b - bh);
}
struct ChunkIn { u32x2 k[4], r[4], v[4]; bf16x8 tl[2], la[2]; };
template <int PASS> DI void chunk_load(ChunkIn& c, const bf16_t* ur, int h, int d, int q) {
#pragma unroll
    for (int n = 0; n < 4; ++n) {
        c.k[n] = *(const u32x2*)(ur + 1024 + h * 64 + 16 * n + 4 * q);
        if (PASS == 2) { c.v[n] = *(const u32x2*)(ur + 2048 + h * 64 + 16 * n + 4 * q); c.r[n] = *(const u32x2*)(ur + h * 64 + 16 * n + 4 * q); }
    }
#pragma unroll
    for (int ks = 0; ks < 2; ++ks) { const bf16_t* ul = ur + 4096 + d * 64 + 32 * ks + 8 * q; c.tl[ks] = *(const bf16x8*)ul; c.la[ks] = *(const bf16x8*)(ul + 128); }
}
DI f32x4 up4(u32x2 c) { return (f32x4){lo16(c.x), hi16(c.x), lo16(c.y), hi16(c.y)}; }
template <int PASS>
__device__ void phase_scan(KP p, int s, unsigned char* ldsg, int wid0) {
    KP_FRESH(p);
    const int wid = wid0;
    int tok0, nseq, T; slab_info(s, tok0, nseq, T);
    const int LS = 256, lgseg = (s == 0) ? 3 : 6, nseg = 1 << lgseg, nblk = (nseq * 32 << lgseg) >> 3;
    const bf16_t* U = (const bf16_t*)(p->ws + WS_U);
    bf16_t* YS = (bf16_t*)(p->ws + WS_YS); float* BON = (float*)(p->ws + WS_BON);
    float* PQ = (float*)(p->ws + WS_PQ); const float* SST = (const float*)(p->ws + WS_SST);
    float* cst = (float*)(ldsg + WG_CONST);
    const int wo = WV_BASE + wid * WV_BYTES;
    for (int ib = blockIdx.x; ib < nblk; ib += gridDim.x) {
        const int item = ib * 8 + wid, g = item & (nseg - 1), chain = item >> lgseg, h = chain & 15, d = (chain >> 4) & 1, b = chain >> 5;
        const int tid = hw_tid(wid0), lane = tid & 63, fr = lane & 15, q = lane >> 4;
        __syncthreads();
        if (tid < 64) {
            const float* mu = p->in[I_MU]; const int c = h * 64 + tid;
            cst[tid] = mu[c]; cst[64 + tid] = mu[1024 + c]; cst[128 + tid] = mu[2048 + c];
            cst[192 + tid] = -1.44269504f * p->in[I_W0][d * 1024 + c]; cst[256 + tid] = -1.44269504f * p->in[I_A0][d * 1024 + c];
            cst[320 + tid] = p->in[I_KK][c]; cst[384 + tid] = p->in[I_KA][c]; cst[448 + tid] = p->in[I_RK][c];
            cst[512 + tid] = mu[4096 + d * 64 + tid]; cst[576 + tid] = mu[4096 + 128 + d * 64 + tid];
        }
        for (int e = tid; e < 1024; e += 512) {
            const int l2 = e & 63, ks = (e >> 6) & 1, mt = (e >> 7) & 3, mat = e >> 9, fr2 = l2 & 15, q2 = l2 >> 4;
            const float* src = (mat ? p->in[I_AUP] : p->in[I_WUP]) + ((size_t)d * 64 + 32 * ks + 8 * q2) * 1024 + h * 64 + 16 * mt + fr2;
            float v8[8];
#pragma unroll
            for (int jj = 0; jj < 8; ++jj) v8[jj] = -1.44269504f * src[(size_t)jj * 1024];
            u32x4 w = {cvtpk(v8[0], v8[1]), cvtpk(v8[2], v8[3]), cvtpk(v8[4], v8[5]), cvtpk(v8[6], v8[7])};
            *(u32x4*)(ldsg + WG_FRAG + e * 16) = w;
        }
        __syncthreads();
        f32x4 St[4][4];
        f32x4 Pa[PASS == 1 ? 4 : 1][PASS == 1 ? 4 : 1];
        int l3 = lane; asm volatile("" : "+v"(l3));
        const float* sstl = SST + (size_t)item * 4096 + l3 * 4;
#pragma unroll
        for (int mt = 0; mt < 4; ++mt)
#pragma unroll
            for (int nt = 0; nt < 4; ++nt) {
                if (PASS == 1) {
#pragma unroll
                    for (int j = 0; j < 4; ++j) { St[mt][nt][j] = 0.f; Pa[PASS == 1 ? mt : 0][PASS == 1 ? nt : 0][j] = (16 * mt + 4 * q + j == 16 * nt + fr) ? 1.f : 0.f; }
                } else {
                    St[mt][nt] = *(const f32x4*)(sstl + (mt * 4 + nt) * 256);
                }
            }
        ChunkIn cin;
        { const int p0 = g * LS, t0 = d ? T - 1 - (p0 + fr) : p0 + fr; chunk_load<PASS>(cin, U + (size_t)(b * T + t0) * UW + URW, h, d, q); }
        for (int ck = 0; ck < LS / 16; ++ck) {
            const int pos0 = g * LS + ck * 16;
            const int lane_c = hw_tid(wid0) & 63;
            const int lane = lane_c, fr = lane_c & 15, q = lane_c >> 4;
            const int ti = d ? T - 1 - (pos0 + fr) : pos0 + fr, row = b * T + ti;
            ChunkIn cc = cin;
            if (PASS == 1) {
#pragma unroll
                for (int n = 0; n < 4; ++n) cc.v[n] = *(const u32x2*)(U + (size_t)row * UW + URW + 2048 + h * 64 + 16 * n + 4 * q);
            }
            {
                const int pn = g * LS + (ck + 1 < LS / 16 ? ck + 1 : ck) * 16, tn = d ? T - 1 - (pn + fr) : pn + fr;
                chunk_load<PASS>(cin, U + (size_t)(b * T + tn) * UW + URW, h, d, q);
            }
            const int lq16 = 16 * q, ll16 = 16 * lane, limg = fr * IMG_STRIDE + 8 * q, ltr = (4 * q + (fr >> 2)) * IMG_STRIDE + 8 * (fr & 3);
            f32x4 ow[4], oa[4];
            {
                const bf16x8 tlf[2] = {cc.tl[0], cc.tl[1]}, laf[2] = {cc.la[0], cc.la[1]};
#pragma unroll
                for (int mt = 0; mt < 4; ++mt) {
                    const bf16x8 w0f = *(const bf16x8*)(ldsg + WG_FRAG + ((0 * 4 + mt) * 2 + 0) * 1024 + ll16), w1f = *(const bf16x8*)(ldsg + WG_FRAG + ((0 * 4 + mt) * 2 + 1) * 1024 + ll16);
                    const bf16x8 a0f = *(const bf16x8*)(ldsg + WG_FRAG + ((1 * 4 + mt) * 2 + 0) * 1024 + ll16), a1f = *(const bf16x8*)(ldsg + WG_FRAG + ((1 * 4 + mt) * 2 + 1) * 1024 + ll16);
                    f32x4 z = {0.f, 0.f, 0.f, 0.f};
                    ow[mt] = MFMA16(w1f, tlf[1], MFMA16(w0f, tlf[0], z));
                    oa[mt] = MFMA16(a1f, laf[1], MFMA16(a0f, laf[0], z));
                }
            }
            f32x4 km[4]; float ss = 0.f;
#pragma unroll
            for (int n = 0; n < 4; ++n) {
                km[n] = up4(cc.k[n]);
                const f32x4 kr = km[n] * *(const f32x4*)(ldsg + WG_CONST + (320 + 16 * n) * 4 + lq16);
                ss += kr[0] * kr[0] + kr[1] * kr[1] + kr[2] * kr[2] + kr[3] * kr[3];
            }
            ss += bperm(ss, lane ^ 16); ss += bperm(ss, lane ^ 32);
            const float kinv = 1.f / fmaxf(sqrtf(ss), 1e-12f);
            u32x2 kapP[4], ktP[4], btP[4], rtP[4]; float bon = 0.f;
#pragma unroll
            for (int n = 0; n < 4; ++n) {
                const int co = 16 * n + 4 * q;
                const f32x4 w0v = *(const f32x4*)(ldsg + WG_CONST + (192 + 16 * n) * 4 + lq16), a0v = *(const f32x4*)(ldsg + WG_CONST + (256 + 16 * n) * 4 + lq16), kkw = *(const f32x4*)(ldsg + WG_CONST + (320 + 16 * n) * 4 + lq16), kav = *(const f32x4*)(ldsg + WG_CONST + (384 + 16 * n) * 4 + lq16);
                f32x4 lw, av, L, gmv;
#pragma unroll
                for (int j = 0; j < 4; ++j) { lw[j] = -0.87503877f * __builtin_amdgcn_rcpf(1.f + __builtin_amdgcn_exp2f(w0v[j] + ow[n][j])); av[j] = __builtin_amdgcn_rcpf(1.f + __builtin_amdgcn_exp2f(a0v[j] + oa[n][j])); }
#pragma unroll
                for (int j = 0; j < 4; ++j) {
                    float x = __builtin_amdgcn_exp2f(lw[j]);
                    x *= dpp1<0x111>(x); x *= dpp1<0x112>(x); x *= dpp1<0x114>(x); x *= dpp1<0x118>(x);
                    L[j] = x; lw[j] = dpp1<0x111>(x); gmv[j] = dpp0<0x121>(x);
                }
                f32x4 kap, kt, bt;
#pragma unroll
                for (int j = 0; j < 4; ++j) {
                    const float eL = L[j], emL = __builtin_amdgcn_rcpf(L[j]), eLm = lw[j];
                    const float kk = km[n][j] * kkw[j] * kinv, kd = km[n][j] * (1.f + (av[j] - 1.f) * kav[j]);
                    kap[j] = kk * eLm; bt[j] = kk * av[j] * emL; kt[j] = kd * emL;
                    if (PASS == 2) { lw[j] = eL; av[j] = kd; }
                }
                if (fr == 0) *(f32x4*)(ldsg + wo + 48 * IMG_STRIDE + 64 * n + lq16) = gmv;
                kapP[n] = (u32x2){cvtpk(kap[0], kap[1]), cvtpk(kap[2], kap[3])};
                ktP[n] = (u32x2){cvtpk(kt[0], kt[1]), cvtpk(kt[2], kt[3])};
                btP[n] = (u32x2){cvtpk(bt[0], bt[1]), cvtpk(bt[2], bt[3])};
                *(u32x2*)(ldsg + wo + 16 * IMG_STRIDE + 32 * n + limg) = ktP[n];
                *(u32x2*)(ldsg + wo + 32 * IMG_STRIDE + 32 * n + limg) = btP[n];
                if (PASS == 2) {
                    const f32x4 rm = up4(cc.r[n]), rk = *(const f32x4*)(ldsg + WG_CONST + (448 + 16 * n) * 4 + lq16);
                    rtP[n] = (u32x2){cvtpk(rm[0] * lw[0], rm[1] * lw[1]), cvtpk(rm[2] * lw[2], rm[3] * lw[3])};
                    bon += rm[0] * av[0] * rk[0] + rm[1] * av[1] * rk[1] + rm[2] * av[2] * rk[2] + rm[3] * av[3] * rk[3];
                }
                *(u32x2*)(ldsg + wo + 32 * n + limg) = cc.v[n];
            }
            if (PASS == 2) {
                bon += bperm(bon, lane ^ 16); bon += bperm(bon, lane ^ 32);
                if (q == 0) BON[((size_t)d * SLAB + row) * 16 + h] = 0.5f * bon;
            }
            const bf16x8 kapF0 = mkfrag(kapP[0].x, kapP[0].y, kapP[1].x, kapP[1].y), kapF1 = mkfrag(kapP[2].x, kapP[2].y, kapP[3].x, kapP[3].y);
            bf16x8 akkA, tA, aryA;
            {
                const bf16x8 ktF0 = mkfrag(ktP[0].x, ktP[0].y, ktP[1].x, ktP[1].y), ktF1 = mkfrag(ktP[2].x, ktP[2].y, ktP[3].x, ktP[3].y);
                const bf16x8 btF0 = mkfrag(btP[0].x, btP[0].y, btP[1].x, btP[1].y), btF1 = mkfrag(btP[2].x, btP[2].y, btP[3].x, btP[3].y);
                const f32x4 z = {0.f, 0.f, 0.f, 0.f};
                f32x4 akk = MFMA16(ktF1, kapF1, MFMA16(ktF0, kapF0, z));
                f32x4 nn = MFMA16(kapF1, btF1, MFMA16(kapF0, btF0, z));
                f32x4 na = MFMA16(btF1, kapF1, MFMA16(btF0, kapF0, z));
                f32x4 idv;
#pragma unroll
                for (int jj = 0; jj < 4; ++jj) {
                    akk[jj] = (4 * q + jj < fr) ? akk[jj] : 0.f; nn[jj] = (fr < 4 * q + jj) ? nn[jj] : 0.f; na[jj] = (4 * q + jj < fr) ? na[jj] : 0.f;
                    idv[jj] = (4 * q + jj == fr) ? 1.f : 0.f;
                }
                akkA = mkfrag(cvtpk(akk[0], akk[1]), cvtpk(akk[2], akk[3]), 0u, 0u);
                if (PASS == 2) {
                    const bf16x8 rtF0 = mkfrag(rtP[0].x, rtP[0].y, rtP[1].x, rtP[1].y), rtF1 = mkfrag(rtP[2].x, rtP[2].y, rtP[3].x, rtP[3].y);
                    f32x4 ark = MFMA16(ktF1, rtF1, MFMA16(ktF0, rtF0, z));
                    f32x4 arb = MFMA16(btF1, rtF1, MFMA16(btF0, rtF0, z));
#pragma unroll
                    for (int jj = 0; jj < 4; ++jj) { ark[jj] = (4 * q + jj <= fr) ? ark[jj] : 0.f; arb[jj] = (4 * q + jj <= fr) ? arb[jj] : 0.f; }
                    aryA = mkfrag(cvtpk(ark[0], ark[1]), cvtpk(ark[2], ark[3]), cvtpk(arb[0], arb[1]), cvtpk(arb[2], arb[3]));
                }
#define TF(x) mkfrag(cvtpk((x)[0], (x)[1]), cvtpk((x)[2], (x)[3]), 0u, 0u)
                const bf16x8 nF = TF(nn), aF = TF(na);
                const f32x4 n2 = MFMA16(aF, nF, z), a2 = MFMA16(nF, aF, z);
                const bf16x8 n2F = TF(n2), a2F = TF(a2);
                const f32x4 n4 = MFMA16(a2F, n2F, z), a4 = MFMA16(n2F, a2F, z);
                const bf16x8 n4F = TF(n4), a4F = TF(a4);
                const f32x4 n8 = MFMA16(a4F, n4F, z);
                const f32x4 t21 = MFMA16(n2F, aF, z);
                f32x4 R = idv - na + a2 - t21;
                R = MFMA16(n4F, TF(R), R);
                R = MFMA16(TF(n8), TF(R), R);
                tA = TF(R);
#undef TF
            }
            s16x4 Vc[4], Kc[4], Bc[4];
            {
                typedef s16x4 __attribute__((address_space(3)))* lp;
#pragma unroll
                for (int t4 = 0; t4 < 4; ++t4) {
                    Vc[t4] = __builtin_amdgcn_ds_read_tr16_b64_v4i16((lp)(ldsg + wo + ltr + 32 * t4));
                    Kc[t4] = __builtin_amdgcn_ds_read_tr16_b64_v4i16((lp)(ldsg + wo + 16 * IMG_STRIDE + ltr + 32 * t4));
                    Bc[t4] = __builtin_amdgcn_ds_read_tr16_b64_v4i16((lp)(ldsg + wo + 32 * IMG_STRIDE + ltr + 32 * t4));
                }
            }
            bf16x8 kbA[4];
#pragma unroll
            for (int mt = 0; mt < 4; ++mt) kbA[mt] = __builtin_shufflevector(Kc[mt], Bc[mt], 0, 1, 2, 3, 4, 5, 6, 7);
#pragma unroll
            for (int nt = 0; nt < 4; ++nt) {
                const f32x4 z = {0.f, 0.f, 0.f, 0.f};
                const bf16x8 stf0 = frag_f4(St[0][nt], St[1][nt]), stf1 = frag_f4(St[2][nt], St[3][nt]);
                const u32x2 vcu = __builtin_bit_cast(u32x2, Vc[nt]);
                f32x4 X = MFMA16(kapF1, stf1, MFMA16(kapF0, stf0, z));
                X = MFMA16(akkA, mkfrag(vcu.x, vcu.y, 0u, 0u), X);
                const f32x4 Uu = MFMA16(tA, mkfrag(cvtpk(X[0], X[1]), cvtpk(X[2], X[3]), 0u, 0u), z);
                const bf16x8 bvu = mkfrag(vcu.x, vcu.y, cvtpk(-Uu[0], -Uu[1]), cvtpk(-Uu[2], -Uu[3]));
                if (PASS == 2) {
                    const bf16x8 rtF0 = mkfrag(rtP[0].x, rtP[0].y, rtP[1].x, rtP[1].y), rtF1 = mkfrag(rtP[2].x, rtP[2].y, rtP[3].x, rtP[3].y);
                    f32x4 Y = MFMA16(rtF1, stf1, MFMA16(rtF0, stf0, z));
                    Y = MFMA16(aryA, bvu, Y);
#pragma unroll
                    for (int jj = 0; jj < 4; ++jj) {
                        const int i = 4 * q + jj, t2 = d ? T - 1 - (pos0 + i) : pos0 + i;
                        YS[((size_t)d * SLAB + b * T + t2) * DR + h * 64 + 16 * nt + fr] = (bf16_t)(cvtpk(Y[jj], 0.f) & 0xffffu);
                    }
                }
#pragma unroll
                for (int mt = 0; mt < 4; ++mt) St[mt][nt] = MFMA16(kbA[mt], bvu, St[mt][nt]) * *(const f32x4*)(ldsg + wo + 48 * IMG_STRIDE + 64 * mt + lq16);
            }
            if (PASS == 1) {
#pragma unroll
                for (int ct = 0; ct < 4; ++ct) {
                    const f32x4 z = {0.f, 0.f, 0.f, 0.f};
                    const bf16x8 pf0 = frag_f4(Pa[0][PASS == 1 ? ct : 0], Pa[PASS == 1 ? 1 : 0][PASS == 1 ? ct : 0]), pf1 = frag_f4(Pa[PASS == 1 ? 2 : 0][PASS == 1 ? ct : 0], Pa[PASS == 1 ? 3 : 0][PASS == 1 ? ct : 0]);
                    const f32x4 X = MFMA16(kapF1, pf1, MFMA16(kapF0, pf0, z));
                    const f32x4 Uu = MFMA16(tA, mkfrag(cvtpk(X[0], X[1]), cvtpk(X[2], X[3]), 0u, 0u), z);
                    const bf16x8 bvu = mkfrag(0u, 0u, cvtpk(-Uu[0], -Uu[1]), cvtpk(-Uu[2], -Uu[3]));
#pragma unroll
                    for (int mt = 0; mt < 4; ++mt) Pa[PASS == 1 ? mt : 0][PASS == 1 ? ct : 0] = MFMA16(kbA[mt], bvu, Pa[PASS == 1 ? mt : 0][PASS == 1 ? ct : 0]) * *(const f32x4*)(ldsg + wo + 48 * IMG_STRIDE + 64 * mt + lq16);
                }
            }
        }
        if (PASS == 1) {
            const int l2 = hw_tid(wid0) & 63, fr2 = l2 & 15, q2 = l2 >> 4;
            unsigned char* pqb = (unsigned char*)(PQ + (size_t)item * 8192);
            float* tl = (float*)(ldsg + wo);
#pragma unroll
            for (int mt = 0; mt < 4; ++mt)
#pragma unroll
                for (int ks = 0; ks < 2; ++ks) {
#pragma unroll
                    for (int e = 0; e < 2; ++e)
#pragma unroll
                        for (int j2 = 0; j2 < 4; ++j2) tl[e * 256 + (4 * q2 + j2) * 16 + fr2] = Pa[PASS == 1 ? mt : 0][PASS == 1 ? 2 * ks + e : 0][j2];
                    __builtin_amdgcn_wave_barrier();
                    const f32x4 pa = *(const f32x4*)(tl + fr2 * 16 + 4 * q2), pb = *(const f32x4*)(tl + 256 + fr2 * 16 + 4 * q2);
                    __builtin_amdgcn_wave_barrier();
                    bf16x8 ah, al; split_frag(pa, pb, ah, al);
                    *(bf16x8*)(pqb + (((mt * 2 + ks) * 2 + 0) * 64 + l2) * 16) = ah;
                }
            float* pq = PQ + (size_t)item * 8192 + 4096 + l2 * 4;
#pragma unroll
            for (int mt = 0; mt < 4; ++mt)
#pragma unroll
                for (int nt = 0; nt < 4; ++nt) *(f32x4*)(pq + (mt * 4 + nt) * 256) = St[mt][nt];
        }
    }
}

constexpr int CR_SLOTS = 10, CR_SLOT_BYTES = 12288, CR_FLAGS = CR_SLOTS * CR_SLOT_BYTES;
__device__ __forceinline__ void phase_combine_ring(KP p, int s, int wid0, unsigned char* ldsg) {
    KP_FRESH(p);
    int tid_ = hw_tid(wid0); asm volatile("" : "+v"(tid_));
    const int lane = tid_ & 63, wid = wid0;
    const int nseg = 64, nsteps = nseg - 1;
    const float* PQ = (const float*)(p->ws + WS_PQ); float* SST = (float*)(p->ws + WS_SST);
    volatile unsigned* flags = (volatile unsigned*)(ldsg + CR_FLAGS);
    __syncthreads();
    if (tid_ < CR_SLOTS) flags[tid_] = 0u;
    __syncthreads();
    if ((int)blockIdx.x >= 128) return;
    const int nt = blockIdx.x & 3, chain = blockIdx.x >> 2;
    if (wid != 0) {
        u32x4 ra[12], rb[12];
#define CR_ISSUE(r, gg) do { const unsigned char* b_ = (const unsigned char*)(PQ + ((size_t)chain * nseg + (gg)) * 8192); \
        _Pragma("unroll") for (int f = 0; f < 8; ++f) (r)[f] = *(const u32x4*)(b_ + ((f * 2 + 0) * 64 + lane) * 16); \
        _Pragma("unroll") for (int mt = 0; mt < 4; ++mt) (r)[8 + mt] = *(const u32x4*)(b_ + 16384 + ((mt * 4 + nt) * 64 + lane) * 16); } while (0)
#define CR_PUT(r, gg) do { const int slot_ = (gg) % CR_SLOTS; const unsigned gen_ = 2u * (unsigned)((gg) / CR_SLOTS); unsigned sp_ = 0;     \
        while (flags[slot_] != gen_ && ++sp_ < (1u << 20)) __builtin_amdgcn_s_sleep(1); \
        _Pragma("unroll") for (int f = 0; f < 12; ++f) *(u32x4*)(ldsg + slot_ * CR_SLOT_BYTES + f * 1024 + lane * 16) = (r)[f]; \
        asm volatile("s_waitcnt lgkmcnt(0)" ::: "memory"); __builtin_amdgcn_wave_barrier(); \
        if (lane == 0) flags[slot_] = gen_ + 1u; } while (0)
        int g = wid - 1;
        if (g < nsteps) CR_ISSUE(ra, g);
        for (; g < nsteps; g += 14) {
            if (g + 7 < nsteps) CR_ISSUE(rb, g + 7);
            CR_PUT(ra, g);
            if (g + 14 < nsteps) CR_ISSUE(ra, g + 14);
            if (g + 7 < nsteps) CR_PUT(rb, g + 7);
        }
#undef CR_ISSUE
#undef CR_PUT
    } else {
        f32x4 S[4];
#pragma unroll
        for (int mt = 0; mt < 4; ++mt) S[mt] = (f32x4){0.f, 0.f, 0.f, 0.f};
        for (int g = 0; g < nseg; ++g) {
            const size_t item = (size_t)chain * nseg + g;
#pragma unroll
            for (int mt = 0; mt < 4; ++mt) *(f32x4*)(SST + item * 4096 + ((mt * 4 + nt) * 64 + lane) * 4) = S[mt];
            if (g == nsteps) break;
            const int slot = g % CR_SLOTS; const unsigned gen = 2u * (unsigned)(g / CR_SLOTS); unsigned sp = 0;
            while (flags[slot] != gen + 1u && ++sp < (1u << 20)) __builtin_amdgcn_s_sleep(1);
            bf16x8 ah[4][2]; f32x4 qv[4];
#pragma unroll
            for (int mt = 0; mt < 4; ++mt) {
                qv[mt] = *(const f32x4*)(ldsg + slot * CR_SLOT_BYTES + (8 + mt) * 1024 + lane * 16);
#pragma unroll
                for (int ks = 0; ks < 2; ++ks) ah[mt][ks] = *(const bf16x8*)(ldsg + slot * CR_SLOT_BYTES + (mt * 2 + ks) * 1024 + lane * 16);
            }
            asm volatile("s_waitcnt lgkmcnt(0)" ::: "memory"); __builtin_amdgcn_wave_barrier();
            if (lane == 0) flags[slot] = gen + 2u;
            bf16x8 bh[2], bl[2];
            split_frag(S[0], S[1], bh[0], bl[0]); split_frag(S[2], S[3], bh[1], bl[1]);
#pragma unroll
            for (int mt = 0; mt < 4; ++mt) {
                f32x4 acc = qv[mt];
#pragma unroll
                for (int ks = 0; ks < 2; ++ks) { acc = MFMA16(ah[mt][ks], bh[ks], acc); acc = MFMA16(ah[mt][ks], bl[ks], acc); }
                S[mt] = acc;
            }
        }
    }
}

__device__ void phase_combine(KP p, int s, int wid0) {
    KP_FRESH(p);
    int tid_ = hw_tid(wid0); asm volatile("" : "+v"(tid_));
    const int lane = tid_ & 63, wid = tid_ >> 6, fr = lane & 15, q = lane >> 4;
    int tok0, nseq, T; slab_info(s, tok0, nseq, T);
    const int lgseg = (s == 0) ? 3 : 6, nseg = 1 << lgseg, nwork = nseq * 32 * 4;
    const float* PQ = (const float*)(p->ws + WS_PQ); float* SST = (float*)(p->ws + WS_SST);
    for (int wk = blockIdx.x * 8 + wid; wk < nwork; wk += gridDim.x * 8) {
        const int nt = wk & 3, chain = wk >> 2;
        f32x4 S[4];
#pragma unroll
        for (int mt = 0; mt < 4; ++mt) S[mt] = (f32x4){0.f, 0.f, 0.f, 0.f};
        struct CStep { bf16x8 ah[4][2]; f32x4 q[4]; };
#define CMB_LOAD(c, gg) do { const int g_ = (gg) < nseg - 1 ? (gg) : nseg - 2; const unsigned char* b_ = (const unsigned char*)(PQ + ((size_t)chain * nseg + g_) * 8192); \
        _Pragma("unroll") for (int mt = 0; mt < 4; ++mt) { (c).q[mt] = *(const f32x4*)(b_ + 16384 + ((mt * 4 + nt) * 64 + lane) * 16); \
            _Pragma("unroll") for (int ks = 0; ks < 2; ++ks) (c).ah[mt][ks] = *(const bf16x8*)(b_ + (((mt * 2 + ks) * 2 + 0) * 64 + lane) * 16); } } while (0)
        CStep c0, c1, c2;
        CMB_LOAD(c0, 0); CMB_LOAD(c1, 1); CMB_LOAD(c2, 2);
        for (int g = 0; g < nseg; ++g) {
            const size_t item = (size_t)chain * nseg + g;
#pragma unroll
            for (int mt = 0; mt < 4; ++mt) *(f32x4*)(SST + item * 4096 + ((mt * 4 + nt) * 64 + lane) * 4) = S[mt];
            if (g == nseg - 1) break;
            const CStep cc = c0; c0 = c1; c1 = c2;
            CMB_LOAD(c2, g + 3);
            bf16x8 bh[2], bl[2];
            split_frag(S[0], S[1], bh[0], bl[0]); split_frag(S[2], S[3], bh[1], bl[1]);
#pragma unroll
            for (int mt = 0; mt < 4; ++mt) {
                f32x4 acc = cc.q[mt];
#pragma unroll
                for (int ks = 0; ks < 2; ++ks) { acc = MFMA16(cc.ah[mt][ks], bh[ks], acc); acc = MFMA16(cc.ah[mt][ks], bl[ks], acc); }
                S[mt] = acc;
            }
        }
#undef CMB_LOAD
    }
}

DI void unpack8(u32x4 w, float (&f)[8]) { f[0] = lo16(w.x); f[1] = hi16(w.x); f[2] = lo16(w.y); f[3] = hi16(w.y); f[4] = lo16(w.z); f[5] = hi16(w.z); f[6] = lo16(w.w); f[7] = hi16(w.w); }
__device__ void phase_shift(KP p, int s, int wid0) {
    KP_FRESH(p);
    int tid_ = hw_tid(wid0); asm volatile("" : "+v"(tid_));
    int tok0, nseq, T; slab_info(s, tok0, nseq, T);
    const bf16_t* TMP = (const bf16_t*)(p->ws + WS_TMP); bf16_t* U = (bf16_t*)(p->ws + WS_U);
    const float* mu = p->in[I_MU];
    const int gt = blockIdx.x * 512 + tid_, nt = gridDim.x * 512;
    for (int unit = gt; unit < 416 * (SLAB / 16); unit += nt) {
        const int cg0 = unit % 416, cg = cg0 < 384 ? cg0 : cg0 + 128, rb = unit / 416, c0 = cg * 8, r0 = rb * 16;
        const bool tanh_cols = (c0 >= 4096) && (c0 < 4096 + 128);
        float m[8];
        { const f32x4 a = *(const f32x4*)(mu + c0), b = *(const f32x4*)(mu + c0 + 4); m[0] = a[0]; m[1] = a[1]; m[2] = a[2]; m[3] = a[3]; m[4] = b[0]; m[5] = b[1]; m[6] = b[2]; m[7] = b[3]; }
        const bf16_t* src = TMP + (size_t)r0 * 4352 + c0; bf16_t* dst = U + (size_t)r0 * UW + URW + c0;
        const int t0 = r0 & (T - 1);
        u32x4 raw[18];
        raw[0] = (t0 > 0) ? *(const u32x4*)(src - 4352) : (u32x4){0u, 0u, 0u, 0u};
#pragma unroll
        for (int i = 0; i < 16; ++i) raw[i + 1] = *(const u32x4*)(src + (size_t)i * 4352);
        raw[17] = (t0 + 16 < T) ? *(const u32x4*)(src + (size_t)16 * 4352) : (u32x4){0u, 0u, 0u, 0u};
        float prev[8], cur[8], nxt[8];
        unpack8(raw[0], prev); unpack8(raw[1], cur);
#pragma unroll
        for (int i = 0; i < 16; ++i) {
            unpack8(raw[i + 2], nxt);
            float o[8];
#pragma unroll
            for (int e = 0; e < 8; ++e) {
                float v = cur[e] + m[e] * (0.5f * (prev[e] + nxt[e]) - cur[e]);
                if (tanh_cols) v = 1.f - 2.f * __builtin_amdgcn_rcpf(1.f + __expf(2.f * v));
                o[e] = v; prev[e] = cur[e]; cur[e] = nxt[e];
            }
            *(u32x4*)(dst + (size_t)i * UW) = (u32x4){cvtpk(o[0], o[1]), cvtpk(o[2], o[3]), cvtpk(o[4], o[5]), cvtpk(o[6], o[7])};
        }
    }
}

__device__ void phase_post(KP p, int s, int wid0) {
    KP_FRESH(p);
    int tid_ = hw_tid(wid0); asm volatile("" : "+v"(tid_));
    const int lane = tid_ & 63, gw = blockIdx.x * 8 + (tid_ >> 6), nw = gridDim.x * 8;
    int tok0, nseq, T; slab_info(s, tok0, nseq, T);
    const bf16_t* U = (const bf16_t*)(p->ws + WS_U);
    const bf16_t* YS = (const bf16_t*)(p->ws + WS_YS); const float* BON = (const float*)(p->ws + WS_BON);
    bf16_t* ymix = (bf16_t*)(p->ws + WS_YMIX);
    for (int unit = gw; unit < (SLAB / 16) * 2; unit += nw) {
        const int half = unit & 1, r0 = (unit >> 1) * 16, c0 = half * 512 + lane * 8, h = c0 >> 6;
        float cw0[8], cw1[8], cw2[8], cbv[8], lg[8], lb[8];
        {
            const float* cw = p->in[I_CW]; const float* cb = p->in[I_CB]; const float* g = p->in[I_LXG]; const float* b = p->in[I_LXB];
#pragma unroll
            for (int e = 0; e < 8; ++e) { cw0[e] = cw[c0 + e]; cw1[e] = cw[1024 + c0 + e]; cw2[e] = cw[2048 + c0 + e]; cbv[e] = cb[c0 + e]; lg[e] = g[c0 + e]; lb[e] = b[c0 + e]; }
        }
        const int t0 = r0 & (T - 1);
        const bf16_t* up = U + (size_t)r0 * UW + c0;
        float pprev[8], pcur[8], pnxt[8], zprev[8], zcur[8], znxt[8], muz[8];
        if (t0 > 0) { unpack8(*(const u32x4*)(up - UW), pprev); unpack8(*(const u32x4*)(up - UW + URW + 3072), zprev); } else { for (int e = 0; e < 8; ++e) { pprev[e] = 0.f; zprev[e] = 0.f; } }
        unpack8(*(const u32x4*)up, pcur); unpack8(*(const u32x4*)(up + URW + 3072), zcur);
        { const float* mu = p->in[I_MU];
#pragma unroll
          for (int e = 0; e < 8; ++e) muz[e] = mu[3072 + c0 + e]; }
        for (int ib = 0; ib < 16; ib += 4) {
            u32x4 rp[4], rg[4], rv[4], rz[4], ry0[4], ry1[4]; float bonv[4];
#pragma unroll
            for (int r = 0; r < 4; ++r) {
                const int i = ib + r, row = r0 + i;
                const bf16_t* ur = up + (size_t)i * UW;
                rp[r] = (t0 + i < T - 1) ? *(const u32x4*)(ur + UW) : (u32x4){0u, 0u, 0u, 0u};
                rz[r] = (t0 + i < T - 1) ? *(const u32x4*)(ur + UW + URW + 3072) : (u32x4){0u, 0u, 0u, 0u};
                rg[r] = *(const u32x4*)(ur + 1024); rv[r] = *(const u32x4*)(ur + URW + 2048);
                ry0[r] = *(const u32x4*)(YS + (size_t)row * DR + c0); ry1[r] = *(const u32x4*)(YS + ((size_t)SLAB + row) * DR + c0);
                bonv[r] = BON[(size_t)row * 16 + h] + BON[((size_t)SLAB + row) * 16 + h];
            }
#pragma unroll
            for (int r = 0; r < 4; ++r) {
                const int row = r0 + ib + r;
                float gg[8], vv[8], zz[8], y[8], y1[8];
                unpack8(rp[r], pnxt); unpack8(rg[r], gg); unpack8(rv[r], vv); unpack8(rz[r], znxt); unpack8(ry0[r], y); unpack8(ry1[r], y1);
#pragma unroll
                for (int e = 0; e < 8; ++e) { zz[e] = zcur[e] + muz[e] * (0.5f * (zprev[e] + znxt[e]) - zcur[e]); zprev[e] = zcur[e]; zcur[e] = znxt[e]; }
                const float bon = bonv[r];
#pragma unroll
                for (int e = 0; e < 8; ++e) y[e] += y1[e];
                float sum = 0.f;
#pragma unroll
                for (int e = 0; e < 8; ++e) sum += y[e];
                sum += shx(sum, lane, 1); sum += shx(sum, lane, 2); sum += shx(sum, lane, 4);
                const float mean = sum * (1.f / 64.f);
                float sq = 0.f;
#pragma unroll
                for (int e = 0; e < 8; ++e) { const float dl = y[e] - mean; sq += dl * dl; }
                sq += shx(sq, lane, 1); sq += shx(sq, lane, 2); sq += shx(sq, lane, 4);
                const float rstd = rsqrtf(sq * (1.f / 64.f) + 64e-5f);
                float oc[8], orw[8];
#pragma unroll
                for (int e = 0; e < 8; ++e) {
                    oc[e] = gg[e] * (cw0[e] * pprev[e] + cw1[e] * pcur[e] + cw2[e] * pnxt[e] + cbv[e]);
                    orw[e] = ((y[e] - mean) * rstd * lg[e] + lb[e] + bon * vv[e]) * (zz[e] * fsig(zz[e]));
                    pprev[e] = pcur[e]; pcur[e] = pnxt[e];
                }
                *(u32x4*)(ymix + (size_t)row * 2048 + c0) = (u32x4){cvtpk(oc[0], oc[1]), cvtpk(oc[2], oc[3]), cvtpk(oc[4], oc[5]), cvtpk(oc[6], oc[7])};
                *(u32x4*)(ymix + (size_t)row * 2048 + 1024 + c0) = (u32x4){cvtpk(orw[0], orw[1]), cvtpk(orw[2], orw[3]), cvtpk(orw[4], orw[5]), cvtpk(orw[6], orw[7])};
            }
        }
    }
}

__device__ void phase_lnout(KP p, int s, int wid0) {
    KP_FRESH(p);
    int tid_ = hw_tid(wid0); asm volatile("" : "+v"(tid_)); int lane = tid_ & 63; const int gw = blockIdx.x * 8 + (tid_ >> 6), nw = gridDim.x * 8;
    float* out = p->out + (size_t)s * SLAB * D;
    const float4* g4 = (const float4*)p->in[I_LG]; const float4* b4 = (const float4*)p->in[I_LB];
    for (int r0 = gw; r0 < SLAB; r0 += 4 * nw) {
        asm volatile("" : "+v"(lane));
        float4 v[4][4];
#pragma unroll
        for (int k = 0; k < 4; ++k)
#pragma unroll
            for (int i = 0; i < 4; ++i) v[k][i] = ((const float4*)(out + (size_t)(r0 + k * nw) * D))[lane + 64 * i];
#pragma unroll
        for (int k = 0; k < 4; ++k) {
            float4* xp = (float4*)(out + (size_t)(r0 + k * nw) * D);
            float sum = 0.f;
#pragma unroll
            for (int i = 0; i < 4; ++i) sum += v[k][i].x + v[k][i].y + v[k][i].z + v[k][i].w;
            const float mean = wsum(sum, lane) * (1.f / 1024.f);
            float sq = 0.f;
#pragma unroll
            for (int i = 0; i < 4; ++i) { float a = v[k][i].x - mean, b = v[k][i].y - mean, c = v[k][i].z - mean, d = v[k][i].w - mean; sq += a * a + b * b + c * c + d * d; }
            const float rstd = rsqrtf(wsum(sq, lane) * (1.f / 1024.f) + 1e-5f);
#pragma unroll
            for (int i = 0; i < 4; ++i) {
                const float4 g = g4[lane + 64 * i], b = b4[lane + 64 * i];
                float4 o; o.x = (v[k][i].x - mean) * rstd * g.x + b.x; o.y = (v[k][i].y - mean) * rstd * g.y + b.y; o.z = (v[k][i].z - mean) * rstd * g.z + b.z; o.w = (v[k][i].w - mean) * rstd * g.w + b.w;
                xp[lane + 64 * i] = o;
            }
        }
    }
}

#define LAS __attribute__((address_space(3)))
#define XB_TMO      128
#define XB_XCNT(j)  (256  + 64 * (j))
#define XB_XSUB(j)  (1280 + 64 * (j))
#define XB_XGEN(j)  (2304 + 64 * (j))
#define XB_TOP      3328
#define XB_TOPGEN   3392
#define XCD_BAR_WORDS 3456
#define XB_SPIN_CAP (1u << 18)

__device__ __forceinline__ unsigned xb_ld(unsigned* p)              { return __hip_atomic_load(p, __ATOMIC_RELAXED, __HIP_MEMORY_SCOPE_AGENT); }
__device__ __forceinline__ unsigned xb_add(unsigned* p, unsigned v) { return __hip_atomic_fetch_add(p, v, __ATOMIC_RELAXED, __HIP_MEMORY_SCOPE_AGENT); }
__device__ __forceinline__ unsigned xb_xcc_id() { return (unsigned)__builtin_amdgcn_s_getreg((3 << 11) | 20) & 0xFu; }
#define XB_SPIN(cond, bar) do { unsigned _sp = 0; while (cond) { __builtin_amdgcn_s_sleep(1); \
    if ((++_sp & 255u) == 0u) { if (xb_ld(&(bar)[XB_TMO])) break; if (_sp > XB_SPIN_CAP) { atomicAdd(&(bar)[XB_TMO], 1u); break; } } } } while (0)

struct XcdBarrier {
    unsigned* bar; unsigned x;
    volatile LAS unsigned* st;
};

__device__ __forceinline__ XcdBarrier xcd_barrier_post(unsigned* bar, volatile LAS unsigned* st) {
    XcdBarrier b; b.bar = bar; b.x = xb_xcc_id(); b.st = st;
    if (threadIdx.x == 0) (void)xb_add(&bar[XB_XCNT(b.x)], 1u);
    return b;
}
__device__ __forceinline__ void xcd_barrier_complete(unsigned* bar, unsigned x, unsigned& nloc, unsigned& nx) {
    const unsigned G = gridDim.x * gridDim.y * gridDim.z;
    unsigned sum, cnt, mine, sp = 0u;
    for (;;) {
        sum = 0u; cnt = 0u; mine = 0u;
#pragma unroll
        for (unsigned j = 0; j < 16; ++j) { const unsigned c = xb_ld(&bar[XB_XCNT(j)]); sum += c; cnt += (c > 0u) ? 1u : 0u; mine = (j == x) ? c : mine; }
        if (sum == G) break;
        __builtin_amdgcn_s_sleep(1);
        if ((++sp & 255u) == 0u) { if (xb_ld(&bar[XB_TMO])) break; if (sp > XB_SPIN_CAP) { atomicAdd(&bar[XB_TMO], 1u); break; } }
    }
    nloc = mine > 0u ? mine : 1u; nx = cnt > 0u ? cnt : 1u;
}

__device__ __forceinline__ void xcd_barrier(const XcdBarrier& b) {
    asm volatile("s_waitcnt vmcnt(0)" ::: "memory");
    __syncthreads();
    if (threadIdx.x == 0) {
        unsigned* bar = b.bar;
        __builtin_amdgcn_s_waitcnt(0);
        unsigned nloc = b.st[0], nx = b.st[1];
        if (nloc == 0u) { xcd_barrier_complete(bar, b.x, nloc, nx); b.st[0] = nloc; b.st[1] = nx; }
        const unsigned old = xb_add(&bar[XB_XSUB(b.x)], 1u);
        const unsigned gen = old / nloc;
        if (old + 1u == (gen + 1u) * nloc) {
            __builtin_amdgcn_fence(__ATOMIC_RELEASE, "agent");
            asm volatile("s_waitcnt vmcnt(0)" ::: "memory");
            const unsigned og = xb_add(&bar[XB_TOP], 1u);
            const unsigned tg = og / nx;
            if (og + 1u == (tg + 1u) * nx) xb_add(&bar[XB_TOPGEN], 1u);
            else XB_SPIN(xb_ld(&bar[XB_TOPGEN]) == tg, bar);
            __builtin_amdgcn_fence(__ATOMIC_ACQUIRE, "agent");
            xb_add(&bar[XB_XGEN(b.x)], 1u);
            asm volatile("s_waitcnt vmcnt(0)" ::: "memory");
        } else {
            XB_SPIN(xb_ld(&bar[XB_XGEN(b.x)]) == gen, bar);
            __builtin_amdgcn_fence(__ATOMIC_ACQUIRE, "agent");
            asm volatile("s_waitcnt vmcnt(0)" ::: "memory");
        }
    }
    __syncthreads();
}

#ifndef REP_SHIFT
#define REP_SHIFT 1
#endif
#ifndef REP_G2
#define REP_G2 1
#endif
#ifndef REP_SCAN
#define REP_SCAN 1
#endif
#ifndef REP_POST
#define REP_POST 1
#endif
#ifndef REP_G1
#define REP_G1 1
#endif
#define GBAR() xcd_barrier(bar)
__global__ void __launch_bounds__(512, 2) fwd_megakernel(Params p_unused) {
    extern __shared__ __attribute__((aligned(16))) unsigned char lds_raw[];
    PG8_LAS unsigned char* lds = (PG8_LAS unsigned char*)lds_raw;
    cg::grid_group grid = cg::this_grid();
    KP p = (KP)__builtin_amdgcn_kernarg_segment_ptr();
    if (threadIdx.x < 2) ((volatile LAS unsigned*)(lds + LDS_BYTES - 64))[threadIdx.x] = 0u;
    __syncthreads();
    {
        unsigned* bw = (unsigned*)(((const Params __attribute__((address_space(4)))*)__builtin_amdgcn_kernarg_segment_ptr())->ws + WS_BAR);
        if (blockIdx.x == 0) { for (int w = threadIdx.x; w < XCD_BAR_WORDS; w += 512) __hip_atomic_store(bw + w, 0u, __ATOMIC_RELAXED, __HIP_MEMORY_SCOPE_AGENT); __threadfence(); }
        grid.sync();
    }
    XcdBarrier bar = xcd_barrier_post((unsigned*)(((const Params __attribute__((address_space(4)))*)__builtin_amdgcn_kernarg_segment_ptr())->ws + WS_BAR), (volatile LAS unsigned*)(lds + LDS_BYTES - 64));
    const int wid0 = __builtin_amdgcn_readfirstlane((int)threadIdx.x >> 6);
    phase_weights(p, wid0);
    for (int s = -1; s < 3; ++s) {
        if (s == 0) GBAR();
        if (s >= 0)
        for (int rep = 0; rep < REP_G1; ++rep) {
            if (rep) GBAR();
            KP_FRESH(p);
            pg8::Gemm g; g.A = xn_buf(p, s); g.Bt = (const bf16_t*)(p->ws + WS_WIN); g.M = SLAB; g.N = NIN; g.K = D;
            pg8::StaticOrder S; S.init(g.M, g.N, gridDim.x, blockIdx.x);
            EpiU E; E.U = (bf16_t*)(p->ws + WS_U); E.TMP = (bf16_t*)(p->ws + WS_TMP);
            pg8::gemm_phase<EpiU, pg8::StaticOrder, true, true>(lds, g, S, E, wid0);
        }
        {
            const int wg0 = (s >= 0 && gridDim.x > 64) ? 64 : 0;
            if (s < 2 && (int)blockIdx.x >= wg0) phase_ln(p, s + 1, wid0, wg0);
        }
        if (s < 0) continue;
        GBAR();
        for (int rep = 0; rep < REP_SHIFT; ++rep) {
        phase_shift(p, s, wid0);
        GBAR();
        }
        for (int rep = 0; rep < REP_SCAN; ++rep) {
        phase_scan<1>(p, s, lds_raw, wid0);
        GBAR();
        if (s > 0 && gridDim.x >= 128) phase_combine_ring(p, s, wid0, lds_raw); else phase_combine(p, s, wid0);
        GBAR();
        phase_scan<2>(p, s, lds_raw, wid0);
        GBAR();
        }
        for (int rep = 0; rep < REP_POST; ++rep) {
        phase_post(p, s, wid0);
        GBAR();
        }
        for (int rep = 0; rep < REP_G2; ++rep) {
            if (rep) GBAR();
            KP_FRESH(p);
            pg8::Gemm g; g.A = (const bf16_t*)(p->ws + WS_YMIX); g.Bt = (const bf16_t*)(p->ws + WS_WOUT); g.M = SLAB; g.N = D; g.K = 2048;
            pg8::StaticOrder S; S.init(g.M, g.N, gridDim.x, blockIdx.x);
            EpiOut E; E.out = p->out + (size_t)s * SLAB * D; E.x = slab_x(p, s); E.stats = (const float*)(p->ws + WS_STATS) + (size_t)s * SLAB * 2; E.eg = p->in[I_EG]; E.eb = p->in[I_EB];
            pg8::gemm_phase<EpiOut, pg8::StaticOrder, true, true>(lds, g, S, E, wid0);
        }
        GBAR();
        phase_lnout(p, s, wid0);
    }
}

extern "C" void kernel_launch(void* const* d_in, const int* in_sizes, int n_in, void* d_out, int out_size, void* d_ws, size_t ws_size, hipStream_t stream) {
    static int grid_blocks = 0;
    if (!grid_blocks) {
        int dev = 0, cus = 0, per_cu = 0;
        hipGetDevice(&dev);
        hipDeviceGetAttribute(&cus, hipDeviceAttributeMultiprocessorCount, dev);
        hipFuncSetAttribute((const void*)fwd_megakernel, hipFuncAttributeMaxDynamicSharedMemorySize, LDS_BYTES);
        hipOccupancyMaxActiveBlocksPerMultiprocessor(&per_cu, (const void*)fwd_megakernel, 512, LDS_BYTES);
        if (per_cu < 1) per_cu = 1;
        if (per_cu > 1) per_cu = 1;
        grid_blocks = cus * per_cu;
    }
    Params p{};
    for (int i = 0; i < 20; ++i) p.in[i] = (const float*)d_in[i];
    p.out = (float*)d_out; p.ws = (unsigned char*)d_ws;
    void* args[] = {&p};
    hipError_t e = hipLaunchCooperativeKernel((const void*)fwd_megakernel, dim3(grid_blocks), dim3(512), args, LDS_BYTES, stream);
    if (e != hipSuccess) fprintf(stderr, "cooperative launch failed: %s (grid %d)\n", hipGetErrorString(e), grid_blocks);
}
```

```cpp
#include <hip/hip_runtime.h>
#include <hip/hip_cooperative_groups.h>
#include <cstdio>
#include <cstdint>
namespace cg = cooperative_groups;
namespace pg8 {
#define PG8_LAS __attribute__((address_space(3)))
typedef unsigned short bf16_t;
typedef short bf16x8 __attribute__((ext_vector_type(8)));
typedef float f32x4 __attribute__((ext_vector_type(4)));
typedef unsigned u32x4 __attribute__((ext_vector_type(4)));
constexpr int BM = 256, BK = 64, HALF = 128, HTB = HALF * BK * 2  , STAGE_BYTES = 8 * HTB, NXCD = 8, WGM = 4;

__host__ __device__ __forceinline__ int lds_byte(int r, int c) { const int st = (r >> 4) * 2 + (c >> 5), rr = r & 15, cc = c & 31, ob = rr * 64 + cc * 2; return st * 1024 + (ob ^ (((ob >> 9) & 1) << 5)); }
__host__ __device__ __forceinline__ void stage_rc(int b, int& R, int& C) { const int st = b / 1024, sb = b % 1024, swz = sb ^ (((sb >> 9) & 1) << 5); R = (st >> 1) * 16 + swz / 64; C = (st & 1) * 32 + (swz % 64) / 2; }
__host__ __device__ __forceinline__ int perm32(int rho) { const int n = rho >> 4, i = rho & 15; return 8 * (i >> 2) + 4 * n + (i & 3); }

struct Unit { int pm, pn; };
struct Gemm { const bf16_t* A; const bf16_t* Bt; int M, N, K; };

struct StaticOrder {
    int nM, nN, nwg, G, c;
    __host__ __device__ void init(int M, int N, int G_, int c_) { nM = M / BM; nN = N / BM; nwg = nM * nN; G = G_; c = c_; }
    __host__ __device__ bool next(int i, Unit& u) const {
        const long L = (long)i * G + c; if (L >= nwg) return false;
        int wgid = (int)L; { const int q = nwg / NXCD, r = nwg % NXCD, xcd = wgid % NXCD, off = wgid / NXCD; wgid = (xcd < r ? xcd * (q + 1) : r * (q + 1) + (xcd - r) * q) + off; }
        const int nig = WGM * nN, gid = wgid / nig, fm = gid * WGM, gsz = (nM - fm) < WGM ? (nM - fm) : WGM;
        u.pm = fm + ((wgid % nig) % gsz); u.pn = (wgid % nig) / gsz; return true;
    }
    __device__ __forceinline__ void a_ready(const Unit&) const {}
    __device__ __forceinline__ void done(const Unit&) const {}
};

template <class Epi, class Sched, bool ALIGN_EPI = false, bool SP2 = false>
__device__ __forceinline__ void gemm_phase(PG8_LAS unsigned char* lds, const Gemm g, const Sched& S, const Epi& E, int wid0) {
    int tid_; asm volatile("v_mbcnt_lo_u32_b32 %0, -1, 0\n\tv_mbcnt_hi_u32_b32 %0, -1, %0" : "=v"(tid_)); tid_ += wid0 * 64; const int tid = tid_, wid = __builtin_amdgcn_readfirstlane(tid >> 6), lane = tid & 63, wr = wid >> 2, wc = wid & 3, fr = lane & 15, fq = lane >> 4;
    const int K = g.K, nt = K / BK;
    unsigned voffA[2], voffB[2];
#pragma unroll
    for (int i = 0; i < 2; ++i) { int R, C; stage_rc(tid * 16 + i * 8192, R, C); const int Rb = Epi::PERM ? ((R & ~31) + perm32(R & 31)) : R;
        voffA[i] = (unsigned)(R * K + C) * 2u; voffB[i] = (unsigned)(Rb * K + C) * 2u; }
    const size_t kstep = (size_t)(BK * 2);
    const size_t hstep = (size_t)HALF * K * 2;
    const size_t tstep = 2 * hstep;
    const unsigned ldsw = (unsigned)wid * 1024u;
    const int aoff = lds_byte(wr * 64 + fr, fq * 8), boff = lds_byte(wc * 32 + fr, fq * 8);
#define PG8_SA(b, h) (((b) * 2 + (h)) * HTB)
#define PG8_SB(b, h) ((4 + (b) * 2 + (h)) * HTB)
#define PG8_STAGE(bufoff, gbase, voff) do { _Pragma("unroll") for (int _i = 0; _i < 2; ++_i) \
        __builtin_amdgcn_global_load_lds((const unsigned*)((const char*)(gbase) + (voff)[_i]), (PG8_LAS unsigned*)(lds + (bufoff) + ldsw + _i * 8192), 16, 0, 0); } while (0)
#define PG8_LDA(dst, b, h) do { _Pragma("unroll") for (int m = 0; m < 4; ++m) _Pragma("unroll") for (int k = 0; k < 2; ++k) dst[m][k] = *(const PG8_LAS bf16x8*)(lds + PG8_SA(b, h) + aoff + m * 2048 + k * 1024); } while (0)
#define PG8_LDB(dst, b, h) do { _Pragma("unroll") for (int n = 0; n < 2; ++n) _Pragma("unroll") for (int k = 0; k < 2; ++k) dst[n][k] = *(const PG8_LAS bf16x8*)(lds + PG8_SB(b, h) + boff + n * 2048 + k * 1024); } while (0)
#define PG8_MMA(ai, bj, At, Bt) do { __builtin_amdgcn_s_setprio(1); _Pragma("unroll") for (int m = 0; m < 4; ++m) _Pragma("unroll") for (int n = 0; n < 2; ++n) _Pragma("unroll") for (int k = 0; k < 2; ++k) \
        acc[ai][bj][m][n] = __builtin_amdgcn_mfma_f32_16x16x32_bf16(Bt[n][k], At[m][k], acc[ai][bj][m][n], 0, 0, 0); __builtin_amdgcn_s_setprio(0); } while (0)
#define PG8_WAIT_V(n) asm volatile("s_waitcnt vmcnt(" #n ")" ::: "memory")
#define PG8_WAIT_L(n) asm volatile("s_waitcnt lgkmcnt(" #n ")" ::: "memory")
#define PG8_BAR __builtin_amdgcn_s_barrier()
#define PG8_SCHED __builtin_amdgcn_sched_barrier(0)
    Unit cur, nxt; int ui = 0;
    if (!S.next(0, cur)) return;
    f32x4 acc[2][2][4][2];
#pragma unroll
    for (int a = 0; a < 2; ++a)
#pragma unroll
        for (int b = 0; b < 2; ++b)
#pragma unroll
            for (int m = 0; m < 4; ++m)
#pragma unroll
                for (int n = 0; n < 2; ++n) acc[a][b][m][n] = (f32x4){0.f, 0.f, 0.f, 0.f};
    bf16x8 At[4][2], B0[2][2], B1[2][2];
    const char* cA = (const char*)g.A + (size_t)cur.pm * tstep; const char* cB = (const char*)g.Bt + (size_t)cur.pn * tstep;
    S.a_ready(cur);
    if constexpr (SP2) {
        PG8_STAGE(PG8_SB(0, 0), cB, voffB); PG8_STAGE(PG8_SB(0, 1), cB + hstep, voffB); PG8_STAGE(PG8_SA(0, 0), cA, voffA); PG8_STAGE(PG8_SA(0, 1), cA + hstep, voffA);
        if (wr == 1) PG8_BAR;
        PG8_WAIT_V(2); PG8_BAR;
        PG8_STAGE(PG8_SB(1, 0), cB + kstep, voffB); PG8_STAGE(PG8_SA(1, 0), cA + kstep, voffA); PG8_STAGE(PG8_SB(1, 1), cB + hstep + kstep, voffB);
        PG8_WAIT_V(6); PG8_BAR;
    } else {
        PG8_STAGE(PG8_SB(0, 0), cB, voffB); PG8_STAGE(PG8_SA(0, 0), cA, voffA); PG8_STAGE(PG8_SB(0, 1), cB + hstep, voffB); PG8_STAGE(PG8_SA(0, 1), cA + hstep, voffA);
        if (wr == 1) PG8_BAR;
        PG8_WAIT_V(4); PG8_BAR;
        PG8_STAGE(PG8_SB(1, 0), cB + kstep, voffB); PG8_STAGE(PG8_SA(1, 0), cA + kstep, voffA); PG8_STAGE(PG8_SB(1, 1), cB + hstep + kstep, voffB);
        PG8_WAIT_V(6); PG8_BAR;
    }
    for (;;) {
        const bool has_next = S.next(ui + 1, nxt);
        const char* nA = has_next ? (const char*)g.A + (size_t)nxt.pm * tstep : cA; const char* nB = has_next ? (const char*)g.Bt + (size_t)nxt.pn * tstep : cB;
        for (int t = 0; t < nt; t += 2) {
            const bool last = (t == nt - 2);
            const char* a1 = cA + (size_t)(t + 1) * kstep;
            const char* a2 = last ? nA : cA + (size_t)(t + 2) * kstep; const char* b2 = last ? nB : cB + (size_t)(t + 2) * kstep;
            const char* a3 = a2 + kstep; const char* b3 = b2 + kstep;
            if (last && has_next) S.a_ready(nxt);
            if constexpr (SP2) {
            PG8_LDB(B0, 0, 0); PG8_LDB(B1, 0, 1); PG8_SCHED; PG8_LDA(At, 0, 0); PG8_STAGE(PG8_SA(1, 1), a1 + hstep, voffA);
            PG8_WAIT_V(8); PG8_WAIT_L(0); PG8_BAR; PG8_MMA(0, 0, At, B0); PG8_MMA(0, 1, At, B1); PG8_BAR; PG8_SCHED;
            PG8_LDA(At, 0, 1); PG8_STAGE(PG8_SB(0, 0), b2, voffB); PG8_STAGE(PG8_SB(0, 1), b2 + hstep, voffB); PG8_STAGE(PG8_SA(0, 0), a2, voffA);
            PG8_WAIT_V(8); PG8_WAIT_L(0); PG8_BAR; PG8_MMA(1, 0, At, B0); PG8_MMA(1, 1, At, B1); PG8_BAR; PG8_SCHED;
            PG8_LDB(B0, 1, 0); PG8_LDB(B1, 1, 1); PG8_SCHED; PG8_LDA(At, 1, 0); PG8_STAGE(PG8_SA(0, 1), a2 + hstep, voffA);
            PG8_WAIT_V(8); PG8_WAIT_L(0); PG8_BAR; PG8_MMA(0, 0, At, B0); PG8_MMA(0, 1, At, B1); PG8_BAR; PG8_SCHED;
            PG8_LDA(At, 1, 1); PG8_STAGE(PG8_SB(1, 0), b3, voffB); PG8_STAGE(PG8_SB(1, 1), b3 + hstep, voffB); PG8_STAGE(PG8_SA(1, 0), a3, voffA);
            PG8_WAIT_V(8); PG8_WAIT_L(0); PG8_BAR; PG8_MMA(1, 0, At, B0); PG8_MMA(1, 1, At, B1); PG8_BAR; PG8_SCHED;
            } else {
            PG8_LDB(B0, 0, 0); PG8_SCHED; PG8_LDA(At, 0, 0); PG8_STAGE(PG8_SA(1, 1), a1 + hstep, voffA);
            PG8_WAIT_L(8); PG8_BAR; PG8_WAIT_L(0); PG8_MMA(0, 0, At, B0); PG8_BAR; PG8_SCHED;
            PG8_LDB(B1, 0, 1); PG8_STAGE(PG8_SB(0, 0), b2, voffB);
            PG8_BAR; PG8_WAIT_L(0); PG8_MMA(0, 1, At, B1); PG8_BAR;
            PG8_LDA(At, 0, 1); PG8_STAGE(PG8_SA(0, 0), a2, voffA);
            PG8_BAR; PG8_WAIT_L(0); PG8_MMA(1, 0, At, B0); PG8_BAR; PG8_SCHED;
            PG8_STAGE(PG8_SB(0, 1), b2 + hstep, voffB);
            PG8_WAIT_V(6); PG8_BAR; PG8_MMA(1, 1, At, B1); PG8_BAR;
            PG8_LDB(B0, 1, 0); PG8_SCHED; PG8_LDA(At, 1, 0); PG8_STAGE(PG8_SA(0, 1), a2 + hstep, voffA);
            PG8_WAIT_L(8); PG8_BAR; PG8_WAIT_L(0); PG8_MMA(0, 0, At, B0); PG8_BAR; PG8_SCHED;
            PG8_LDB(B1, 1, 1); PG8_STAGE(PG8_SB(1, 0), b3, voffB);
            PG8_BAR; PG8_WAIT_L(0); PG8_MMA(0, 1, At, B1); PG8_BAR;
            PG8_LDA(At, 1, 1); PG8_STAGE(PG8_SA(1, 0), a3, voffA);
            PG8_BAR; PG8_WAIT_L(0); PG8_MMA(1, 0, At, B0); PG8_BAR; PG8_SCHED;
            PG8_STAGE(PG8_SB(1, 1), b3 + hstep, voffB);
            PG8_WAIT_V(6); PG8_BAR; PG8_MMA(1, 1, At, B1); PG8_BAR;
            }
        }
        if constexpr (ALIGN_EPI) { if (wr == 0) PG8_BAR; }
        if constexpr (!Epi::AFTER_DRAIN) { E(acc, cur, wr, wc, fr, fq); S.done(cur); }
        if (!has_next) break;
#pragma unroll
        for (int a = 0; a < 2; ++a)
#pragma unroll
            for (int b = 0; b < 2; ++b)
#pragma unroll
                for (int m = 0; m < 4; ++m)
#pragma unroll
                    for (int n = 0; n < 2; ++n) acc[a][b][m][n] = (f32x4){0.f, 0.f, 0.f, 0.f};
        cur = nxt; cA = nA; cB = nB; ++ui;
        if constexpr (ALIGN_EPI) { if (wr == 1) PG8_BAR; }
    }
    PG8_WAIT_V(0);
    if constexpr (!ALIGN_EPI) { if (wr == 0) PG8_BAR; }
    PG8_BAR;
    if constexpr (Epi::AFTER_DRAIN) { E.fused(acc, cur, wr, wc, fr, fq, lds, wid, lane); S.done(cur); }
#undef PG8_SA
#undef PG8_SB
#undef PG8_STAGE
#undef PG8_LDA
#undef PG8_LDB
#undef PG8_MMA
#undef PG8_WAIT_V
#undef PG8_WAIT_L
#undef PG8_BAR
#undef PG8_SCHED
}
}

typedef unsigned short bf16_t;
typedef float f32x4 __attribute__((ext_vector_type(4)));
typedef unsigned u32x4 __attribute__((ext_vector_type(4)));
typedef unsigned u32x2 __attribute__((ext_vector_type(2)));

constexpr int D = 1024, NIN = 8448, DR = 1024, UW = 6400  , URW = 2048  ;
constexpr int SLAB = 16384, NTOK = 49152;
constexpr float DN_ALPHA = 1.189207115002721f;
constexpr size_t WS_WIN = 0;
constexpr size_t WS_WOUT = WS_WIN + (size_t)NIN * D * 2;
constexpr size_t WS_STATS = WS_WOUT + (size_t)D * 2048 * 2;
constexpr size_t WS_XN = WS_STATS + (size_t)NTOK * 2 * 4;
constexpr size_t WS_U = WS_XN + (size_t)SLAB * D * 2;
constexpr size_t WS_YS = WS_U + (size_t)SLAB * UW * 2;
constexpr size_t WS_BON = WS_YS + (size_t)2 * SLAB * DR * 4;
constexpr size_t WS_YMIX = WS_BON + (size_t)2 * SLAB * 16 * 4;
constexpr size_t WS_TMP = WS_YS;
constexpr size_t WS_PQ = WS_YMIX;
constexpr size_t WS_SST = WS_YMIX + (size_t)SLAB * 2048 * 2;
constexpr size_t WS_BAR = WS_SST + (size_t)2048 * 4096 * 4;
constexpr size_t WS_END = WS_BAR + 16384;
static_assert(WS_END <= (size_t)512 * 1024 * 1024, "ws map");
constexpr int LDS_BYTES = 147456;

struct Params { const float* in[20]; float* out; unsigned char* ws; };
typedef const Params __attribute__((address_space(4)))* KP;
#define KP_FRESH(p) asm volatile("" : "+s"(p))
__device__ __forceinline__ int hw_tid(int wid0) { int l; asm volatile("v_mbcnt_lo_u32_b32 %0, -1, 0\n\tv_mbcnt_hi_u32_b32 %0, -1, %0" : "=v"(l)); return wid0 * 64 + l; }
enum { I_XP = 0, I_XS, I_EG, I_EB, I_WIN, I_CW, I_CB, I_MU, I_W0, I_WUP, I_A0, I_AUP, I_KK, I_KA, I_RK, I_LXG, I_LXB, I_WOUT, I_LG, I_LB };

__device__ __forceinline__ float bf2f(unsigned short h) { return __uint_as_float((unsigned)h << 16); }
__device__ __forceinline__ unsigned f2bf(float f) { unsigned u = __float_as_uint(f); return (u + 0x7fffu + ((u >> 16) & 1u)) >> 16; }
__device__ __forceinline__ unsigned pk2(float lo, float hi) { return f2bf(lo) | (f2bf(hi) << 16); }
typedef __bf16 bf16x2e_t __attribute__((ext_vector_type(2)));
typedef float f32x2e __attribute__((ext_vector_type(2)));
__device__ __forceinline__ unsigned cvtpk_(float lo, float hi) { f32x2e v = {lo, hi}; bf16x2e_t b = __builtin_convertvector(v, bf16x2e_t); return __builtin_bit_cast(unsigned, b); }
__device__ __forceinline__ float shx(float v, int lane, int o) { return __int_as_float(__builtin_amdgcn_ds_bpermute((lane ^ o) << 2, __float_as_int(v))); }
__device__ __forceinline__ float wsum(float v, int lane) {
#pragma unroll
    for (int o = 32; o; o >>= 1) v += shx(v, lane, o);
    return v;
}
__device__ __forceinline__ float sigmoidf_(float x) { return 1.f / (1.f + __expf(-x)); }
__device__ __forceinline__ float siluf_(float x) { return x * sigmoidf_(x); }
__device__ __forceinline__ float rl(float v, int l) { return __int_as_float(__builtin_amdgcn_readlane(__float_as_int(v), l)); }

__device__ __forceinline__ void slab_info(int s, int& tok0, int& nseq, int& T) { if (s == 0) { tok0 = 0; nseq = 8; T = 2048; } else { tok0 = SLAB * s; nseq = 1; T = 16384; } }
__device__ __forceinline__ const float* slab_x(KP p, int s) { return s == 0 ? p->in[I_XP] : p->in[I_XS] + (size_t)(s - 1) * SLAB * D; }

__device__ __forceinline__ int orig_col(int jv) {
    if (jv >= 4096) return jv;
    const int pn = jv >> 8, bj = (jv >> 7) & 1, wc = (jv >> 5) & 3, fq = (jv >> 3) & 3, n = (jv >> 2) & 1, j = jv & 3;
    return (2 * bj + n) * 1024 + 64 * pn + 16 * wc + 4 * fq + j;
}

__device__ void phase_weights(KP p, int wid0) {
    KP_FRESH(p);
    int gt = blockIdx.x * 512 + hw_tid(wid0); asm volatile("" : "+v"(gt)); const int nt = gridDim.x * 512;
    bf16_t* win = (bf16_t*)(p->ws + WS_WIN); bf16_t* wout = (bf16_t*)(p->ws + WS_WOUT);
    const float* w_in = p->in[I_WIN]; const float* w_out = p->in[I_WOUT];
    for (int idx = gt; idx < NIN * 128; idx += nt) {
        const int jv = idx % NIN, kg = idx / NIN, oc = orig_col(jv);
        float v[8];
#pragma unroll
        for (int i = 0; i < 8; ++i) v[i] = w_in[(size_t)(kg * 8 + i) * NIN + oc];
        u32x4 w; w.x = pk2(v[0], v[1]); w.y = pk2(v[2], v[3]); w.z = pk2(v[4], v[5]); w.w = pk2(v[6], v[7]);
        *(u32x4*)(win + (size_t)jv * D + kg * 8) = w;
    }
    for (int idx = gt; idx < D * 256; idx += nt) {
        const int n = idx % D, kg = idx / D;
        float v[8];
#pragma unroll
        for (int i = 0; i < 8; ++i) v[i] = w_out[(size_t)(kg * 8 + i) * D + n];
        u32x4 w; w.x = pk2(v[0], v[1]); w.y = pk2(v[2], v[3]); w.z = pk2(v[4], v[5]); w.w = pk2(v[6], v[7]);
        *(u32x4*)(wout + (size_t)n * 2048 + kg * 8) = w;
    }
}

__device__ __forceinline__ bf16_t* xn_buf(KP p, int s) { return s == 1 ? (bf16_t*)(p->out + (size_t)2 * SLAB * D) : (bf16_t*)(p->ws + WS_XN); }
__device__ __forceinline__ void phase_ln(KP p, int s, int wid0, int wg0) {
    KP_FRESH(p);
    int tid_ = hw_tid(wid0); asm volatile("" : "+v"(tid_)); int lane = tid_ & 63; const int gw = ((int)blockIdx.x - wg0) * 8 + (tid_ >> 6), nw = ((int)gridDim.x - wg0) * 8;
    const float* x = slab_x(p, s); bf16_t* xn = xn_buf(p, s); float* stats = (float*)(p->ws + WS_STATS) + (size_t)s * SLAB * 2;
    const float4* g4 = (const float4*)p->in[I_EG]; const float4* b4 = (const float4*)p->in[I_EB];
    for (int gi = gw; gi < SLAB / 4; gi += nw) {
        const int r0 = gi * 4;
        asm volatile("" : "+v"(lane));
        float4 v[4][4];
#pragma unroll
        for (int k = 0; k < 4; ++k)
#pragma unroll
            for (int i = 0; i < 4; ++i) v[k][i] = ((const float4*)(x + (size_t)(r0 + k) * D))[lane + 64 * i];
#pragma unroll
        for (int k = 0; k < 4; ++k) {
            const int r = r0 + k;
            float sum = 0.f;
#pragma unroll
            for (int i = 0; i < 4; ++i) sum += v[k][i].x + v[k][i].y + v[k][i].z + v[k][i].w;
            const float mean = wsum(sum, lane) * (1.f / 1024.f);
            float sq = 0.f;
#pragma unroll
            for (int i = 0; i < 4; ++i) { float a = v[k][i].x - mean, b = v[k][i].y - mean, c = v[k][i].z - mean, d = v[k][i].w - mean; sq += a * a + b * b + c * c + d * d; }
            const float rstd = rsqrtf(wsum(sq, lane) * (1.f / 1024.f) + 1e-5f);
            if (lane == 0) { stats[r * 2] = mean; stats[r * 2 + 1] = rstd; }
#pragma unroll
            for (int i = 0; i < 4; ++i) {
                const float4 g = g4[lane + 64 * i], b = b4[lane + 64 * i];
                u32x2 w; w.x = cvtpk_((v[k][i].x - mean) * rstd * g.x + b.x, (v[k][i].y - mean) * rstd * g.y + b.y);
                w.y = cvtpk_((v[k][i].z - mean) * rstd * g.z + b.z, (v[k][i].w - mean) * rstd * g.w + b.w);
                *(u32x2*)(xn + (size_t)r * D + (lane + 64 * i) * 4) = w;
            }
        }
    }
}

struct EpiU {
    static constexpr bool PERM = true, AFTER_DRAIN = false;
    bf16_t* U; bf16_t* TMP;
    __device__ __forceinline__ void operator()(const f32x4 (&acc)[2][2][4][2], const pg8::Unit& u, int wr, int wc, int fr, int fq) const {
        const int row0 = u.pm * 256 + wr * 64 + fr;
        if (u.pn < 16) {
            const int ch0 = 64 * u.pn + 16 * wc + 4 * fq;
#pragma unroll
            for (int ai = 0; ai < 2; ++ai)
#pragma unroll
                for (int m = 0; m < 4; ++m) {
                    bf16_t* rowp = U + (size_t)(row0 + ai * 128 + m * 16) * UW + ch0;
                    const f32x4 h = acc[ai][0][m][0], B = acc[ai][0][m][1], C = acc[ai][1][m][0], z = acc[ai][1][m][1];
                    float pp[4], gg[4];
#pragma unroll
                    for (int j = 0; j < 4; ++j) { pp[j] = C[j] * h[j]; gg[j] = B[j] * siluf_(z[j]); }
                    u32x2 w0; w0.x = pk2(pp[0], pp[1]); w0.y = pk2(pp[2], pp[3]);
                    u32x2 w1; w1.x = pk2(gg[0], gg[1]); w1.y = pk2(gg[2], gg[3]);
                    *(u32x2*)rowp = w0; *(u32x2*)(rowp + 1024) = w1;
                }
        } else {
            const int col0 = 256 * (u.pn - 16) + 32 * wc + 8 * fq; const bool zt = (u.pn >= 28) && (u.pn < 32);
#pragma unroll
            for (int ai = 0; ai < 2; ++ai)
#pragma unroll
                for (int m = 0; m < 4; ++m) {
                    bf16_t* rowp = zt ? U + (size_t)(row0 + ai * 128 + m * 16) * UW + URW + col0 : TMP + (size_t)(row0 + ai * 128 + m * 16) * 4352 + col0;
#pragma unroll
                    for (int bj = 0; bj < 2; ++bj) {
                        const f32x4 v0 = acc[ai][bj][m][0], v1 = acc[ai][bj][m][1];
                        u32x4 w; w.x = pk2(v0[0], v0[1]); w.y = pk2(v0[2], v0[3]); w.z = pk2(v1[0], v1[1]); w.w = pk2(v1[2], v1[3]);
                        *(u32x4*)(rowp + bj * 128) = w;
                    }
                }
        }
    }
};

struct EpiOut {
    static constexpr bool PERM = true, AFTER_DRAIN = false;
    float* out; const float* x; const float* stats; const float* eg; const float* eb;
    __device__ __forceinline__ void operator()(const f32x4 (&acc)[2][2][4][2], const pg8::Unit& u, int wr, int wc, int fr, int fq) const {
        const int row0 = u.pm * 256 + wr * 64 + fr, col0 = u.pn * 256 + wc * 32 + 8 * fq;
#pragma unroll
        for (int ai = 0; ai < 2; ++ai)
#pragma unroll
            for (int m = 0; m < 4; ++m) {
                const int row = row0 + ai * 128 + m * 16;
                const float mean = stats[row * 2], rstd = stats[row * 2 + 1];
#pragma unroll
                for (int bj = 0; bj < 2; ++bj)
#pragma unroll
                    for (int n = 0; n < 2; ++n) {
                        const int c = col0 + bj * 128 + 4 * n;
                        const float4 xv = *(const float4*)(x + (size_t)row * D + c), g = *(const float4*)(eg + c), b = *(const float4*)(eb + c);
                        const f32x4 a = acc[ai][bj][m][n];
                        float4 o;
                        o.x = DN_ALPHA * ((xv.x - mean) * rstd * g.x + b.x) + a[0]; o.y = DN_ALPHA * ((xv.y - mean) * rstd * g.y + b.y) + a[1];
                        o.z = DN_ALPHA * ((xv.z - mean) * rstd * g.z + b.z) + a[2]; o.w = DN_ALPHA * ((xv.w - mean) * rstd * g.w + b.w) + a[3];
                        *(float4*)(out + (size_t)row * D + c) = o;
                    }
            }
    }
};

typedef short bf16x8 __attribute__((ext_vector_type(8)));
typedef short s16x4 __attribute__((ext_vector_type(4)));
typedef __bf16 bf16x2_t __attribute__((ext_vector_type(2)));
typedef float f32x2 __attribute__((ext_vector_type(2)));
#define MFMA16(a, b, c) __builtin_amdgcn_mfma_f32_16x16x32_bf16((a), (b), (c), 0, 0, 0)
#define DI __device__ __forceinline__
constexpr int IMG_STRIDE = 144;
constexpr int WG_FRAG = 0;
constexpr int WG_CONST = 16384;
constexpr int WV_BASE = 16384 + 2560;
constexpr int WV_BYTES = 3 * 16 * IMG_STRIDE + 256;
static_assert(WV_BASE + 8 * WV_BYTES <= LDS_BYTES, "scan LDS map");

DI unsigned cvtpk(float lo, float hi) { f32x2 v = {lo, hi}; bf16x2_t b = __builtin_convertvector(v, bf16x2_t); return __builtin_bit_cast(unsigned, b); }
DI bf16x8 mkfrag(unsigned a, unsigned b, unsigned c, unsigned d) { u32x4 w = {a, b, c, d}; return __builtin_bit_cast(bf16x8, w); }
DI bf16x8 frag_f4(f32x4 a, f32x4 b) { return mkfrag(cvtpk(a[0], a[1]), cvtpk(a[2], a[3]), cvtpk(b[0], b[1]), cvtpk(b[2], b[3])); }
DI float bperm(float v, int srclane) { return __int_as_float(__builtin_amdgcn_ds_bpermute(srclane << 2, __float_as_int(v))); }
DI float lo16(unsigned w) { return __uint_as_float(w << 16); }
DI float hi16(unsigned w) { return __uint_as_float(w & 0xffff0000u); }
template <int CTRL> DI float dpp0(float x) { return __int_as_float(__builtin_amdgcn_update_dpp(0, __float_as_int(x), CTRL, 0xf, 0xf, true)); }
template <int CTRL> DI float dpp1(float x) { return __int_as_float(__builtin_amdgcn_update_dpp(0x3f800000, __float_as_int(x), CTRL, 0xf, 0xf, false)); }
DI float fsig(float x) { return __builtin_amdgcn_rcpf(1.f + __expf(-x)); }
DI f32x4 ld4(const bf16_t* ur) { const u32x2 c = *(const u32x2*)ur; return (f32x4){lo16(c.x), hi16(c.x), lo16(c.y), hi16(c.y)}; }

DI void split_frag(f32x4 a, f32x4 b, bf16x8& hi, bf16x8& lo) {
    f32x4 ah, bh;
    unsigned w[4] = {cvtpk(a[0], a[1]), cvtpk(a[2], a[3]), cvtpk(b[0], b[1]), cvtpk(b[2], b[3])};
    ah[0] = lo16(w[0]); ah[1] = hi16(w[0]); ah[2] = lo16(w[1]); ah[3] = hi16(w[1]); bh[0] = lo16(w[2]); bh[1] = hi16(w[2]); bh[2] = lo16(w[3]); bh[3] = hi16(w[3]);
    hi = mkfrag(w[0], w[1], w[2], w[3]); lo = frag_f4(a - ah, b - bh);
}
struct ChunkIn { u32x2 k[4], r[4], v[4]; bf16x8 tl[2], la[2]; };
template <int PASS> DI void chunk_load(ChunkIn& c, const bf16_t* ur, int h, int d, int q) {
#pragma unroll
    for (int n = 0; n < 4; ++n) {
        c.k[n] = *(const u32x2*)(ur + 1024 + h * 64 + 16 * n + 4 * q);
        if (PASS == 2) { c.v[n] = *(const u32x2*)(ur + 2048 + h * 64 + 16 * n + 4 * q); c.r[n] = *(const u32x2*)(ur + h * 64 + 16 * n + 4 * q); }
    }
#pragma unroll
    for (int ks = 0; ks < 2; ++ks) { const bf16_t* ul = ur + 4096 + d * 64 + 32 * ks + 8 * q; c.tl[ks] = *(const bf16x8*)ul; c.la[ks] = *(const bf16x8*)(ul + 128); }
}
DI f32x4 up4(u32x2 c) { return (f32x4){lo16(c.x), hi16(c.x), lo16(c.y), hi16(c.y)}; }
template <int PASS>
__device__ void phase_scan(KP p, int s, unsigned char* ldsg, int wid0) {
    KP_FRESH(p);
    const int wid = wid0;
    int tok0, nseq, T; slab_info(s, tok0, nseq, T);
    const int LS = 256, lgseg = (s == 0) ? 3 : 6, nseg = 1 << lgseg, nblk = (nseq * 32 << lgseg) >> 3;
    const bf16_t* U = (const bf16_t*)(p->ws + WS_U);
    bf16_t* YS = (bf16_t*)(p->ws + WS_YS); float* BON = (float*)(p->ws + WS_BON);
    float* PQ = (float*)(p->ws + WS_PQ); const float* SST = (const float*)(p->ws + WS_SST);
    float* cst = (float*)(ldsg + WG_CONST);
    const int wo = WV_BASE + wid * WV_BYTES;
    for (int ib = blockIdx.x; ib < nblk; ib += gridDim.x) {
        const int item = ib * 8 + wid, g = item & (nseg - 1), chain = item >> lgseg, h = chain & 15, d = (chain >> 4) & 1, b = chain >> 5;
        const int tid = hw_tid(wid0), lane = tid & 63, fr = lane & 15, q = lane >> 4;
        __syncthreads();
        if (tid < 64) {
            const float* mu = p->in[I_MU]; const int c = h * 64 + tid;
            cst[tid] = mu[c]; cst[64 + tid] = mu[1024 + c]; cst[128 + tid] = mu[2048 + c];
            cst[192 + tid] = -1.44269504f * p->in[I_W0][d * 1024 + c]; cst[256 + tid] = -1.44269504f * p->in[I_A0][d * 1024 + c];
            cst[320 + tid] = p->in[I_KK][c]; cst[384 + tid] = p->in[I_KA][c]; cst[448 + tid] = p->in[I_RK][c];
            cst[512 + tid] = mu[4096 + d * 64 + tid]; cst[576 + tid] = mu[4096 + 128 + d * 64 + tid];
        }
        for (int e = tid; e < 1024; e += 512) {
            const int l2 = e & 63, ks = (e >> 6) & 1, mt = (e >> 7) & 3, mat = e >> 9, fr2 = l2 & 15, q2 = l2 >> 4;
            const float* src = (mat ? p->in[I_AUP] : p->in[I_WUP]) + ((size_t)d * 64 + 32 * ks + 8 * q2) * 1024 + h * 64 + 16 * mt + fr2;
            float v8[8];
#pragma unroll
            for (int jj = 0; jj < 8; ++jj) v8[jj] = -1.44269504f * src[(size_t)jj * 1024];
            u32x4 w = {cvtpk(v8[0], v8[1]), cvtpk(v8[2], v8[3]), cvtpk(v8[4], v8[5]), cvtpk(v8[6], v8[7])};
            *(u32x4*)(ldsg + WG_FRAG + e * 16) = w;
        }
        __syncthreads();
        f32x4 St[4][4];
        f32x4 Pa[PASS == 1 ? 4 : 1][PASS == 1 ? 4 : 1];
        int l3 = lane; asm volatile("" : "+v"(l3));
        const float* sstl = SST + (size_t)item * 4096 + l3 * 4;
#pragma unroll
        for (int mt = 0; mt < 4; ++mt)
#pragma unroll
            for (int nt = 0; nt < 4; ++nt) {
                if (PASS == 1) {
#pragma unroll
                    for (int j = 0; j < 4; ++j) { St[mt][nt][j] = 0.f; Pa[PASS == 1 ? mt : 0][PASS == 1 ? nt : 0][j] = (16 * mt + 4 * q + j == 16 * nt + fr) ? 1.f : 0.f; }
                } else {
                    St[mt][nt] = *(const f32x4*)(sstl + (mt * 4 + nt) * 256);
                }
            }
        ChunkIn cin;
        { const int p0 = g * LS, t0 = d ? T - 1 - (p0 + fr) : p0 + fr; chunk_load<PASS>(cin, U + (size_t)(b * T + t0) * UW + URW, h, d, q); }
        for (int ck = 0; ck < LS / 16; ++ck) {
            const int pos0 = g * LS + ck * 16;
            const int lane_c = hw_tid(wid0) & 63;
            const int lane = lane_c, fr = lane_c & 15, q = lane_c >> 4;
            const int ti = d ? T - 1 - (pos0 + fr) : pos0 + fr, row = b * T + ti;
            ChunkIn cc = cin;
            if (PASS == 1) {
#pragma unroll
                for (int n = 0; n < 4; ++n) cc.v[n] = *(const u32x2*)(U + (size_t)row * UW + URW + 2048 + h * 64 + 16 * n + 4 * q);
            }
            {
                const int pn = g * LS + (ck + 1 < LS / 16 ? ck + 1 : ck) * 16, tn = d ? T - 1 - (pn + fr) : pn + fr;
                chunk_load<PASS>(cin, U + (size_t)(b * T + tn) * UW + URW, h, d, q);
            }
            const int lq16 = 16 * q, ll16 = 16 * lane, limg = fr * IMG_STRIDE + 8 * q, ltr = (4 * q + (fr >> 2)) * IMG_STRIDE + 8 * (fr & 3);
            f32x4 ow[4], oa[4];
            {
                const bf16x8 tlf[2] = {cc.tl[0], cc.tl[1]}, laf[2] = {cc.la[0], cc.la[1]};
#pragma unroll
                for (int mt = 0; mt < 4; ++mt) {
                    const bf16x8 w0f = *(const bf16x8*)(ldsg + WG_FRAG + ((0 * 4 + mt) * 2 + 0) * 1024 + ll16), w1f = *(const bf16x8*)(ldsg + WG_FRAG + ((0 * 4 + mt) * 2 + 1) * 1024 + ll16);
                    const bf16x8 a0f = *(const bf16x8*)(ldsg + WG_FRAG + ((1 * 4 + mt) * 2 + 0) * 1024 + ll16), a1f = *(const bf16x8*)(ldsg + WG_FRAG + ((1 * 4 + mt) * 2 + 1) * 1024 + ll16);
                    f32x4 z = {0.f, 0.f, 0.f, 0.f};
                    ow[mt] = MFMA16(w1f, tlf[1], MFMA16(w0f, tlf[0], z));
                    oa[mt] = MFMA16(a1f, laf[1], MFMA16(a0f, laf[0], z));
                }
            }
            f32x4 km[4]; float ss = 0.f;
#pragma unroll
            for (int n = 0; n < 4; ++n) {
                km[n] = up4(cc.k[n]);
                const f32x4 kr = km[n] * *(const f32x4*)(ldsg + WG_CONST + (320 + 16 * n) * 4 + lq16);
                ss += kr[0] * kr[0] + kr[1] * kr[1] + kr[2] * kr[2] + kr[3] * kr[3];
            }
            ss += bperm(ss, lane ^ 16); ss += bperm(ss, lane ^ 32);
            const float kinv = 1.f / fmaxf(sqrtf(ss), 1e-12f);
            u32x2 kapP[4], ktP[4], btP[4], rtP[4]; float bon = 0.f;
#pragma unroll
            for (int n = 0; n < 4; ++n) {
                const int co = 16 * n + 4 * q;
                const f32x4 w0v = *(const f32x4*)(ldsg + WG_CONST + (192 + 16 * n) * 4 + lq16), a0v = *(const f32x4*)(ldsg + WG_CONST + (256 + 16 * n) * 4 + lq16), kkw = *(const f32x4*)(ldsg + WG_CONST + (320 + 16 * n) * 4 + lq16), kav = *(const f32x4*)(ldsg + WG_CONST + (384 + 16 * n) * 4 + lq16);
                f32x4 lw, av, L, gmv;
#pragma unroll
                for (int j = 0; j < 4; ++j) { lw[j] = -0.87503877f * __builtin_amdgcn_rcpf(1.f + __builtin_amdgcn_exp2f(w0v[j] + ow[n][j])); av[j] = __builtin_amdgcn_rcpf(1.f + __builtin_amdgcn_exp2f(a0v[j] + oa[n][j])); }
#pragma unroll
                for (int j = 0; j < 4; ++j) {
                    float x = __builtin_amdgcn_exp2f(lw[j]);
                    x *= dpp1<0x111>(x); x *= dpp1<0x112>(x); x *= dpp1<0x114>(x); x *= dpp1<0x118>(x);
                    L[j] = x; lw[j] = dpp1<0x111>(x); gmv[j] = dpp0<0x121>(x);
                }
                f32x4 kap, kt, bt;
#pragma unroll
                for (int j = 0; j < 4; ++j) {
                    const float eL = L[j], emL = __builtin_amdgcn_rcpf(L[j]), eLm = lw[j];
                    const float kk = km[n][j] * kkw[j] * kinv, kd = km[n][j] * (1.f + (av[j] - 1.f) * kav[j]);
                    kap[j] = kk * eLm; bt[j] = kk * av[j] * emL; kt[j] = kd * emL;
                    if (PASS == 2) { lw[j] = eL; av[j] = kd; }
                }
                if (fr == 0) *(f32x4*)(ldsg + wo + 48 * IMG_STRIDE + 64 * n + lq16) = gmv;
                kapP[n] = (u32x2){cvtpk(kap[0], kap[1]), cvtpk(kap[2], kap[3])};
                ktP[n] = (u32x2){cvtpk(kt[0], kt[1]), cvtpk(kt[2], kt[3])};
                btP[n] = (u32x2){cvtpk(bt[0], bt[1]), cvtpk(bt[2], bt[3])};
                *(u32x2*)(ldsg + wo + 16 * IMG_STRIDE + 32 * n + limg) = ktP[n];
                *(u32x2*)(ldsg + wo + 32 * IMG_STRIDE + 32 * n + limg) = btP[n];
                if (PASS == 2) {
                    const f32x4 rm = up4(cc.r[n]), rk = *(const f32x4*)(ldsg + WG_CONST + (448 + 16 * n) * 4 + lq16);
                    rtP[n] = (u32x2){cvtpk(rm[0] * lw[0], rm[1] * lw[1]), cvtpk(rm[2] * lw[2], rm[3] * lw[3])};
                    bon += rm[0] * av[0] * rk[0] + rm[1] * av[1] * rk[1] + rm[2] * av[2] * rk[2] + rm[3] * av[3] * rk[3];
                }
                *(u32x2*)(ldsg + wo + 32 * n + limg) = cc.v[n];
            }
            if (PASS == 2) {
                bon += bperm(bon, lane ^ 16); bon += bperm(bon, lane ^ 32);
                if (q == 0) BON[((size_t)d * SLAB + row) * 16 + h] = 0.5f * bon;
            }
            const bf16x8 kapF0 = mkfrag(kapP[0].x, kapP[0].y, kapP[1].x, kapP[1].y), kapF1 = mkfrag(kapP[2].x, kapP[2].y, kapP[3].x, kapP[3].y);
            bf16x8 akkA, tA, aryA;
            {
                const bf16x8 ktF0 = mkfrag(ktP[0].x, ktP[0].y, ktP[1].x, ktP[1].y), ktF1 = mkfrag(ktP[2].x, ktP[2].y, ktP[3].x, ktP[3].y);
                const bf16x8 btF0 = mkfrag(btP[0].x, btP[0].y, btP[1].x, btP[1].y), btF1 = mkfrag(btP[2].x, btP[2].y, btP[3].x, btP[3].y);
                const f32x4 z = {0.f, 0.f, 0.f, 0.f};
                f32x4 akk = MFMA16(ktF1, kapF1, MFMA16(ktF0, kapF0, z));
                f32x4 nn = MFMA16(kapF1, btF1, MFMA16(kapF0, btF0, z));
                f32x4 na = MFMA16(btF1, kapF1, MFMA16(btF0, kapF0, z));
                f32x4 idv;
#pragma unroll
                for (int jj = 0; jj < 4; ++jj) {
                    akk[jj] = (4 * q + jj < fr) ? akk[jj] : 0.f; nn[jj] = (fr < 4 * q + jj) ? nn[jj] : 0.f; na[jj] = (4 * q + jj < fr) ? na[jj] : 0.f;
                    idv[jj] = (4 * q + jj == fr) ? 1.f : 0.f;
                }
                akkA = mkfrag(cvtpk(akk[0], akk[1]), cvtpk(akk[2], akk[3]), 0u, 0u);
                if (PASS == 2) {
                    const bf16x8 rtF0 = mkfrag(rtP[0].x, rtP[0].y, rtP[1].x, rtP[1].y), rtF1 = mkfrag(rtP[2].x, rtP[2].y, rtP[3].x, rtP[3].y);
                    f32x4 ark = MFMA16(ktF1, rtF1, MFMA16(ktF0, rtF0, z));
                    f32x4 arb = MFMA16(btF1, rtF1, MFMA16(btF0, rtF0, z));
#pragma unroll
                    for (int jj = 0; jj < 4; ++jj) { ark[jj] = (4 * q + jj <= fr) ? ark[jj] : 0.f; arb[jj] = (4 * q + jj <= fr) ? arb[jj] : 0.f; }
                    aryA = mkfrag(cvtpk(ark[0], ark[1]), cvtpk(ark[2], ark[3]), cvtpk(arb[0], arb[1]), cvtpk(arb[2], arb[3]));
                }
#define TF(x) mkfrag(cvtpk((x)[0], (x)[1]), cvtpk((x)[2], (x)[3]), 0u, 0u)
                const bf16x8 nF = TF(nn), aF = TF(na);
                const f32x4 n2 = MFMA16(aF, nF, z), a2 = MFMA16(nF, aF, z);
                const bf16x8 n2F = TF(n2), a2F = TF(a2);
                const f32x4 n4 = MFMA16(a2F, n2F, z), a4 = MFMA16(n2F, a2F, z);
                const bf16x8 n4F = TF(n4), a4F = TF(a4);
                const f32x4 n8 = MFMA16(a4F, n4F, z);
                const f32x4 t21 = MFMA16(n2F, aF, z);
                f32x4 R = idv - na + a2 - t21;
                R = MFMA16(n4F, TF(R), R);
                R = MFMA16(TF(n8), TF(R), R);
                tA = TF(R);
#undef TF
            }
            s16x4 Vc[4], Kc[4], Bc[4];
            {
                typedef s16x4 __attribute__((address_space(3)))* lp;
#pragma unroll
                for (int t4 = 0; t4 < 4; ++t4) {
                    Vc[t4] = __builtin_amdgcn_ds_read_tr16_b64_v4i16((lp)(ldsg + wo + ltr + 32 * t4));
                    Kc[t4] = __builtin_amdgcn_ds_read_tr16_b64_v4i16((lp)(ldsg + wo + 16 * IMG_STRIDE + ltr + 32 * t4));
                    Bc[t4] = __builtin_amdgcn_ds_read_tr16_b64_v4i16((lp)(ldsg + wo + 32 * IMG_STRIDE + ltr + 32 * t4));
                }
            }
            bf16x8 kbA[4];
#pragma unroll
            for (int mt = 0; mt < 4; ++mt) kbA[mt] = __builtin_shufflevector(Kc[mt], Bc[mt], 0, 1, 2, 3, 4, 5, 6, 7);
#pragma unroll
            for (int nt = 0; nt < 4; ++nt) {
                const f32x4 z = {0.f, 0.f, 0.f, 0.f};
                const bf16x8 stf0 = frag_f4(St[0][nt], St[1][nt]), stf1 = frag_f4(St[2][nt], St[3][nt]);
                const u32x2 vcu = __builtin_bit_cast(u32x2, Vc[nt]);
                f32x4 X = MFMA16(kapF1, stf1, MFMA16(kapF0, stf0, z));
                X = MFMA16(akkA, mkfrag(vcu.x, vcu.y, 0u, 0u), X);
                const f32x4 Uu = MFMA16(tA, mkfrag(cvtpk(X[0], X[1]), cvtpk(X[2], X[3]), 0u, 0u), z);
                const bf16x8 bvu = mkfrag(vcu.x, vcu.y, cvtpk(-Uu[0], -Uu[1]), cvtpk(-Uu[2], -Uu[3]));
                if (PASS == 2) {
                    const bf16x8 rtF0 = mkfrag(rtP[0].x, rtP[0].y, rtP[1].x, rtP[1].y), rtF1 = mkfrag(rtP[2].x, rtP[2].y, rtP[3].x, rtP[3].y);
                    f32x4 Y = MFMA16(rtF1, stf1, MFMA16(rtF0, stf0, z));
                    Y = MFMA16(aryA, bvu, Y);
#pragma unroll
                    for (int jj = 0; jj < 4; ++jj) {
                        const int i = 4 * q + jj, t2 = d ? T - 1 - (pos0 + i) : pos0 + i;
                        YS[((size_t)d * SLAB + b * T + t2) * DR + h * 64 + 16 * nt + fr] = (bf16_t)(cvtpk(Y[jj], 0.f) & 0xffffu);
                    }
                }
#pragma unroll
                for (int mt = 0; mt < 4; ++mt) St[mt][nt] = MFMA16(kbA[mt], bvu, St[mt][nt]) * *(const f32x4*)(ldsg + wo + 48 * IMG_STRIDE + 64 * mt + lq16);
            }
            if (PASS == 1) {
#pragma unroll
                for (int ct = 0; ct < 4; ++ct) {
                    const f32x4 z = {0.f, 0.f, 0.f, 0.f};
                    const bf16x8 pf0 = frag_f4(Pa[0][PASS == 1 ? ct : 0], Pa[PASS == 1 ? 1 : 0][PASS == 1 ? ct : 0]), pf1 = frag_f4(Pa[PASS == 1 ? 2 : 0][PASS == 1 ? ct : 0], Pa[PASS == 1 ? 3 : 0][PASS == 1 ? ct : 0]);
                    const f32x4 X = MFMA16(kapF1, pf1, MFMA16(kapF0, pf0, z));
                    const f32x4 Uu = MFMA16(tA, mkfrag(cvtpk(X[0], X[1]), cvtpk(X[2], X[3]), 0u, 0u), z);
                    const bf16x8 bvu = mkfrag(0u, 0u, cvtpk(-Uu[0], -Uu[1]), cvtpk(-Uu[2], -Uu[3]));
#pragma unroll
                    for (int mt = 0; mt < 4; ++mt) Pa[PASS == 1 ? mt : 0][PASS == 1 ? ct : 0] = MFMA16(kbA[mt], bvu, Pa[PASS == 1 ? mt : 0][PASS == 1 ? ct : 0]) * *(const f32x4*)(ldsg + wo + 48 * IMG_STRIDE + 64 * mt + lq16);
                }
            }
        }
        if (PASS == 1) {
            const int l2 = hw_tid(wid0) & 63, fr2 = l2 & 15, q2 = l2 >> 4;
            unsigned char* pqb = (unsigned char*)(PQ + (size_t)item * 8192);
            float* tl = (float*)(ldsg + wo);
#pragma unroll
            for (int mt = 0; mt < 4; ++mt)
#pragma unroll
                for (int ks = 0; ks < 2; ++ks) {
#pragma unroll
                    for (int e = 0; e < 2; ++e)
#pragma unroll
                        for (int j2 = 0; j2 < 4; ++j2) tl[e * 256 + (4 * q2 + j2) * 16 + fr2] = Pa[PASS == 1 ? mt : 0][PASS == 1 ? 2 * ks + e : 0][j2];
                    __builtin_amdgcn_wave_barrier();
                    const f32x4 pa = *(const f32x4*)(tl + fr2 * 16 + 4 * q2), pb = *(const f32x4*)(tl + 256 + fr2 * 16 + 4 * q2);
                    __builtin_amdgcn_wave_barrier();
                    bf16x8 ah, al; split_frag(pa, pb, ah, al);
                    *(bf16x8*)(pqb + (((mt * 2 + ks) * 2 + 0) * 64 + l2) * 16) = ah;
                }
            float* pq = PQ + (size_t)item * 8192 + 4096 + l2 * 4;
#pragma unroll
            for (int mt = 0; mt < 4; ++mt)
#pragma unroll
                for (int nt = 0; nt < 4; ++nt) *(f32x4*)(pq + (mt * 4 + nt) * 256) = St[mt][nt];
        }
    }
}

constexpr int CR_SLOTS = 10, CR_SLOT_BYTES = 12288, CR_FLAGS = CR_SLOTS * CR_SLOT_BYTES;
__device__ __forceinline__ void phase_combine_ring(KP p, int s, int wid0, unsigned char* ldsg) {
    KP_FRESH(p);
    int tid_ = hw_tid(wid0); asm volatile("" : "+v"(tid_));
    const int lane = tid_ & 63, wid = wid0;
    const int nseg = 64, nsteps = nseg - 1;
    const float* PQ = (const float*)(p->ws + WS_PQ); float* SST = (float*)(p->ws + WS_SST);
    volatile unsigned* flags = (volatile unsigned*)(ldsg + CR_FLAGS);
    __syncthreads();
    if (tid_ < CR_SLOTS) flags[tid_] = 0u;
    __syncthreads();
    if ((int)blockIdx.x >= 128) return;
    const int nt = blockIdx.x & 3, chain = blockIdx.x >> 2;
    if (wid != 0) {
        u32x4 ra[12], rb[12];
#define CR_ISSUE(r, gg) do { const unsigned char* b_ = (const unsigned char*)(PQ + ((size_t)chain * nseg + (gg)) * 8192); \
        _Pragma("unroll") for (int f = 0; f < 8; ++f) (r)[f] = *(const u32x4*)(b_ + ((f * 2 + 0) * 64 + lane) * 16); \
        _Pragma("unroll") for (int mt = 0; mt < 4; ++mt) (r)[8 + mt] = *(const u32x4*)(b_ + 16384 + ((mt * 4 + nt) * 64 + lane) * 16); } while (0)
#define CR_PUT(r, gg) do { const int slot_ = (gg) % CR_SLOTS; const unsigned gen_ = 2u * (unsigned)((gg) / CR_SLOTS); unsigned sp_ = 0;     \
        while (flags[slot_] != gen_ && ++sp_ < (1u << 20)) __builtin_amdgcn_s_sleep(1); \
        _Pragma("unroll") for (int f = 0; f < 12; ++f) *(u32x4*)(ldsg + slot_ * CR_SLOT_BYTES + f * 1024 + lane * 16) = (r)[f]; \
        asm volatile("s_waitcnt lgkmcnt(0)" ::: "memory"); __builtin_amdgcn_wave_barrier(); \
        if (lane == 0) flags[slot_] = gen_ + 1u; } while (0)
        int g = wid - 1;
        if (g < nsteps) CR_ISSUE(ra, g);
        for (; g < nsteps; g += 14) {
            if (g + 7 < nsteps) CR_ISSUE(rb, g + 7);
            CR_PUT(ra, g);
            if (g + 14 < nsteps) CR_ISSUE(ra, g + 14);
            if (g + 7 < nsteps) CR_PUT(rb, g + 7);
        }
#undef CR_ISSUE
#undef CR_PUT
    } else {
        f32x4 S[4];
#pragma unroll
        for (int mt = 0; mt < 4; ++mt) S[mt] = (f32x4){0.f, 0.f, 0.f, 0.f};
        for (int g = 0; g < nseg; ++g) {
            const size_t item = (size_t)chain * nseg + g;
#pragma unroll
            for (int mt = 0; mt < 4; ++mt) *(f32x4*)(SST + item * 4096 + ((mt * 4 + nt) * 64 + lane) * 4) = S[mt];
            if (g == nsteps) break;
            const int slot = g % CR_SLOTS; const unsigned gen = 2u * (unsigned)(g / CR_SLOTS); unsigned sp = 0;
            while (flags[slot] != gen + 1u && ++sp < (1u << 20)) __builtin_amdgcn_s_sleep(1);
            bf16x8 ah[4][2]; f32x4 qv[4];
#pragma unroll
            for (int mt = 0; mt < 4; ++mt) {
                qv[mt] = *(const f32x4*)(ldsg + slot * CR_SLOT_BYTES + (8 + mt) * 1024 + lane * 16);
#pragma unroll
                for (int ks = 0; ks < 2; ++ks) ah[mt][ks] = *(const bf16x8*)(ldsg + slot * CR_SLOT_BYTES + (mt * 2 + ks) * 1024 + lane * 16);
            }
            asm volatile("s_waitcnt lgkmcnt(0)" ::: "memory"); __builtin_amdgcn_wave_barrier();
            if (lane == 0) flags[slot] = gen + 2u;
            bf16x8 bh[2], bl[2];
            split_frag(S[0], S[1], bh[0], bl[0]); split_frag(S[2], S[3], bh[1], bl[1]);
#pragma unroll
            for (int mt = 0; mt < 4; ++mt) {
                f32x4 acc = qv[mt];
#pragma unroll
                for (int ks = 0; ks < 2; ++ks) { acc = MFMA16(ah[mt][ks], bh[ks], acc); acc = MFMA16(ah[mt][ks], bl[ks], acc); }
                S[mt] = acc;
            }
        }
    }
}

__device__ void phase_combine(KP p, int s, int wid0) {
    KP_FRESH(p);
    int tid_ = hw_tid(wid0); asm volatile("" : "+v"(tid_));
    const int lane = tid_ & 63, wid = tid_ >> 6, fr = lane & 15, q = lane >> 4;
    int tok0, nseq, T; slab_info(s, tok0, nseq, T);
    const int lgseg = (s == 0) ? 3 : 6, nseg = 1 << lgseg, nwork = nseq * 32 * 4;
    const float* PQ = (const float*)(p->ws + WS_PQ); float* SST = (float*)(p->ws + WS_SST);
    for (int wk = blockIdx.x * 8 + wid; wk < nwork; wk += gridDim.x * 8) {
        const int nt = wk & 3, chain = wk >> 2;
        f32x4 S[4];
#pragma unroll
        for (int mt = 0; mt < 4; ++mt) S[mt] = (f32x4){0.f, 0.f, 0.f, 0.f};
        struct CStep { bf16x8 ah[4][2]; f32x4 q[4]; };
#define CMB_LOAD(c, gg) do { const int g_ = (gg) < nseg - 1 ? (gg) : nseg - 2; const unsigned char* b_ = (const unsigned char*)(PQ + ((size_t)chain * nseg + g_) * 8192); \
        _Pragma("unroll") for (int mt = 0; mt < 4; ++mt) { (c).q[mt] = *(const f32x4*)(b_ + 16384 + ((mt * 4 + nt) * 64 + lane) * 16); \
            _Pragma("unroll") for (int ks = 0; ks < 2; ++ks) (c).ah[mt][ks] = *(const bf16x8*)(b_ + (((mt * 2 + ks) * 2 + 0) * 64 + lane) * 16); } } while (0)
        CStep c0, c1, c2;
        CMB_LOAD(c0, 0); CMB_LOAD(c1, 1); CMB_LOAD(c2, 2);
        for (int g = 0; g < nseg; ++g) {
            const size_t item = (size_t)chain * nseg + g;
#pragma unroll
            for (int mt = 0; mt < 4; ++mt) *(f32x4*)(SST + item * 4096 + ((mt * 4 + nt) * 64 + lane) * 4) = S[mt];
            if (g == nseg - 1) break;
            const CStep cc = c0; c0 = c1; c1 = c2;
            CMB_LOAD(c2, g + 3);
            bf16x8 bh[2], bl[2];
            split_frag(S[0], S[1], bh[0], bl[0]); split_frag(S[2], S[3], bh[1], bl[1]);
#pragma unroll
            for (int mt = 0; mt < 4; ++mt) {
                f32x4 acc = cc.q[mt];
#pragma unroll
                for (int ks = 0; ks < 2; ++ks) { acc = MFMA16(cc.ah[mt][ks], bh[ks], acc); acc = MFMA16(cc.ah[mt][ks], bl[ks], acc); }
                S[mt] = acc;
            }
        }
#undef CMB_LOAD
    }
}

DI void unpack8(u32x4 w, float (&f)[8]) { f[0] = lo16(w.x); f[1] = hi16(w.x); f[2] = lo16(w.y); f[3] = hi16(w.y); f[4] = lo16(w.z); f[5] = hi16(w.z); f[6] = lo16(w.w); f[7] = hi16(w.w); }
__device__ void phase_shift(KP p, int s, int wid0) {
    KP_FRESH(p);
    int tid_ = hw_tid(wid0); asm volatile("" : "+v"(tid_));
    int tok0, nseq, T; slab_info(s, tok0, nseq, T);
    const bf16_t* TMP = (const bf16_t*)(p->ws + WS_TMP); bf16_t* U = (bf16_t*)(p->ws + WS_U);
    const float* mu = p->in[I_MU];
    const int gt = blockIdx.x * 512 + tid_, nt = gridDim.x * 512;
    for (int unit = gt; unit < 416 * (SLAB / 16); unit += nt) {
        const int cg0 = unit % 416, cg = cg0 < 384 ? cg0 : cg0 + 128, rb = unit / 416, c0 = cg * 8, r0 = rb * 16;
        const bool tanh_cols = (c0 >= 4096) && (c0 < 4096 + 128);
        float m[8];
        { const f32x4 a = *(const f32x4*)(mu + c0), b = *(const f32x4*)(mu + c0 + 4); m[0] = a[0]; m[1] = a[1]; m[2] = a[2]; m[3] = a[3]; m[4] = b[0]; m[5] = b[1]; m[6] = b[2]; m[7] = b[3]; }
        const bf16_t* src = TMP + (size_t)r0 * 4352 + c0; bf16_t* dst = U + (size_t)r0 * UW + URW + c0;
        const int t0 = r0 & (T - 1);
        u32x4 raw[18];
        raw[0] = (t0 > 0) ? *(const u32x4*)(src - 4352) : (u32x4){0u, 0u, 0u, 0u};
#pragma unroll
        for (int i = 0; i < 16; ++i) raw[i + 1] = *(const u32x4*)(src + (size_t)i * 4352);
        raw[17] = (t0 + 16 < T) ? *(const u32x4*)(src + (size_t)16 * 4352) : (u32x4){0u, 0u, 0u, 0u};
        float prev[8], cur[8], nxt[8];
        unpack8(raw[0], prev); unpack8(raw[1], cur);
#pragma unroll
        for (int i = 0; i < 16; ++i) {
            unpack8(raw[i + 2], nxt);
            float o[8];
#pragma unroll
            for (int e = 0; e < 8; ++e) {
                float v = cur[e] + m[e] * (0.5f * (prev[e] + nxt[e]) - cur[e]);
                if (tanh_cols) v = 1.f - 2.f * __builtin_amdgcn_rcpf(1.f + __expf(2.f * v));
                o[e] = v; prev[e] = cur[e]; cur[e] = nxt[e];
            }
            *(u32x4*)(dst + (size_t)i * UW) = (u32x4){cvtpk(o[0], o[1]), cvtpk(o[2], o[3]), cvtpk(o[4], o[5]), cvtpk(o[6], o[7])};
        }
    }
}

__device__ void phase_post(KP p, int s, int wid0) {
    KP_FRESH(p);
    int tid_ = hw_tid(wid0); asm volatile("" : "+v"(tid_));
    const int lane = tid_ & 63, gw = blockIdx.x * 8 + (tid_ >> 6), nw = gridDim.x * 8;
    int tok0, nseq, T; slab_info(s, tok0, nseq, T);
    const bf16_t* U = (const bf16_t*)(p->ws + WS_U);
    const bf16_t* YS = (const bf16_t*)(p->ws + WS_YS); const float* BON = (const float*)(p->ws + WS_BON);
    bf16_t* ymix = (bf16_t*)(p->ws + WS_YMIX);
    for (int unit = gw; unit < (SLAB / 16) * 2; unit += nw) {
        const int half = unit & 1, r0 = (unit >> 1) * 16, c0 = half * 512 + lane * 8, h = c0 >> 6;
        float cw0[8], cw1[8], cw2[8], cbv[8], lg[8], lb[8];
        {
            const float* cw = p->in[I_CW]; const float* cb = p->in[I_CB]; const float* g = p->in[I_LXG]; const float* b = p->in[I_LXB];
#pragma unroll
            for (int e = 0; e < 8; ++e) { cw0[e] = cw[c0 + e]; cw1[e] = cw[1024 + c0 + e]; cw2[e] = cw[2048 + c0 + e]; cbv[e] = cb[c0 + e]; lg[e] = g[c0 + e]; lb[e] = b[c0 + e]; }
        }
        const int t0 = r0 & (T - 1);
        const bf16_t* up = U + (size_t)r0 * UW + c0;
        float pprev[8], pcur[8], pnxt[8], zprev[8], zcur[8], znxt[8], muz[8];
        if (t0 > 0) { unpack8(*(const u32x4*)(up - UW), pprev); unpack8(*(const u32x4*)(up - UW + URW + 3072), zprev); } else { for (int e = 0; e < 8; ++e) { pprev[e] = 0.f; zprev[e] = 0.f; } }
        unpack8(*(const u32x4*)up, pcur); unpack8(*(const u32x4*)(up + URW + 3072), zcur);
        { const float* mu = p->in[I_MU];
#pragma unroll
          for (int e = 0; e < 8; ++e) muz[e] = mu[3072 + c0 + e]; }
        for (int ib = 0; ib < 16; ib += 4) {
            u32x4 rp[4], rg[4], rv[4], rz[4], ry0[4], ry1[4]; float bonv[4];
#pragma unroll
            for (int r = 0; r < 4; ++r) {
                const int i = ib + r, row = r0 + i;
                const bf16_t* ur = up + (size_t)i * UW;
                rp[r] = (t0 + i < T - 1) ? *(const u32x4*)(ur + UW) : (u32x4){0u, 0u, 0u, 0u};
                rz[r] = (t0 + i < T - 1) ? *(const u32x4*)(ur + UW + URW + 3072) : (u32x4){0u, 0u, 0u, 0u};
                rg[r] = *(const u32x4*)(ur + 1024); rv[r] = *(const u32x4*)(ur + URW + 2048);
                ry0[r] = *(const u32x4*)(YS + (size_t)row * DR + c0); ry1[r] = *(const u32x4*)(YS + ((size_t)SLAB + row) * DR + c0);
                bonv[r] = BON[(size_t)row * 16 + h] + BON[((size_t)SLAB + row) * 16 + h];
            }
#pragma unroll
            for (int r = 0; r < 4; ++r) {
                const int row = r0 + ib + r;
                float gg[8], vv[8], zz[8], y[8], y1[8];
                unpack8(rp[r], pnxt); unpack8(rg[r], gg); unpack8(rv[r], vv); unpack8(rz[r], znxt); unpack8(ry0[r], y); unpack8(ry1[r], y1);
#pragma unroll
                for (int e = 0; e < 8; ++e) { zz[e] = zcur[e] + muz[e] * (0.5f * (zprev[e] + znxt[e]) - zcur[e]); zprev[e] = zcur[e]; zcur[e] = znxt[e]; }
                const float bon = bonv[r];
#pragma unroll
                for (int e = 0; e < 8; ++e) y[e] += y1[e];
                float sum = 0.f;
#pragma unroll
                for (int e = 0; e < 8; ++e) sum += y[e];
                sum += shx(sum, lane, 1); sum += shx(sum, lane, 2); sum += shx(sum, lane, 4);
                const float mean = sum * (1.f / 64.f);
                float sq = 0.f;
#pragma unroll
                for (int e = 0; e < 8; ++e) { const float dl = y[e] - mean; sq += dl * dl; }
                sq += shx(sq, lane, 1); sq += shx(sq, lane, 2); sq += shx(sq, lane, 4);
                const float rstd = rsqrtf(sq * (1.f / 64.f) + 64e-5f);
                float oc[8], orw[8];
#pragma unroll
                for (int e = 0; e < 8; ++e) {
                    oc[e] = gg[e] * (cw0[e] * pprev[e] + cw1[e] * pcur[e] + cw2[e] * pnxt[e] + cbv[e]);
                    orw[e] = ((y[e] - mean) * rstd * lg[e] + lb[e] + bon * vv[e]) * (zz[e] * fsig(zz[e]));
                    pprev[e] = pcur[e]; pcur[e] = pnxt[e];
                }
                *(u32x4*)(ymix + (size_t)row * 2048 + c0) = (u32x4){cvtpk(oc[0], oc[1]), cvtpk(oc[2], oc[3]), cvtpk(oc[4], oc[5]), cvtpk(oc[6], oc[7])};
                *(u32x4*)(ymix + (size_t)row * 2048 + 1024 + c0) = (u32x4){cvtpk(orw[0], orw[1]), cvtpk(orw[2], orw[3]), cvtpk(orw[4], orw[5]), cvtpk(orw[6], orw[7])};
            }
        }
    }
}

__device__ void phase_lnout(KP p, int s, int wid0) {
    KP_FRESH(p);
    int tid_ = hw_tid(wid0); asm volatile("" : "+v"(tid_)); int lane = tid_ & 63; const int gw = blockIdx.x * 8 + (tid_ >> 6), nw = gridDim.x * 8;
    float* out = p->out + (size_t)s * SLAB * D;
    const float4* g4 = (const float4*)p->in[I_LG]; const float4* b4 = (const float4*)p->in[I_LB];
    for (int r0 = gw; r0 < SLAB; r0 += 4 * nw) {
        asm volatile("" : "+v"(lane));
        float4 v[4][4];
#pragma unroll
        for (int k = 0; k < 4; ++k)
#pragma unroll
            for (int i = 0; i < 4; ++i) v[k][i] = ((const float4*)(out + (size_t)(r0 + k * nw) * D))[lane + 64 * i];
#pragma unroll
        for (int k = 0; k < 4; ++k) {
            float4* xp = (float4*)(out + (size_t)(r0 + k * nw) * D);
            float sum = 0.f;
#pragma unroll
            for (int i = 0; i < 4; ++i) sum += v[k][i].x + v[k][i].y + v[k][i].z + v[k][i].w;
            const float mean = wsum(sum, lane) * (1.f / 1024.f);
            float sq = 0.f;
#pragma unroll
            for (int i = 0; i < 4; ++i) { float a = v[k][i].x - mean, b = v[k][i].y - mean, c = v[k][i].z - mean, d = v[k][i].w - mean; sq += a * a + b * b + c * c + d * d; }
            const float rstd = rsqrtf(wsum(sq, lane) * (1.f / 1024.f) + 1e-5f);
#pragma unroll
            for (int i = 0; i < 4; ++i) {
                const float4 g = g4[lane + 64 * i], b = b4[lane + 64 * i];
                float4 o; o.x = (v[k][i].x - mean) * rstd * g.x + b.x; o.y = (v[k][i].y - mean) * rstd * g.y + b.y; o.z = (v[k][i].z - mean) * rstd * g.z + b.z; o.w = (v[k][i].w - mean) * rstd * g.w + b.w;
                xp[lane + 64 * i] = o;
            }
        }
    }
}

#define LAS __attribute__((address_space(3)))
#define XB_TMO      128
#define XB_XCNT(j)  (256  + 64 * (j))
#define XB_XSUB(j)  (1280 + 64 * (j))
#define XB_XGEN(j)  (2304 + 64 * (j))
#define XB_TOP      3328
#define XB_TOPGEN   3392
#define XCD_BAR_WORDS 3456
#define XB_SPIN_CAP (1u << 18)

__device__ __forceinline__ unsigned xb_ld(unsigned* p)              { return __hip_atomic_load(p, __ATOMIC_RELAXED, __HIP_MEMORY_SCOPE_AGENT); }
__device__ __forceinline__ unsigned xb_add(unsigned* p, unsigned v) { return __hip_atomic_fetch_add(p, v, __ATOMIC_RELAXED, __HIP_MEMORY_SCOPE_AGENT); }
__device__ __forceinline__ unsigned xb_xcc_id() { return (unsigned)__builtin_amdgcn_s_getreg((3 << 11) | 20) & 0xFu; }
#define XB_SPIN(cond, bar) do { unsigned _sp = 0; while (cond) { __builtin_amdgcn_s_sleep(1); \
    if ((++_sp & 255u) == 0u) { if (xb_ld(&(bar)[XB_TMO])) break; if (_sp > XB_SPIN_CAP) { atomicAdd(&(bar)[XB_TMO], 1u); break; } } } } while (0)

struct XcdBarrier {
    unsigned* bar; unsigned x;
    volatile LAS unsigned* st;
};

__device__ __forceinline__ XcdBarrier xcd_barrier_post(unsigned* bar, volatile LAS unsigned* st) {
    XcdBarrier b; b.bar = bar; b.x = xb_xcc_id(); b.st = st;
    if (threadIdx.x == 0) (void)xb_add(&bar[XB_XCNT(b.x)], 1u);
    return b;
}
__device__ __forceinline__ void xcd_barrier_complete(unsigned* bar, unsigned x, unsigned& nloc, unsigned& nx) {
    const unsigned G = gridDim.x * gridDim.y * gridDim.z;
    unsigned sum, cnt, mine, sp = 0u;
    for (;;) {
        sum = 0u; cnt = 0u; mine = 0u;
#pragma unroll
        for (unsigned j = 0; j < 16; ++j) { const unsigned c = xb_ld(&bar[XB_XCNT(j)]); sum += c; cnt += (c > 0u) ? 1u : 0u; mine = (j == x) ? c : mine; }
        if (sum == G) break;
        __builtin_amdgcn_s_sleep(1);
        if ((++sp & 255u) == 0u) { if (xb_ld(&bar[XB_TMO])) break; if (sp > XB_SPIN_CAP) { atomicAdd(&bar[XB_TMO], 1u); break; } }
    }
    nloc = mine > 0u ? mine : 1u; nx = cnt > 0u ? cnt : 1u;
}

__device__ __forceinline__ void xcd_barrier(const XcdBarrier& b) {
    asm volatile("s_waitcnt vmcnt(0)" ::: "memory");
    __syncthreads();
    if (threadIdx.x == 0) {
        unsigned* bar = b.bar;
        __builtin_amdgcn_s_waitcnt(0);
        unsigned nloc = b.st[0], nx = b.st[1];
        if (nloc == 0u) { xcd_barrier_complete(bar, b.x, nloc, nx); b.st[0] = nloc; b.st[1] = nx; }
        const unsigned old = xb_add(&bar[XB_XSUB(b.x)], 1u);
        const unsigned gen = old / nloc;
        if (old + 1u == (gen + 1u) * nloc) {
            __builtin_amdgcn_fence(__ATOMIC_RELEASE, "agent");
            asm volatile("s_waitcnt vmcnt(0)" ::: "memory");
            const unsigned og = xb_add(&bar[XB_TOP], 1u);
            const unsigned tg = og / nx;
            if (og + 1u == (tg + 1u) * nx) xb_add(&bar[XB_TOPGEN], 1u);
            else XB_SPIN(xb_ld(&bar[XB_TOPGEN]) == tg, bar);
            __builtin_amdgcn_fence(__ATOMIC_ACQUIRE, "agent");
            xb_add(&bar[XB_XGEN(b.x)], 1u);
            asm volatile("s_waitcnt vmcnt(0)" ::: "memory");
        } else {
            XB_SPIN(xb_ld(&bar[XB_XGEN(b.x)]) == gen, bar);
            __builtin_amdgcn_fence(__ATOMIC_ACQUIRE, "agent");
            asm volatile("s_waitcnt vmcnt(0)" ::: "memory");
        }
    }
    __syncthreads();
}

#ifndef REP_SHIFT
#define REP_SHIFT 1
#endif
#ifndef REP_G2
#define REP_G2 1
#endif
#ifndef REP_SCAN
#define REP_SCAN 1
#endif
#ifndef REP_POST
#define REP_POST 1
#endif
#ifndef REP_G1
#define REP_G1 1
#endif
#define GBAR() xcd_barrier(bar)
__global__ void __launch_bounds__(512, 2) fwd_megakernel(Params p_unused) {
    extern __shared__ __attribute__((aligned(16))) unsigned char lds_raw[];
    PG8_LAS unsigned char* lds = (PG8_LAS unsigned char*)lds_raw;
    cg::grid_group grid = cg::this_grid();
    KP p = (KP)__builtin_amdgcn_kernarg_segment_ptr();
    if (threadIdx.x < 2) ((volatile LAS unsigned*)(lds + LDS_BYTES - 64))[threadIdx.x] = 0u;
    __syncthreads();
    {
        unsigned* bw = (unsigned*)(((const Params __attribute__((address_space(4)))*)__builtin_amdgcn_kernarg_segment_ptr())->ws + WS_BAR);
        if (blockIdx.x == 0) { for (int w = threadIdx.x; w < XCD_BAR_WORDS; w += 512) __hip_atomic_store(bw + w, 0u, __ATOMIC_RELAXED, __HIP_MEMORY_SCOPE_AGENT); __threadfence(); }
        grid.sync();
    }
    XcdBarrier bar = xcd_barrier_post((unsigned*)(((const Params __attribute__((address_space(4)))*)__builtin_amdgcn_kernarg_segment_ptr())->ws + WS_BAR), (volatile LAS unsigned*)(lds + LDS_BYTES - 64));
    const int wid0 = __builtin_amdgcn_readfirstlane((int)threadIdx.x >> 6);
    phase_weights(p, wid0);
    for (int s = -1; s < 3; ++s) {
        if (s == 0) GBAR();
        if (s >= 0)
        for (int rep = 0; rep < REP_G1; ++rep) {
            if (rep) GBAR();
            KP_FRESH(p);
            pg8::Gemm g; g.A = xn_buf(p, s); g.Bt = (const bf16_t*)(p->ws + WS_WIN); g.M = SLAB; g.N = NIN; g.K = D;
            pg8::StaticOrder S; S.init(g.M, g.N, gridDim.x, blockIdx.x);
            EpiU E; E.U = (bf16_t*)(p->ws + WS_U); E.TMP = (bf16_t*)(p->ws + WS_TMP);
            pg8::gemm_phase<EpiU, pg8::StaticOrder, true, true>(lds, g, S, E, wid0);
        }
        {
            const int wg0 = (s >= 0 && gridDim.x > 64) ? 64 : 0;
            if (s < 2 && (int)blockIdx.x >= wg0) phase_ln(p, s + 1, wid0, wg0);
        }
        if (s < 0) continue;
        GBAR();
        for (int rep = 0; rep < REP_SHIFT; ++rep) {
        phase_shift(p, s, wid0);
        GBAR();
        }
        for (int rep = 0; rep < REP_SCAN; ++rep) {
        phase_scan<1>(p, s, lds_raw, wid0);
        GBAR();
        if (s > 0 && gridDim.x >= 128) phase_combine_ring(p, s, wid0, lds_raw); else phase_combine(p, s, wid0);
        GBAR();
        phase_scan<2>(p, s, lds_raw, wid0);
        GBAR();
        }
        for (int rep = 0; rep < REP_POST; ++rep) {
        phase_post(p, s, wid0);
        GBAR();
        }
        for (int rep = 0; rep < REP_G2; ++rep) {
            if (rep) GBAR();
            KP_FRESH(p);
            pg8::Gemm g; g.A = (const bf16_t*)(p->ws + WS_YMIX); g.Bt = (const bf16_t*)(p->ws + WS_WOUT); g.M = SLAB; g.N = D; g.K = 2048;
            pg8::StaticOrder S; S.init(g.M, g.N, gridDim.x, blockIdx.x);
            EpiOut E; E.out = p->out + (size_t)s * SLAB * D; E.x = slab_x(p, s); E.stats = (const float*)(p->ws + WS_STATS) + (size_t)s * SLAB * 2; E.eg = p->in[I_EG]; E.eb = p->in[I_EB];
            pg8::gemm_phase<EpiOut, pg8::StaticOrder, true, true>(lds, g, S, E, wid0);
        }
        GBAR();
        phase_lnout(p, s, wid0);
    }
}

extern "C" void kernel_launch(void* const* d_in, const int* in_sizes, int n_in, void* d_out, int out_size, void* d_ws, size_t ws_size, hipStream_t stream) {
    static int grid_blocks = 0;
    if (!grid_blocks) {
        int dev = 0, cus = 0, per_cu = 0;
        hipGetDevice(&dev);
        hipDeviceGetAttribute(&cus, hipDeviceAttributeMultiprocessorCount, dev);
        hipFuncSetAttribute((const void*)fwd_megakernel, hipFuncAttributeMaxDynamicSharedMemorySize, LDS_BYTES);
        hipOccupancyMaxActiveBlocksPerMultiprocessor(&per_cu, (const void*)fwd_megakernel, 512, LDS_BYTES);
        if (per_cu < 1) per_cu = 1;
        if (per_cu > 1) per_cu = 1;
        grid_blocks = cus * per_cu;
    }
    Params p{};
    for (int i = 0; i < 20; ++i) p.in[i] = (const float*)d_in[i];
    p.out = (float*)d_out; p.ws = (unsigned char*)d_ws;
    void* args[] = {&p};
    hipError_t e = hipLaunchCooperativeKernel((const void*)fwd_megakernel, dim3(grid_blocks), dim3(512), args, LDS_BYTES, stream);
    if (e != hipSuccess) fprintf(stderr, "cooperative launch failed: %s (grid %d)\n", hipGetErrorString(e), grid_blocks);
}
```

```cpp
#include <hip/hip_runtime.h>
#include <hip/hip_cooperative_groups.h>
#include <cstdio>
#include <cstdint>
namespace cg = cooperative_groups;
namespace pg8 {
#define PG8_LAS __attribute__((address_space(3)))
typedef unsigned short bf16_t;
typedef short bf16x8 __attribute__((ext_vector_type(8)));
typedef float f32x4 __attribute__((ext_vector_type(4)));
typedef unsigned u32x4 __attribute__((ext_vector_type(4)));
constexpr int BM = 256, BK = 64, HALF = 128, HTB = HALF * BK * 2  , STAGE_BYTES = 8 * HTB, NXCD = 8, WGM = 4;

__host__ __device__ __forceinline__ int lds_byte(int r, int c) { const int st = (r >> 4) * 2 + (c >> 5), rr = r & 15, cc = c & 31, ob = rr * 64 + cc * 2; return st * 1024 + (ob ^ (((ob >> 9) & 1) << 5)); }
__host__ __device__ __forceinline__ void stage_rc(int b, int& R, int& C) { const int st = b / 1024, sb = b % 1024, swz = sb ^ (((sb >> 9) & 1) << 5); R = (st >> 1) * 16 + swz / 64; C = (st & 1) * 32 + (swz % 64) / 2; }
__host__ __device__ __forceinline__ int perm32(int rho) { const int n = rho >> 4, i = rho & 15; return 8 * (i >> 2) + 4 * n + (i & 3); }

struct Unit { int pm, pn; };
struct Gemm { const bf16_t* A; const bf16_t* Bt; int M, N, K; };

struct StaticOrder {
    int nM, nN, nwg, G, c;
    __host__ __device__ void init(int M, int N, int G_, int c_) { nM = M / BM; nN = N / BM; nwg = nM * nN; G = G_; c = c_; }
    __host__ __device__ bool next(int i, Unit& u) const {
        const long L = (long)i * G + c; if (L >= nwg) return false;
        int wgid = (int)L; { const int q = nwg / NXCD, r = nwg % NXCD, xcd = wgid % NXCD, off = wgid / NXCD; wgid = (xcd < r ? xcd * (q + 1) : r * (q + 1) + (xcd - r) * q) + off; }
        const int nig = WGM * nN, gid = wgid / nig, fm = gid * WGM, gsz = (nM - fm) < WGM ? (nM - fm) : WGM;
        u.pm = fm + ((wgid % nig) % gsz); u.pn = (wgid % nig) / gsz; return true;
    }
    __device__ __forceinline__ void a_ready(const Unit&) const {}
    __device__ __forceinline__ void done(const Unit&) const {}
};

template <class Epi, class Sched, bool ALIGN_EPI = false, bool SP2 = false>
__device__ __forceinline__ void gemm_phase(PG8_LAS unsigned char* lds, const Gemm g, const Sched& S, const Epi& E, int wid0) {
    int tid_; asm volatile("v_mbcnt_lo_u32_b32 %0, -1, 0\n\tv_mbcnt_hi_u32_b32 %0, -1, %0" : "=v"(tid_)); tid_ += wid0 * 64; const int tid = tid_, wid = __builtin_amdgcn_readfirstlane(tid >> 6), lane = tid & 63, wr = wid >> 2, wc = wid & 3, fr = lane & 15, fq = lane >> 4;
    const int K = g.K, nt = K / BK;
    unsigned voffA[2], voffB[2];
#pragma unroll
    for (int i = 0; i < 2; ++i) { int R, C; stage_rc(tid * 16 + i * 8192, R, C); const int Rb = Epi::PERM ? ((R & ~31) + perm32(R & 31)) : R;
        voffA[i] = (unsigned)(R * K + C) * 2u; voffB[i] = (unsigned)(Rb * K + C) * 2u; }
    const size_t kstep = (size_t)(BK * 2);
    const size_t hstep = (size_t)HALF * K * 2;
    const size_t tstep = 2 * hstep;
    const unsigned ldsw = (unsigned)wid * 1024u;
    const int aoff = lds_byte(wr * 64 + fr, fq * 8), boff = lds_byte(wc * 32 + fr, fq * 8);
#define PG8_SA(b, h) (((b) * 2 + (h)) * HTB)
#define PG8_SB(b, h) ((4 + (b) * 2 + (h)) * HTB)
#define PG8_STAGE(bufoff, gbase, voff) do { _Pragma("unroll") for (int _i = 0; _i < 2; ++_i) \
        __builtin_amdgcn_global_load_lds((const unsigned*)((const char*)(gbase) + (voff)[_i]), (PG8_LAS unsigned*)(lds + (bufoff) + ldsw + _i * 8192), 16, 0, 0); } while (0)
#define PG8_LDA(dst, b, h) do { _Pragma("unroll") for (int m = 0; m < 4; ++m) _Pragma("unroll") for (int k = 0; k < 2; ++k) dst[m][k] = *(const PG8_LAS bf16x8*)(lds + PG8_SA(b, h) + aoff + m * 2048 + k * 1024); } while (0)
#define PG8_LDB(dst, b, h) do { _Pragma("unroll") for (int n = 0; n < 2; ++n) _Pragma("unroll") for (int k = 0; k < 2; ++k) dst[n][k] = *(const PG8_LAS bf16x8*)(lds + PG8_SB(b, h) + boff + n * 2048 + k * 1024); } while (0)
#define PG8_MMA(ai, bj, At, Bt) do { __builtin_amdgcn_s_setprio(1); _Pragma("unroll") for (int m = 0; m < 4; ++m) _Pragma("unroll") for (int n = 0; n < 2; ++n) _Pragma("unroll") for (int k = 0; k < 2; ++k) \
        acc[ai][bj][m][n] = __builtin_amdgcn_mfma_f32_16x16x32_bf16(Bt[n][k], At[m][k], acc[ai][bj][m][n], 0, 0, 0); __builtin_amdgcn_s_setprio(0); } while (0)
#define PG8_WAIT_V(n) asm volatile("s_waitcnt vmcnt(" #n ")" ::: "memory")
#define PG8_WAIT_L(n) asm volatile("s_waitcnt lgkmcnt(" #n ")" ::: "memory")
#define PG8_BAR __builtin_amdgcn_s_barrier()
#define PG8_SCHED __builtin_amdgcn_sched_barrier(0)
    Unit cur, nxt; int ui = 0;
    if (!S.next(0, cur)) return;
    f32x4 acc[2][2][4][2];
#pragma unroll
    for (int a = 0; a < 2; ++a)
#pragma unroll
        for (int b = 0; b < 2; ++b)
#pragma unroll
            for (int m = 0; m < 4; ++m)
#pragma unroll
                for (int n = 0; n < 2; ++n) acc[a][b][m][n] = (f32x4){0.f, 0.f, 0.f, 0.f};
    bf16x8 At[4][2], B0[2][2], B1[2][2];
    const char* cA = (const char*)g.A + (size_t)cur.pm * tstep; const char* cB = (const char*)g.Bt + (size_t)cur.pn * tstep;
    S.a_ready(cur);
    if constexpr (SP2) {
        PG8_STAGE(PG8_SB(0, 0), cB, voffB); PG8_STAGE(PG8_SB(0, 1), cB + hstep, voffB); PG8_STAGE(PG8_SA(0, 0), cA, voffA); PG8_STAGE(PG8_SA(0, 1), cA + hstep, voffA);
        if (wr == 1) PG8_BAR;
        PG8_WAIT_V(2); PG8_BAR;
        PG8_STAGE(PG8_SB(1, 0), cB + kstep, voffB); PG8_STAGE(PG8_SA(1, 0), cA + kstep, voffA); PG8_STAGE(PG8_SB(1, 1), cB + hstep + kstep, voffB);
        PG8_WAIT_V(6); PG8_BAR;
    } else {
        PG8_STAGE(PG8_SB(0, 0), cB, voffB); PG8_STAGE(PG8_SA(0, 0), cA, voffA); PG8_STAGE(PG8_SB(0, 1), cB + hstep, voffB); PG8_STAGE(PG8_SA(0, 1), cA + hstep, voffA);
        if (wr == 1) PG8_BAR;
        PG8_WAIT_V(4); PG8_BAR;
        PG8_STAGE(PG8_SB(1, 0), cB + kstep, voffB); PG8_STAGE(PG8_SA(1, 0), cA + kstep, voffA); PG8_STAGE(PG8_SB(1, 1), cB + hstep + kstep, voffB);
        PG8_WAIT_V(6); PG8_BAR;
    }
    for (;;) {
        const bool has_next = S.next(ui + 1, nxt);
        const char* nA = has_next ? (const char*)g.A + (size_t)nxt.pm * tstep : cA; const char* nB = has_next ? (const char*)g.Bt + (size_t)nxt.pn * tstep : cB;
        for (int t = 0; t < nt; t += 2) {
            const bool last = (t == nt - 2);
            const char* a1 = cA + (size_t)(t + 1) * kstep;
            const char* a2 = last ? nA : cA + (size_t)(t + 2) * kstep; const char* b2 = last ? nB : cB + (size_t)(t + 2) * kstep;
            const char* a3 = a2 + kstep; const char* b3 = b2 + kstep;
            if (last && has_next) S.a_ready(nxt);
            if constexpr (SP2) {
            PG8_LDB(B0, 0, 0); PG8_LDB(B1, 0, 1); PG8_SCHED; PG8_LDA(At, 0, 0); PG8_STAGE(PG8_SA(1, 1), a1 + hstep, voffA);
            PG8_WAIT_V(8); PG8_WAIT_L(0); PG8_BAR; PG8_MMA(0, 0, At, B0); PG8_MMA(0, 1, At, B1); PG8_BAR; PG8_SCHED;
            PG8_LDA(At, 0, 1); PG8_STAGE(PG8_SB(0, 0), b2, voffB); PG8_STAGE(PG8_SB(0, 1), b2 + hstep, voffB); PG8_STAGE(PG8_SA(0, 0), a2, voffA);
            PG8_WAIT_V(8); PG8_WAIT_L(0); PG8_BAR; PG8_MMA(1, 0, At, B0); PG8_MMA(1, 1, At, B1); PG8_BAR; PG8_SCHED;
            PG8_LDB(B0, 1, 0); PG8_LDB(B1, 1, 1); PG8_SCHED; PG8_LDA(At, 1, 0); PG8_STAGE(PG8_SA(0, 1), a2 + hstep, voffA);
            PG8_WAIT_V(8); PG8_WAIT_L(0); PG8_BAR; PG8_MMA(0, 0, At, B0); PG8_MMA(0, 1, At, B1); PG8_BAR; PG8_SCHED;
            PG8_LDA(At, 1, 1); PG8_STAGE(PG8_SB(1, 0), b3, voffB); PG8_STAGE(PG8_SB(1, 1), b3 + hstep, voffB); PG8_STAGE(PG8_SA(1, 0), a3, voffA);
            PG8_WAIT_V(8); PG8_WAIT_L(0); PG8_BAR; PG8_MMA(1, 0, At, B0); PG8_MMA(1, 1, At, B1); PG8_BAR; PG8_SCHED;
            } else {
            PG8_LDB(B0, 0, 0); PG8_SCHED; PG8_LDA(At, 0, 0); PG8_STAGE(PG8_SA(1, 1), a1 + hstep, voffA);
            PG8_WAIT_L(8); PG8_BAR; PG8_WAIT_L(0); PG8_MMA(0, 0, At, B0); PG8_BAR; PG8_SCHED;
            PG8_LDB(B1, 0, 1); PG8_STAGE(PG8_SB(0, 0), b2, voffB);
            PG8_BAR; PG8_WAIT_L(0); PG8_MMA(0, 1, At, B1); PG8_BAR;
            PG8_LDA(At, 0, 1); PG8_STAGE(PG8_SA(0, 0), a2, voffA);
            PG8_BAR; PG8_WAIT_L(0); PG8_MMA(1, 0, At, B0); PG8_BAR; PG8_SCHED;
            PG8_STAGE(PG8_SB(0, 1), b2 + hstep, voffB);
            PG8_WAIT_V(6); PG8_BAR; PG8_MMA(1, 1, At, B1); PG8_BAR;
            PG8_LDB(B0, 1, 0); PG8_SCHED; PG8_LDA(At, 1, 0); PG8_STAGE(PG8_SA(0, 1), a2 + hstep, voffA);
            PG8_WAIT_L(8); PG8_BAR; PG8_WAIT_L(0); PG8_MMA(0, 0, At, B0); PG8_BAR; PG8_SCHED;
            PG8_LDB(B1, 1, 1); PG8_STAGE(PG8_SB(1, 0), b3, voffB);
            PG8_BAR; PG8_WAIT_L(0); PG8_MMA(0, 1, At, B1); PG8_BAR;
            PG8_LDA(At, 1, 1); PG8_STAGE(PG8_SA(1, 0), a3, voffA);
            PG8_BAR; PG8_WAIT_L(0); PG8_MMA(1, 0, At, B0); PG8_BAR; PG8_SCHED;
            PG8_STAGE(PG8_SB(1, 1), b3 + hstep, voffB);
            PG8_WAIT_V(6); PG8_BAR; PG8_MMA(1, 1, At, B1); PG8_BAR;
            }
        }
        if constexpr (ALIGN_EPI) { if (wr == 0) PG8_BAR; }
        if constexpr (!Epi::AFTER_DRAIN) { E(acc, cur, wr, wc, fr, fq); S.done(cur); }
        if (!has_next) break;
#pragma unroll
        for (int a = 0; a < 2; ++a)
#pragma unroll
            for (int b = 0; b < 2; ++b)
#pragma unroll
                for (int m = 0; m < 4; ++m)
#pragma unroll
                    for (int n = 0; n < 2; ++n) acc[a][b][m][n] = (f32x4){0.f, 0.f, 0.f, 0.f};
        cur = nxt; cA = nA; cB = nB; ++ui;
        if constexpr (ALIGN_EPI) { if (wr == 1) PG8_BAR; }
    }
    PG8_WAIT_V(0);
    if constexpr (!ALIGN_EPI) { if (wr == 0) PG8_BAR; }
    PG8_BAR;
    if constexpr (Epi::AFTER_DRAIN) { E.fused(acc, cur, wr, wc, fr, fq, lds, wid, lane); S.done(cur); }
#undef PG8_SA
#undef PG8_SB
#undef PG8_STAGE
#undef PG8_LDA
#undef PG8_LDB
#undef PG8_MMA
#undef PG8_WAIT_V
#undef PG8_WAIT_L
#undef PG8_BAR
#undef PG8_SCHED
}
}

typedef unsigned short bf16_t;
typedef float f32x4 __attribute__((ext_vector_type(4)));
typedef unsigned u32x4 __attribute__((ext_vector_type(4)));
typedef unsigned u32x2 __attribute__((ext_vector_type(2)));

constexpr int D = 1024, NIN = 8448, DR = 1024, UW = 6400  , URW = 2048  ;
constexpr int SLAB = 16384, NTOK = 49152;
constexpr float DN_ALPHA = 1.189207115002721f;
constexpr size_t WS_WIN = 0;
constexpr size_t WS_WOUT = WS_WIN + (size_t)NIN * D * 2;
constexpr size_t WS_STATS = WS_WOUT + (size_t)D * 2048 * 2;
constexpr size_t WS_XN = WS_STATS + (size_t)NTOK * 2 * 4;
constexpr size_t WS_U = WS_XN + (size_t)SLAB * D * 2;
constexpr size_t WS_YS = WS_U + (size_t)SLAB * UW * 2;
constexpr size_t WS_BON = WS_YS + (size_t)2 * SLAB * DR * 4;
constexpr size_t WS_YMIX = WS_BON + (size_t)2 * SLAB * 16 * 4;
constexpr size_t WS_TMP = WS_YS;
constexpr size_t WS_PQ = WS_YMIX;
constexpr size_t WS_SST = WS_YMIX + (size_t)SLAB * 2048 * 2;
constexpr size_t WS_BAR = WS_SST + (size_t)2048 * 4096 * 4;
constexpr size_t WS_END = WS_BAR + 16384;
static_assert(WS_END <= (size_t)512 * 1024 * 1024, "ws map");
constexpr int LDS_BYTES = 147456;

struct Params { const float* in[20]; float* out; unsigned char* ws; };
typedef const Params __attribute__((address_space(4)))* KP;
#define KP_FRESH(p) asm volatile("" : "+s"(p))
__device__ __forceinline__ int hw_tid(int wid0) { int l; asm volatile("v_mbcnt_lo_u32_b32 %0, -1, 0\n\tv_mbcnt_hi_u32_b32 %0, -1, %0" : "=v"(l)); return wid0 * 64 + l; }
enum { I_XP = 0, I_XS, I_EG, I_EB, I_WIN, I_CW, I_CB, I_MU, I_W0, I_WUP, I_A0, I_AUP, I_KK, I_KA, I_RK, I_LXG, I_LXB, I_WOUT, I_LG, I_LB };

__device__ __forceinline__ float bf2f(unsigned short h) { return __uint_as_float((unsigned)h << 16); }
__device__ __forceinline__ unsigned f2bf(float f) { unsigned u = __float_as_uint(f); return (u + 0x7fffu + ((u >> 16) & 1u)) >> 16; }
__device__ __forceinline__ unsigned pk2(float lo, float hi) { return f2bf(lo) | (f2bf(hi) << 16); }
typedef __bf16 bf16x2e_t __attribute__((ext_vector_type(2)));
typedef float f32x2e __attribute__((ext_vector_type(2)));
__device__ __forceinline__ unsigned cvtpk_(float lo, float hi) { f32x2e v = {lo, hi}; bf16x2e_t b = __builtin_convertvector(v, bf16x2e_t); return __builtin_bit_cast(unsigned, b); }
__device__ __forceinline__ float shx(float v, int lane, int o) { return __int_as_float(__builtin_amdgcn_ds_bpermute((lane ^ o) << 2, __float_as_int(v))); }
__device__ __forceinline__ float wsum(float v, int lane) {
#pragma unroll
    for (int o = 32; o; o >>= 1) v += shx(v, lane, o);
    return v;
}
__device__ __forceinline__ float sigmoidf_(float x) { return 1.f / (1.f + __expf(-x)); }
__device__ __forceinline__ float siluf_(float x) { return x * sigmoidf_(x); }
__device__ __forceinline__ float rl(float v, int l) { return __int_as_float(__builtin_amdgcn_readlane(__float_as_int(v), l)); }

__device__ __forceinline__ void slab_info(int s, int& tok0, int& nseq, int& T) { if (s == 0) { tok0 = 0; nseq = 8; T = 2048; } else { tok0 = SLAB * s; nseq = 1; T = 16384; } }
__device__ __forceinline__ const float* slab_x(KP p, int s) { return s == 0 ? p->in[I_XP] : p->in[I_XS] + (size_t)(s - 1) * SLAB * D; }

__device__ __forceinline__ int orig_col(int jv) {
    if (jv >= 4096) return jv;
    const int pn = jv >> 8, bj = (jv >> 7) & 1, wc = (jv >> 5) & 3, fq = (jv >> 3) & 3, n = (jv >> 2) & 1, j = jv & 3;
    return (2 * bj + n) * 1024 + 64 * pn + 16 * wc + 4 * fq + j;
}

__device__ void phase_weights(KP p, int wid0) {
    KP_FRESH(p);
    int gt = blockIdx.x * 512 + hw_tid(wid0); asm volatile("" : "+v"(gt)); const int nt = gridDim.x * 512;
    bf16_t* win = (bf16_t*)(p->ws + WS_WIN); bf16_t* wout = (bf16_t*)(p->ws + WS_WOUT);
    const float* w_in = p->in[I_WIN]; const float* w_out = p->in[I_WOUT];
    for (int idx = gt; idx < NIN * 128; idx += nt) {
        const int jv = idx % NIN, kg = idx / NIN, oc = orig_col(jv);
        float v[8];
#pragma unroll
        for (int i = 0; i < 8; ++i) v[i] = w_in[(size_t)(kg * 8 + i) * NIN + oc];
        u32x4 w; w.x = pk2(v[0], v[1]); w.y = pk2(v[2], v[3]); w.z = pk2(v[4], v[5]); w.w = pk2(v[6], v[7]);
        *(u32x4*)(win + (size_t)jv * D + kg * 8) = w;
    }
    for (int idx = gt; idx < D * 256; idx += nt) {
        const int n = idx % D, kg = idx / D;
        float v[8];
#pragma unroll
        for (int i = 0; i < 8; ++i) v[i] = w_out[(size_t)(kg * 8 + i) * D + n];
        u32x4 w; w.x = pk2(v[0], v[1]); w.y = pk2(v[2], v[3]); w.z = pk2(v[4], v[5]); w.w = pk2(v[6], v[7]);
        *(u32x4*)(wout + (size_t)n * 2048 + kg * 8) = w;
    }
}

__device__ __forceinline__ bf16_t* xn_buf(KP p, int s) { return s == 1 ? (bf16_t*)(p->out + (size_t)2 * SLAB * D) : (bf16_t*)(p->ws + WS_XN); }
__device__ __forceinline__ void phase_ln(KP p, int s, int wid0, int wg0) {
    KP_FRESH(p);
    int tid_ = hw_tid(wid0); asm volatile("" : "+v"(tid_)); int lane = tid_ & 63; const int gw = ((int)blockIdx.x - wg0) * 8 + (tid_ >> 6), nw = ((int)gridDim.x - wg0) * 8;
    const float* x = slab_x(p, s); bf16_t* xn = xn_buf(p, s); float* stats = (float*)(p->ws + WS_STATS) + (size_t)s * SLAB * 2;
    const float4* g4 = (const float4*)p->in[I_EG]; const float4* b4 = (const float4*)p->in[I_EB];
    for (int gi = gw; gi < SLAB / 4; gi += nw) {
        const int r0 = gi * 4;
        asm volatile("" : "+v"(lane));
        float4 v[4][4];
#pragma unroll
        for (int k = 0; k < 4; ++k)
#pragma unroll
            for (int i = 0; i < 4; ++i) v[k][i] = ((const float4*)(x + (size_t)(r0 + k) * D))[lane + 64 * i];
#pragma unroll
        for (int k = 0; k < 4; ++k) {
            const int r = r0 + k;
            float sum = 0.f;
#pragma unroll
            for (int i = 0; i < 4; ++i) sum += v[k][i].x + v[k][i].y + v[k][i].z + v[k][i].w;
            const float mean = wsum(sum, lane) * (1.f / 1024.f);
            float sq = 0.f;
#pragma unroll
            for (int i = 0; i < 4; ++i) { float a = v[k][i].x - mean, b = v[k][i].y - mean, c = v[k][i].z - mean, d = v[k][i].w - mean; sq += a * a + b * b + c * c + d * d; }
            const float rstd = rsqrtf(wsum(sq, lane) * (1.f / 1024.f) + 1e-5f);
            if (lane == 0) { stats[r * 2] = mean; stats[r * 2 + 1] = rstd; }
#pragma unroll
            for (int i = 0; i < 4; ++i) {
                const float4 g = g4[lane + 64 * i], b = b4[lane + 64 * i];
                u32x2 w; w.x = cvtpk_((v[k][i].x - mean) * rstd * g.x + b.x, (v[k][i].y - mean) * rstd * g.y + b.y);
                w.y = cvtpk_((v[k][i].z - mean) * rstd * g.z + b.z, (v[k][i].w - mean) * rstd * g.w + b.w);
                *(u32x2*)(xn + (size_t)r * D + (lane + 64 * i) * 4) = w;
            }
        }
    }
}

struct EpiU {
    static constexpr bool PERM = true, AFTER_DRAIN = false;
    bf16_t* U; bf16_t* TMP;
    __device__ __forceinline__ void operator()(const f32x4 (&acc)[2][2][4][2], const pg8::Unit& u, int wr, int wc, int fr, int fq) const {
        const int row0 = u.pm * 256 + wr * 64 + fr;
        if (u.pn < 16) {
            const int ch0 = 64 * u.pn + 16 * wc + 4 * fq;
#pragma unroll
            for (int ai = 0; ai < 2; ++ai)
#pragma unroll
                for (int m = 0; m < 4; ++m) {
                    bf16_t* rowp = U + (size_t)(row0 + ai * 128 + m * 16) * UW + ch0;
                    const f32x4 h = acc[ai][0][m][0], B = acc[ai][0][m][1], C = acc[ai][1][m][0], z = acc[ai][1][m][1];
                    float pp[4], gg[4];
#pragma unroll
                    for (int j = 0; j < 4; ++j) { pp[j] = C[j] * h[j]; gg[j] = B[j] * siluf_(z[j]); }
                    u32x2 w0; w0.x = pk2(pp[0], pp[1]); w0.y = pk2(pp[2], pp[3]);
                    u32x2 w1; w1.x = pk2(gg[0], gg[1]); w1.y = pk2(gg[2], gg[3]);
                    *(u32x2*)rowp = w0; *(u32x2*)(rowp + 1024) = w1;
                }
        } else {
            const int col0 = 256 * (u.pn - 16) + 32 * wc + 8 * fq; const bool zt = (u.pn >= 28) && (u.pn < 32);
#pragma unroll
            for (int ai = 0; ai < 2; ++ai)
#pragma unroll
                for (int m = 0; m < 4; ++m) {
                    bf16_t* rowp = zt ? U + (size_t)(row0 + ai * 128 + m * 16) * UW + URW + col0 : TMP + (size_t)(row0 + ai * 128 + m * 16) * 4352 + col0;
#pragma unroll
                    for (int bj = 0; bj < 2; ++bj) {
                        const f32x4 v0 = acc[ai][bj][m][0], v1 = acc[ai][bj][m][1];
                        u32x4 w; w.x = pk2(v0[0], v0[1]); w.y = pk2(v0[2], v0[3]); w.z = pk2(v1[0], v1[1]); w.w = pk2(v1[2], v1[3]);
                        *(u32x4*)(rowp + bj * 128) = w;
                    }
                }
        }
    }
};

struct EpiOut {
    static constexpr bool PERM = true, AFTER_DRAIN = false;
    float* out; const float* x; const float* stats; const float* eg; const float* eb;
    __device__ __forceinline__ void operator()(const f32x4 (&acc)[2][2][4][2], const pg8::Unit& u, int wr, int wc, int fr, int fq) const {
        const int row0 = u.pm * 256 + wr * 64 + fr, col0 = u.pn * 256 + wc * 32 + 8 * fq;
#pragma unroll
        for (int ai = 0; ai < 2; ++ai)
#pragma unroll
            for (int m = 0; m < 4; ++m) {
                const int row = row0 + ai * 128 + m * 16;
                const float mean = stats[row * 2], rstd = stats[row * 2 + 1];
#pragma unroll
                for (int bj = 0; bj < 2; ++bj)
#pragma unroll
                    for (int n = 0; n < 2; ++n) {
                        const int c = col0 + bj * 128 + 4 * n;
                        const float4 xv = *(const float4*)(x + (size_t)row * D + c), g = *(const float4*)(eg + c), b = *(const float4*)(eb + c);
                        const f32x4 a = acc[ai][bj][m][n];
                        float4 o;
                        o.x = DN_ALPHA * ((xv.x - mean) * rstd * g.x + b.x) + a[0]; o.y = DN_ALPHA * ((xv.y - mean) * rstd * g.y + b.y) + a[1];
                        o.z = DN_ALPHA * ((xv.z - mean) * rstd * g.z + b.z) + a[2]; o.w = DN_ALPHA * ((xv.w - mean) * rstd * g.w + b.w) + a[3];
                        *(float4*)(out + (size_t)row * D + c) = o;
                    }
            }
    }
};

typedef short bf16x8 __attribute__((ext_vector_type(8)));
typedef short s16x4 __attribute__((ext_vector_type(4)));
typedef __bf16 bf16x2_t __attribute__((ext_vector_type(2)));
typedef float f32x2 __attribute__((ext_vector_type(2)));
#define MFMA16(a, b, c) __builtin_amdgcn_mfma_f32_16x16x32_bf16((a), (b), (c), 0, 0, 0)
#define DI __device__ __forceinline__
constexpr int IMG_STRIDE = 144;
constexpr int WG_FRAG = 0;
constexpr int WG_CONST = 16384;
constexpr int WV_BASE = 16384 + 2560;
constexpr int WV_BYTES = 3 * 16 * IMG_STRIDE + 256;
static_assert(WV_BASE + 8 * WV_BYTES <= LDS_BYTES, "scan LDS map");

DI unsigned cvtpk(float lo, float hi) { f32x2 v = {lo, hi}; bf16x2_t b = __builtin_convertvector(v, bf16x2_t); return __builtin_bit_cast(unsigned, b); }
DI bf16x8 mkfrag(unsigned a, unsigned b, unsigned c, unsigned d) { u32x4 w = {a, b, c, d}; return __builtin_bit_cast(bf16x8, w); }
DI bf16x8 frag_f4(f32x4 a, f32x4 b) { return mkfrag(cvtpk(a[0], a[1]), cvtpk(a[2], a[3]), cvtpk(b[0], b[1]), cvtpk(b[2], b[3])); }
DI float bperm(float v, int srclane) { return __int_as_float(__builtin_amdgcn_ds_bpermute(srclane << 2, __float_as_int(v))); }
DI float lo16(unsigned w) { return __uint_as_float(w << 16); }
DI float hi16(unsigned w) { return __uint_as_float(w & 0xffff0000u); }
template <int CTRL> DI float dpp0(float x) { return __int_as_float(__builtin_amdgcn_update_dpp(0, __float_as_int(x), CTRL, 0xf, 0xf, true)); }
template <int CTRL> DI float dpp1(float x) { return __int_as_float(__builtin_amdgcn_update_dpp(0x3f800000, __float_as_int(x), CTRL, 0xf, 0xf, false)); }
DI float fsig(float x) { return __builtin_amdgcn_rcpf(1.f + __expf(-x)); }
DI f32x4 ld4(const bf16_t* ur) { const u32x2 c = *(const u32x2*)ur; return (f32x4){lo16(c.x), hi16(c.x), lo16(c.y), hi16(c.y)}; }

DI void split_frag(f32x4 a, f32x4 b, bf16x8& hi, bf16x8& lo) {
    f32x4 ah, bh;
    unsigned w[4] = {cvtpk(a[0], a[1]), cvtpk(a[2], a[3]), cvtpk(b[0], b[1]), cvtpk(b[2], b[3])};
    ah[0] = lo16(w[0]); ah[1] = hi16(w[0]); ah[2] = lo16(w[1]); ah[3] = hi16(w[1]); bh[0] = lo16(w[2]); bh[1] = hi16(w[2]); bh[2] = lo16(w[3]); bh[3] = hi16(w[3]);
    hi = mkfrag(w[0], w[1], w[2], w[3]); lo = frag_f4(a - ah, b - bh);
}
struct ChunkIn { u32x2 k[4], r[4], v[4]; bf16x8 tl[2], la[2]; };
template <int PASS> DI void chunk_load(ChunkIn& c, const bf16_t* ur, int h, int d, int q) {
#pragma unroll
    for (int n = 0; n < 4; ++n) {
        c.k[n] = *(const u32x2*)(ur + 1024 + h * 64 + 16 * n + 4 * q);
        if (PASS == 2) { c.v[n] = *(const u32x2*)(ur + 2048 + h * 64 + 16 * n + 4 * q); c.r[n] = *(const u32x2*)(ur + h * 64 + 16 * n + 4 * q); }
    }
#pragma unroll
    for (int ks = 0; ks < 2; ++ks) { const bf16_t* ul = ur + 4096 + d * 64 + 32 * ks + 8 * q; c.tl[ks] = *(const bf16x8*)ul; c.la[ks] = *(const bf16x8*)(ul + 128); }
}
DI f32x4 up4(u32x2 c) { return (f32x4){lo16(c.x), hi16(c.x), lo16(c.y), hi16(c.y)}; }
template <int PASS>
__device__ void phase_scan(KP p, int s, unsigned char* ldsg, int wid0) {
    KP_FRESH(p);
    const int wid = wid0;
    int tok0, nseq, T; slab_info(s, tok0, nseq, T);
    const int LS = 256, lgseg = (s == 0) ? 3 : 6, nseg = 1 << lgseg, nblk = (nseq * 32 << lgseg) >> 3;
    const bf16_t* U = (const bf16_t*)(p->ws + WS_U);
    bf16_t* YS = (bf16_t*)(p->ws + WS_YS); float* BON = (float*)(p->ws + WS_BON);
    float* PQ = (float*)(p->ws + WS_PQ); const float* SST = (const float*)(p->ws + WS_SST);
    float* cst = (float*)(ldsg + WG_CONST);
    const int wo = WV_BASE + wid * WV_BYTES;
    for (int ib = blockIdx.x; ib < nblk; ib += gridDim.x) {
        const int item = ib * 8 + wid, g = item & (nseg - 1), chain = item >> lgseg, h = chain & 15, d = (chain >> 4) & 1, b = chain >> 5;
        const int tid = hw_tid(wid0), lane = tid & 63, fr = lane & 15, q = lane >> 4;
        __syncthreads();
        if (tid < 64) {
            const float* mu = p->in[I_MU]; const int c = h * 64 + tid;
            cst[tid] = mu[c]; cst[64 + tid] = mu[1024 + c]; cst[128 + tid] = mu[2048 + c];
            cst[192 + tid] = -1.44269504f * p->in[I_W0][d * 1024 + c]; cst[256 + tid] = -1.44269504f * p->in[I_A0][d * 1024 + c];
            cst[320 + tid] = p->in[I_KK][c]; cst[384 + tid] = p->in[I_KA][c]; cst[448 + tid] = p->in[I_RK][c];
            cst[512 + tid] = mu[4096 + d * 64 + tid]; cst[576 + tid] = mu[4096 + 128 + d * 64 + tid];
        }
        for (int e = tid; e < 1024; e += 512) {
            const int l2 = e & 63, ks = (e >> 6) & 1, mt = (e >> 7) & 3, mat = e >> 9, fr2 = l2 & 15, q2 = l2 >> 4;
            const float* src = (mat ? p->in[I_AUP] : p->in[I_WUP]) + ((size_t)d * 64 + 32 * ks + 8 * q2) * 1024 + h * 64 + 16 * mt + fr2;
            float v8[8];
#pragma unroll
            for (int jj = 0; jj < 8; ++jj) v8[jj] = -1.44269504f * src[(size_t)jj * 1024];
            u32x4 w = {cvtpk(v8[0], v8[1]), cvtpk(v8[2], v8[3]), cvtpk(v8[4], v8[5]), cvtpk(v8[6], v8[7])};
            *(u32x4*)(ldsg + WG_FRAG + e * 16) = w;
        }
        __syncthreads();
        f32x4 St[4][4];
        f32x4 Pa[PASS == 1 ? 4 : 1][PASS == 1 ? 4 : 1];
        int l3 = lane; asm volatile("" : "+v"(l3));
        const float* sstl = SST + (size_t)item * 4096 + l3 * 4;
#pragma unroll
        for (int mt = 0; mt < 4; ++mt)
#pragma unroll
            for (int nt = 0; nt < 4; ++nt) {
                if (PASS == 1) {
#pragma unroll
                    for (int j = 0; j < 4; ++j) { St[mt][nt][j] = 0.f; Pa[PASS == 1 ? mt : 0][PASS == 1 ? nt : 0][j] = (16 * mt + 4 * q + j == 16 * nt + fr) ? 1.f : 0.f; }
                } else {
                    St[mt][nt] = *(const f32x4*)(sstl + (mt * 4 + nt) * 256);
                }
            }
        ChunkIn cin;
        { const int p0 = g * LS, t0 = d ? T - 1 - (p0 + fr) : p0 + fr; chunk_load<PASS>(cin, U + (size_t)(b * T + t0) * UW + URW, h, d, q); }
        for (int ck = 0; ck < LS / 16; ++ck) {
            const int pos0 = g * LS + ck * 16;
            const int lane_c = hw_tid(wid0) & 63;
            const int lane = lane_c, fr = lane_c & 15, q = lane_c >> 4;
            const int ti = d ? T - 1 - (pos0 + fr) : pos0 + fr, row = b * T + ti;
            ChunkIn cc = cin;
            if (PASS == 1) {
#pragma unroll
                for (int n = 0; n < 4; ++n) cc.v[n] = *(const u32x2*)(U + (size_t)row * UW + URW + 2048 + h * 64 + 16 * n + 4 * q);
            }
            {
                const int pn = g * LS + (ck + 1 < LS / 16 ? ck + 1 : ck) * 16, tn = d ? T - 1 - (pn + fr) : pn + fr;
                chunk_load<PASS>(cin, U + (size_t)(b * T + tn) * UW + URW, h, d, q);
            }
            const int lq16 = 16 * q, ll16 = 16 * lane, limg = fr * IMG_STRIDE + 8 * q, ltr = (4 * q + (fr >> 2)) * IMG_STRIDE + 8 * (fr & 3);
            f32x4 ow[4], oa[4];
            {
                const bf16x8 tlf[2] = {cc.tl[0], cc.tl[1]}, laf[2] = {cc.la[0], cc.la[1]};
#pragma unroll
                for (int mt = 0; mt < 4; ++mt) {
                    const bf16x8 w0f = *(const bf16x8*)(ldsg + WG_FRAG + ((0 * 4 + mt) * 2 + 0) * 1024 + ll16), w1f = *(const bf16x8*)(ldsg + WG_FRAG + ((0 * 4 + mt) * 2 + 1) * 1024 + ll16);
                    const bf16x8 a0f = *(const bf16x8*)(ldsg + WG_FRAG + ((1 * 4 + mt) * 2 + 0) * 1024 + ll16), a1f = *(const bf16x8*)(ldsg + WG_FRAG + ((1 * 4 + mt) * 2 + 1) * 1024 + ll16);
                    f32x4 z = {0.f, 0.f, 0.f, 0.f};
                    ow[mt] = MFMA16(w1f, tlf[1], MFMA16(w0f, tlf[0], z));
                    oa[mt] = MFMA16(a1f, laf[1], MFMA16(a0f, laf[0], z));
                }
            }
            f32x4 km[4]; f32x4 ss4 = {0.f, 0.f, 0.f, 0.f};
#pragma unroll
            for (int n = 0; n < 4; ++n) {
                km[n] = up4(cc.k[n]);
                const f32x4 kr = km[n] * *(const f32x4*)(ldsg + WG_CONST + (320 + 16 * n) * 4 + lq16);
                ss4 += kr * kr;
            }
            float ss = (ss4[0] + ss4[1]) + (ss4[2] + ss4[3]);
            ss += bperm(ss, lane ^ 16); ss += bperm(ss, lane ^ 32);
            const float kinv = 1.f / fmaxf(sqrtf(ss), 1e-12f);
            u32x2 kapP[4], ktP[4], btP[4], rtP[4]; f32x4 bon4 = {0.f, 0.f, 0.f, 0.f};
#pragma unroll
            for (int n = 0; n < 4; ++n) {
                const f32x4 w0v = *(const f32x4*)(ldsg + WG_CONST + (192 + 16 * n) * 4 + lq16), a0v = *(const f32x4*)(ldsg + WG_CONST + (256 + 16 * n) * 4 + lq16), kkw = *(const f32x4*)(ldsg + WG_CONST + (320 + 16 * n) * 4 + lq16), kav = *(const f32x4*)(ldsg + WG_CONST + (384 + 16 * n) * 4 + lq16);
                const f32x4 tw = w0v + ow[n], ta = a0v + oa[n];
                f32x4 ew, ea;
#pragma unroll
                for (int j = 0; j < 4; ++j) { ew[j] = __builtin_amdgcn_exp2f(tw[j]); ea[j] = __builtin_amdgcn_exp2f(ta[j]); }
                const f32x4 dw = ew + 1.f, da = ea + 1.f;
                f32x4 sw, av;
#pragma unroll
                for (int j = 0; j < 4; ++j) { sw[j] = __builtin_amdgcn_rcpf(dw[j]); av[j] = __builtin_amdgcn_rcpf(da[j]); }
                const f32x4 lw2 = sw * -0.87503877f;
                f32x4 L, Lm, gmv, emL;
#pragma unroll
                for (int j = 0; j < 4; ++j) {
                    float x = __builtin_amdgcn_exp2f(lw2[j]);
                    x *= dpp1<0x111>(x); x *= dpp1<0x112>(x); x *= dpp1<0x114>(x); x *= dpp1<0x118>(x);
                    L[j] = x; Lm[j] = dpp1<0x111>(x); gmv[j] = dpp0<0x121>(x);
                    emL[j] = __builtin_amdgcn_rcpf(x);
                }
                const f32x4 kk = km[n] * kkw * kinv;
                const f32x4 kd = km[n] * ((av - 1.f) * kav + 1.f);
                const f32x4 kap = kk * Lm, bt = kk * av * emL, kt = kd * emL;
                if (fr == 0) *(f32x4*)(ldsg + wo + 48 * IMG_STRIDE + 64 * n + lq16) = gmv;
                kapP[n] = (u32x2){cvtpk(kap[0], kap[1]), cvtpk(kap[2], kap[3])};
                ktP[n] = (u32x2){cvtpk(kt[0], kt[1]), cvtpk(kt[2], kt[3])};
                btP[n] = (u32x2){cvtpk(bt[0], bt[1]), cvtpk(bt[2], bt[3])};
                *(u32x2*)(ldsg + wo + 16 * IMG_STRIDE + 32 * n + limg) = ktP[n];
                *(u32x2*)(ldsg + wo + 32 * IMG_STRIDE + 32 * n + limg) = btP[n];
                if (PASS == 2) {
                    const f32x4 rm = up4(cc.r[n]), rk = *(const f32x4*)(ldsg + WG_CONST + (448 + 16 * n) * 4 + lq16);
                    const f32x4 rt = rm * L;
                    rtP[n] = (u32x2){cvtpk(rt[0], rt[1]), cvtpk(rt[2], rt[3])};
                    bon4 += rm * kd * rk;
                }
                *(u32x2*)(ldsg + wo + 32 * n + limg) = cc.v[n];
            }
            if (PASS == 2) {
                float bon = (bon4[0] + bon4[1]) + (bon4[2] + bon4[3]);
                bon += bperm(bon, lane ^ 16); bon += bperm(bon, lane ^ 32);
                if (q == 0) BON[((size_t)d * SLAB + row) * 16 + h] = 0.5f * bon;
            }
            const bf16x8 kapF0 = mkfrag(kapP[0].x, kapP[0].y, kapP[1].x, kapP[1].y), kapF1 = mkfrag(kapP[2].x, kapP[2].y, kapP[3].x, kapP[3].y);
            bf16x8 akkA, tA, aryA;
            {
                const bf16x8 ktF0 = mkfrag(ktP[0].x, ktP[0].y, ktP[1].x, ktP[1].y), ktF1 = mkfrag(ktP[2].x, ktP[2].y, ktP[3].x, ktP[3].y);
                const bf16x8 btF0 = mkfrag(btP[0].x, btP[0].y, btP[1].x, btP[1].y), btF1 = mkfrag(btP[2].x, btP[2].y, btP[3].x, btP[3].y);
                const f32x4 z = {0.f, 0.f, 0.f, 0.f};
                f32x4 akk = MFMA16(ktF1, kapF1, MFMA16(ktF0, kapF0, z));
                f32x4 nn = MFMA16(kapF1, btF1, MFMA16(kapF0, btF0, z));
                f32x4 na = MFMA16(btF1, kapF1, MFMA16(btF0, kapF0, z));
                f32x4 idv;
#pragma unroll
                for (int jj = 0; jj < 4; ++jj) {
                    akk[jj] = (4 * q + jj < fr) ? akk[jj] : 0.f; nn[jj] = (fr < 4 * q + jj) ? nn[jj] : 0.f; na[jj] = (4 * q + jj < fr) ? na[jj] : 0.f;
                    idv[jj] = (4 * q + jj == fr) ? 1.f : 0.f;
                }
                akkA = mkfrag(cvtpk(akk[0], akk[1]), cvtpk(akk[2], akk[3]), 0u, 0u);
                if (PASS == 2) {
                    const bf16x8 rtF0 = mkfrag(rtP[0].x, rtP[0].y, rtP[1].x, rtP[1].y), rtF1 = mkfrag(rtP[2].x, rtP[2].y, rtP[3].x, rtP[3].y);
                    f32x4 ark = MFMA16(ktF1, rtF1, MFMA16(ktF0, rtF0, z));
                    f32x4 arb = MFMA16(btF1, rtF1, MFMA16(btF0, rtF0, z));
#pragma unroll
                    for (int jj = 0; jj < 4; ++jj) { ark[jj] = (4 * q + jj <= fr) ? ark[jj] : 0.f; arb[jj] = (4 * q + jj <= fr) ? arb[jj] : 0.f; }
                    aryA = mkfrag(cvtpk(ark[0], ark[1]), cvtpk(ark[2], ark[3]), cvtpk(arb[0], arb[1]), cvtpk(arb[2], arb[3]));
                }
#define TF(x) mkfrag(cvtpk((x)[0], (x)[1]), cvtpk((x)[2], (x)[3]), 0u, 0u)
                const bf16x8 nF = TF(nn), aF = TF(na);
                const f32x4 n2 = MFMA16(aF, nF, z), a2 = MFMA16(nF, aF, z);
                const bf16x8 n2F = TF(n2), a2F = TF(a2);
                const f32x4 n4 = MFMA16(a2F, n2F, z), a4 = MFMA16(n2F, a2F, z);
                const bf16x8 n4F = TF(n4), a4F = TF(a4);
                const f32x4 n8 = MFMA16(a4F, n4F, z);
                const f32x4 t21 = MFMA16(n2F, aF, z);
                f32x4 R = idv - na + a2 - t21;
                R = MFMA16(n4F, TF(R), R);
                R = MFMA16(TF(n8), TF(R), R);
                tA = TF(R);
#undef TF
            }
            s16x4 Vc[4], Kc[4], Bc[4];
            {
                typedef s16x4 __attribute__((address_space(3)))* lp;
#pragma unroll
                for (int t4 = 0; t4 < 4; ++t4) {
                    Vc[t4] = __builtin_amdgcn_ds_read_tr16_b64_v4i16((lp)(ldsg + wo + ltr + 32 * t4));
                    Kc[t4] = __builtin_amdgcn_ds_read_tr16_b64_v4i16((lp)(ldsg + wo + 16 * IMG_STRIDE + ltr + 32 * t4));
                    Bc[t4] = __builtin_amdgcn_ds_read_tr16_b64_v4i16((lp)(ldsg + wo + 32 * IMG_STRIDE + ltr + 32 * t4));
                }
            }
            bf16x8 kbA[4];
#pragma unroll
            for (int mt = 0; mt < 4; ++mt) kbA[mt] = __builtin_shufflevector(Kc[mt], Bc[mt], 0, 1, 2, 3, 4, 5, 6, 7);
#pragma unroll
            for (int nt = 0; nt < 4; ++nt) {
                const f32x4 z = {0.f, 0.f, 0.f, 0.f};
                const bf16x8 stf0 = frag_f4(St[0][nt], St[1][nt]), stf1 = frag_f4(St[2][nt], St[3][nt]);
                const u32x2 vcu = __builtin_bit_cast(u32x2, Vc[nt]);
                f32x4 X = MFMA16(kapF1, stf1, MFMA16(kapF0, stf0, z));
                X = MFMA16(akkA, mkfrag(vcu.x, vcu.y, 0u, 0u), X);
                const f32x4 Uu = MFMA16(tA, mkfrag(cvtpk(X[0], X[1]), cvtpk(X[2], X[3]), 0u, 0u), z);
                const bf16x8 bvu = mkfrag(vcu.x, vcu.y, cvtpk(-Uu[0], -Uu[1]), cvtpk(-Uu[2], -Uu[3]));
                if (PASS == 2) {
                    const bf16x8 rtF0 = mkfrag(rtP[0].x, rtP[0].y, rtP[1].x, rtP[1].y), rtF1 = mkfrag(rtP[2].x, rtP[2].y, rtP[3].x, rtP[3].y);
                    f32x4 Y = MFMA16(rtF1, stf1, MFMA16(rtF0, stf0, z));
                    Y = MFMA16(aryA, bvu, Y);
#pragma unroll
                    for (int jj = 0; jj < 4; ++jj) {
                        const int i = 4 * q + jj, t2 = d ? T - 1 - (pos0 + i) : pos0 + i;
                        YS[((size_t)d * SLAB + b * T + t2) * DR + h * 64 + 16 * nt + fr] = (bf16_t)(cvtpk(Y[jj], 0.f) & 0xffffu);
                    }
                }
#pragma unroll
                for (int mt = 0; mt < 4; ++mt) St[mt][nt] = MFMA16(kbA[mt], bvu, St[mt][nt]) * *(const f32x4*)(ldsg + wo + 48 * IMG_STRIDE + 64 * mt + lq16);
            }
            if (PASS == 1) {
#pragma unroll
                for (int ct = 0; ct < 4; ++ct) {
                    const f32x4 z = {0.f, 0.f, 0.f, 0.f};
                    const bf16x8 pf0 = frag_f4(Pa[0][PASS == 1 ? ct : 0], Pa[PASS == 1 ? 1 : 0][PASS == 1 ? ct : 0]), pf1 = frag_f4(Pa[PASS == 1 ? 2 : 0][PASS == 1 ? ct : 0], Pa[PASS == 1 ? 3 : 0][PASS == 1 ? ct : 0]);
                    const f32x4 X = MFMA16(kapF1, pf1, MFMA16(kapF0, pf0, z));
                    const f32x4 Uu = MFMA16(tA, mkfrag(cvtpk(X[0], X[1]), cvtpk(X[2], X[3]), 0u, 0u), z);
                    const bf16x8 bvu = mkfrag(0u, 0u, cvtpk(-Uu[0], -Uu[1]), cvtpk(-Uu[2], -Uu[3]));
#pragma unroll
                    for (int mt = 0; mt < 4; ++mt) Pa[PASS == 1 ? mt : 0][PASS == 1 ? ct : 0] = MFMA16(kbA[mt], bvu, Pa[PASS == 1 ? mt : 0][PASS == 1 ? ct : 0]) * *(const f32x4*)(ldsg + wo + 48 * IMG_STRIDE + 64 * mt + lq16);
                }
            }
        }
        if (PASS == 1) {
            const int l2 = hw_tid(wid0) & 63, fr2 = l2 & 15, q2 = l2 >> 4;
            unsigned char* pqb = (unsigned char*)(PQ + (size_t)item * 8192);
            float* tl = (float*)(ldsg + wo);
#pragma unroll
            for (int mt = 0; mt < 4; ++mt)
#pragma unroll
                for (int ks = 0; ks < 2; ++ks) {
#pragma unroll
                    for (int e = 0; e < 2; ++e)
#pragma unroll
                        for (int j2 = 0; j2 < 4; ++j2) tl[e * 256 + (4 * q2 + j2) * 16 + fr2] = Pa[PASS == 1 ? mt : 0][PASS == 1 ? 2 * ks + e : 0][j2];
                    __builtin_amdgcn_wave_barrier();
                    const f32x4 pa = *(const f32x4*)(tl + fr2 * 16 + 4 * q2), pb = *(const f32x4*)(tl + 256 + fr2 * 16 + 4 * q2);
                    __builtin_amdgcn_wave_barrier();
                    bf16x8 ah, al; split_frag(pa, pb, ah, al);
                    *(bf16x8*)(pqb + (((mt * 2 + ks) * 2 + 0) * 64 + l2) * 16) = ah;
                }
            float* pq = PQ + (size_t)item * 8192 + 4096 + l2 * 4;
#pragma unroll
            for (int mt = 0; mt < 4; ++mt)
#pragma unroll
                for (int nt = 0; nt < 4; ++nt) *(f32x4*)(pq + (mt * 4 + nt) * 256) = St[mt][nt];
        }
    }
}

constexpr int CR_SLOTS = 10, CR_SLOT_BYTES = 12288, CR_FLAGS = CR_SLOTS * CR_SLOT_BYTES;
__device__ __forceinline__ void phase_combine_ring(KP p, int s, int wid0, unsigned char* ldsg) {
    KP_FRESH(p);
    int tid_ = hw_tid(wid0); asm volatile("" : "+v"(tid_));
    const int lane = tid_ & 63, wid = wid0;
    const int nseg = 64, nsteps = nseg - 1;
    const float* PQ = (const float*)(p->ws + WS_PQ); float* SST = (float*)(p->ws + WS_SST);
    volatile unsigned* flags = (volatile unsigned*)(ldsg + CR_FLAGS);
    __syncthreads();
    if (tid_ < CR_SLOTS) flags[tid_] = 0u;
    __syncthreads();
    if ((int)blockIdx.x >= 128) return;
    const int nt = blockIdx.x & 3, chain = blockIdx.x >> 2;
    if (wid != 0) {
        u32x4 ra[12], rb[12];
#define CR_ISSUE(r, gg) do { const unsigned char* b_ = (const unsigned char*)(PQ + ((size_t)chain * nseg + (gg)) * 8192); \
        _Pragma("unroll") for (int f = 0; f < 8; ++f) (r)[f] = *(const u32x4*)(b_ + ((f * 2 + 0) * 64 + lane) * 16); \
        _Pragma("unroll") for (int mt = 0; mt < 4; ++mt) (r)[8 + mt] = *(const u32x4*)(b_ + 16384 + ((mt * 4 + nt) * 64 + lane) * 16); } while (0)
#define CR_PUT(r, gg) do { const int slot_ = (gg) % CR_SLOTS; const unsigned gen_ = 2u * (unsigned)((gg) / CR_SLOTS); unsigned sp_ = 0;     \
        while (flags[slot_] != gen_ && ++sp_ < (1u << 20)) __builtin_amdgcn_s_sleep(1); \
        _Pragma("unroll") for (int f = 0; f < 12; ++f) *(u32x4*)(ldsg + slot_ * CR_SLOT_BYTES + f * 1024 + lane * 16) = (r)[f]; \
        asm volatile("s_waitcnt lgkmcnt(0)" ::: "memory"); __builtin_amdgcn_wave_barrier(); \
        if (lane == 0) flags[slot_] = gen_ + 1u; } while (0)
        int g = wid - 1;
        if (g < nsteps) CR_ISSUE(ra, g);
        for (; g < nsteps; g += 14) {
            if (g + 7 < nsteps) CR_ISSUE(rb, g + 7);
            CR_PUT(ra, g);
            if (g + 14 < nsteps) CR_ISSUE(ra, g + 14);
            if (g + 7 < nsteps) CR_PUT(rb, g + 7);
        }
#undef CR_ISSUE
#undef CR_PUT
    } else {
        f32x4 S[4];
#pragma unroll
        for (int mt = 0; mt < 4; ++mt) S[mt] = (f32x4){0.f, 0.f, 0.f, 0.f};
        for (int g = 0; g < nseg; ++g) {
            const size_t item = (size_t)chain * nseg + g;
#pragma unroll
            for (int mt = 0; mt < 4; ++mt) *(f32x4*)(SST + item * 4096 + ((mt * 4 + nt) * 64 + lane) * 4) = S[mt];
            if (g == nsteps) break;
            const int slot = g % CR_SLOTS; const unsigned gen = 2u * (unsigned)(g / CR_SLOTS); unsigned sp = 0;
            while (flags[slot] != gen + 1u && ++sp < (1u << 20)) __builtin_amdgcn_s_sleep(1);
            bf16x8 ah[4][2]; f32x4 qv[4];
#pragma unroll
            for (int mt = 0; mt < 4; ++mt) {
                qv[mt] = *(const f32x4*)(ldsg + slot * CR_SLOT_BYTES + (8 + mt) * 1024 + lane * 16);
#pragma unroll
                for (int ks = 0; ks < 2; ++ks) ah[mt][ks] = *(const bf16x8*)(ldsg + slot * CR_SLOT_BYTES + (mt * 2 + ks) * 1024 + lane * 16);
            }
            asm volatile("s_waitcnt lgkmcnt(0)" ::: "memory"); __builtin_amdgcn_wave_barrier();
            if (lane == 0) flags[slot] = gen + 2u;
            bf16x8 bh[2], bl[2];
            split_frag(S[0], S[1], bh[0], bl[0]); split_frag(S[2], S[3], bh[1], bl[1]);
#pragma unroll
            for (int mt = 0; mt < 4; ++mt) {
                f32x4 acc = qv[mt];
#pragma unroll
                for (int ks = 0; ks < 2; ++ks) { acc = MFMA16(ah[mt][ks], bh[ks], acc); acc = MFMA16(ah[mt][ks], bl[ks], acc); }
                S[mt] = acc;
            }
        }
    }
}

__device__ void phase_combine(KP p, int s, int wid0) {
    KP_FRESH(p);
    int tid_ = hw_tid(wid0); asm volatile("" : "+v"(tid_));
    const int lane = tid_ & 63, wid = tid_ >> 6, fr = lane & 15, q = lane >> 4;
    int tok0, nseq, T; slab_info(s, tok0, nseq, T);
    const int lgseg = (s == 0) ? 3 : 6, nseg = 1 << lgseg, nwork = nseq * 32 * 4;
    const float* PQ = (const float*)(p->ws + WS_PQ); float* SST = (float*)(p->ws + WS_SST);
    for (int wk = blockIdx.x * 8 + wid; wk < nwork; wk += gridDim.x * 8) {
        const int nt = wk & 3, chain = wk >> 2;
        f32x4 S[4];
#pragma unroll
        for (int mt = 0; mt < 4; ++mt) S[mt] = (f32x4){0.f, 0.f, 0.f, 0.f};
        struct CStep { bf16x8 ah[4][2]; f32x4 q[4]; };
#define CMB_LOAD(c, gg) do { const int g_ = (gg) < nseg - 1 ? (gg) : nseg - 2; const unsigned char* b_ = (const unsigned char*)(PQ + ((size_t)chain * nseg + g_) * 8192); \
        _Pragma("unroll") for (int mt = 0; mt < 4; ++mt) { (c).q[mt] = *(const f32x4*)(b_ + 16384 + ((mt * 4 + nt) * 64 + lane) * 16); \
            _Pragma("unroll") for (int ks = 0; ks < 2; ++ks) (c).ah[mt][ks] = *(const bf16x8*)(b_ + (((mt * 2 + ks) * 2 + 0) * 64 + lane) * 16); } } while (0)
        CStep c0, c1, c2;
        CMB_LOAD(c0, 0); CMB_LOAD(c1, 1); CMB_LOAD(c2, 2);
        for (int g = 0; g < nseg; ++g) {
            const size_t item = (size_t)chain * nseg + g;
#pragma unroll
            for (int mt = 0; mt < 4; ++mt) *(f32x4*)(SST + item * 4096 + ((mt * 4 + nt) * 64 + lane) * 4) = S[mt];
            if (g == nseg - 1) break;
            const CStep cc = c0; c0 = c1; c1 = c2;
            CMB_LOAD(c2, g + 3);
            bf16x8 bh[2], bl[2];
            split_frag(S[0], S[1], bh[0], bl[0]); split_frag(S[2], S[3], bh[1], bl[1]);
#pragma unroll
            for (int mt = 0; mt < 4; ++mt) {
                f32x4 acc = cc.q[mt];
#pragma unroll
                for (int ks = 0; ks < 2; ++ks) { acc = MFMA16(cc.ah[mt][ks], bh[ks], acc); acc = MFMA16(cc.ah[mt][ks], bl[ks], acc); }
                S[mt] = acc;
            }
        }
#undef CMB_LOAD
    }
}

DI void unpack8(u32x4 w, float (&f)[8]) { f[0] = lo16(w.x); f[1] = hi16(w.x); f[2] = lo16(w.y); f[3] = hi16(w.y); f[4] = lo16(w.z); f[5] = hi16(w.z); f[6] = lo16(w.w); f[7] = hi16(w.w); }
__device__ void phase_shift(KP p, int s, int wid0) {
    KP_FRESH(p);
    int tid_ = hw_tid(wid0); asm volatile("" : "+v"(tid_));
    int tok0, nseq, T; slab_info(s, tok0, nseq, T);
    const bf16_t* TMP = (const bf16_t*)(p->ws + WS_TMP); bf16_t* U = (bf16_t*)(p->ws + WS_U);
    const float* mu = p->in[I_MU];
    const int gt = blockIdx.x * 512 + tid_, nt = gridDim.x * 512;
    for (int unit = gt; unit < 416 * (SLAB / 16); unit += nt) {
        const int cg0 = unit % 416, cg = cg0 < 384 ? cg0 : cg0 + 128, rb = unit / 416, c0 = cg * 8, r0 = rb * 16;
        const bool tanh_cols = (c0 >= 4096) && (c0 < 4096 + 128);
        float m[8];
        { const f32x4 a = *(const f32x4*)(mu + c0), b = *(const f32x4*)(mu + c0 + 4); m[0] = a[0]; m[1] = a[1]; m[2] = a[2]; m[3] = a[3]; m[4] = b[0]; m[5] = b[1]; m[6] = b[2]; m[7] = b[3]; }
        const bf16_t* src = TMP + (size_t)r0 * 4352 + c0; bf16_t* dst = U + (size_t)r0 * UW + URW + c0;
        const int t0 = r0 & (T - 1);
        u32x4 raw[18];
        raw[0] = (t0 > 0) ? *(const u32x4*)(src - 4352) : (u32x4){0u, 0u, 0u, 0u};
#pragma unroll
        for (int i = 0; i < 16; ++i) raw[i + 1] = *(const u32x4*)(src + (size_t)i * 4352);
        raw[17] = (t0 + 16 < T) ? *(const u32x4*)(src + (size_t)16 * 4352) : (u32x4){0u, 0u, 0u, 0u};
        float prev[8], cur[8], nxt[8];
        unpack8(raw[0], prev); unpack8(raw[1], cur);
#pragma unroll
        for (int i = 0; i < 16; ++i) {
            unpack8(raw[i + 2], nxt);
            float o[8];
#pragma unroll
            for (int e = 0; e < 8; ++e) {
                float v = cur[e] + m[e] * (0.5f * (prev[e] + nxt[e]) - cur[e]);
                if (tanh_cols) v = 1.f - 2.f * __builtin_amdgcn_rcpf(1.f + __expf(2.f * v));
                o[e] = v; prev[e] = cur[e]; cur[e] = nxt[e];
            }
            *(u32x4*)(dst + (size_t)i * UW) = (u32x4){cvtpk(o[0], o[1]), cvtpk(o[2], o[3]), cvtpk(o[4], o[5]), cvtpk(o[6], o[7])};
        }
    }
}

__device__ void phase_post(KP p, int s, int wid0) {
    KP_FRESH(p);
    int tid_ = hw_tid(wid0); asm volatile("" : "+v"(tid_));
    const int lane = tid_ & 63, gw = blockIdx.x * 8 + (tid_ >> 6), nw = gridDim.x * 8;
    int tok0, nseq, T; slab_info(s, tok0, nseq, T);
    const bf16_t* U = (const bf16_t*)(p->ws + WS_U);
    const bf16_t* YS = (const bf16_t*)(p->ws + WS_YS); const float* BON = (const float*)(p->ws + WS_BON);
    bf16_t* ymix = (bf16_t*)(p->ws + WS_YMIX);
    for (int unit = gw; unit < (SLAB / 16) * 2; unit += nw) {
        const int half = unit & 1, r0 = (unit >> 1) * 16, c0 = half * 512 + lane * 8, h = c0 >> 6;
        float cw0[8], cw1[8], cw2[8], cbv[8], lg[8], lb[8];
        {
            const float* cw = p->in[I_CW]; const float* cb = p->in[I_CB]; const float* g = p->in[I_LXG]; const float* b = p->in[I_LXB];
#pragma unroll
            for (int e = 0; e < 8; ++e) { cw0[e] = cw[c0 + e]; cw1[e] = cw[1024 + c0 + e]; cw2[e] = cw[2048 + c0 + e]; cbv[e] = cb[c0 + e]; lg[e] = g[c0 + e]; lb[e] = b[c0 + e]; }
        }
        const int t0 = r0 & (T - 1);
        const bf16_t* up = U + (size_t)r0 * UW + c0;
        float pprev[8], pcur[8], pnxt[8], zprev[8], zcur[8], znxt[8], muz[8];
        if (t0 > 0) { unpack8(*(const u32x4*)(up - UW), pprev); unpack8(*(const u32x4*)(up - UW + URW + 3072), zprev); } else { for (int e = 0; e < 8; ++e) { pprev[e] = 0.f; zprev[e] = 0.f; } }
        unpack8(*(const u32x4*)up, pcur); unpack8(*(const u32x4*)(up + URW + 3072), zcur);
        { const float* mu = p->in[I_MU];
#pragma unroll
          for (int e = 0; e < 8; ++e) muz[e] = mu[3072 + c0 + e]; }
        for (int ib = 0; ib < 16; ib += 4) {
            u32x4 rp[4], rg[4], rv[4], rz[4], ry0[4], ry1[4]; float bonv[4];
#pragma unroll
            for (int r = 0; r < 4; ++r) {
                const int i = ib + r, row = r0 + i;
                const bf16_t* ur = up + (size_t)i * UW;
                rp[r] = (t0 + i < T - 1) ? *(const u32x4*)(ur + UW) : (u32x4){0u, 0u, 0u, 0u};
                rz[r] = (t0 + i < T - 1) ? *(const u32x4*)(ur + UW + URW + 3072) : (u32x4){0u, 0u, 0u, 0u};
                rg[r] = *(const u32x4*)(ur + 1024); rv[r] = *(const u32x4*)(ur + URW + 2048);
                ry0[r] = *(const u32x4*)(YS + (size_t)row * DR + c0); ry1[r] = *(const u32x4*)(YS + ((size_t)SLAB + row) * DR + c0);
                bonv[r] = BON[(size_t)row * 16 + h] + BON[((size_t)SLAB + row) * 16 + h];
            }
#pragma unroll
            for (int r = 0; r < 4; ++r) {
                const int row = r0 + ib + r;
                float gg[8], vv[8], zz[8], y[8], y1[8];
                unpack8(rp[r], pnxt); unpack8(rg[r], gg); unpack8(rv[r], vv); unpack8(rz[r], znxt); unpack8(ry0[r], y); unpack8(ry1[r], y1);
#pragma unroll
                for (int e = 0; e < 8; ++e) { zz[e] = zcur[e] + muz[e] * (0.5f * (zprev[e] + znxt[e]) - zcur[e]); zprev[e] = zcur[e]; zcur[e] = znxt[e]; }
                const float bon = bonv[r];
#pragma unroll
                for (int e = 0; e < 8; ++e) y[e] += y1[e];
                float sum = 0.f;
#pragma unroll
                for (int e = 0; e < 8; ++e) sum += y[e];
                sum += shx(sum, lane, 1); sum += shx(sum, lane, 2); sum += shx(sum, lane, 4);
                const float mean = sum * (1.f / 64.f);
                float sq = 0.f;
#pragma unroll
                for (int e = 0; e < 8; ++e) { const float dl = y[e] - mean; sq += dl * dl; }
                sq += shx(sq, lane, 1); sq += shx(sq, lane, 2); sq += shx(sq, lane, 4);
                const float rstd = rsqrtf(sq * (1.f / 64.f) + 64e-5f);
                float oc[8], orw[8];
#pragma unroll
                for (int e = 0; e < 8; ++e) {
                    oc[e] = gg[e] * (cw0[e] * pprev[e] + cw1[e] * pcur[e] + cw2[e] * pnxt[e] + cbv[e]);
                    orw[e] = ((y[e] - mean) * rstd * lg[e] + lb[e] + bon * vv[e]) * (zz[e] * fsig(zz[e]));
                    pprev[e] = pcur[e]; pcur[e] = pnxt[e];
                }
                *(u32x4*)(ymix + (size_t)row * 2048 + c0) = (u32x4){cvtpk(oc[0], oc[1]), cvtpk(oc[2], oc[3]), cvtpk(oc[4], oc[5]), cvtpk(oc[6], oc[7])};
                *(u32x4*)(ymix + (size_t)row * 2048 + 1024 + c0) = (u32x4){cvtpk(orw[0], orw[1]), cvtpk(orw[2], orw[3]), cvtpk(orw[4], orw[5]), cvtpk(orw[6], orw[7])};
            }
        }
    }
}

__device__ void phase_lnout(KP p, int s, int wid0) {
    KP_FRESH(p);
    int tid_ = hw_tid(wid0); asm volatile("" : "+v"(tid_)); int lane = tid_ & 63; const int gw = blockIdx.x * 8 + (tid_ >> 6), nw = gridDim.x * 8;
    float* out = p->out + (size_t)s * SLAB * D;
    const float4* g4 = (const float4*)p->in[I_LG]; const float4* b4 = (const float4*)p->in[I_LB];
    for (int r0 = gw; r0 < SLAB; r0 += 4 * nw) {
        asm volatile("" : "+v"(lane));
        float4 v[4][4];
#pragma unroll
        for (int k = 0; k < 4; ++k)
#pragma unroll
            for (int i = 0; i < 4; ++i) v[k][i] = ((const float4*)(out + (size_t)(r0 + k * nw) * D))[lane + 64 * i];
#pragma unroll
        for (int k = 0; k < 4; ++k) {
            float4* xp = (float4*)(out + (size_t)(r0 + k * nw) * D);
            float sum = 0.f;
#pragma unroll
            for (int i = 0; i < 4; ++i) sum += v[k][i].x + v[k][i].y + v[k][i].z + v[k][i].w;
            const float mean = wsum(sum, lane) * (1.f / 1024.f);
            float sq = 0.f;
#pragma unroll
            for (int i = 0; i < 4; ++i) { float a = v[k][i].x - mean, b = v[k][i].y - mean, c = v[k][i].z - mean, d = v[k][i].w - mean; sq += a * a + b * b + c * c + d * d; }
            const float rstd = rsqrtf(wsum(sq, lane) * (1.f / 1024.f) + 1e-5f);
#pragma unroll
            for (int i = 0; i < 4; ++i) {
                const float4 g = g4[lane + 64 * i], b = b4[lane + 64 * i];
                float4 o; o.x = (v[k][i].x - mean) * rstd * g.x + b.x; o.y = (v[k][i].y - mean) * rstd * g.y + b.y; o.z = (v[k][i].z - mean) * rstd * g.z + b.z; o.w = (v[k][i].w - mean) * rstd * g.w + b.w;
                xp[lane + 64 * i] = o;
            }
        }
    }
}

#define LAS __attribute__((address_space(3)))
#define XB_TMO      128
#define XB_XCNT(j)  (256  + 64 * (j))
#define XB_XSUB(j)  (1280 + 64 * (j))
#define XB_XGEN(j)  (2304 + 64 * (j))
#define XB_TOP      3328
#define XB_TOPGEN   3392
#define XCD_BAR_WORDS 3456
#define XB_SPIN_CAP (1u << 18)

__device__ __forceinline__ unsigned xb_ld(unsigned* p)              { return __hip_atomic_load(p, __ATOMIC_RELAXED, __HIP_MEMORY_SCOPE_AGENT); }
__device__ __forceinline__ unsigned xb_add(unsigned* p, unsigned v) { return __hip_atomic_fetch_add(p, v, __ATOMIC_RELAXED, __HIP_MEMORY_SCOPE_AGENT); }
__device__ __forceinline__ unsigned xb_xcc_id() { return (unsigned)__builtin_amdgcn_s_getreg((3 << 11) | 20) & 0xFu; }
#define XB_SPIN(cond, bar) do { unsigned _sp = 0; while (cond) { __builtin_amdgcn_s_sleep(1); \
    if ((++_sp & 255u) == 0u) { if (xb_ld(&(bar)[XB_TMO])) break; if (_sp > XB_SPIN_CAP) { atomicAdd(&(bar)[XB_TMO], 1u); break; } } } } while (0)

struct XcdBarrier {
    unsigned* bar; unsigned x;
    volatile LAS unsigned* st;
};

__device__ __forceinline__ XcdBarrier xcd_barrier_post(unsigned* bar, volatile LAS unsigned* st) {
    XcdBarrier b; b.bar = bar; b.x = xb_xcc_id(); b.st = st;
    if (threadIdx.x == 0) (void)xb_add(&bar[XB_XCNT(b.x)], 1u);
    return b;
}
__device__ __forceinline__ void xcd_barrier_complete(unsigned* bar, unsigned x, unsigned& nloc, unsigned& nx) {
    const unsigned G = gridDim.x * gridDim.y * gridDim.z;
    unsigned sum, cnt, mine, sp = 0u;
    for (;;) {
        sum = 0u; cnt = 0u; mine = 0u;
#pragma unroll
        for (unsigned j = 0; j < 16; ++j) { const unsigned c = xb_ld(&bar[XB_XCNT(j)]); sum += c; cnt += (c > 0u) ? 1u : 0u; mine = (j == x) ? c : mine; }
        if (sum == G) break;
        __builtin_amdgcn_s_sleep(1);
        if ((++sp & 255u) == 0u) { if (xb_ld(&bar[XB_TMO])) break; if (sp > XB_SPIN_CAP) { atomicAdd(&bar[XB_TMO], 1u); break; } }
    }
    nloc = mine > 0u ? mine : 1u; nx = cnt > 0u ? cnt : 1u;
}

__device__ __forceinline__ void xcd_barrier(const XcdBarrier& b) {
    asm volatile("s_waitcnt vmcnt(0)" ::: "memory");
    __syncthreads();
    if (threadIdx.x == 0) {
        unsigned* bar = b.bar;
        __builtin_amdgcn_s_waitcnt(0);
        unsigned nloc = b.st[0], nx = b.st[1];
        if (nloc == 0u) { xcd_barrier_complete(bar, b.x, nloc, nx); b.st[0] = nloc; b.st[1] = nx; }
        const unsigned old = xb_add(&bar[XB_XSUB(b.x)], 1u);
        const unsigned gen = old / nloc;
        if (old + 1u == (gen + 1u) * nloc) {
            __builtin_amdgcn_fence(__ATOMIC_RELEASE, "agent");
            asm volatile("s_waitcnt vmcnt(0)" ::: "memory");
            const unsigned og = xb_add(&bar[XB_TOP], 1u);
            const unsigned tg = og / nx;
            if (og + 1u == (tg + 1u) * nx) xb_add(&bar[XB_TOPGEN], 1u);
            else XB_SPIN(xb_ld(&bar[XB_TOPGEN]) == tg, bar);
            __builtin_amdgcn_fence(__ATOMIC_ACQUIRE, "agent");
            xb_add(&bar[XB_XGEN(b.x)], 1u);
            asm volatile("s_waitcnt vmcnt(0)" ::: "memory");
        } else {
            XB_SPIN(xb_ld(&bar[XB_XGEN(b.x)]) == gen, bar);
            __builtin_amdgcn_fence(__ATOMIC_ACQUIRE, "agent");
            asm volatile("s_waitcnt vmcnt(0)" ::: "memory");
        }
    }
    __syncthreads();
}

#ifndef REP_SHIFT
#define REP_SHIFT 1
#endif
#ifndef REP_G2
#define REP_G2 1
#endif
#ifndef REP_SCAN
#define REP_SCAN 1
#endif
#ifndef REP_POST
#define REP_POST 1
#endif
#ifndef REP_G1
#define REP_G1 1
#endif
#define GBAR() xcd_barrier(bar)
__global__ void __launch_bounds__(512, 2) fwd_megakernel(Params p_unused) {
    extern __shared__ __attribute__((aligned(16))) unsigned char lds_raw[];
    PG8_LAS unsigned char* lds = (PG8_LAS unsigned char*)lds_raw;
    cg::grid_group grid = cg::this_grid();
    KP p = (KP)__builtin_amdgcn_kernarg_segment_ptr();
    if (threadIdx.x < 2) ((volatile LAS unsigned*)(lds + LDS_BYTES - 64))[threadIdx.x] = 0u;
    __syncthreads();
    {
        unsigned* bw = (unsigned*)(((const Params __attribute__((address_space(4)))*)__builtin_amdgcn_kernarg_segment_ptr())->ws + WS_BAR);
        if (blockIdx.x == 0) { for (int w = threadIdx.x; w < XCD_BAR_WORDS; w += 512) __hip_atomic_store(bw + w, 0u, __ATOMIC_RELAXED, __HIP_MEMORY_SCOPE_AGENT); __threadfence(); }
        grid.sync();
    }
    XcdBarrier bar = xcd_barrier_post((unsigned*)(((const Params __attribute__((address_space(4)))*)__builtin_amdgcn_kernarg_segment_ptr())->ws + WS_BAR), (volatile LAS unsigned*)(lds + LDS_BYTES - 64));
    const int wid0 = __builtin_amdgcn_readfirstlane((int)threadIdx.x >> 6);
    phase_weights(p, wid0);
    for (int s = -1; s < 3; ++s) {
        if (s == 0) GBAR();
        if (s >= 0)
        for (int rep = 0; rep < REP_G1; ++rep) {
            if (rep) GBAR();
            KP_FRESH(p);
            pg8::Gemm g; g.A = xn_buf(p, s); g.Bt = (const bf16_t*)(p->ws + WS_WIN); g.M = SLAB; g.N = NIN; g.K = D;
            pg8::StaticOrder S; S.init(g.M, g.N, gridDim.x, blockIdx.x);
            EpiU E; E.U = (bf16_t*)(p->ws + WS_U); E.TMP = (bf16_t*)(p->ws + WS_TMP);
            pg8::gemm_phase<EpiU, pg8::StaticOrder, true, true>(lds, g, S, E, wid0);
        }
        {
            const int wg0 = (s >= 0 && gridDim.x > 64) ? 64 : 0;
            if (s < 2 && (int)blockIdx.x >= wg0) phase_ln(p, s + 1, wid0, wg0);
        }
        if (s < 0) continue;
        GBAR();
        for (int rep = 0; rep < REP_SHIFT; ++rep) {
        phase_shift(p, s, wid0);
        GBAR();
        }
        for (int rep = 0; rep < REP_SCAN; ++rep) {
        phase_scan<1>(p, s, lds_raw, wid0);
        GBAR();
        if (s > 0 && gridDim.x >= 128) phase_combine_ring(p, s, wid0, lds_raw); else phase_combine(p, s, wid0);
        GBAR();
        phase_scan<2>(p, s, lds_raw, wid0);
        GBAR();
        }
        for (int rep = 0; rep < REP_POST; ++rep) {
        phase_post(p, s, wid0);
        GBAR();
        }
        for (int rep = 0; rep < REP_G2; ++rep) {
            if (rep) GBAR();
            KP_FRESH(p);
            pg8::Gemm g; g.A = (const bf16_t*)(p->ws + WS_YMIX); g.Bt = (const bf16_t*)(p->ws + WS_WOUT); g.M = SLAB; g.N = D; g.K = 2048;
            pg8::StaticOrder S; S.init(g.M, g.N, gridDim.x, blockIdx.x);
            EpiOut E; E.out = p->out + (size_t)s * SLAB * D; E.x = slab_x(p, s); E.stats = (const float*)(p->ws + WS_STATS) + (size_t)s * SLAB * 2; E.eg = p->in[I_EG]; E.eb = p->in[I_EB];
            pg8::gemm_phase<EpiOut, pg8::StaticOrder, true, true>(lds, g, S, E, wid0);
        }
        GBAR();
        phase_lnout(p, s, wid0);
    }
}

extern "C" void kernel_launch(void* const* d_in, const int* in_sizes, int n_in, void* d_out, int out_size, void* d_ws, size_t ws_size, hipStream_t stream) {
    static int grid_blocks = 0;
    if (!grid_blocks) {
        int dev = 0, cus = 0, per_cu = 0;
        hipGetDevice(&dev);
        hipDeviceGetAttribute(&cus, hipDeviceAttributeMultiprocessorCount, dev);
        hipFuncSetAttribute((const void*)fwd_megakernel, hipFuncAttributeMaxDynamicSharedMemorySize, LDS_BYTES);
        hipOccupancyMaxActiveBlocksPerMultiprocessor(&per_cu, (const void*)fwd_megakernel, 512, LDS_BYTES);
        if (per_cu < 1) per_cu = 1;
        if (per_cu > 1) per_cu = 1;
        grid_blocks = cus * per_cu;
    }
    Params p{};
    for (int i = 0; i < 20; ++i) p.in[i] = (const float*)d_in[i];
    p.out = (float*)d_out; p.ws = (unsigned char*)d_ws;
    void* args[] = {&p};
    hipError_t e = hipLaunchCooperativeKernel((const void*)fwd_megakernel, dim3(grid_blocks), dim3(512), args, LDS_BYTES, stream);
    if (e != hipSuccess) fprintf(stderr, "cooperative launch failed: %s (grid %d)\n", hipGetErrorString(e), grid_blocks);
}
```

```cpp
#include <hip/hip_runtime.h>
#include <hip/hip_cooperative_groups.h>
#include <cstdio>
#include <cstdint>
namespace cg = cooperative_groups;
namespace pg8 {
#define PG8_LAS __attribute__((address_space(3)))
typedef unsigned short bf16_t;
typedef short bf16x8 __attribute__((ext_vector_type(8)));
typedef float f32x4 __attribute__((ext_vector_type(4)));
typedef unsigned u32x4 __attribute__((ext_vector_type(4)));
constexpr int BM = 256, BK = 64, HALF = 128, HTB = HALF * BK * 2  , STAGE_BYTES = 8 * HTB, NXCD = 8, WGM = 4;

__host__ __device__ __forceinline__ int lds_byte(int r, int c) { const int st = (r >> 4) * 2 + (c >> 5), rr = r & 15, cc = c & 31, ob = rr * 64 + cc * 2; return st * 1024 + (ob ^ (((ob >> 9) & 1) << 5)); }
__host__ __device__ __forceinline__ void stage_rc(int b, int& R, int& C) { const int st = b / 1024, sb = b % 1024, swz = sb ^ (((sb >> 9) & 1) << 5); R = (st >> 1) * 16 + swz / 64; C = (st & 1) * 32 + (swz % 64) / 2; }
__host__ __device__ __forceinline__ int perm32(int rho) { const int n = rho >> 4, i = rho & 15; return 8 * (i >> 2) + 4 * n + (i & 3); }

struct Unit { int pm, pn; };
struct Gemm { const bf16_t* A; const bf16_t* Bt; int M, N, K; };

struct StaticOrder {
    int nM, nN, nwg, G, c;
    __host__ __device__ void init(int M, int N, int G_, int c_) { nM = M / BM; nN = N / BM; nwg = nM * nN; G = G_; c = c_; }
    __host__ __device__ bool next(int i, Unit& u) const {
        const long L = (long)i * G + c; if (L >= nwg) return false;
        int wgid = (int)L; { const int q = nwg / NXCD, r = nwg % NXCD, xcd = wgid % NXCD, off = wgid / NXCD; wgid = (xcd < r ? xcd * (q + 1) : r * (q + 1) + (xcd - r) * q) + off; }
        const int nig = WGM * nN, gid = wgid / nig, fm = gid * WGM, gsz = (nM - fm) < WGM ? (nM - fm) : WGM;
        u.pm = fm + ((wgid % nig) % gsz); u.pn = (wgid % nig) / gsz; return true;
    }
    __device__ __forceinline__ void a_ready(const Unit&) const {}
    __device__ __forceinline__ void done(const Unit&) const {}
};

template <class Epi, class Sched, bool ALIGN_EPI = false, bool SP2 = false>
__device__ __forceinline__ void gemm_phase(PG8_LAS unsigned char* lds, const Gemm g, const Sched& S, const Epi& E, int wid0) {
    int tid_; asm volatile("v_mbcnt_lo_u32_b32 %0, -1, 0\n\tv_mbcnt_hi_u32_b32 %0, -1, %0" : "=v"(tid_)); tid_ += wid0 * 64; const int tid = tid_, wid = __builtin_amdgcn_readfirstlane(tid >> 6), lane = tid & 63, wr = wid >> 2, wc = wid & 3, fr = lane & 15, fq = lane >> 4;
    const int K = g.K, nt = K / BK;
    unsigned voffA[2], voffB[2];
#pragma unroll
    for (int i = 0; i < 2; ++i) { int R, C; stage_rc(tid * 16 + i * 8192, R, C); const int Rb = Epi::PERM ? ((R & ~31) + perm32(R & 31)) : R;
        voffA[i] = (unsigned)(R * K + C) * 2u; voffB[i] = (unsigned)(Rb * K + C) * 2u; }
    const size_t kstep = (size_t)(BK * 2);
    const size_t hstep = (size_t)HALF * K * 2;
    const size_t tstep = 2 * hstep;
    const unsigned ldsw = (unsigned)wid * 1024u;
    const int aoff = lds_byte(wr * 64 + fr, fq * 8), boff = lds_byte(wc * 32 + fr, fq * 8);
#define PG8_SA(b, h) (((b) * 2 + (h)) * HTB)
#define PG8_SB(b, h) ((4 + (b) * 2 + (h)) * HTB)
#define PG8_STAGE(bufoff, gbase, voff) do { _Pragma("unroll") for (int _i = 0; _i < 2; ++_i) \
        __builtin_amdgcn_global_load_lds((const unsigned*)((const char*)(gbase) + (voff)[_i]), (PG8_LAS unsigned*)(lds + (bufoff) + ldsw + _i * 8192), 16, 0, 0); } while (0)
#define PG8_LDA(dst, b, h) do { _Pragma("unroll") for (int m = 0; m < 4; ++m) _Pragma("unroll") for (int k = 0; k < 2; ++k) dst[m][k] = *(const PG8_LAS bf16x8*)(lds + PG8_SA(b, h) + aoff + m * 2048 + k * 1024); } while (0)
#define PG8_LDB(dst, b, h) do { _Pragma("unroll") for (int n = 0; n < 2; ++n) _Pragma("unroll") for (int k = 0; k < 2; ++k) dst[n][k] = *(const PG8_LAS bf16x8*)(lds + PG8_SB(b, h) + boff + n * 2048 + k * 1024); } while (0)
#define PG8_MMA(ai, bj, At, Bt) do { __builtin_amdgcn_s_setprio(1); _Pragma("unroll") for (int m = 0; m < 4; ++m) _Pragma("unroll") for (int n = 0; n < 2; ++n) _Pragma("unroll") for (int k = 0; k < 2; ++k) \
        acc[ai][bj][m][n] = __builtin_amdgcn_mfma_f32_16x16x32_bf16(Bt[n][k], At[m][k], acc[ai][bj][m][n], 0, 0, 0); __builtin_amdgcn_s_setprio(0); } while (0)
#define PG8_WAIT_V(n) asm volatile("s_waitcnt vmcnt(" #n ")" ::: "memory")
#define PG8_WAIT_L(n) asm volatile("s_waitcnt lgkmcnt(" #n ")" ::: "memory")
#define PG8_BAR __builtin_amdgcn_s_barrier()
#define PG8_SCHED __builtin_amdgcn_sched_barrier(0)
    Unit cur, nxt; int ui = 0;
    if (!S.next(0, cur)) return;
    f32x4 acc[2][2][4][2];
#pragma unroll
    for (int a = 0; a < 2; ++a)
#pragma unroll
        for (int b = 0; b < 2; ++b)
#pragma unroll
            for (int m = 0; m < 4; ++m)
#pragma unroll
                for (int n = 0; n < 2; ++n) acc[a][b][m][n] = (f32x4){0.f, 0.f, 0.f, 0.f};
    bf16x8 At[4][2], B0[2][2], B1[2][2];
    const char* cA = (const char*)g.A + (size_t)cur.pm * tstep; const char* cB = (const char*)g.Bt + (size_t)cur.pn * tstep;
    S.a_ready(cur);
    if constexpr (SP2) {
        PG8_STAGE(PG8_SB(0, 0), cB, voffB); PG8_STAGE(PG8_SB(0, 1), cB + hstep, voffB); PG8_STAGE(PG8_SA(0, 0), cA, voffA); PG8_STAGE(PG8_SA(0, 1), cA + hstep, voffA);
        if (wr == 1) PG8_BAR;
        PG8_WAIT_V(2); PG8_BAR;
        PG8_STAGE(PG8_SB(1, 0), cB + kstep, voffB); PG8_STAGE(PG8_SA(1, 0), cA + kstep, voffA); PG8_STAGE(PG8_SB(1, 1), cB + hstep + kstep, voffB);
        PG8_WAIT_V(6); PG8_BAR;
    } else {
        PG8_STAGE(PG8_SB(0, 0), cB, voffB); PG8_STAGE(PG8_SA(0, 0), cA, voffA); PG8_STAGE(PG8_SB(0, 1), cB + hstep, voffB); PG8_STAGE(PG8_SA(0, 1), cA + hstep, voffA);
        if (wr == 1) PG8_BAR;
        PG8_WAIT_V(4); PG8_BAR;
        PG8_STAGE(PG8_SB(1, 0), cB + kstep, voffB); PG8_STAGE(PG8_SA(1, 0), cA + kstep, voffA); PG8_STAGE(PG8_SB(1, 1), cB + hstep + kstep, voffB);
        PG8_WAIT_V(6); PG8_BAR;
    }
    for (;;) {
        const bool has_next = S.next(ui + 1, nxt);
        const char* nA = has_next ? (const char*)g.A + (size_t)nxt.pm * tstep : cA; const char* nB = has_next ? (const char*)g.Bt + (size_t)nxt.pn * tstep : cB;
        for (int t = 0; t < nt; t += 2) {
            const bool last = (t == nt - 2);
            const char* a1 = cA + (size_t)(t + 1) * kstep;
            const char* a2 = last ? nA : cA + (size_t)(t + 2) * kstep; const char* b2 = last ? nB : cB + (size_t)(t + 2) * kstep;
            const char* a3 = a2 + kstep; const char* b3 = b2 + kstep;
            if (last && has_next) S.a_ready(nxt);
            if constexpr (SP2) {
            PG8_LDB(B0, 0, 0); PG8_LDB(B1, 0, 1); PG8_SCHED; PG8_LDA(At, 0, 0); PG8_STAGE(PG8_SA(1, 1), a1 + hstep, voffA);
            PG8_WAIT_V(8); PG8_WAIT_L(0); PG8_BAR; PG8_MMA(0, 0, At, B0); PG8_MMA(0, 1, At, B1); PG8_BAR; PG8_SCHED;
            PG8_LDA(At, 0, 1); PG8_STAGE(PG8_SB(0, 0), b2, voffB); PG8_STAGE(PG8_SB(0, 1), b2 + hstep, voffB); PG8_STAGE(PG8_SA(0, 0), a2, voffA);
            PG8_WAIT_V(8); PG8_WAIT_L(0); PG8_BAR; PG8_MMA(1, 0, At, B0); PG8_MMA(1, 1, At, B1); PG8_BAR; PG8_SCHED;
            PG8_LDB(B0, 1, 0); PG8_LDB(B1, 1, 1); PG8_SCHED; PG8_LDA(At, 1, 0); PG8_STAGE(PG8_SA(0, 1), a2 + hstep, voffA);
            PG8_WAIT_V(8); PG8_WAIT_L(0); PG8_BAR; PG8_MMA(0, 0, At, B0); PG8_MMA(0, 1, At, B1); PG8_BAR; PG8_SCHED;
            PG8_LDA(At, 1, 1); PG8_STAGE(PG8_SB(1, 0), b3, voffB); PG8_STAGE(PG8_SB(1, 1), b3 + hstep, voffB); PG8_STAGE(PG8_SA(1, 0), a3, voffA);
            PG8_WAIT_V(8); PG8_WAIT_L(0); PG8_BAR; PG8_MMA(1, 0, At, B0); PG8_MMA(1, 1, At, B1); PG8_BAR; PG8_SCHED;
            } else {
            PG8_LDB(B0, 0, 0); PG8_SCHED; PG8_LDA(At, 0, 0); PG8_STAGE(PG8_SA(1, 1), a1 + hstep, voffA);
            PG8_WAIT_L(8); PG8_BAR; PG8_WAIT_L(0); PG8_MMA(0, 0, At, B0); PG8_BAR; PG8_SCHED;
            PG8_LDB(B1, 0, 1); PG8_STAGE(PG8_SB(0, 0), b2, voffB);
            PG8_BAR; PG8_WAIT_L(0); PG8_MMA(0, 1, At, B1); PG8_BAR;
            PG8_LDA(At, 0, 1); PG8_STAGE(PG8_SA(0, 0), a2, voffA);
            PG8_BAR; PG8_WAIT_L(0); PG8_MMA(1, 0, At, B0); PG8_BAR; PG8_SCHED;
            PG8_STAGE(PG8_SB(0, 1), b2 + hstep, voffB);
            PG8_WAIT_V(6); PG8_BAR; PG8_MMA(1, 1, At, B1); PG8_BAR;
            PG8_LDB(B0, 1, 0); PG8_SCHED; PG8_LDA(At, 1, 0); PG8_STAGE(PG8_SA(0, 1), a2 + hstep, voffA);
            PG8_WAIT_L(8); PG8_BAR; PG8_WAIT_L(0); PG8_MMA(0, 0, At, B0); PG8_BAR; PG8_SCHED;
            PG8_LDB(B1, 1, 1); PG8_STAGE(PG8_SB(1, 0), b3, voffB);
            PG8_BAR; PG8_WAIT_L(0); PG8_MMA(0, 1, At, B1); PG8_BAR;
            PG8_LDA(At, 1, 1); PG8_STAGE(PG8_SA(1, 0), a3, voffA);
            PG8_BAR; PG8_WAIT_L(0); PG8_MMA(1, 0, At, B0); PG8_BAR; PG8_SCHED;
            PG8_STAGE(PG8_SB(1, 1), b3 + hstep, voffB);
            PG8_WAIT_V(6); PG8_BAR; PG8_MMA(1, 1, At, B1); PG8_BAR;
            }
        }
        if constexpr (ALIGN_EPI) { if (wr == 0) PG8_BAR; }
        if constexpr (!Epi::AFTER_DRAIN) { E(acc, cur, wr, wc, fr, fq); S.done(cur); }
        if (!has_next) break;
#pragma unroll
        for (int a = 0; a < 2; ++a)
#pragma unroll
            for (int b = 0; b < 2; ++b)
#pragma unroll
                for (int m = 0; m < 4; ++m)
#pragma unroll
                    for (int n = 0; n < 2; ++n) acc[a][b][m][n] = (f32x4){0.f, 0.f, 0.f, 0.f};
        cur = nxt; cA = nA; cB = nB; ++ui;
        if constexpr (ALIGN_EPI) { if (wr == 1) PG8_BAR; }
    }
    PG8_WAIT_V(0);
    if constexpr (!ALIGN_EPI) { if (wr == 0) PG8_BAR; }
    PG8_BAR;
    if constexpr (Epi::AFTER_DRAIN) { E.fused(acc, cur, wr, wc, fr, fq, lds, wid, lane); S.done(cur); }
#undef PG8_SA
#undef PG8_SB
#undef PG8_STAGE
#undef PG8_LDA
#undef PG8_LDB
#undef PG8_MMA
#undef PG8_WAIT_V
#undef PG8_WAIT_L
#undef PG8_BAR
#undef PG8_SCHED
}
}

typedef unsigned short bf16_t;
typedef float f32x4 __attribute__((ext_vector_type(4)));
typedef unsigned u32x4 __attribute__((ext_vector_type(4)));
typedef unsigned u32x2 __attribute__((ext_vector_type(2)));

constexpr int D = 1024, NIN = 8448, DR = 1024, UW = 6400  , URW = 2048  ;
constexpr int SLAB = 16384, NTOK = 49152;
constexpr float DN_ALPHA = 1.189207115002721f;
constexpr size_t WS_WIN = 0;
constexpr size_t WS_WOUT = WS_WIN + (size_t)NIN * D * 2;
constexpr size_t WS_STATS = WS_WOUT + (size_t)D * 2048 * 2;
constexpr size_t WS_XN = WS_STATS + (size_t)NTOK * 2 * 4;
constexpr size_t WS_U = WS_XN + (size_t)SLAB * D * 2;
constexpr size_t WS_YS = WS_U + (size_t)SLAB * UW * 2;
constexpr size_t WS_BON = WS_YS + (size_t)2 * SLAB * DR * 4;
constexpr size_t WS_YMIX = WS_BON + (size_t)2 * SLAB * 16 * 4;
constexpr size_t WS_TMP = WS_YS;
constexpr size_t WS_PQ = WS_YMIX;
constexpr size_t WS_SST = WS_YMIX + (size_t)SLAB * 2048 * 2;
constexpr size_t WS_BAR = WS_SST + (size_t)2048 * 4096 * 4;
constexpr size_t WS_END = WS_BAR + 16384;
static_assert(WS_END <= (size_t)512 * 1024 * 1024, "ws map");
constexpr int LDS_BYTES = 147456;

struct Params { const float* in[20]; float* out; unsigned char* ws; };
typedef const Params __attribute__((address_space(4)))* KP;
#define KP_FRESH(p) asm volatile("" : "+s"(p))
__device__ __forceinline__ int hw_tid(int wid0) { int l; asm volatile("v_mbcnt_lo_u32_b32 %0, -1, 0\n\tv_mbcnt_hi_u32_b32 %0, -1, %0" : "=v"(l)); return wid0 * 64 + l; }
enum { I_XP = 0, I_XS, I_EG, I_EB, I_WIN, I_CW, I_CB, I_MU, I_W0, I_WUP, I_A0, I_AUP, I_KK, I_KA, I_RK, I_LXG, I_LXB, I_WOUT, I_LG, I_LB };

__device__ __forceinline__ float bf2f(unsigned short h) { return __uint_as_float((unsigned)h << 16); }
__device__ __forceinline__ unsigned f2bf(float f) { unsigned u = __float_as_uint(f); return (u + 0x7fffu + ((u >> 16) & 1u)) >> 16; }
__device__ __forceinline__ unsigned pk2(float lo, float hi) { return f2bf(lo) | (f2bf(hi) << 16); }
typedef __bf16 bf16x2e_t __attribute__((ext_vector_type(2)));
typedef float f32x2e __attribute__((ext_vector_type(2)));
__device__ __forceinline__ unsigned cvtpk_(float lo, float hi) { f32x2e v = {lo, hi}; bf16x2e_t b = __builtin_convertvector(v, bf16x2e_t); return __builtin_bit_cast(unsigned, b); }
__device__ __forceinline__ float shx(float v, int lane, int o) { return __int_as_float(__builtin_amdgcn_ds_bpermute((lane ^ o) << 2, __float_as_int(v))); }
__device__ __forceinline__ float wsum(float v, int lane) {
#pragma unroll
    for (int o = 32; o; o >>= 1) v += shx(v, lane, o);
    return v;
}
__device__ __forceinline__ float sigmoidf_(float x) { return 1.f / (1.f + __expf(-x)); }
__device__ __forceinline__ float siluf_(float x) { return x * sigmoidf_(x); }
__device__ __forceinline__ float rl(float v, int l) { return __int_as_float(__builtin_amdgcn_readlane(__float_as_int(v), l)); }

__device__ __forceinline__ void slab_info(int s, int& tok0, int& nseq, int& T) { if (s == 0) { tok0 = 0; nseq = 8; T = 2048; } else { tok0 = SLAB * s; nseq = 1; T = 16384; } }
__device__ __forceinline__ const float* slab_x(KP p, int s) { return s == 0 ? p->in[I_XP] : p->in[I_XS] + (size_t)(s - 1) * SLAB * D; }

__device__ __forceinline__ int orig_col(int jv) {
    if (jv >= 4096) return jv;
    const int pn = jv >> 8, bj = (jv >> 7) & 1, wc = (jv >> 5) & 3, fq = (jv >> 3) & 3, n = (jv >> 2) & 1, j = jv & 3;
    return (2 * bj + n) * 1024 + 64 * pn + 16 * wc + 4 * fq + j;
}

__device__ void phase_weights(KP p, int wid0) {
    KP_FRESH(p);
    int gt = blockIdx.x * 512 + hw_tid(wid0); asm volatile("" : "+v"(gt)); const int nt = gridDim.x * 512;
    bf16_t* win = (bf16_t*)(p->ws + WS_WIN); bf16_t* wout = (bf16_t*)(p->ws + WS_WOUT);
    const float* w_in = p->in[I_WIN]; const float* w_out = p->in[I_WOUT];
    for (int idx = gt; idx < NIN * 128; idx += nt) {
        const int jv = idx % NIN, kg = idx / NIN, oc = orig_col(jv);
        float v[8];
#pragma unroll
        for (int i = 0; i < 8; ++i) v[i] = w_in[(size_t)(kg * 8 + i) * NIN + oc];
        u32x4 w; w.x = pk2(v[0], v[1]); w.y = pk2(v[2], v[3]); w.z = pk2(v[4], v[5]); w.w = pk2(v[6], v[7]);
        *(u32x4*)(win + (size_t)jv * D + kg * 8) = w;
    }
    for (int idx = gt; idx < D * 256; idx += nt) {
        const int n = idx % D, kg = idx / D;
        float v[8];
#pragma unroll
        for (int i = 0; i < 8; ++i) v[i] = w_out[(size_t)(kg * 8 + i) * D + n];
        u32x4 w; w.x = pk2(v[0], v[1]); w.y = pk2(v[2], v[3]); w.z = pk2(v[4], v[5]); w.w = pk2(v[6], v[7]);
        *(u32x4*)(wout + (size_t)n * 2048 + kg * 8) = w;
    }
}

__device__ __forceinline__ bf16_t* xn_buf(KP p, int s) { return s == 1 ? (bf16_t*)(p->out + (size_t)2 * SLAB * D) : (bf16_t*)(p->ws + WS_XN); }
__device__ __forceinline__ void phase_ln(KP p, int s, int wid0, int wg0) {
    KP_FRESH(p);
    int tid_ = hw_tid(wid0); asm volatile("" : "+v"(tid_)); int lane = tid_ & 63; const int gw = ((int)blockIdx.x - wg0) * 8 + (tid_ >> 6), nw = ((int)gridDim.x - wg0) * 8;
    const float* x = slab_x(p, s); bf16_t* xn = xn_buf(p, s); float* stats = (float*)(p->ws + WS_STATS) + (size_t)s * SLAB * 2;
    const float4* g4 = (const float4*)p->in[I_EG]; const float4* b4 = (const float4*)p->in[I_EB];
    for (int gi = gw; gi < SLAB / 4; gi += nw) {
        const int r0 = gi * 4;
        asm volatile("" : "+v"(lane));
        float4 v[4][4];
#pragma unroll
        for (int k = 0; k < 4; ++k)
#pragma unroll
            for (int i = 0; i < 4; ++i) v[k][i] = ((const float4*)(x + (size_t)(r0 + k) * D))[lane + 64 * i];
#pragma unroll
        for (int k = 0; k < 4; ++k) {
            const int r = r0 + k;
            float sum = 0.f;
#pragma unroll
            for (int i = 0; i < 4; ++i) sum += v[k][i].x + v[k][i].y + v[k][i].z + v[k][i].w;
            const float mean = wsum(sum, lane) * (1.f / 1024.f);
            float sq = 0.f;
#pragma unroll
            for (int i = 0; i < 4; ++i) { float a = v[k][i].x - mean, b = v[k][i].y - mean, c = v[k][i].z - mean, d = v[k][i].w - mean; sq += a * a + b * b + c * c + d * d; }
            const float rstd = rsqrtf(wsum(sq, lane) * (1.f / 1024.f) + 1e-5f);
            if (lane == 0) { stats[r * 2] = mean; stats[r * 2 + 1] = rstd; }
#pragma unroll
            for (int i = 0; i < 4; ++i) {
                const float4 g = g4[lane + 64 * i], b = b4[lane + 64 * i];
                u32x2 w; w.x = cvtpk_((v[k][i].x - mean) * rstd * g.x + b.x, (v[k][i].y - mean) * rstd * g.y + b.y);
                w.y = cvtpk_((v[k][i].z - mean) * rstd * g.z + b.z, (v[k][i].w - mean) * rstd * g.w + b.w);
                *(u32x2*)(xn + (size_t)r * D + (lane + 64 * i) * 4) = w;
            }
        }
    }
}

struct EpiU {
    static constexpr bool PERM = true, AFTER_DRAIN = false;
    bf16_t* U; bf16_t* TMP; const float* mu;
    __device__ __forceinline__ void operator()(const f32x4 (&acc)[2][2][4][2], const pg8::Unit& u, int wr, int wc, int fr, int fq) const {
        const int row0 = u.pm * 256 + wr * 64 + fr;
        if (u.pn < 16) {
            const int ch0 = 64 * u.pn + 16 * wc + 4 * fq;
#pragma unroll
            for (int ai = 0; ai < 2; ++ai)
#pragma unroll
                for (int m = 0; m < 4; ++m) {
                    bf16_t* rowp = U + (size_t)(row0 + ai * 128 + m * 16) * UW + ch0;
                    const f32x4 h = acc[ai][0][m][0], B = acc[ai][0][m][1], C = acc[ai][1][m][0], z = acc[ai][1][m][1];
                    float pp[4], gg[4];
#pragma unroll
                    for (int j = 0; j < 4; ++j) { pp[j] = C[j] * h[j]; gg[j] = B[j] * siluf_(z[j]); }
                    u32x2 w0; w0.x = pk2(pp[0], pp[1]); w0.y = pk2(pp[2], pp[3]);
                    u32x2 w1; w1.x = pk2(gg[0], gg[1]); w1.y = pk2(gg[2], gg[3]);
                    *(u32x2*)rowp = w0; *(u32x2*)(rowp + 1024) = w1;
                }
        } else {
            const int col0 = 256 * (u.pn - 16) + 32 * wc + 8 * fq; const bool zt = (u.pn >= 28) && (u.pn < 32);
            if (zt) {
#pragma unroll
                for (int ai = 0; ai < 2; ++ai)
#pragma unroll
                    for (int m = 0; m < 4; ++m) {
                        bf16_t* rowp = U + (size_t)(row0 + ai * 128 + m * 16) * UW + URW + col0;
#pragma unroll
                        for (int bj = 0; bj < 2; ++bj) {
                            const f32x4 v0 = acc[ai][bj][m][0], v1 = acc[ai][bj][m][1];
                            u32x4 w; w.x = pk2(v0[0], v0[1]); w.y = pk2(v0[2], v0[3]); w.z = pk2(v1[0], v1[1]); w.w = pk2(v1[2], v1[3]);
                            *(u32x4*)(rowp + bj * 128) = w;
                        }
                    }
            } else {
#define EPI_DPP(old_, src_, ctrl_) __int_as_float(__builtin_amdgcn_update_dpp(__float_as_int(old_), __float_as_int(src_), ctrl_, 0xf, 0xf, false))
#pragma unroll
                for (int ai = 0; ai < 2; ++ai)
#pragma unroll
                    for (int bj = 0; bj < 2; ++bj) {
                        const int cb = col0 + bj * 128;
                        const f32x4 mu0 = *(const f32x4*)(mu + cb), mu1 = *(const f32x4*)(mu + cb + 4);
                        const bool th = (u.pn == 32) && (bj == 0);
                        const int blk = 4 * u.pm + 2 * ai + wr;
#pragma unroll
                        for (int m = 0; m < 4; ++m) {
                            u32x4 wv;
#pragma unroll
                            for (int n = 0; n < 2; ++n) {
                                const f32x4 cur = acc[ai][bj][m][n], mun = n ? mu1 : mu0;
                                f32x4 o;
#pragma unroll
                                for (int j = 0; j < 4; ++j) {
                                    const float po = (m > 0) ? EPI_DPP(0.f, acc[ai][bj][m > 0 ? m - 1 : 0][n][j], 0x121) : 0.f;
                                    const float no = (m < 3) ? EPI_DPP(0.f, acc[ai][bj][m < 3 ? m + 1 : 3][n][j], 0x12F) : 0.f;
                                    const float pv = EPI_DPP(po, cur[j], 0x111), nx = EPI_DPP(no, cur[j], 0x101);
                                    float v = cur[j] + mun[j] * (0.5f * (pv + nx) - cur[j]);
                                    if (th) v = 1.f - 2.f * __builtin_amdgcn_rcpf(1.f + __builtin_amdgcn_exp2f(2.88539008f * v));
                                    o[j] = v;
                                }
                                if (n == 0) { wv.x = pk2(o[0], o[1]); wv.y = pk2(o[2], o[3]); } else { wv.z = pk2(o[0], o[1]); wv.w = pk2(o[2], o[3]); }
                            }
                            *(u32x4*)(U + (size_t)(row0 + ai * 128 + m * 16) * UW + URW + cb) = wv;
                            if ((m == 0 && fr < 2) || (m == 3 && fr >= 14)) {
                                const int w4 = (m == 0) ? fr : fr - 12;
                                const f32x4 v0 = acc[ai][bj][m][0], v1 = acc[ai][bj][m][1];
                                u32x4 w; w.x = pk2(v0[0], v0[1]); w.y = pk2(v0[2], v0[3]); w.z = pk2(v1[0], v1[1]); w.w = pk2(v1[2], v1[3]);
                                *(u32x4*)(TMP + ((size_t)blk * 4 + w4) * 4352 + cb) = w;
                            }
                        }
                    }
#undef EPI_DPP
            }
        }
    }
};

struct EpiOut {
    static constexpr bool PERM = true, AFTER_DRAIN = false;
    float* out; const float* x; const float* stats; const float* eg; const float* eb;
    __device__ __forceinline__ void operator()(const f32x4 (&acc)[2][2][4][2], const pg8::Unit& u, int wr, int wc, int fr, int fq) const {
        const int row0 = u.pm * 256 + wr * 64 + fr, col0 = u.pn * 256 + wc * 32 + 8 * fq;
#pragma unroll
        for (int ai = 0; ai < 2; ++ai)
#pragma unroll
            for (int m = 0; m < 4; ++m) {
                const int row = row0 + ai * 128 + m * 16;
                const float mean = stats[row * 2], rstd = stats[row * 2 + 1];
#pragma unroll
                for (int bj = 0; bj < 2; ++bj)
#pragma unroll
                    for (int n = 0; n < 2; ++n) {
                        const int c = col0 + bj * 128 + 4 * n;
                        const float4 xv = *(const float4*)(x + (size_t)row * D + c), g = *(const float4*)(eg + c), b = *(const float4*)(eb + c);
                        const f32x4 a = acc[ai][bj][m][n];
                        float4 o;
                        o.x = DN_ALPHA * ((xv.x - mean) * rstd * g.x + b.x) + a[0]; o.y = DN_ALPHA * ((xv.y - mean) * rstd * g.y + b.y) + a[1];
                        o.z = DN_ALPHA * ((xv.z - mean) * rstd * g.z + b.z) + a[2]; o.w = DN_ALPHA * ((xv.w - mean) * rstd * g.w + b.w) + a[3];
                        *(float4*)(out + (size_t)row * D + c) = o;
                    }
            }
    }
};

typedef short bf16x8 __attribute__((ext_vector_type(8)));
typedef short s16x4 __attribute__((ext_vector_type(4)));
typedef __bf16 bf16x2_t __attribute__((ext_vector_type(2)));
typedef float f32x2 __attribute__((ext_vector_type(2)));
#define MFMA16(a, b, c) __builtin_amdgcn_mfma_f32_16x16x32_bf16((a), (b), (c), 0, 0, 0)
#define DI __device__ __forceinline__
constexpr int IMG_STRIDE = 144;
constexpr int WG_FRAG = 0;
constexpr int WG_CONST = 16384;
constexpr int WV_BASE = 16384 + 2560;
constexpr int WV_BYTES = 3 * 16 * IMG_STRIDE + 256;
static_assert(WV_BASE + 8 * WV_BYTES <= LDS_BYTES, "scan LDS map");

DI unsigned cvtpk(float lo, float hi) { f32x2 v = {lo, hi}; bf16x2_t b = __builtin_convertvector(v, bf16x2_t); return __builtin_bit_cast(unsigned, b); }
DI bf16x8 mkfrag(unsigned a, unsigned b, unsigned c, unsigned d) { u32x4 w = {a, b, c, d}; return __builtin_bit_cast(bf16x8, w); }
DI bf16x8 frag_f4(f32x4 a, f32x4 b) { return mkfrag(cvtpk(a[0], a[1]), cvtpk(a[2], a[3]), cvtpk(b[0], b[1]), cvtpk(b[2], b[3])); }
DI float bperm(float v, int srclane) { return __int_as_float(__builtin_amdgcn_ds_bpermute(srclane << 2, __float_as_int(v))); }
DI float lo16(unsigned w) { return __uint_as_float(w << 16); }
DI float hi16(unsigned w) { return __uint_as_float(w & 0xffff0000u); }
template <int CTRL> DI float dpp0(float x) { return __int_as_float(__builtin_amdgcn_update_dpp(0, __float_as_int(x), CTRL, 0xf, 0xf, true)); }
template <int CTRL> DI float dpp1(float x) { return __int_as_float(__builtin_amdgcn_update_dpp(0x3f800000, __float_as_int(x), CTRL, 0xf, 0xf, false)); }
DI float fsig(float x) { return __builtin_amdgcn_rcpf(1.f + __expf(-x)); }
DI f32x4 ld4(const bf16_t* ur) { const u32x2 c = *(const u32x2*)ur; return (f32x4){lo16(c.x), hi16(c.x), lo16(c.y), hi16(c.y)}; }

DI void split_frag(f32x4 a, f32x4 b, bf16x8& hi, bf16x8& lo) {
    f32x4 ah, bh;
    unsigned w[4] = {cvtpk(a[0], a[1]), cvtpk(a[2], a[3]), cvtpk(b[0], b[1]), cvtpk(b[2], b[3])};
    ah[0] = lo16(w[0]); ah[1] = hi16(w[0]); ah[2] = lo16(w[1]); ah[3] = hi16(w[1]); bh[0] = lo16(w[2]); bh[1] = hi16(w[2]); bh[2] = lo16(w[3]); bh[3] = hi16(w[3]);
    hi = mkfrag(w[0], w[1], w[2], w[3]); lo = frag_f4(a - ah, b - bh);
}
struct ChunkIn { u32x2 k[4], r[4], v[4]; bf16x8 tl[2], la[2]; };
template <int PASS> DI void chunk_load(ChunkIn& c, const bf16_t* ur, int h, int d, int q) {
#pragma unroll
    for (int n = 0; n < 4; ++n) {
        c.k[n] = *(const u32x2*)(ur + 1024 + h * 64 + 16 * n + 4 * q);
        if (PASS == 2) { c.v[n] = *(const u32x2*)(ur + 2048 + h * 64 + 16 * n + 4 * q); c.r[n] = *(const u32x2*)(ur + h * 64 + 16 * n + 4 * q); }
    }
#pragma unroll
    for (int ks = 0; ks < 2; ++ks) { const bf16_t* ul = ur + 4096 + d * 64 + 32 * ks + 8 * q; c.tl[ks] = *(const bf16x8*)ul; c.la[ks] = *(const bf16x8*)(ul + 128); }
}
DI f32x4 up4(u32x2 c) { return (f32x4){lo16(c.x), hi16(c.x), lo16(c.y), hi16(c.y)}; }
template <int PASS>
__device__ void phase_scan(KP p, int s, unsigned char* ldsg, int wid0) {
    KP_FRESH(p);
    const int wid = wid0;
    int tok0, nseq, T; slab_info(s, tok0, nseq, T);
    const int LS = 256, lgseg = (s == 0) ? 3 : 6, nseg = 1 << lgseg, nblk = (nseq * 32 << lgseg) >> 3;
    const bf16_t* U = (const bf16_t*)(p->ws + WS_U);
    bf16_t* YS = (bf16_t*)(p->ws + WS_YS); float* BON = (float*)(p->ws + WS_BON);
    float* PQ = (float*)(p->ws + WS_PQ); const float* SST = (const float*)(p->ws + WS_SST);
    float* cst = (float*)(ldsg + WG_CONST);
    const int wo = WV_BASE + wid * WV_BYTES;
    for (int ib = blockIdx.x; ib < nblk; ib += gridDim.x) {
        const int item = ib * 8 + wid, g = item & (nseg - 1), chain = item >> lgseg, h = chain & 15, d = (chain >> 4) & 1, b = chain >> 5;
        const int tid = hw_tid(wid0), lane = tid & 63, fr = lane & 15, q = lane >> 4;
        __syncthreads();
        if (tid < 64) {
            const float* mu = p->in[I_MU]; const int c = h * 64 + tid;
            cst[tid] = mu[c]; cst[64 + tid] = mu[1024 + c]; cst[128 + tid] = mu[2048 + c];
            cst[192 + tid] = -1.44269504f * p->in[I_W0][d * 1024 + c]; cst[256 + tid] = -1.44269504f * p->in[I_A0][d * 1024 + c];
            cst[320 + tid] = p->in[I_KK][c]; cst[384 + tid] = p->in[I_KA][c]; cst[448 + tid] = p->in[I_RK][c];
            cst[512 + tid] = mu[4096 + d * 64 + tid]; cst[576 + tid] = mu[4096 + 128 + d * 64 + tid];
        }
        for (int e = tid; e < 1024; e += 512) {
            const int l2 = e & 63, ks = (e >> 6) & 1, mt = (e >> 7) & 3, mat = e >> 9, fr2 = l2 & 15, q2 = l2 >> 4;
            const float* src = (mat ? p->in[I_AUP] : p->in[I_WUP]) + ((size_t)d * 64 + 32 * ks + 8 * q2) * 1024 + h * 64 + 16 * mt + fr2;
            float v8[8];
#pragma unroll
            for (int jj = 0; jj < 8; ++jj) v8[jj] = -1.44269504f * src[(size_t)jj * 1024];
            u32x4 w = {cvtpk(v8[0], v8[1]), cvtpk(v8[2], v8[3]), cvtpk(v8[4], v8[5]), cvtpk(v8[6], v8[7])};
            *(u32x4*)(ldsg + WG_FRAG + e * 16) = w;
        }
        __syncthreads();
        f32x4 St[4][4];
        f32x4 Pa[PASS == 1 ? 4 : 1][PASS == 1 ? 4 : 1];
        int l3 = lane; asm volatile("" : "+v"(l3));
        const float* sstl = SST + (size_t)item * 4096 + l3 * 4;
#pragma unroll
        for (int mt = 0; mt < 4; ++mt)
#pragma unroll
            for (int nt = 0; nt < 4; ++nt) {
                if (PASS == 1) {
#pragma unroll
                    for (int j = 0; j < 4; ++j) { St[mt][nt][j] = 0.f; Pa[PASS == 1 ? mt : 0][PASS == 1 ? nt : 0][j] = (16 * mt + 4 * q + j == 16 * nt + fr) ? 1.f : 0.f; }
                } else {
                    St[mt][nt] = *(const f32x4*)(sstl + (mt * 4 + nt) * 256);
                }
            }
        ChunkIn cin;
        { const int p0 = g * LS, t0 = d ? T - 1 - (p0 + fr) : p0 + fr; chunk_load<PASS>(cin, U + (size_t)(b * T + t0) * UW + URW, h, d, q); }
        for (int ck = 0; ck < LS / 16; ++ck) {
            const int pos0 = g * LS + ck * 16;
            const int lane_c = hw_tid(wid0) & 63;
            const int lane = lane_c, fr = lane_c & 15, q = lane_c >> 4;
            const int ti = d ? T - 1 - (pos0 + fr) : pos0 + fr, row = b * T + ti;
            ChunkIn cc = cin;
            if (PASS == 1) {
#pragma unroll
                for (int n = 0; n < 4; ++n) cc.v[n] = *(const u32x2*)(U + (size_t)row * UW + URW + 2048 + h * 64 + 16 * n + 4 * q);
            }
            {
                const int pn = g * LS + (ck + 1 < LS / 16 ? ck + 1 : ck) * 16, tn = d ? T - 1 - (pn + fr) : pn + fr;
                chunk_load<PASS>(cin, U + (size_t)(b * T + tn) * UW + URW, h, d, q);
            }
            const int lq16 = 16 * q, ll16 = 16 * lane, limg = fr * IMG_STRIDE + 8 * q, ltr = (4 * q + (fr >> 2)) * IMG_STRIDE + 8 * (fr & 3);
            f32x4 ow[4], oa[4];
            {
                const bf16x8 tlf[2] = {cc.tl[0], cc.tl[1]}, laf[2] = {cc.la[0], cc.la[1]};
#pragma unroll
                for (int mt = 0; mt < 4; ++mt) {
                    const bf16x8 w0f = *(const bf16x8*)(ldsg + WG_FRAG + ((0 * 4 + mt) * 2 + 0) * 1024 + ll16), w1f = *(const bf16x8*)(ldsg + WG_FRAG + ((0 * 4 + mt) * 2 + 1) * 1024 + ll16);
                    const bf16x8 a0f = *(const bf16x8*)(ldsg + WG_FRAG + ((1 * 4 + mt) * 2 + 0) * 1024 + ll16), a1f = *(const bf16x8*)(ldsg + WG_FRAG + ((1 * 4 + mt) * 2 + 1) * 1024 + ll16);
                    f32x4 z = {0.f, 0.f, 0.f, 0.f};
                    ow[mt] = MFMA16(w1f, tlf[1], MFMA16(w0f, tlf[0], z));
                    oa[mt] = MFMA16(a1f, laf[1], MFMA16(a0f, laf[0], z));
                }
            }
            f32x4 km[4]; f32x4 ss4 = {0.f, 0.f, 0.f, 0.f};
#pragma unroll
            for (int n = 0; n < 4; ++n) {
                km[n] = up4(cc.k[n]);
                const f32x4 kr = km[n] * *(const f32x4*)(ldsg + WG_CONST + (320 + 16 * n) * 4 + lq16);
                ss4 += kr * kr;
            }
            float ss = (ss4[0] + ss4[1]) + (ss4[2] + ss4[3]);
            ss += bperm(ss, lane ^ 16); ss += bperm(ss, lane ^ 32);
            const float kinv = 1.f / fmaxf(sqrtf(ss), 1e-12f);
            u32x2 kapP[4], ktP[4], btP[4], rtP[4]; f32x4 bon4 = {0.f, 0.f, 0.f, 0.f};
#pragma unroll
            for (int n = 0; n < 4; ++n) {
                const f32x4 w0v = *(const f32x4*)(ldsg + WG_CONST + (192 + 16 * n) * 4 + lq16), a0v = *(const f32x4*)(ldsg + WG_CONST + (256 + 16 * n) * 4 + lq16), kkw = *(const f32x4*)(ldsg + WG_CONST + (320 + 16 * n) * 4 + lq16), kav = *(const f32x4*)(ldsg + WG_CONST + (384 + 16 * n) * 4 + lq16);
                const f32x4 tw = w0v + ow[n], ta = a0v + oa[n];
                f32x4 ew, ea;
#pragma unroll
                for (int j = 0; j < 4; ++j) { ew[j] = __builtin_amdgcn_exp2f(tw[j]); ea[j] = __builtin_amdgcn_exp2f(ta[j]); }
                const f32x4 dw = ew + 1.f, da = ea + 1.f;
                f32x4 sw, av;
#pragma unroll
                for (int j = 0; j < 4; ++j) { sw[j] = __builtin_amdgcn_rcpf(dw[j]); av[j] = __builtin_amdgcn_rcpf(da[j]); }
                const f32x4 lw2 = sw * -0.87503877f;
                f32x4 L, Lm, gmv, emL;
#pragma unroll
                for (int j = 0; j < 4; ++j) {
                    float x = __builtin_amdgcn_exp2f(lw2[j]);
                    x *= dpp1<0x111>(x); x *= dpp1<0x112>(x); x *= dpp1<0x114>(x); x *= dpp1<0x118>(x);
                    L[j] = x; Lm[j] = dpp1<0x111>(x); gmv[j] = dpp0<0x121>(x);
                    emL[j] = __builtin_amdgcn_rcpf(x);
                }
                const f32x4 kk = km[n] * kkw * kinv;
                const f32x4 kd = km[n] * ((av - 1.f) * kav + 1.f);
                const f32x4 kap = kk * Lm, bt = kk * av * emL, kt = kd * emL;
                if (fr == 0) *(f32x4*)(ldsg + wo + 48 * IMG_STRIDE + 64 * n + lq16) = gmv;
                kapP[n] = (u32x2){cvtpk(kap[0], kap[1]), cvtpk(kap[2], kap[3])};
                ktP[n] = (u32x2){cvtpk(kt[0], kt[1]), cvtpk(kt[2], kt[3])};
                btP[n] = (u32x2){cvtpk(bt[0], bt[1]), cvtpk(bt[2], bt[3])};
                *(u32x2*)(ldsg + wo + 16 * IMG_STRIDE + 32 * n + limg) = ktP[n];
                *(u32x2*)(ldsg + wo + 32 * IMG_STRIDE + 32 * n + limg) = btP[n];
                if (PASS == 2) {
                    const f32x4 rm = up4(cc.r[n]), rk = *(const f32x4*)(ldsg + WG_CONST + (448 + 16 * n) * 4 + lq16);
                    const f32x4 rt = rm * L;
                    rtP[n] = (u32x2){cvtpk(rt[0], rt[1]), cvtpk(rt[2], rt[3])};
                    bon4 += rm * kd * rk;
                }
                *(u32x2*)(ldsg + wo + 32 * n + limg) = cc.v[n];
            }
            if (PASS == 2) {
                float bon = (bon4[0] + bon4[1]) + (bon4[2] + bon4[3]);
                bon += bperm(bon, lane ^ 16); bon += bperm(bon, lane ^ 32);
                if (q == 0) BON[((size_t)d * SLAB + row) * 16 + h] = 0.5f * bon;
            }
            const bf16x8 kapF0 = mkfrag(kapP[0].x, kapP[0].y, kapP[1].x, kapP[1].y), kapF1 = mkfrag(kapP[2].x, kapP[2].y, kapP[3].x, kapP[3].y);
            bf16x8 akkA, tA, aryA;
            {
                const bf16x8 ktF0 = mkfrag(ktP[0].x, ktP[0].y, ktP[1].x, ktP[1].y), ktF1 = mkfrag(ktP[2].x, ktP[2].y, ktP[3].x, ktP[3].y);
                const bf16x8 btF0 = mkfrag(btP[0].x, btP[0].y, btP[1].x, btP[1].y), btF1 = mkfrag(btP[2].x, btP[2].y, btP[3].x, btP[3].y);
                const f32x4 z = {0.f, 0.f, 0.f, 0.f};
                f32x4 akk = MFMA16(ktF1, kapF1, MFMA16(ktF0, kapF0, z));
                f32x4 nn = MFMA16(kapF1, btF1, MFMA16(kapF0, btF0, z));
                f32x4 na = MFMA16(btF1, kapF1, MFMA16(btF0, kapF0, z));
                f32x4 idv;
#pragma unroll
                for (int jj = 0; jj < 4; ++jj) {
                    akk[jj] = (4 * q + jj < fr) ? akk[jj] : 0.f; nn[jj] = (fr < 4 * q + jj) ? nn[jj] : 0.f; na[jj] = (4 * q + jj < fr) ? na[jj] : 0.f;
                    idv[jj] = (4 * q + jj == fr) ? 1.f : 0.f;
                }
                akkA = mkfrag(cvtpk(akk[0], akk[1]), cvtpk(akk[2], akk[3]), 0u, 0u);
                if (PASS == 2) {
                    const bf16x8 rtF0 = mkfrag(rtP[0].x, rtP[0].y, rtP[1].x, rtP[1].y), rtF1 = mkfrag(rtP[2].x, rtP[2].y, rtP[3].x, rtP[3].y);
                    f32x4 ark = MFMA16(ktF1, rtF1, MFMA16(ktF0, rtF0, z));
                    f32x4 arb = MFMA16(btF1, rtF1, MFMA16(btF0, rtF0, z));
#pragma unroll
                    for (int jj = 0; jj < 4; ++jj) { ark[jj] = (4 * q + jj <= fr) ? ark[jj] : 0.f; arb[jj] = (4 * q + jj <= fr) ? arb[jj] : 0.f; }
                    aryA = mkfrag(cvtpk(ark[0], ark[1]), cvtpk(ark[2], ark[3]), cvtpk(arb[0], arb[1]), cvtpk(arb[2], arb[3]));
                }
#define TF(x) mkfrag(cvtpk((x)[0], (x)[1]), cvtpk((x)[2], (x)[3]), 0u, 0u)
                const bf16x8 nF = TF(nn), aF = TF(na);
                const f32x4 n2 = MFMA16(aF, nF, z), a2 = MFMA16(nF, aF, z);
                const bf16x8 n2F = TF(n2), a2F = TF(a2);
                const f32x4 n4 = MFMA16(a2F, n2F, z), a4 = MFMA16(n2F, a2F, z);
                const bf16x8 n4F = TF(n4), a4F = TF(a4);
                const f32x4 n8 = MFMA16(a4F, n4F, z);
                const f32x4 t21 = MFMA16(n2F, aF, z);
                f32x4 R = idv - na + a2 - t21;
                R = MFMA16(n4F, TF(R), R);
                R = MFMA16(TF(n8), TF(R), R);
                tA = TF(R);
#undef TF
            }
            s16x4 Vc[4], Kc[4], Bc[4];
            {
                typedef s16x4 __attribute__((address_space(3)))* lp;
#pragma unroll
                for (int t4 = 0; t4 < 4; ++t4) {
                    Vc[t4] = __builtin_amdgcn_ds_read_tr16_b64_v4i16((lp)(ldsg + wo + ltr + 32 * t4));
                    Kc[t4] = __builtin_amdgcn_ds_read_tr16_b64_v4i16((lp)(ldsg + wo + 16 * IMG_STRIDE + ltr + 32 * t4));
                    Bc[t4] = __builtin_amdgcn_ds_read_tr16_b64_v4i16((lp)(ldsg + wo + 32 * IMG_STRIDE + ltr + 32 * t4));
                }
            }
            bf16x8 kbA[4];
#pragma unroll
            for (int mt = 0; mt < 4; ++mt) kbA[mt] = __builtin_shufflevector(Kc[mt], Bc[mt], 0, 1, 2, 3, 4, 5, 6, 7);
#pragma unroll
            for (int nt = 0; nt < 4; ++nt) {
                const f32x4 z = {0.f, 0.f, 0.f, 0.f};
                const bf16x8 stf0 = frag_f4(St[0][nt], St[1][nt]), stf1 = frag_f4(St[2][nt], St[3][nt]);
                const u32x2 vcu = __builtin_bit_cast(u32x2, Vc[nt]);
                f32x4 X = MFMA16(kapF1, stf1, MFMA16(kapF0, stf0, z));
                X = MFMA16(akkA, mkfrag(vcu.x, vcu.y, 0u, 0u), X);
                const f32x4 Uu = MFMA16(tA, mkfrag(cvtpk(X[0], X[1]), cvtpk(X[2], X[3]), 0u, 0u), z);
                const bf16x8 bvu = mkfrag(vcu.x, vcu.y, cvtpk(-Uu[0], -Uu[1]), cvtpk(-Uu[2], -Uu[3]));
                if (PASS == 2) {
                    const bf16x8 rtF0 = mkfrag(rtP[0].x, rtP[0].y, rtP[1].x, rtP[1].y), rtF1 = mkfrag(rtP[2].x, rtP[2].y, rtP[3].x, rtP[3].y);
                    f32x4 Y = MFMA16(rtF1, stf1, MFMA16(rtF0, stf0, z));
                    Y = MFMA16(aryA, bvu, Y);
#pragma unroll
                    for (int jj = 0; jj < 4; ++jj) {
                        const int i = 4 * q + jj, t2 = d ? T - 1 - (pos0 + i) : pos0 + i;
                        YS[((size_t)d * SLAB + b * T + t2) * DR + h * 64 + 16 * nt + fr] = (bf16_t)(cvtpk(Y[jj], 0.f) & 0xffffu);
                    }
                }
#pragma unroll
                for (int mt = 0; mt < 4; ++mt) St[mt][nt] = MFMA16(kbA[mt], bvu, St[mt][nt]) * *(const f32x4*)(ldsg + wo + 48 * IMG_STRIDE + 64 * mt + lq16);
            }
            if (PASS == 1) {
#pragma unroll
                for (int ct = 0; ct < 4; ++ct) {
                    const f32x4 z = {0.f, 0.f, 0.f, 0.f};
                    const bf16x8 pf0 = frag_f4(Pa[0][PASS == 1 ? ct : 0], Pa[PASS == 1 ? 1 : 0][PASS == 1 ? ct : 0]), pf1 = frag_f4(Pa[PASS == 1 ? 2 : 0][PASS == 1 ? ct : 0], Pa[PASS == 1 ? 3 : 0][PASS == 1 ? ct : 0]);
                    const f32x4 X = MFMA16(kapF1, pf1, MFMA16(kapF0, pf0, z));
                    const f32x4 Uu = MFMA16(tA, mkfrag(cvtpk(X[0], X[1]), cvtpk(X[2], X[3]), 0u, 0u), z);
                    const bf16x8 bvu = mkfrag(0u, 0u, cvtpk(-Uu[0], -Uu[1]), cvtpk(-Uu[2], -Uu[3]));
#pragma unroll
                    for (int mt = 0; mt < 4; ++mt) Pa[PASS == 1 ? mt : 0][PASS == 1 ? ct : 0] = MFMA16(kbA[mt], bvu, Pa[PASS == 1 ? mt : 0][PASS == 1 ? ct : 0]) * *(const f32x4*)(ldsg + wo + 48 * IMG_STRIDE + 64 * mt + lq16);
                }
            }
        }
        if (PASS == 1) {
            const int l2 = hw_tid(wid0) & 63, fr2 = l2 & 15, q2 = l2 >> 4;
            unsigned char* pqb = (unsigned char*)(PQ + (size_t)item * 8192);
            float* tl = (float*)(ldsg + wo);
#pragma unroll
            for (int mt = 0; mt < 4; ++mt)
#pragma unroll
                for (int ks = 0; ks < 2; ++ks) {
#pragma unroll
                    for (int e = 0; e < 2; ++e)
#pragma unroll
                        for (int j2 = 0; j2 < 4; ++j2) tl[e * 256 + (4 * q2 + j2) * 16 + fr2] = Pa[PASS == 1 ? mt : 0][PASS == 1 ? 2 * ks + e : 0][j2];
                    __builtin_amdgcn_wave_barrier();
                    const f32x4 pa = *(const f32x4*)(tl + fr2 * 16 + 4 * q2), pb = *(const f32x4*)(tl + 256 + fr2 * 16 + 4 * q2);
                    __builtin_amdgcn_wave_barrier();
                    bf16x8 ah, al; split_frag(pa, pb, ah, al);
                    *(bf16x8*)(pqb + (((mt * 2 + ks) * 2 + 0) * 64 + l2) * 16) = ah;
                }
            float* pq = PQ + (size_t)item * 8192 + 4096 + l2 * 4;
#pragma unroll
            for (int mt = 0; mt < 4; ++mt)
#pragma unroll
                for (int nt = 0; nt < 4; ++nt) *(f32x4*)(pq + (mt * 4 + nt) * 256) = St[mt][nt];
        }
    }
}

constexpr int CR_SLOTS = 10, CR_SLOT_BYTES = 12288, CR_FLAGS = CR_SLOTS * CR_SLOT_BYTES;
__device__ __forceinline__ void phase_combine_ring(KP p, int s, int wid0, unsigned char* ldsg) {
    KP_FRESH(p);
    int tid_ = hw_tid(wid0); asm volatile("" : "+v"(tid_));
    const int lane = tid_ & 63, wid = wid0;
    const int nseg = 64, nsteps = nseg - 1;
    const float* PQ = (const float*)(p->ws + WS_PQ); float* SST = (float*)(p->ws + WS_SST);
    volatile unsigned* flags = (volatile unsigned*)(ldsg + CR_FLAGS);
    __syncthreads();
    if (tid_ < CR_SLOTS) flags[tid_] = 0u;
    __syncthreads();
    if ((int)blockIdx.x >= 128) return;
    const int nt = blockIdx.x & 3, chain = blockIdx.x >> 2;
    if (wid != 0) {
        u32x4 ra[12], rb[12];
#define CR_ISSUE(r, gg) do { const unsigned char* b_ = (const unsigned char*)(PQ + ((size_t)chain * nseg + (gg)) * 8192); \
        _Pragma("unroll") for (int f = 0; f < 8; ++f) (r)[f] = *(const u32x4*)(b_ + ((f * 2 + 0) * 64 + lane) * 16); \
        _Pragma("unroll") for (int mt = 0; mt < 4; ++mt) (r)[8 + mt] = *(const u32x4*)(b_ + 16384 + ((mt * 4 + nt) * 64 + lane) * 16); } while (0)
#define CR_PUT(r, gg) do { const int slot_ = (gg) % CR_SLOTS; const unsigned gen_ = 2u * (unsigned)((gg) / CR_SLOTS); unsigned sp_ = 0;     \
        while (flags[slot_] != gen_ && ++sp_ < (1u << 20)) __builtin_amdgcn_s_sleep(1); \
        _Pragma("unroll") for (int f = 0; f < 12; ++f) *(u32x4*)(ldsg + slot_ * CR_SLOT_BYTES + f * 1024 + lane * 16) = (r)[f]; \
        asm volatile("s_waitcnt lgkmcnt(0)" ::: "memory"); __builtin_amdgcn_wave_barrier(); \
        if (lane == 0) flags[slot_] = gen_ + 1u; } while (0)
        int g = wid - 1;
        if (g < nsteps) CR_ISSUE(ra, g);
        for (; g < nsteps; g += 14) {
            if (g + 7 < nsteps) CR_ISSUE(rb, g + 7);
            CR_PUT(ra, g);
            if (g + 14 < nsteps) CR_ISSUE(ra, g + 14);
            if (g + 7 < nsteps) CR_PUT(rb, g + 7);
        }
#undef CR_ISSUE
#undef CR_PUT
    } else {
        f32x4 S[4];
#pragma unroll
        for (int mt = 0; mt < 4; ++mt) S[mt] = (f32x4){0.f, 0.f, 0.f, 0.f};
        for (int g = 0; g < nseg; ++g) {
            const size_t item = (size_t)chain * nseg + g;
#pragma unroll
            for (int mt = 0; mt < 4; ++mt) *(f32x4*)(SST + item * 4096 + ((mt * 4 + nt) * 64 + lane) * 4) = S[mt];
            if (g == nsteps) break;
            const int slot = g % CR_SLOTS; const unsigned gen = 2u * (unsigned)(g / CR_SLOTS); unsigned sp = 0;
            while (flags[slot] != gen + 1u && ++sp < (1u << 20)) __builtin_amdgcn_s_sleep(1);
            bf16x8 ah[4][2]; f32x4 qv[4];
#pragma unroll
            for (int mt = 0; mt < 4; ++mt) {
                qv[mt] = *(const f32x4*)(ldsg + slot * CR_SLOT_BYTES + (8 + mt) * 1024 + lane * 16);
#pragma unroll
                for (int ks = 0; ks < 2; ++ks) ah[mt][ks] = *(const bf16x8*)(ldsg + slot * CR_SLOT_BYTES + (mt * 2 + ks) * 1024 + lane * 16);
            }
            asm volatile("s_waitcnt lgkmcnt(0)" ::: "memory"); __builtin_amdgcn_wave_barrier();
            if (lane == 0) flags[slot] = gen + 2u;
            bf16x8 bh[2], bl[2];
            split_frag(S[0], S[1], bh[0], bl[0]); split_frag(S[2], S[3], bh[1], bl[1]);
#pragma unroll
            for (int mt = 0; mt < 4; ++mt) {
                f32x4 acc = qv[mt];
#pragma unroll
                for (int ks = 0; ks < 2; ++ks) { acc = MFMA16(ah[mt][ks], bh[ks], acc); acc = MFMA16(ah[mt][ks], bl[ks], acc); }
                S[mt] = acc;
            }
        }
    }
}

__device__ void phase_combine(KP p, int s, int wid0) {
    KP_FRESH(p);
    int tid_ = hw_tid(wid0); asm volatile("" : "+v"(tid_));
    const int lane = tid_ & 63, wid = tid_ >> 6, fr = lane & 15, q = lane >> 4;
    int tok0, nseq, T; slab_info(s, tok0, nseq, T);
    const int lgseg = (s == 0) ? 3 : 6, nseg = 1 << lgseg, nwork = nseq * 32 * 4;
    const float* PQ = (const float*)(p->ws + WS_PQ); float* SST = (float*)(p->ws + WS_SST);
    for (int wk = blockIdx.x * 8 + wid; wk < nwork; wk += gridDim.x * 8) {
        const int nt = wk & 3, chain = wk >> 2;
        f32x4 S[4];
#pragma unroll
        for (int mt = 0; mt < 4; ++mt) S[mt] = (f32x4){0.f, 0.f, 0.f, 0.f};
        struct CStep { bf16x8 ah[4][2]; f32x4 q[4]; };
#define CMB_LOAD(c, gg) do { const int g_ = (gg) < nseg - 1 ? (gg) : nseg - 2; const unsigned char* b_ = (const unsigned char*)(PQ + ((size_t)chain * nseg + g_) * 8192); \
        _Pragma("unroll") for (int mt = 0; mt < 4; ++mt) { (c).q[mt] = *(const f32x4*)(b_ + 16384 + ((mt * 4 + nt) * 64 + lane) * 16); \
            _Pragma("unroll") for (int ks = 0; ks < 2; ++ks) (c).ah[mt][ks] = *(const bf16x8*)(b_ + (((mt * 2 + ks) * 2 + 0) * 64 + lane) * 16); } } while (0)
        CStep c0, c1, c2;
        CMB_LOAD(c0, 0); CMB_LOAD(c1, 1); CMB_LOAD(c2, 2);
        for (int g = 0; g < nseg; ++g) {
            const size_t item = (size_t)chain * nseg + g;
#pragma unroll
            for (int mt = 0; mt < 4; ++mt) *(f32x4*)(SST + item * 4096 + ((mt * 4 + nt) * 64 + lane) * 4) = S[mt];
            if (g == nseg - 1) break;
            const CStep cc = c0; c0 = c1; c1 = c2;
            CMB_LOAD(c2, g + 3);
            bf16x8 bh[2], bl[2];
            split_frag(S[0], S[1], bh[0], bl[0]); split_frag(S[2], S[3], bh[1], bl[1]);
#pragma unroll
            for (int mt = 0; mt < 4; ++mt) {
                f32x4 acc = cc.q[mt];
#pragma unroll
                for (int ks = 0; ks < 2; ++ks) { acc = MFMA16(cc.ah[mt][ks], bh[ks], acc); acc = MFMA16(cc.ah[mt][ks], bl[ks], acc); }
                S[mt] = acc;
            }
        }
#undef CMB_LOAD
    }
}

DI void unpack8(u32x4 w, float (&f)[8]) { f[0] = lo16(w.x); f[1] = hi16(w.x); f[2] = lo16(w.y); f[3] = hi16(w.y); f[4] = lo16(w.z); f[5] = hi16(w.z); f[6] = lo16(w.w); f[7] = hi16(w.w); }
__device__ void phase_shift(KP p, int s, int wid0) {
    KP_FRESH(p);
    int tid_ = hw_tid(wid0); asm volatile("" : "+v"(tid_));
    int tok0, nseq, T; slab_info(s, tok0, nseq, T);
    const bf16_t* SB = (const bf16_t*)(p->ws + WS_TMP); bf16_t* U = (bf16_t*)(p->ws + WS_U);
    const float* mu = p->in[I_MU];
    const int gt = blockIdx.x * 512 + tid_, nt = gridDim.x * 512;
    for (int unit = gt; unit < 416 * 512; unit += nt) {
        const int cg0 = unit % 416, cg = cg0 < 384 ? cg0 : cg0 + 128, be = unit / 416, blk = be >> 1, e = be & 1, c0 = cg * 8;
        const int r = blk * 64 + (e ? 63 : 0), t = r & (T - 1);
        const bool tanh_cols = (c0 >= 4096) && (c0 < 4096 + 128);
        const bf16_t* sb = SB + (size_t)blk * 4 * 4352 + c0;
        float prev[8], cur[8], nxt[8], m[8];
        { const f32x4 a = *(const f32x4*)(mu + c0), b = *(const f32x4*)(mu + c0 + 4); m[0] = a[0]; m[1] = a[1]; m[2] = a[2]; m[3] = a[3]; m[4] = b[0]; m[5] = b[1]; m[6] = b[2]; m[7] = b[3]; }
        if (e == 0) {
            if (t > 0) unpack8(*(const u32x4*)(sb - 4352), prev); else { for (int k = 0; k < 8; ++k) prev[k] = 0.f; }
            unpack8(*(const u32x4*)sb, cur); unpack8(*(const u32x4*)(sb + 4352), nxt);
        } else {
            unpack8(*(const u32x4*)(sb + 2 * 4352), prev); unpack8(*(const u32x4*)(sb + 3 * 4352), cur);
            if (t < T - 1) unpack8(*(const u32x4*)(sb + 4 * 4352), nxt); else { for (int k = 0; k < 8; ++k) nxt[k] = 0.f; }
        }
        float o[8];
#pragma unroll
        for (int k = 0; k < 8; ++k) {
            float v = cur[k] + m[k] * (0.5f * (prev[k] + nxt[k]) - cur[k]);
            if (tanh_cols) v = 1.f - 2.f * __builtin_amdgcn_rcpf(1.f + __expf(2.f * v));
            o[k] = v;
        }
        *(u32x4*)(U + (size_t)r * UW + URW + c0) = (u32x4){cvtpk(o[0], o[1]), cvtpk(o[2], o[3]), cvtpk(o[4], o[5]), cvtpk(o[6], o[7])};
    }
}

__device__ void phase_post(KP p, int s, int wid0) {
    KP_FRESH(p);
    int tid_ = hw_tid(wid0); asm volatile("" : "+v"(tid_));
    const int lane = tid_ & 63, gw = blockIdx.x * 8 + (tid_ >> 6), nw = gridDim.x * 8;
    int tok0, nseq, T; slab_info(s, tok0, nseq, T);
    const bf16_t* U = (const bf16_t*)(p->ws + WS_U);
    const bf16_t* YS = (const bf16_t*)(p->ws + WS_YS); const float* BON = (const float*)(p->ws + WS_BON);
    bf16_t* ymix = (bf16_t*)(p->ws + WS_YMIX);
    for (int unit = gw; unit < (SLAB / 16) * 2; unit += nw) {
        const int half = unit & 1, r0 = (unit >> 1) * 16, c0 = half * 512 + lane * 8, h = c0 >> 6;
        float cw0[8], cw1[8], cw2[8], cbv[8], lg[8], lb[8];
        {
            const float* cw = p->in[I_CW]; const float* cb = p->in[I_CB]; const float* g = p->in[I_LXG]; const float* b = p->in[I_LXB];
#pragma unroll
            for (int e = 0; e < 8; ++e) { cw0[e] = cw[c0 + e]; cw1[e] = cw[1024 + c0 + e]; cw2[e] = cw[2048 + c0 + e]; cbv[e] = cb[c0 + e]; lg[e] = g[c0 + e]; lb[e] = b[c0 + e]; }
        }
        const int t0 = r0 & (T - 1);
        const bf16_t* up = U + (size_t)r0 * UW + c0;
        float pprev[8], pcur[8], pnxt[8], zprev[8], zcur[8], znxt[8], muz[8];
        if (t0 > 0) { unpack8(*(const u32x4*)(up - UW), pprev); unpack8(*(const u32x4*)(up - UW + URW + 3072), zprev); } else { for (int e = 0; e < 8; ++e) { pprev[e] = 0.f; zprev[e] = 0.f; } }
        unpack8(*(const u32x4*)up, pcur); unpack8(*(const u32x4*)(up + URW + 3072), zcur);
        { const float* mu = p->in[I_MU];
#pragma unroll
          for (int e = 0; e < 8; ++e) muz[e] = mu[3072 + c0 + e]; }
        for (int ib = 0; ib < 16; ib += 4) {
            u32x4 rp[4], rg[4], rv[4], rz[4], ry0[4], ry1[4]; float bonv[4];
#pragma unroll
            for (int r = 0; r < 4; ++r) {
                const int i = ib + r, row = r0 + i;
                const bf16_t* ur = up + (size_t)i * UW;
                rp[r] = (t0 + i < T - 1) ? *(const u32x4*)(ur + UW) : (u32x4){0u, 0u, 0u, 0u};
                rz[r] = (t0 + i < T - 1) ? *(const u32x4*)(ur + UW + URW + 3072) : (u32x4){0u, 0u, 0u, 0u};
                rg[r] = *(const u32x4*)(ur + 1024); rv[r] = *(const u32x4*)(ur + URW + 2048);
                ry0[r] = *(const u32x4*)(YS + (size_t)row * DR + c0); ry1[r] = *(const u32x4*)(YS + ((size_t)SLAB + row) * DR + c0);
                bonv[r] = BON[(size_t)row * 16 + h] + BON[((size_t)SLAB + row) * 16 + h];
            }
#pragma unroll
            for (int r = 0; r < 4; ++r) {
                const int row = r0 + ib + r;
                float gg[8], vv[8], zz[8], y[8], y1[8];
                unpack8(rp[r], pnxt); unpack8(rg[r], gg); unpack8(rv[r], vv); unpack8(rz[r], znxt); unpack8(ry0[r], y); unpack8(ry1[r], y1);
#pragma unroll
                for (int e = 0; e < 8; ++e) { zz[e] = zcur[e] + muz[e] * (0.5f * (zprev[e] + znxt[e]) - zcur[e]); zprev[e] = zcur[e]; zcur[e] = znxt[e]; }
                const float bon = bonv[r];
#pragma unroll
                for (int e = 0; e < 8; ++e) y[e] += y1[e];
                float sum = 0.f;
#pragma unroll
                for (int e = 0; e < 8; ++e) sum += y[e];
                sum += shx(sum, lane, 1); sum += shx(sum, lane, 2); sum += shx(sum, lane, 4);
                const float mean = sum * (1.f / 64.f);
                float sq = 0.f;
#pragma unroll
                for (int e = 0; e < 8; ++e) { const float dl = y[e] - mean; sq += dl * dl; }
                sq += shx(sq, lane, 1); sq += shx(sq, lane, 2); sq += shx(sq, lane, 4);
                const float rstd = rsqrtf(sq * (1.f / 64.f) + 64e-5f);
                float oc[8], orw[8];
#pragma unroll
                for (int e = 0; e < 8; ++e) {
                    oc[e] = gg[e] * (cw0[e] * pprev[e] + cw1[e] * pcur[e] + cw2[e] * pnxt[e] + cbv[e]);
                    orw[e] = ((y[e] - mean) * rstd * lg[e] + lb[e] + bon * vv[e]) * (zz[e] * fsig(zz[e]));
                    pprev[e] = pcur[e]; pcur[e] = pnxt[e];
                }
                *(u32x4*)(ymix + (size_t)row * 2048 + c0) = (u32x4){cvtpk(oc[0], oc[1]), cvtpk(oc[2], oc[3]), cvtpk(oc[4], oc[5]), cvtpk(oc[6], oc[7])};
                *(u32x4*)(ymix + (size_t)row * 2048 + 1024 + c0) = (u32x4){cvtpk(orw[0], orw[1]), cvtpk(orw[2], orw[3]), cvtpk(orw[4], orw[5]), cvtpk(orw[6], orw[7])};
            }
        }
    }
}

__device__ void phase_lnout(KP p, int s, int wid0) {
    KP_FRESH(p);
    int tid_ = hw_tid(wid0); asm volatile("" : "+v"(tid_)); int lane = tid_ & 63; const int gw = blockIdx.x * 8 + (tid_ >> 6), nw = gridDim.x * 8;
    float* out = p->out + (size_t)s * SLAB * D;
    const float4* g4 = (const float4*)p->in[I_LG]; const float4* b4 = (const float4*)p->in[I_LB];
    for (int r0 = gw; r0 < SLAB; r0 += 4 * nw) {
        asm volatile("" : "+v"(lane));
        float4 v[4][4];
#pragma unroll
        for (int k = 0; k < 4; ++k)
#pragma unroll
            for (int i = 0; i < 4; ++i) v[k][i] = ((const float4*)(out + (size_t)(r0 + k * nw) * D))[lane + 64 * i];
#pragma unroll
        for (int k = 0; k < 4; ++k) {
            float4* xp = (float4*)(out + (size_t)(r0 + k * nw) * D);
            float sum = 0.f;
#pragma unroll
            for (int i = 0; i < 4; ++i) sum += v[k][i].x + v[k][i].y + v[k][i].z + v[k][i].w;
            const float mean = wsum(sum, lane) * (1.f / 1024.f);
            float sq = 0.f;
#pragma unroll
            for (int i = 0; i < 4; ++i) { float a = v[k][i].x - mean, b = v[k][i].y - mean, c = v[k][i].z - mean, d = v[k][i].w - mean; sq += a * a + b * b + c * c + d * d; }
            const float rstd = rsqrtf(wsum(sq, lane) * (1.f / 1024.f) + 1e-5f);
#pragma unroll
            for (int i = 0; i < 4; ++i) {
                const float4 g = g4[lane + 64 * i], b = b4[lane + 64 * i];
                float4 o; o.x = (v[k][i].x - mean) * rstd * g.x + b.x; o.y = (v[k][i].y - mean) * rstd * g.y + b.y; o.z = (v[k][i].z - mean) * rstd * g.z + b.z; o.w = (v[k][i].w - mean) * rstd * g.w + b.w;
                xp[lane + 64 * i] = o;
            }
        }
    }
}

#define LAS __attribute__((address_space(3)))
#define XB_TMO      128
#define XB_XCNT(j)  (256  + 64 * (j))
#define XB_XSUB(j)  (1280 + 64 * (j))
#define XB_XGEN(j)  (2304 + 64 * (j))
#define XB_TOP      3328
#define XB_TOPGEN   3392
#define XCD_BAR_WORDS 3456
#define XB_SPIN_CAP (1u << 18)

__device__ __forceinline__ unsigned xb_ld(unsigned* p)              { return __hip_atomic_load(p, __ATOMIC_RELAXED, __HIP_MEMORY_SCOPE_AGENT); }
__device__ __forceinline__ unsigned xb_add(unsigned* p, unsigned v) { return __hip_atomic_fetch_add(p, v, __ATOMIC_RELAXED, __HIP_MEMORY_SCOPE_AGENT); }
__device__ __forceinline__ unsigned xb_xcc_id() { return (unsigned)__builtin_amdgcn_s_getreg((3 << 11) | 20) & 0xFu; }
#define XB_SPIN(cond, bar) do { unsigned _sp = 0; while (cond) { __builtin_amdgcn_s_sleep(1); \
    if ((++_sp & 255u) == 0u) { if (xb_ld(&(bar)[XB_TMO])) break; if (_sp > XB_SPIN_CAP) { atomicAdd(&(bar)[XB_TMO], 1u); break; } } } } while (0)

struct XcdBarrier {
    unsigned* bar; unsigned x;
    volatile LAS unsigned* st;
};

__device__ __forceinline__ XcdBarrier xcd_barrier_post(unsigned* bar, volatile LAS unsigned* st) {
    XcdBarrier b; b.bar = bar; b.x = xb_xcc_id(); b.st = st;
    if (threadIdx.x == 0) (void)xb_add(&bar[XB_XCNT(b.x)], 1u);
    return b;
}
__device__ __forceinline__ void xcd_barrier_complete(unsigned* bar, unsigned x, unsigned& nloc, unsigned& nx) {
    const unsigned G = gridDim.x * gridDim.y * gridDim.z;
    unsigned sum, cnt, mine, sp = 0u;
    for (;;) {
        sum = 0u; cnt = 0u; mine = 0u;
#pragma unroll
        for (unsigned j = 0; j < 16; ++j) { const unsigned c = xb_ld(&bar[XB_XCNT(j)]); sum += c; cnt += (c > 0u) ? 1u : 0u; mine = (j == x) ? c : mine; }
        if (sum == G) break;
        __builtin_amdgcn_s_sleep(1);
        if ((++sp & 255u) == 0u) { if (xb_ld(&bar[XB_TMO])) break; if (sp > XB_SPIN_CAP) { atomicAdd(&bar[XB_TMO], 1u); break; } }
    }
    nloc = mine > 0u ? mine : 1u; nx = cnt > 0u ? cnt : 1u;
}

__device__ __forceinline__ void xcd_barrier(const XcdBarrier& b) {
    asm volatile("s_waitcnt vmcnt(0)" ::: "memory");
    __syncthreads();
    if (threadIdx.x == 0) {
        unsigned* bar = b.bar;
        __builtin_amdgcn_s_waitcnt(0);
        unsigned nloc = b.st[0], nx = b.st[1];
        if (nloc == 0u) { xcd_barrier_complete(bar, b.x, nloc, nx); b.st[0] = nloc; b.st[1] = nx; }
        const unsigned old = xb_add(&bar[XB_XSUB(b.x)], 1u);
        const unsigned gen = old / nloc;
        if (old + 1u == (gen + 1u) * nloc) {
            __builtin_amdgcn_fence(__ATOMIC_RELEASE, "agent");
            asm volatile("s_waitcnt vmcnt(0)" ::: "memory");
            const unsigned og = xb_add(&bar[XB_TOP], 1u);
            const unsigned tg = og / nx;
            if (og + 1u == (tg + 1u) * nx) xb_add(&bar[XB_TOPGEN], 1u);
            else XB_SPIN(xb_ld(&bar[XB_TOPGEN]) == tg, bar);
            __builtin_amdgcn_fence(__ATOMIC_ACQUIRE, "agent");
            xb_add(&bar[XB_XGEN(b.x)], 1u);
            asm volatile("s_waitcnt vmcnt(0)" ::: "memory");
        } else {
            XB_SPIN(xb_ld(&bar[XB_XGEN(b.x)]) == gen, bar);
            __builtin_amdgcn_fence(__ATOMIC_ACQUIRE, "agent");
            asm volatile("s_waitcnt vmcnt(0)" ::: "memory");
        }
    }
    __syncthreads();
}

#ifndef REP_SHIFT
#define REP_SHIFT 1
#endif
#ifndef REP_G2
#define REP_G2 1
#endif
#ifndef REP_SCAN
#define REP_SCAN 1
#endif
#ifndef REP_POST
#define REP_POST 1
#endif
#ifndef REP_G1
#define REP_G1 1
#endif
#define GBAR() xcd_barrier(bar)
__global__ void __launch_bounds__(512, 2) fwd_megakernel(Params p_unused) {
    extern __shared__ __attribute__((aligned(16))) unsigned char lds_raw[];
    PG8_LAS unsigned char* lds = (PG8_LAS unsigned char*)lds_raw;
    cg::grid_group grid = cg::this_grid();
    KP p = (KP)__builtin_amdgcn_kernarg_segment_ptr();
    if (threadIdx.x < 2) ((volatile LAS unsigned*)(lds + LDS_BYTES - 64))[threadIdx.x] = 0u;
    __syncthreads();
    {
        unsigned* bw = (unsigned*)(((const Params __attribute__((address_space(4)))*)__builtin_amdgcn_kernarg_segment_ptr())->ws + WS_BAR);
        if (blockIdx.x == 0) { for (int w = threadIdx.x; w < XCD_BAR_WORDS; w += 512) __hip_atomic_store(bw + w, 0u, __ATOMIC_RELAXED, __HIP_MEMORY_SCOPE_AGENT); __threadfence(); }
        grid.sync();
    }
    XcdBarrier bar = xcd_barrier_post((unsigned*)(((const Params __attribute__((address_space(4)))*)__builtin_amdgcn_kernarg_segment_ptr())->ws + WS_BAR), (volatile LAS unsigned*)(lds + LDS_BYTES - 64));
    const int wid0 = __builtin_amdgcn_readfirstlane((int)threadIdx.x >> 6);
    phase_weights(p, wid0);
    for (int s = -1; s < 3; ++s) {
        if (s == 0) GBAR();
        if (s >= 0)
        for (int rep = 0; rep < REP_G1; ++rep) {
            if (rep) GBAR();
            KP_FRESH(p);
            pg8::Gemm g; g.A = xn_buf(p, s); g.Bt = (const bf16_t*)(p->ws + WS_WIN); g.M = SLAB; g.N = NIN; g.K = D;
            pg8::StaticOrder S; S.init(g.M, g.N, gridDim.x, blockIdx.x);
            EpiU E; E.U = (bf16_t*)(p->ws + WS_U); E.TMP = (bf16_t*)(p->ws + WS_TMP); E.mu = p->in[I_MU];
            pg8::gemm_phase<EpiU, pg8::StaticOrder, true, true>(lds, g, S, E, wid0);
        }
        {
            const int wg0 = (s >= 0 && gridDim.x > 64) ? 64 : 0;
            if (s < 2 && (int)blockIdx.x >= wg0) phase_ln(p, s + 1, wid0, wg0);
        }
        if (s < 0) continue;
        GBAR();
        for (int rep = 0; rep < REP_SHIFT; ++rep) {
        phase_shift(p, s, wid0);
        GBAR();
        }
        for (int rep = 0; rep < REP_SCAN; ++rep) {
        phase_scan<1>(p, s, lds_raw, wid0);
        GBAR();
        if (s > 0 && gridDim.x >= 128) phase_combine_ring(p, s, wid0, lds_raw); else phase_combine(p, s, wid0);
        GBAR();
        phase_scan<2>(p, s, lds_raw, wid0);
        GBAR();
        }
        for (int rep = 0; rep < REP_POST; ++rep) {
        phase_post(p, s, wid0);
        GBAR();
        }
        for (int rep = 0; rep < REP_G2; ++rep) {
            if (rep) GBAR();
            KP_FRESH(p);
            pg8::Gemm g; g.A = (const bf16_t*)(p->ws + WS_YMIX); g.Bt = (const bf16_t*)(p->ws + WS_WOUT); g.M = SLAB; g.N = D; g.K = 2048;
            pg8::StaticOrder S; S.init(g.M, g.N, gridDim.x, blockIdx.x);
            EpiOut E; E.out = p->out + (size_t)s * SLAB * D; E.x = slab_x(p, s); E.stats = (const float*)(p->ws + WS_STATS) + (size_t)s * SLAB * 2; E.eg = p->in[I_EG]; E.eb = p->in[I_EB];
            pg8::gemm_phase<EpiOut, pg8::StaticOrder, true, true>(lds, g, S, E, wid0);
        }
        GBAR();
        phase_lnout(p, s, wid0);
    }
}

extern "C" void kernel_launch(void* const* d_in, const int* in_sizes, int n_in, void* d_out, int out_size, void* d_ws, size_t ws_size, hipStream_t stream) {
    static int grid_blocks = 0;
    if (!grid_blocks) {
        int dev = 0, cus = 0, per_cu = 0;
        hipGetDevice(&dev);
        hipDeviceGetAttribute(&cus, hipDeviceAttributeMultiprocessorCount, dev);
        hipFuncSetAttribute((const void*)fwd_megakernel, hipFuncAttributeMaxDynamicSharedMemorySize, LDS_BYTES);
        hipOccupancyMaxActiveBlocksPerMultiprocessor(&per_cu, (const void*)fwd_megakernel, 512, LDS_BYTES);
        if (per_cu < 1) per_cu = 1;
        if (per_cu > 1) per_cu = 1;
        grid_blocks = cus * per_cu;
    }
    Params p{};
    for (int i = 0; i < 20; ++i) p.in[i] = (const float*)d_in[i];
    p.out = (float*)d_out; p.ws = (unsigned char*)d_ws;
    void* args[] = {&p};
    hipError_t e = hipLaunchCooperativeKernel((const void*)fwd_megakernel, dim3(grid_blocks), dim3(512), args, LDS_BYTES, stream);
    if (e != hipSuccess) fprintf(stderr, "cooperative launch failed: %s (grid %d)\n", hipGetErrorString(e), grid_blocks);
}
```

```cpp
#include <hip/hip_runtime.h>
#include <hip/hip_cooperative_groups.h>
#include <cstdio>
#include <cstdint>
namespace cg = cooperative_groups;
namespace pg8 {
#define PG8_LAS __attribute__((address_space(3)))
typedef unsigned short bf16_t;
typedef short bf16x8 __attribute__((ext_vector_type(8)));
typedef float f32x4 __attribute__((ext_vector_type(4)));
typedef unsigned u32x4 __attribute__((ext_vector_type(4)));
constexpr int BM = 256, BK = 64, HALF = 128, HTB = HALF * BK * 2  , STAGE_BYTES = 8 * HTB, NXCD = 8, WGM = 4;

__host__ __device__ __forceinline__ int lds_byte(int r, int c) { const int st = (r >> 4) * 2 + (c >> 5), rr = r & 15, cc = c & 31, ob = rr * 64 + cc * 2; return st * 1024 + (ob ^ (((ob >> 9) & 1) << 5)); }
__host__ __device__ __forceinline__ void stage_rc(int b, int& R, int& C) { const int st = b / 1024, sb = b % 1024, swz = sb ^ (((sb >> 9) & 1) << 5); R = (st >> 1) * 16 + swz / 64; C = (st & 1) * 32 + (swz % 64) / 2; }
__host__ __device__ __forceinline__ int perm32(int rho) { const int n = rho >> 4, i = rho & 15; return 8 * (i >> 2) + 4 * n + (i & 3); }

struct Unit { int pm, pn; };
struct Gemm { const bf16_t* A; const bf16_t* Bt; int M, N, K; };

struct StaticOrder {
    int nM, nN, nwg, G, c;
    __host__ __device__ void init(int M, int N, int G_, int c_) { nM = M / BM; nN = N / BM; nwg = nM * nN; G = G_; c = c_; }
    __host__ __device__ bool next(int i, Unit& u) const {
        const long L = (long)i * G + c; if (L >= nwg) return false;
        int wgid = (int)L; { const int q = nwg / NXCD, r = nwg % NXCD, xcd = wgid % NXCD, off = wgid / NXCD; wgid = (xcd < r ? xcd * (q + 1) : r * (q + 1) + (xcd - r) * q) + off; }
        const int nig = WGM * nN, gid = wgid / nig, fm = gid * WGM, gsz = (nM - fm) < WGM ? (nM - fm) : WGM;
        u.pm = fm + ((wgid % nig) % gsz); u.pn = (wgid % nig) / gsz; return true;
    }
    __device__ __forceinline__ void a_ready(const Unit&) const {}
    __device__ __forceinline__ void done(const Unit&) const {}
};

template <class Epi, class Sched, bool ALIGN_EPI = false, bool SP2 = false>
__device__ __forceinline__ void gemm_phase(PG8_LAS unsigned char* lds, const Gemm g, const Sched& S, const Epi& E, int wid0) {
    int tid_; asm volatile("v_mbcnt_lo_u32_b32 %0, -1, 0\n\tv_mbcnt_hi_u32_b32 %0, -1, %0" : "=v"(tid_)); tid_ += wid0 * 64; const int tid = tid_, wid = __builtin_amdgcn_readfirstlane(tid >> 6), lane = tid & 63, wr = wid >> 2, wc = wid & 3, fr = lane & 15, fq = lane >> 4;
    const int K = g.K, nt = K / BK;
    unsigned voffA[2], voffB[2];
#pragma unroll
    for (int i = 0; i < 2; ++i) { int R, C; stage_rc(tid * 16 + i * 8192, R, C); const int Rb = Epi::PERM ? ((R & ~31) + perm32(R & 31)) : R;
        voffA[i] = (unsigned)(R * K + C) * 2u; voffB[i] = (unsigned)(Rb * K + C) * 2u; }
    const size_t kstep = (size_t)(BK * 2);
    const size_t hstep = (size_t)HALF * K * 2;
    const size_t tstep = 2 * hstep;
    const unsigned ldsw = (unsigned)wid * 1024u;
    const int aoff = lds_byte(wr * 64 + fr, fq * 8), boff = lds_byte(wc * 32 + fr, fq * 8);
#define PG8_SA(b, h) (((b) * 2 + (h)) * HTB)
#define PG8_SB(b, h) ((4 + (b) * 2 + (h)) * HTB)
#define PG8_STAGE(bufoff, gbase, voff) do { _Pragma("unroll") for (int _i = 0; _i < 2; ++_i) \
        __builtin_amdgcn_global_load_lds((const unsigned*)((const char*)(gbase) + (voff)[_i]), (PG8_LAS unsigned*)(lds + (bufoff) + ldsw + _i * 8192), 16, 0, 0); } while (0)
#define PG8_LDA(dst, b, h) do { _Pragma("unroll") for (int m = 0; m < 4; ++m) _Pragma("unroll") for (int k = 0; k < 2; ++k) dst[m][k] = *(const PG8_LAS bf16x8*)(lds + PG8_SA(b, h) + aoff + m * 2048 + k * 1024); } while (0)
#define PG8_LDB(dst, b, h) do { _Pragma("unroll") for (int n = 0; n < 2; ++n) _Pragma("unroll") for (int k = 0; k < 2; ++k) dst[n][k] = *(const PG8_LAS bf16x8*)(lds + PG8_SB(b, h) + boff + n * 2048 + k * 1024); } while (0)
#define PG8_MMA(ai, bj, At, Bt) do { __builtin_amdgcn_s_setprio(1); _Pragma("unroll") for (int m = 0; m < 4; ++m) _Pragma("unroll") for (int n = 0; n < 2; ++n) _Pragma("unroll") for (int k = 0; k < 2; ++k) \
        acc[ai][bj][m][n] = __builtin_amdgcn_mfma_f32_16x16x32_bf16(Bt[n][k], At[m][k], acc[ai][bj][m][n], 0, 0, 0); __builtin_amdgcn_s_setprio(0); } while (0)
#define PG8_WAIT_V(n) asm volatile("s_waitcnt vmcnt(" #n ")" ::: "memory")
#define PG8_WAIT_L(n) asm volatile("s_waitcnt lgkmcnt(" #n ")" ::: "memory")
#define PG8_BAR __builtin_amdgcn_s_barrier()
#define PG8_SCHED __builtin_amdgcn_sched_barrier(0)
    Unit cur, nxt; int ui = 0;
    if (!S.next(0, cur)) return;
    f32x4 acc[2][2][4][2];
#pragma unroll
    for (int a = 0; a < 2; ++a)
#pragma unroll
        for (int b = 0; b < 2; ++b)
#pragma unroll
            for (int m = 0; m < 4; ++m)
#pragma unroll
                for (int n = 0; n < 2; ++n) acc[a][b][m][n] = (f32x4){0.f, 0.f, 0.f, 0.f};
    bf16x8 At[4][2], B0[2][2], B1[2][2];
    const char* cA = (const char*)g.A + (size_t)cur.pm * tstep; const char* cB = (const char*)g.Bt + (size_t)cur.pn * tstep;
    S.a_ready(cur);
    if constexpr (SP2) {
        PG8_STAGE(PG8_SB(0, 0), cB, voffB); PG8_STAGE(PG8_SB(0, 1), cB + hstep, voffB); PG8_STAGE(PG8_SA(0, 0), cA, voffA); PG8_STAGE(PG8_SA(0, 1), cA + hstep, voffA);
        if (wr == 1) PG8_BAR;
        PG8_WAIT_V(2); PG8_BAR;
        PG8_STAGE(PG8_SB(1, 0), cB + kstep, voffB); PG8_STAGE(PG8_SA(1, 0), cA + kstep, voffA); PG8_STAGE(PG8_SB(1, 1), cB + hstep + kstep, voffB);
        PG8_WAIT_V(6); PG8_BAR;
    } else {
        PG8_STAGE(PG8_SB(0, 0), cB, voffB); PG8_STAGE(PG8_SA(0, 0), cA, voffA); PG8_STAGE(PG8_SB(0, 1), cB + hstep, voffB); PG8_STAGE(PG8_SA(0, 1), cA + hstep, voffA);
        if (wr == 1) PG8_BAR;
        PG8_WAIT_V(4); PG8_BAR;
        PG8_STAGE(PG8_SB(1, 0), cB + kstep, voffB); PG8_STAGE(PG8_SA(1, 0), cA + kstep, voffA); PG8_STAGE(PG8_SB(1, 1), cB + hstep + kstep, voffB);
        PG8_WAIT_V(6); PG8_BAR;
    }
    for (;;) {
        const bool has_next = S.next(ui + 1, nxt);
        const char* nA = has_next ? (const char*)g.A + (size_t)nxt.pm * tstep : cA; const char* nB = has_next ? (const char*)g.Bt + (size_t)nxt.pn * tstep : cB;
        for (int t = 0; t < nt; t += 2) {
            const bool last = (t == nt - 2);
            const char* a1 = cA + (size_t)(t + 1) * kstep;
            const char* a2 = last ? nA : cA + (size_t)(t + 2) * kstep; const char* b2 = last ? nB : cB + (size_t)(t + 2) * kstep;
            const char* a3 = a2 + kstep; const char* b3 = b2 + kstep;
            if (last && has_next) S.a_ready(nxt);
            if constexpr (SP2) {
            PG8_LDB(B0, 0, 0); PG8_LDB(B1, 0, 1); PG8_SCHED; PG8_LDA(At, 0, 0); PG8_STAGE(PG8_SA(1, 1), a1 + hstep, voffA);
            PG8_WAIT_V(8); PG8_WAIT_L(0); PG8_BAR; PG8_MMA(0, 0, At, B0); PG8_MMA(0, 1, At, B1); PG8_BAR; PG8_SCHED;
            PG8_LDA(At, 0, 1); PG8_STAGE(PG8_SB(0, 0), b2, voffB); PG8_STAGE(PG8_SB(0, 1), b2 + hstep, voffB); PG8_STAGE(PG8_SA(0, 0), a2, voffA);
            PG8_WAIT_V(8); PG8_WAIT_L(0); PG8_BAR; PG8_MMA(1, 0, At, B0); PG8_MMA(1, 1, At, B1); PG8_BAR; PG8_SCHED;
            PG8_LDB(B0, 1, 0); PG8_LDB(B1, 1, 1); PG8_SCHED; PG8_LDA(At, 1, 0); PG8_STAGE(PG8_SA(0, 1), a2 + hstep, voffA);
            PG8_WAIT_V(8); PG8_WAIT_L(0); PG8_BAR; PG8_MMA(0, 0, At, B0); PG8_MMA(0, 1, At, B1); PG8_BAR; PG8_SCHED;
            PG8_LDA(At, 1, 1); PG8_STAGE(PG8_SB(1, 0), b3, voffB); PG8_STAGE(PG8_SB(1, 1), b3 + hstep, voffB); PG8_STAGE(PG8_SA(1, 0), a3, voffA);
            PG8_WAIT_V(8); PG8_WAIT_L(0); PG8_BAR; PG8_MMA(1, 0, At, B0); PG8_MMA(1, 1, At, B1); PG8_BAR; PG8_SCHED;
            } else {
            PG8_LDB(B0, 0, 0); PG8_SCHED; PG8_LDA(At, 0, 0); PG8_STAGE(PG8_SA(1, 1), a1 + hstep, voffA);
            PG8_WAIT_L(8); PG8_BAR; PG8_WAIT_L(0); PG8_MMA(0, 0, At, B0); PG8_BAR; PG8_SCHED;
            PG8_LDB(B1, 0, 1); PG8_STAGE(PG8_SB(0, 0), b2, voffB);
            PG8_BAR; PG8_WAIT_L(0); PG8_MMA(0, 1, At, B1); PG8_BAR;
            PG8_LDA(At, 0, 1); PG8_STAGE(PG8_SA(0, 0), a2, voffA);
            PG8_BAR; PG8_WAIT_L(0); PG8_MMA(1, 0, At, B0); PG8_BAR; PG8_SCHED;
            PG8_STAGE(PG8_SB(0, 1), b2 + hstep, voffB);
            PG8_WAIT_V(6); PG8_BAR; PG8_MMA(1, 1, At, B1); PG8_BAR;
            PG8_LDB(B0, 1, 0); PG8_SCHED; PG8_LDA(At, 1, 0); PG8_STAGE(PG8_SA(0, 1), a2 + hstep, voffA);
            PG8_WAIT_L(8); PG8_BAR; PG8_WAIT_L(0); PG8_MMA(0, 0, At, B0); PG8_BAR; PG8_SCHED;
            PG8_LDB(B1, 1, 1); PG8_STAGE(PG8_SB(1, 0), b3, voffB);
            PG8_BAR; PG8_WAIT_L(0); PG8_MMA(0, 1, At, B1); PG8_BAR;
            PG8_LDA(At, 1, 1); PG8_STAGE(PG8_SA(1, 0), a3, voffA);
            PG8_BAR; PG8_WAIT_L(0); PG8_MMA(1, 0, At, B0); PG8_BAR; PG8_SCHED;
            PG8_STAGE(PG8_SB(1, 1), b3 + hstep, voffB);
            PG8_WAIT_V(6); PG8_BAR; PG8_MMA(1, 1, At, B1); PG8_BAR;
            }
        }
        if constexpr (ALIGN_EPI) { if (wr == 0) PG8_BAR; }
        if constexpr (!Epi::AFTER_DRAIN) { E(acc, cur, wr, wc, fr, fq); S.done(cur); }
        if (!has_next) break;
#pragma unroll
        for (int a = 0; a < 2; ++a)
#pragma unroll
            for (int b = 0; b < 2; ++b)
#pragma unroll
                for (int m = 0; m < 4; ++m)
#pragma unroll
                    for (int n = 0; n < 2; ++n) acc[a][b][m][n] = (f32x4){0.f, 0.f, 0.f, 0.f};
        cur = nxt; cA = nA; cB = nB; ++ui;
        if constexpr (ALIGN_EPI) { if (wr == 1) PG8_BAR; }
    }
    PG8_WAIT_V(0);
    if constexpr (!ALIGN_EPI) { if (wr == 0) PG8_BAR; }
    PG8_BAR;
    if constexpr (Epi::AFTER_DRAIN) { E.fused(acc, cur, wr, wc, fr, fq, lds, wid, lane); S.done(cur); }
#undef PG8_SA
#undef PG8_SB
#undef PG8_STAGE
#undef PG8_LDA
#undef PG8_LDB
#undef PG8_MMA
#undef PG8_WAIT_V
#undef PG8_WAIT_L
#undef PG8_BAR
#undef PG8_SCHED
}
}

typedef unsigned short bf16_t;
typedef float f32x4 __attribute__((ext_vector_type(4)));
typedef unsigned u32x4 __attribute__((ext_vector_type(4)));
typedef unsigned u32x2 __attribute__((ext_vector_type(2)));

constexpr int D = 1024, NIN = 8448, DR = 1024, UW = 6400  , URW = 2048  ;
constexpr int SLAB = 16384, NTOK = 49152;
constexpr float DN_ALPHA = 1.189207115002721f;
constexpr size_t WS_WIN = 0;
constexpr size_t WS_WOUT = WS_WIN + (size_t)NIN * D * 2;
constexpr size_t WS_STATS = WS_WOUT + (size_t)D * 2048 * 2;
constexpr size_t WS_XN = WS_STATS + (size_t)NTOK * 2 * 4;
constexpr size_t WS_U = WS_XN + (size_t)SLAB * D * 2;
constexpr size_t WS_YS = WS_U + (size_t)SLAB * UW * 2;
constexpr size_t WS_BON = WS_YS + (size_t)2 * SLAB * DR * 4;
constexpr size_t WS_YMIX = WS_YS + (size_t)2 * SLAB * DR * 2;
constexpr size_t WS_SB2 = WS_YS + (size_t)16 * 1024 * 1024;
constexpr size_t WS_TMP = WS_YS;
constexpr size_t WS_PQ = WS_BON + (size_t)2 * SLAB * 16 * 4;
constexpr size_t WS_SST = WS_PQ + (size_t)2048 * 8192 * 4;
constexpr size_t WS_BAR = WS_SST + (size_t)2048 * 4096 * 4;
constexpr size_t WS_END = WS_BAR + 16384;
static_assert(WS_END <= (size_t)512 * 1024 * 1024, "ws map");
constexpr int LDS_BYTES = 147456;

struct Params { const float* in[20]; float* out; unsigned char* ws; };
typedef const Params __attribute__((address_space(4)))* KP;
#define KP_FRESH(p) asm volatile("" : "+s"(p))
__device__ __forceinline__ int hw_tid(int wid0) { int l; asm volatile("v_mbcnt_lo_u32_b32 %0, -1, 0\n\tv_mbcnt_hi_u32_b32 %0, -1, %0" : "=v"(l)); return wid0 * 64 + l; }
enum { I_XP = 0, I_XS, I_EG, I_EB, I_WIN, I_CW, I_CB, I_MU, I_W0, I_WUP, I_A0, I_AUP, I_KK, I_KA, I_RK, I_LXG, I_LXB, I_WOUT, I_LG, I_LB };

__device__ __forceinline__ float bf2f(unsigned short h) { return __uint_as_float((unsigned)h << 16); }
__device__ __forceinline__ unsigned f2bf(float f) { unsigned u = __float_as_uint(f); return (u + 0x7fffu + ((u >> 16) & 1u)) >> 16; }
__device__ __forceinline__ unsigned pk2(float lo, float hi) { return f2bf(lo) | (f2bf(hi) << 16); }
typedef __bf16 bf16x2e_t __attribute__((ext_vector_type(2)));
typedef float f32x2e __attribute__((ext_vector_type(2)));
__device__ __forceinline__ unsigned cvtpk_(float lo, float hi) { f32x2e v = {lo, hi}; bf16x2e_t b = __builtin_convertvector(v, bf16x2e_t); return __builtin_bit_cast(unsigned, b); }
__device__ __forceinline__ float shx(float v, int lane, int o) { return __int_as_float(__builtin_amdgcn_ds_bpermute((lane ^ o) << 2, __float_as_int(v))); }
__device__ __forceinline__ float wsum(float v, int lane) {
#pragma unroll
    for (int o = 32; o; o >>= 1) v += shx(v, lane, o);
    return v;
}
__device__ __forceinline__ float sigmoidf_(float x) { return 1.f / (1.f + __expf(-x)); }
__device__ __forceinline__ float siluf_(float x) { return x * sigmoidf_(x); }
__device__ __forceinline__ float rl(float v, int l) { return __int_as_float(__builtin_amdgcn_readlane(__float_as_int(v), l)); }

__device__ __forceinline__ void slab_info(int s, int& tok0, int& nseq, int& T) { if (s == 0) { tok0 = 0; nseq = 8; T = 2048; } else { tok0 = SLAB * s; nseq = 1; T = 16384; } }
__device__ __forceinline__ const float* slab_x(KP p, int s) { return s == 0 ? p->in[I_XP] : p->in[I_XS] + (size_t)(s - 1) * SLAB * D; }

__device__ __forceinline__ int orig_col(int jv) {
    if (jv >= 4096) return jv;
    const int pn = jv >> 8, bj = (jv >> 7) & 1, wc = (jv >> 5) & 3, fq = (jv >> 3) & 3, n = (jv >> 2) & 1, j = jv & 3;
    return (2 * bj + n) * 1024 + 64 * pn + 16 * wc + 4 * fq + j;
}

__device__ void phase_weights(KP p, int wid0) {
    KP_FRESH(p);
    int gt = blockIdx.x * 512 + hw_tid(wid0); asm volatile("" : "+v"(gt)); const int nt = gridDim.x * 512;
    bf16_t* win = (bf16_t*)(p->ws + WS_WIN); bf16_t* wout = (bf16_t*)(p->ws + WS_WOUT);
    const float* w_in = p->in[I_WIN]; const float* w_out = p->in[I_WOUT];
    for (int idx = gt; idx < NIN * 128; idx += nt) {
        const int jv = idx % NIN, kg = idx / NIN, oc = orig_col(jv);
        float v[8];
#pragma unroll
        for (int i = 0; i < 8; ++i) v[i] = w_in[(size_t)(kg * 8 + i) * NIN + oc];
        u32x4 w; w.x = pk2(v[0], v[1]); w.y = pk2(v[2], v[3]); w.z = pk2(v[4], v[5]); w.w = pk2(v[6], v[7]);
        *(u32x4*)(win + (size_t)jv * D + kg * 8) = w;
    }
    for (int idx = gt; idx < D * 256; idx += nt) {
        const int n = idx % D, kg = idx / D;
        float v[8];
#pragma unroll
        for (int i = 0; i < 8; ++i) v[i] = w_out[(size_t)(kg * 8 + i) * D + n];
        u32x4 w; w.x = pk2(v[0], v[1]); w.y = pk2(v[2], v[3]); w.z = pk2(v[4], v[5]); w.w = pk2(v[6], v[7]);
        *(u32x4*)(wout + (size_t)n * 2048 + kg * 8) = w;
    }
}

__device__ __forceinline__ bf16_t* xn_buf(KP p, int s) { return s == 1 ? (bf16_t*)(p->out + (size_t)2 * SLAB * D) : (bf16_t*)(p->ws + WS_XN); }
__device__ __forceinline__ void phase_ln(KP p, int s, int wid0, int wg0) {
    KP_FRESH(p);
    int tid_ = hw_tid(wid0); asm volatile("" : "+v"(tid_)); int lane = tid_ & 63; const int gw = ((int)blockIdx.x - wg0) * 8 + (tid_ >> 6), nw = ((int)gridDim.x - wg0) * 8;
    const float* x = slab_x(p, s); bf16_t* xn = xn_buf(p, s); float* stats = (float*)(p->ws + WS_STATS) + (size_t)s * SLAB * 2;
    const float4* g4 = (const float4*)p->in[I_EG]; const float4* b4 = (const float4*)p->in[I_EB];
    for (int gi = gw; gi < SLAB / 4; gi += nw) {
        const int r0 = gi * 4;
        asm volatile("" : "+v"(lane));
        float4 v[4][4];
#pragma unroll
        for (int k = 0; k < 4; ++k)
#pragma unroll
            for (int i = 0; i < 4; ++i) v[k][i] = ((const float4*)(x + (size_t)(r0 + k) * D))[lane + 64 * i];
#pragma unroll
        for (int k = 0; k < 4; ++k) {
            const int r = r0 + k;
            float sum = 0.f;
#pragma unroll
            for (int i = 0; i < 4; ++i) sum += v[k][i].x + v[k][i].y + v[k][i].z + v[k][i].w;
            const float mean = wsum(sum, lane) * (1.f / 1024.f);
            float sq = 0.f;
#pragma unroll
            for (int i = 0; i < 4; ++i) { float a = v[k][i].x - mean, b = v[k][i].y - mean, c = v[k][i].z - mean, d = v[k][i].w - mean; sq += a * a + b * b + c * c + d * d; }
            const float rstd = rsqrtf(wsum(sq, lane) * (1.f / 1024.f) + 1e-5f);
            if (lane == 0) { stats[r * 2] = mean; stats[r * 2 + 1] = rstd; }
#pragma unroll
            for (int i = 0; i < 4; ++i) {
                const float4 g = g4[lane + 64 * i], b = b4[lane + 64 * i];
                u32x2 w; w.x = cvtpk_((v[k][i].x - mean) * rstd * g.x + b.x, (v[k][i].y - mean) * rstd * g.y + b.y);
                w.y = cvtpk_((v[k][i].z - mean) * rstd * g.z + b.z, (v[k][i].w - mean) * rstd * g.w + b.w);
                *(u32x2*)(xn + (size_t)r * D + (lane + 64 * i) * 4) = w;
            }
        }
    }
}

struct EpiU {
    static constexpr bool PERM = true, AFTER_DRAIN = false;
    bf16_t* U; bf16_t* TMP; const float* mu; bf16_t* YM; bf16_t* SB2; const float* cw; const float* cb;
    __device__ __forceinline__ void operator()(const f32x4 (&acc)[2][2][4][2], const pg8::Unit& u, int wr, int wc, int fr, int fq) const {
        const int row0 = u.pm * 256 + wr * 64 + fr;
        if (u.pn < 16) {
            const int ch0 = 64 * u.pn + 16 * wc + 4 * fq;
            const f32x4 cw0 = *(const f32x4*)(cw + ch0), cw1 = *(const f32x4*)(cw + 1024 + ch0), cw2 = *(const f32x4*)(cw + 2048 + ch0), cbv = *(const f32x4*)(cb + ch0);
#define EPI_DPP(old_, src_, ctrl_) __int_as_float(__builtin_amdgcn_update_dpp(__float_as_int(old_), __float_as_int(src_), ctrl_, 0xf, 0xf, false))
#pragma unroll
            for (int ai = 0; ai < 2; ++ai) {
                f32x4 pv_[4], gv_[4];
#pragma unroll
                for (int m = 0; m < 4; ++m) {
                    const f32x4 h = acc[ai][0][m][0], B = acc[ai][0][m][1], C = acc[ai][1][m][0], z = acc[ai][1][m][1];
                    pv_[m] = C * h;
#pragma unroll
                    for (int j = 0; j < 4; ++j) gv_[m][j] = B[j] * siluf_(z[j]);
                }
                const int blk = 4 * u.pm + 2 * ai + wr;
#pragma unroll
                for (int m = 0; m < 4; ++m) {
                    float y[4];
#pragma unroll
                    for (int j = 0; j < 4; ++j) {
                        const float po = (m > 0) ? EPI_DPP(0.f, pv_[m > 0 ? m - 1 : 0][j], 0x121) : 0.f, no = (m < 3) ? EPI_DPP(0.f, pv_[m < 3 ? m + 1 : 3][j], 0x12F) : 0.f;
                        const float pr = EPI_DPP(po, pv_[m][j], 0x111), nx = EPI_DPP(no, pv_[m][j], 0x101);
                        y[j] = gv_[m][j] * (cw0[j] * pr + cw1[j] * pv_[m][j] + cw2[j] * nx + cbv[j]);
                    }
                    u32x2 wy; wy.x = pk2(y[0], y[1]); wy.y = pk2(y[2], y[3]);
                    *(u32x2*)(YM + (size_t)(row0 + ai * 128 + m * 16) * 2048 + ch0) = wy;
                    if ((m == 0 && fr < 2) || (m == 3 && fr >= 14)) {
                        const int w4 = (m == 0) ? fr : fr - 12;
                        u32x2 wp; wp.x = pk2(pv_[m][0], pv_[m][1]); wp.y = pk2(pv_[m][2], pv_[m][3]);
                        *(u32x2*)(SB2 + ((size_t)blk * 6 + w4) * 1024 + ch0) = wp;
                        if (w4 == 0 || w4 == 3) {
                            u32x2 wg; wg.x = pk2(gv_[m][0], gv_[m][1]); wg.y = pk2(gv_[m][2], gv_[m][3]);
                            *(u32x2*)(SB2 + ((size_t)blk * 6 + (w4 == 0 ? 4 : 5)) * 1024 + ch0) = wg;
                        }
                    }
                }
            }
#undef EPI_DPP
        } else {
            const int col0 = 256 * (u.pn - 16) + 32 * wc + 8 * fq; const bool zt = (u.pn >= 28) && (u.pn < 32);
            if (zt) {
#pragma unroll
                for (int ai = 0; ai < 2; ++ai)
#pragma unroll
                    for (int m = 0; m < 4; ++m) {
                        bf16_t* rowp = U + (size_t)(row0 + ai * 128 + m * 16) * UW + URW + col0;
#pragma unroll
                        for (int bj = 0; bj < 2; ++bj) {
                            const f32x4 v0 = acc[ai][bj][m][0], v1 = acc[ai][bj][m][1];
                            u32x4 w; w.x = pk2(v0[0], v0[1]); w.y = pk2(v0[2], v0[3]); w.z = pk2(v1[0], v1[1]); w.w = pk2(v1[2], v1[3]);
                            *(u32x4*)(rowp + bj * 128) = w;
                        }
                    }
            } else {
#define EPI_DPP(old_, src_, ctrl_) __int_as_float(__builtin_amdgcn_update_dpp(__float_as_int(old_), __float_as_int(src_), ctrl_, 0xf, 0xf, false))
#pragma unroll
                for (int ai = 0; ai < 2; ++ai)
#pragma unroll
                    for (int bj = 0; bj < 2; ++bj) {
                        const int cb = col0 + bj * 128;
                        const f32x4 mu0 = *(const f32x4*)(mu + cb), mu1 = *(const f32x4*)(mu + cb + 4);
                        const bool th = (u.pn == 32) && (bj == 0);
                        const int blk = 4 * u.pm + 2 * ai + wr;
#pragma unroll
                        for (int m = 0; m < 4; ++m) {
                            u32x4 wv;
#pragma unroll
                            for (int n = 0; n < 2; ++n) {
                                const f32x4 cur = acc[ai][bj][m][n], mun = n ? mu1 : mu0;
                                f32x4 o;
#pragma unroll
                                for (int j = 0; j < 4; ++j) {
                                    const float po = (m > 0) ? EPI_DPP(0.f, acc[ai][bj][m > 0 ? m - 1 : 0][n][j], 0x121) : 0.f;
                                    const float no = (m < 3) ? EPI_DPP(0.f, acc[ai][bj][m < 3 ? m + 1 : 3][n][j], 0x12F) : 0.f;
                                    const float pv = EPI_DPP(po, cur[j], 0x111), nx = EPI_DPP(no, cur[j], 0x101);
                                    float v = cur[j] + mun[j] * (0.5f * (pv + nx) - cur[j]);
                                    if (th) v = 1.f - 2.f * __builtin_amdgcn_rcpf(1.f + __builtin_amdgcn_exp2f(2.88539008f * v));
                                    o[j] = v;
                                }
                                if (n == 0) { wv.x = pk2(o[0], o[1]); wv.y = pk2(o[2], o[3]); } else { wv.z = pk2(o[0], o[1]); wv.w = pk2(o[2], o[3]); }
                            }
                            *(u32x4*)(U + (size_t)(row0 + ai * 128 + m * 16) * UW + URW + cb) = wv;
                            if ((m == 0 && fr < 2) || (m == 3 && fr >= 14)) {
                                const int w4 = (m == 0) ? fr : fr - 12;
                                const f32x4 v0 = acc[ai][bj][m][0], v1 = acc[ai][bj][m][1];
                                u32x4 w; w.x = pk2(v0[0], v0[1]); w.y = pk2(v0[2], v0[3]); w.z = pk2(v1[0], v1[1]); w.w = pk2(v1[2], v1[3]);
                                *(u32x4*)(TMP + ((size_t)blk * 4 + w4) * 4352 + cb) = w;
                            }
                        }
                    }
#undef EPI_DPP
            }
        }
    }
};

struct EpiOut {
    static constexpr bool PERM = true, AFTER_DRAIN = false;
    float* out; const float* x; const float* stats; const float* eg; const float* eb;
    __device__ __forceinline__ void operator()(const f32x4 (&acc)[2][2][4][2], const pg8::Unit& u, int wr, int wc, int fr, int fq) const {
        const int row0 = u.pm * 256 + wr * 64 + fr, col0 = u.pn * 256 + wc * 32 + 8 * fq;
#pragma unroll
        for (int ai = 0; ai < 2; ++ai)
#pragma unroll
            for (int m = 0; m < 4; ++m) {
                const int row = row0 + ai * 128 + m * 16;
                const float mean = stats[row * 2], rstd = stats[row * 2 + 1];
#pragma unroll
                for (int bj = 0; bj < 2; ++bj)
#pragma unroll
                    for (int n = 0; n < 2; ++n) {
                        const int c = col0 + bj * 128 + 4 * n;
                        const float4 xv = *(const float4*)(x + (size_t)row * D + c), g = *(const float4*)(eg + c), b = *(const float4*)(eb + c);
                        const f32x4 a = acc[ai][bj][m][n];
                        float4 o;
                        o.x = DN_ALPHA * ((xv.x - mean) * rstd * g.x + b.x) + a[0]; o.y = DN_ALPHA * ((xv.y - mean) * rstd * g.y + b.y) + a[1];
                        o.z = DN_ALPHA * ((xv.z - mean) * rstd * g.z + b.z) + a[2]; o.w = DN_ALPHA * ((xv.w - mean) * rstd * g.w + b.w) + a[3];
                        *(float4*)(out + (size_t)row * D + c) = o;
                    }
            }
    }
};

typedef short bf16x8 __attribute__((ext_vector_type(8)));
typedef short s16x4 __attribute__((ext_vector_type(4)));
typedef __bf16 bf16x2_t __attribute__((ext_vector_type(2)));
typedef float f32x2 __attribute__((ext_vector_type(2)));
#define MFMA16(a, b, c) __builtin_amdgcn_mfma_f32_16x16x32_bf16((a), (b), (c), 0, 0, 0)
#define DI __device__ __forceinline__
constexpr int IMG_STRIDE = 144;
constexpr int WG_FRAG = 0;
constexpr int WG_CONST = 16384;
constexpr int WV_BASE = 16384 + 2560;
constexpr int WV_BYTES = 3 * 16 * IMG_STRIDE + 256;
static_assert(WV_BASE + 8 * WV_BYTES <= LDS_BYTES, "scan LDS map");

DI unsigned cvtpk(float lo, float hi) { f32x2 v = {lo, hi}; bf16x2_t b = __builtin_convertvector(v, bf16x2_t); return __builtin_bit_cast(unsigned, b); }
DI bf16x8 mkfrag(unsigned a, unsigned b, unsigned c, unsigned d) { u32x4 w = {a, b, c, d}; return __builtin_bit_cast(bf16x8, w); }
DI bf16x8 frag_f4(f32x4 a, f32x4 b) { return mkfrag(cvtpk(a[0], a[1]), cvtpk(a[2], a[3]), cvtpk(b[0], b[1]), cvtpk(b[2], b[3])); }
DI float bperm(float v, int srclane) { return __int_as_float(__builtin_amdgcn_ds_bpermute(srclane << 2, __float_as_int(v))); }
DI float lo16(unsigned w) { return __uint_as_float(w << 16); }
DI float hi16(unsigned w) { return __uint_as_float(w & 0xffff0000u); }
template <int CTRL> DI float dpp0(float x) { return __int_as_float(__builtin_amdgcn_update_dpp(0, __float_as_int(x), CTRL, 0xf, 0xf, true)); }
template <int CTRL> DI float dpp1(float x) { return __int_as_float(__builtin_amdgcn_update_dpp(0x3f800000, __float_as_int(x), CTRL, 0xf, 0xf, false)); }
DI float fsig(float x) { return __builtin_amdgcn_rcpf(1.f + __expf(-x)); }
DI f32x4 ld4(const bf16_t* ur) { const u32x2 c = *(const u32x2*)ur; return (f32x4){lo16(c.x), hi16(c.x), lo16(c.y), hi16(c.y)}; }

DI void split_frag(f32x4 a, f32x4 b, bf16x8& hi, bf16x8& lo) {
    f32x4 ah, bh;
    unsigned w[4] = {cvtpk(a[0], a[1]), cvtpk(a[2], a[3]), cvtpk(b[0], b[1]), cvtpk(b[2], b[3])};
    ah[0] = lo16(w[0]); ah[1] = hi16(w[0]); ah[2] = lo16(w[1]); ah[3] = hi16(w[1]); bh[0] = lo16(w[2]); bh[1] = hi16(w[2]); bh[2] = lo16(w[3]); bh[3] = hi16(w[3]);
    hi = mkfrag(w[0], w[1], w[2], w[3]); lo = frag_f4(a - ah, b - bh);
}
struct ChunkIn { u32x2 k[4], r[4], v[4]; bf16x8 tl[2], la[2]; };
template <int PASS> DI void chunk_load(ChunkIn& c, const bf16_t* ur, int h, int d, int q) {
#pragma unroll
    for (int n = 0; n < 4; ++n) {
        c.k[n] = *(const u32x2*)(ur + 1024 + h * 64 + 16 * n + 4 * q);
        if (PASS == 2) { c.v[n] = *(const u32x2*)(ur + 2048 + h * 64 + 16 * n + 4 * q); c.r[n] = *(const u32x2*)(ur + h * 64 + 16 * n + 4 * q); }
    }
#pragma unroll
    for (int ks = 0; ks < 2; ++ks) { const bf16_t* ul = ur + 4096 + d * 64 + 32 * ks + 8 * q; c.tl[ks] = *(const bf16x8*)ul; c.la[ks] = *(const bf16x8*)(ul + 128); }
}
DI f32x4 up4(u32x2 c) { return (f32x4){lo16(c.x), hi16(c.x), lo16(c.y), hi16(c.y)}; }
template <int PASS>
__device__ void phase_scan(KP p, int s, unsigned char* ldsg, int wid0) {
    KP_FRESH(p);
    const int wid = wid0;
    int tok0, nseq, T; slab_info(s, tok0, nseq, T);
    const int LS = 256, lgseg = (s == 0) ? 3 : 6, nseg = 1 << lgseg, nblk = (nseq * 32 << lgseg) >> 3;
    const bf16_t* U = (const bf16_t*)(p->ws + WS_U);
    bf16_t* YS = (bf16_t*)(p->ws + WS_YS); float* BON = (float*)(p->ws + WS_BON);
    float* PQ = (float*)(p->ws + WS_PQ); const float* SST = (const float*)(p->ws + WS_SST);
    float* cst = (float*)(ldsg + WG_CONST);
    const int wo = WV_BASE + wid * WV_BYTES;
    for (int ib = blockIdx.x; ib < nblk; ib += gridDim.x) {
        const int item = ib * 8 + wid, g = item & (nseg - 1), chain = item >> lgseg, h = chain & 15, d = (chain >> 4) & 1, b = chain >> 5;
        const int tid = hw_tid(wid0), lane = tid & 63, fr = lane & 15, q = lane >> 4;
        __syncthreads();
        if (tid < 64) {
            const float* mu = p->in[I_MU]; const int c = h * 64 + tid;
            cst[tid] = mu[c]; cst[64 + tid] = mu[1024 + c]; cst[128 + tid] = mu[2048 + c];
            cst[192 + tid] = -1.44269504f * p->in[I_W0][d * 1024 + c]; cst[256 + tid] = -1.44269504f * p->in[I_A0][d * 1024 + c];
            cst[320 + tid] = p->in[I_KK][c]; cst[384 + tid] = p->in[I_KA][c]; cst[448 + tid] = p->in[I_RK][c];
            cst[512 + tid] = mu[4096 + d * 64 + tid]; cst[576 + tid] = mu[4096 + 128 + d * 64 + tid];
        }
        for (int e = tid; e < 1024; e += 512) {
            const int l2 = e & 63, ks = (e >> 6) & 1, mt = (e >> 7) & 3, mat = e >> 9, fr2 = l2 & 15, q2 = l2 >> 4;
            const float* src = (mat ? p->in[I_AUP] : p->in[I_WUP]) + ((size_t)d * 64 + 32 * ks + 8 * q2) * 1024 + h * 64 + 16 * mt + fr2;
            float v8[8];
#pragma unroll
            for (int jj = 0; jj < 8; ++jj) v8[jj] = -1.44269504f * src[(size_t)jj * 1024];
            u32x4 w = {cvtpk(v8[0], v8[1]), cvtpk(v8[2], v8[3]), cvtpk(v8[4], v8[5]), cvtpk(v8[6], v8[7])};
            *(u32x4*)(ldsg + WG_FRAG + e * 16) = w;
        }
        __syncthreads();
        f32x4 St[4][4];
        f32x4 Pa[PASS == 1 ? 4 : 1][PASS == 1 ? 4 : 1];
        int l3 = lane; asm volatile("" : "+v"(l3));
        const float* sstl = SST + (size_t)item * 4096 + l3 * 4;
#pragma unroll
        for (int mt = 0; mt < 4; ++mt)
#pragma unroll
            for (int nt = 0; nt < 4; ++nt) {
                if (PASS == 1) {
#pragma unroll
                    for (int j = 0; j < 4; ++j) { St[mt][nt][j] = 0.f; Pa[PASS == 1 ? mt : 0][PASS == 1 ? nt : 0][j] = (16 * mt + 4 * q + j == 16 * nt + fr) ? 1.f : 0.f; }
                } else {
                    St[mt][nt] = *(const f32x4*)(sstl + (mt * 4 + nt) * 256);
                }
            }
        ChunkIn cin;
        { const int p0 = g * LS, t0 = d ? T - 1 - (p0 + fr) : p0 + fr; chunk_load<PASS>(cin, U + (size_t)(b * T + t0) * UW + URW, h, d, q); }
        for (int ck = 0; ck < LS / 16; ++ck) {
            const int pos0 = g * LS + ck * 16;
            const int lane_c = hw_tid(wid0) & 63;
            const int lane = lane_c, fr = lane_c & 15, q = lane_c >> 4;
            const int ti = d ? T - 1 - (pos0 + fr) : pos0 + fr, row = b * T + ti;
            ChunkIn cc = cin;
            if (PASS == 1) {
#pragma unroll
                for (int n = 0; n < 4; ++n) cc.v[n] = *(const u32x2*)(U + (size_t)row * UW + URW + 2048 + h * 64 + 16 * n + 4 * q);
            }
            {
                const int pn = g * LS + (ck + 1 < LS / 16 ? ck + 1 : ck) * 16, tn = d ? T - 1 - (pn + fr) : pn + fr;
                chunk_load<PASS>(cin, U + (size_t)(b * T + tn) * UW + URW, h, d, q);
            }
            const int lq16 = 16 * q, ll16 = 16 * lane, limg = fr * IMG_STRIDE + 8 * q, ltr = (4 * q + (fr >> 2)) * IMG_STRIDE + 8 * (fr & 3);
            f32x4 ow[4], oa[4];
            {
                const bf16x8 tlf[2] = {cc.tl[0], cc.tl[1]}, laf[2] = {cc.la[0], cc.la[1]};
#pragma unroll
                for (int mt = 0; mt < 4; ++mt) {
                    const bf16x8 w0f = *(const bf16x8*)(ldsg + WG_FRAG + ((0 * 4 + mt) * 2 + 0) * 1024 + ll16), w1f = *(const bf16x8*)(ldsg + WG_FRAG + ((0 * 4 + mt) * 2 + 1) * 1024 + ll16);
                    const bf16x8 a0f = *(const bf16x8*)(ldsg + WG_FRAG + ((1 * 4 + mt) * 2 + 0) * 1024 + ll16), a1f = *(const bf16x8*)(ldsg + WG_FRAG + ((1 * 4 + mt) * 2 + 1) * 1024 + ll16);
                    f32x4 z = {0.f, 0.f, 0.f, 0.f};
                    ow[mt] = MFMA16(w1f, tlf[1], MFMA16(w0f, tlf[0], z));
                    oa[mt] = MFMA16(a1f, laf[1], MFMA16(a0f, laf[0], z));
                }
            }
            f32x4 km[4]; f32x4 ss4 = {0.f, 0.f, 0.f, 0.f};
#pragma unroll
            for (int n = 0; n < 4; ++n) {
                km[n] = up4(cc.k[n]);
                const f32x4 kr = km[n] * *(const f32x4*)(ldsg + WG_CONST + (320 + 16 * n) * 4 + lq16);
                ss4 += kr * kr;
            }
            float ss = (ss4[0] + ss4[1]) + (ss4[2] + ss4[3]);
            ss += bperm(ss, lane ^ 16); ss += bperm(ss, lane ^ 32);
            const float kinv = 1.f / fmaxf(sqrtf(ss), 1e-12f);
            u32x2 kapP[4], ktP[4], btP[4], rtP[4]; f32x4 bon4 = {0.f, 0.f, 0.f, 0.f};
#pragma unroll
            for (int n = 0; n < 4; ++n) {
                const f32x4 w0v = *(const f32x4*)(ldsg + WG_CONST + (192 + 16 * n) * 4 + lq16), a0v = *(const f32x4*)(ldsg + WG_CONST + (256 + 16 * n) * 4 + lq16), kkw = *(const f32x4*)(ldsg + WG_CONST + (320 + 16 * n) * 4 + lq16), kav = *(const f32x4*)(ldsg + WG_CONST + (384 + 16 * n) * 4 + lq16);
                const f32x4 tw = w0v + ow[n], ta = a0v + oa[n];
                f32x4 ew, ea;
#pragma unroll
                for (int j = 0; j < 4; ++j) { ew[j] = __builtin_amdgcn_exp2f(tw[j]); ea[j] = __builtin_amdgcn_exp2f(ta[j]); }
                const f32x4 dw = ew + 1.f, da = ea + 1.f;
                f32x4 sw, av;
#pragma unroll
                for (int j = 0; j < 4; ++j) { sw[j] = __builtin_amdgcn_rcpf(dw[j]); av[j] = __builtin_amdgcn_rcpf(da[j]); }
                const f32x4 lw2 = sw * -0.87503877f;
                f32x4 L, Lm, gmv, emL;
#pragma unroll
                for (int j = 0; j < 4; ++j) {
                    float x = __builtin_amdgcn_exp2f(lw2[j]);
                    x *= dpp1<0x111>(x); x *= dpp1<0x112>(x); x *= dpp1<0x114>(x); x *= dpp1<0x118>(x);
                    L[j] = x; Lm[j] = dpp1<0x111>(x); gmv[j] = dpp0<0x121>(x);
                    emL[j] = __builtin_amdgcn_rcpf(x);
                }
                const f32x4 kk = km[n] * kkw * kinv;
                const f32x4 kd = km[n] * ((av - 1.f) * kav + 1.f);
                const f32x4 kap = kk * Lm, bt = kk * av * emL, kt = kd * emL;
                if (fr == 0) *(f32x4*)(ldsg + wo + 48 * IMG_STRIDE + 64 * n + lq16) = gmv;
                kapP[n] = (u32x2){cvtpk(kap[0], kap[1]), cvtpk(kap[2], kap[3])};
                ktP[n] = (u32x2){cvtpk(kt[0], kt[1]), cvtpk(kt[2], kt[3])};
                btP[n] = (u32x2){cvtpk(bt[0], bt[1]), cvtpk(bt[2], bt[3])};
                *(u32x2*)(ldsg + wo + 16 * IMG_STRIDE + 32 * n + limg) = ktP[n];
                *(u32x2*)(ldsg + wo + 32 * IMG_STRIDE + 32 * n + limg) = btP[n];
                if (PASS == 2) {
                    const f32x4 rm = up4(cc.r[n]), rk = *(const f32x4*)(ldsg + WG_CONST + (448 + 16 * n) * 4 + lq16);
                    const f32x4 rt = rm * L;
                    rtP[n] = (u32x2){cvtpk(rt[0], rt[1]), cvtpk(rt[2], rt[3])};
                    bon4 += rm * kd * rk;
                }
                *(u32x2*)(ldsg + wo + 32 * n + limg) = cc.v[n];
            }
            if (PASS == 2) {
                float bon = (bon4[0] + bon4[1]) + (bon4[2] + bon4[3]);
                bon += bperm(bon, lane ^ 16); bon += bperm(bon, lane ^ 32);
                if (q == 0) BON[((size_t)d * SLAB + row) * 16 + h] = 0.5f * bon;
            }
            const bf16x8 kapF0 = mkfrag(kapP[0].x, kapP[0].y, kapP[1].x, kapP[1].y), kapF1 = mkfrag(kapP[2].x, kapP[2].y, kapP[3].x, kapP[3].y);
            bf16x8 akkA, tA, aryA;
            {
                const bf16x8 ktF0 = mkfrag(ktP[0].x, ktP[0].y, ktP[1].x, ktP[1].y), ktF1 = mkfrag(ktP[2].x, ktP[2].y, ktP[3].x, ktP[3].y);
                const bf16x8 btF0 = mkfrag(btP[0].x, btP[0].y, btP[1].x, btP[1].y), btF1 = mkfrag(btP[2].x, btP[2].y, btP[3].x, btP[3].y);
                const f32x4 z = {0.f, 0.f, 0.f, 0.f};
                f32x4 akk = MFMA16(ktF1, kapF1, MFMA16(ktF0, kapF0, z));
                f32x4 nn = MFMA16(kapF1, btF1, MFMA16(kapF0, btF0, z));
                f32x4 na = MFMA16(btF1, kapF1, MFMA16(btF0, kapF0, z));
                f32x4 idv;
#pragma unroll
                for (int jj = 0; jj < 4; ++jj) {
                    akk[jj] = (4 * q + jj < fr) ? akk[jj] : 0.f; nn[jj] = (fr < 4 * q + jj) ? nn[jj] : 0.f; na[jj] = (4 * q + jj < fr) ? na[jj] : 0.f;
                    idv[jj] = (4 * q + jj == fr) ? 1.f : 0.f;
                }
                akkA = mkfrag(cvtpk(akk[0], akk[1]), cvtpk(akk[2], akk[3]), 0u, 0u);
                if (PASS == 2) {
                    const bf16x8 rtF0 = mkfrag(rtP[0].x, rtP[0].y, rtP[1].x, rtP[1].y), rtF1 = mkfrag(rtP[2].x, rtP[2].y, rtP[3].x, rtP[3].y);
                    f32x4 ark = MFMA16(ktF1, rtF1, MFMA16(ktF0, rtF0, z));
                    f32x4 arb = MFMA16(btF1, rtF1, MFMA16(btF0, rtF0, z));
#pragma unroll
                    for (int jj = 0; jj < 4; ++jj) { ark[jj] = (4 * q + jj <= fr) ? ark[jj] : 0.f; arb[jj] = (4 * q + jj <= fr) ? arb[jj] : 0.f; }
                    aryA = mkfrag(cvtpk(ark[0], ark[1]), cvtpk(ark[2], ark[3]), cvtpk(arb[0], arb[1]), cvtpk(arb[2], arb[3]));
                }
#define TF(x) mkfrag(cvtpk((x)[0], (x)[1]), cvtpk((x)[2], (x)[3]), 0u, 0u)
                const bf16x8 nF = TF(nn), aF = TF(na);
                const f32x4 n2 = MFMA16(aF, nF, z), a2 = MFMA16(nF, aF, z);
                const bf16x8 n2F = TF(n2), a2F = TF(a2);
                const f32x4 n4 = MFMA16(a2F, n2F, z), a4 = MFMA16(n2F, a2F, z);
                const bf16x8 n4F = TF(n4), a4F = TF(a4);
                const f32x4 n8 = MFMA16(a4F, n4F, z);
                const f32x4 t21 = MFMA16(n2F, aF, z);
                f32x4 R = idv - na + a2 - t21;
                R = MFMA16(n4F, TF(R), R);
                R = MFMA16(TF(n8), TF(R), R);
                tA = TF(R);
#undef TF
            }
            s16x4 Vc[4], Kc[4], Bc[4];
            {
                typedef s16x4 __attribute__((address_space(3)))* lp;
#pragma unroll
                for (int t4 = 0; t4 < 4; ++t4) {
                    Vc[t4] = __builtin_amdgcn_ds_read_tr16_b64_v4i16((lp)(ldsg + wo + ltr + 32 * t4));
                    Kc[t4] = __builtin_amdgcn_ds_read_tr16_b64_v4i16((lp)(ldsg + wo + 16 * IMG_STRIDE + ltr + 32 * t4));
                    Bc[t4] = __builtin_amdgcn_ds_read_tr16_b64_v4i16((lp)(ldsg + wo + 32 * IMG_STRIDE + ltr + 32 * t4));
                }
            }
            bf16x8 kbA[4];
#pragma unroll
            for (int mt = 0; mt < 4; ++mt) kbA[mt] = __builtin_shufflevector(Kc[mt], Bc[mt], 0, 1, 2, 3, 4, 5, 6, 7);
#pragma unroll
            for (int nt = 0; nt < 4; ++nt) {
                const f32x4 z = {0.f, 0.f, 0.f, 0.f};
                const bf16x8 stf0 = frag_f4(St[0][nt], St[1][nt]), stf1 = frag_f4(St[2][nt], St[3][nt]);
                const u32x2 vcu = __builtin_bit_cast(u32x2, Vc[nt]);
                f32x4 X = MFMA16(kapF1, stf1, MFMA16(kapF0, stf0, z));
                X = MFMA16(akkA, mkfrag(vcu.x, vcu.y, 0u, 0u), X);
                const f32x4 Uu = MFMA16(tA, mkfrag(cvtpk(X[0], X[1]), cvtpk(X[2], X[3]), 0u, 0u), z);
                const bf16x8 bvu = mkfrag(vcu.x, vcu.y, cvtpk(-Uu[0], -Uu[1]), cvtpk(-Uu[2], -Uu[3]));
                if (PASS == 2) {
                    const bf16x8 rtF0 = mkfrag(rtP[0].x, rtP[0].y, rtP[1].x, rtP[1].y), rtF1 = mkfrag(rtP[2].x, rtP[2].y, rtP[3].x, rtP[3].y);
                    f32x4 Y = MFMA16(rtF1, stf1, MFMA16(rtF0, stf0, z));
                    Y = MFMA16(aryA, bvu, Y);
#pragma unroll
                    for (int jj = 0; jj < 4; ++jj) {
                        const int i = 4 * q + jj, t2 = d ? T - 1 - (pos0 + i) : pos0 + i;
                        YS[((size_t)d * SLAB + b * T + t2) * DR + h * 64 + 16 * nt + fr] = (bf16_t)(cvtpk(Y[jj], 0.f) & 0xffffu);
                    }
                }
#pragma unroll
                for (int mt = 0; mt < 4; ++mt) St[mt][nt] = MFMA16(kbA[mt], bvu, St[mt][nt]) * *(const f32x4*)(ldsg + wo + 48 * IMG_STRIDE + 64 * mt + lq16);
            }
            if (PASS == 1) {
#pragma unroll
                for (int ct = 0; ct < 4; ++ct) {
                    const f32x4 z = {0.f, 0.f, 0.f, 0.f};
                    const bf16x8 pf0 = frag_f4(Pa[0][PASS == 1 ? ct : 0], Pa[PASS == 1 ? 1 : 0][PASS == 1 ? ct : 0]), pf1 = frag_f4(Pa[PASS == 1 ? 2 : 0][PASS == 1 ? ct : 0], Pa[PASS == 1 ? 3 : 0][PASS == 1 ? ct : 0]);
                    const f32x4 X = MFMA16(kapF1, pf1, MFMA16(kapF0, pf0, z));
                    const f32x4 Uu = MFMA16(tA, mkfrag(cvtpk(X[0], X[1]), cvtpk(X[2], X[3]), 0u, 0u), z);
                    const bf16x8 bvu = mkfrag(0u, 0u, cvtpk(-Uu[0], -Uu[1]), cvtpk(-Uu[2], -Uu[3]));
#pragma unroll
                    for (int mt = 0; mt < 4; ++mt) Pa[PASS == 1 ? mt : 0][PASS == 1 ? ct : 0] = MFMA16(kbA[mt], bvu, Pa[PASS == 1 ? mt : 0][PASS == 1 ? ct : 0]) * *(const f32x4*)(ldsg + wo + 48 * IMG_STRIDE + 64 * mt + lq16);
                }
            }
        }
        if (PASS == 1) {
            const int l2 = hw_tid(wid0) & 63, fr2 = l2 & 15, q2 = l2 >> 4;
            unsigned char* pqb = (unsigned char*)(PQ + (size_t)item * 8192);
            float* tl = (float*)(ldsg + wo);
#pragma unroll
            for (int mt = 0; mt < 4; ++mt)
#pragma unroll
                for (int ks = 0; ks < 2; ++ks) {
#pragma unroll
                    for (int e = 0; e < 2; ++e)
#pragma unroll
                        for (int j2 = 0; j2 < 4; ++j2) tl[e * 256 + (4 * q2 + j2) * 16 + fr2] = Pa[PASS == 1 ? mt : 0][PASS == 1 ? 2 * ks + e : 0][j2];
                    __builtin_amdgcn_wave_barrier();
                    const f32x4 pa = *(const f32x4*)(tl + fr2 * 16 + 4 * q2), pb = *(const f32x4*)(tl + 256 + fr2 * 16 + 4 * q2);
                    __builtin_amdgcn_wave_barrier();
                    bf16x8 ah, al; split_frag(pa, pb, ah, al);
                    *(bf16x8*)(pqb + (((mt * 2 + ks) * 2 + 0) * 64 + l2) * 16) = ah;
                }
            float* pq = PQ + (size_t)item * 8192 + 4096 + l2 * 4;
#pragma unroll
            for (int mt = 0; mt < 4; ++mt)
#pragma unroll
                for (int nt = 0; nt < 4; ++nt) *(f32x4*)(pq + (mt * 4 + nt) * 256) = St[mt][nt];
        }
    }
}

constexpr int CR_SLOTS = 10, CR_SLOT_BYTES = 12288, CR_FLAGS = CR_SLOTS * CR_SLOT_BYTES;
__device__ __forceinline__ void phase_combine_ring(KP p, int s, int wid0, unsigned char* ldsg) {
    KP_FRESH(p);
    int tid_ = hw_tid(wid0); asm volatile("" : "+v"(tid_));
    const int lane = tid_ & 63, wid = wid0;
    const int nseg = 64, nsteps = nseg - 1;
    const float* PQ = (const float*)(p->ws + WS_PQ); float* SST = (float*)(p->ws + WS_SST);
    volatile unsigned* flags = (volatile unsigned*)(ldsg + CR_FLAGS);
    __syncthreads();
    if (tid_ < CR_SLOTS) flags[tid_] = 0u;
    __syncthreads();
    if ((int)blockIdx.x >= 128) return;
    const int nt = blockIdx.x & 3, chain = blockIdx.x >> 2;
    if (wid != 0) {
        u32x4 ra[12], rb[12];
#define CR_ISSUE(r, gg) do { const unsigned char* b_ = (const unsigned char*)(PQ + ((size_t)chain * nseg + (gg)) * 8192); \
        _Pragma("unroll") for (int f = 0; f < 8; ++f) (r)[f] = *(const u32x4*)(b_ + ((f * 2 + 0) * 64 + lane) * 16); \
        _Pragma("unroll") for (int mt = 0; mt < 4; ++mt) (r)[8 + mt] = *(const u32x4*)(b_ + 16384 + ((mt * 4 + nt) * 64 + lane) * 16); } while (0)
#define CR_PUT(r, gg) do { const int slot_ = (gg) % CR_SLOTS; const unsigned gen_ = 2u * (unsigned)((gg) / CR_SLOTS); unsigned sp_ = 0;     \
        while (flags[slot_] != gen_ && ++sp_ < (1u << 20)) __builtin_amdgcn_s_sleep(1); \
        _Pragma("unroll") for (int f = 0; f < 12; ++f) *(u32x4*)(ldsg + slot_ * CR_SLOT_BYTES + f * 1024 + lane * 16) = (r)[f]; \
        asm volatile("s_waitcnt lgkmcnt(0)" ::: "memory"); __builtin_amdgcn_wave_barrier(); \
        if (lane == 0) flags[slot_] = gen_ + 1u; } while (0)
        int g = wid - 1;
        if (g < nsteps) CR_ISSUE(ra, g);
        for (; g < nsteps; g += 14) {
            if (g + 7 < nsteps) CR_ISSUE(rb, g + 7);
            CR_PUT(ra, g);
            if (g + 14 < nsteps) CR_ISSUE(ra, g + 14);
            if (g + 7 < nsteps) CR_PUT(rb, g + 7);
        }
#undef CR_ISSUE
#undef CR_PUT
    } else {
        f32x4 S[4];
#pragma unroll
        for (int mt = 0; mt < 4; ++mt) S[mt] = (f32x4){0.f, 0.f, 0.f, 0.f};
        for (int g = 0; g < nseg; ++g) {
            const size_t item = (size_t)chain * nseg + g;
#pragma unroll
            for (int mt = 0; mt < 4; ++mt) *(f32x4*)(SST + item * 4096 + ((mt * 4 + nt) * 64 + lane) * 4) = S[mt];
            if (g == nsteps) break;
            const int slot = g % CR_SLOTS; const unsigned gen = 2u * (unsigned)(g / CR_SLOTS); unsigned sp = 0;
            while (flags[slot] != gen + 1u && ++sp < (1u << 20)) __builtin_amdgcn_s_sleep(1);
            bf16x8 ah[4][2]; f32x4 qv[4];
#pragma unroll
            for (int mt = 0; mt < 4; ++mt) {
                qv[mt] = *(const f32x4*)(ldsg + slot * CR_SLOT_BYTES + (8 + mt) * 1024 + lane * 16);
#pragma unroll
                for (int ks = 0; ks < 2; ++ks) ah[mt][ks] = *(const bf16x8*)(ldsg + slot * CR_SLOT_BYTES + (mt * 2 + ks) * 1024 + lane * 16);
            }
            asm volatile("s_waitcnt lgkmcnt(0)" ::: "memory"); __builtin_amdgcn_wave_barrier();
            if (lane == 0) flags[slot] = gen + 2u;
            bf16x8 bh[2], bl[2];
            split_frag(S[0], S[1], bh[0], bl[0]); split_frag(S[2], S[3], bh[1], bl[1]);
#pragma unroll
            for (int mt = 0; mt < 4; ++mt) {
                f32x4 acc = qv[mt];
#pragma unroll
                for (int ks = 0; ks < 2; ++ks) { acc = MFMA16(ah[mt][ks], bh[ks], acc); acc = MFMA16(ah[mt][ks], bl[ks], acc); }
                S[mt] = acc;
            }
        }
    }
}

__device__ void phase_combine(KP p, int s, int wid0) {
    KP_FRESH(p);
    int tid_ = hw_tid(wid0); asm volatile("" : "+v"(tid_));
    const int lane = tid_ & 63, wid = tid_ >> 6, fr = lane & 15, q = lane >> 4;
    int tok0, nseq, T; slab_info(s, tok0, nseq, T);
    const int lgseg = (s == 0) ? 3 : 6, nseg = 1 << lgseg, nwork = nseq * 32 * 4;
    const float* PQ = (const float*)(p->ws + WS_PQ); float* SST = (float*)(p->ws + WS_SST);
    for (int wk = blockIdx.x * 8 + wid; wk < nwork; wk += gridDim.x * 8) {
        const int nt = wk & 3, chain = wk >> 2;
        f32x4 S[4];
#pragma unroll
        for (int mt = 0; mt < 4; ++mt) S[mt] = (f32x4){0.f, 0.f, 0.f, 0.f};
        struct CStep { bf16x8 ah[4][2]; f32x4 q[4]; };
#define CMB_LOAD(c, gg) do { const int g_ = (gg) < nseg - 1 ? (gg) : nseg - 2; const unsigned char* b_ = (const unsigned char*)(PQ + ((size_t)chain * nseg + g_) * 8192); \
        _Pragma("unroll") for (int mt = 0; mt < 4; ++mt) { (c).q[mt] = *(const f32x4*)(b_ + 16384 + ((mt * 4 + nt) * 64 + lane) * 16); \
            _Pragma("unroll") for (int ks = 0; ks < 2; ++ks) (c).ah[mt][ks] = *(const bf16x8*)(b_ + (((mt * 2 + ks) * 2 + 0) * 64 + lane) * 16); } } while (0)
        CStep c0, c1, c2;
        CMB_LOAD(c0, 0); CMB_LOAD(c1, 1); CMB_LOAD(c2, 2);
        for (int g = 0; g < nseg; ++g) {
            const size_t item = (size_t)chain * nseg + g;
#pragma unroll
            for (int mt = 0; mt < 4; ++mt) *(f32x4*)(SST + item * 4096 + ((mt * 4 + nt) * 64 + lane) * 4) = S[mt];
            if (g == nseg - 1) break;
            const CStep cc = c0; c0 = c1; c1 = c2;
            CMB_LOAD(c2, g + 3);
            bf16x8 bh[2], bl[2];
            split_frag(S[0], S[1], bh[0], bl[0]); split_frag(S[2], S[3], bh[1], bl[1]);
#pragma unroll
            for (int mt = 0; mt < 4; ++mt) {
                f32x4 acc = cc.q[mt];
#pragma unroll
                for (int ks = 0; ks < 2; ++ks) { acc = MFMA16(cc.ah[mt][ks], bh[ks], acc); acc = MFMA16(cc.ah[mt][ks], bl[ks], acc); }
                S[mt] = acc;
            }
        }
#undef CMB_LOAD
    }
}

DI void unpack8(u32x4 w, float (&f)[8]) { f[0] = lo16(w.x); f[1] = hi16(w.x); f[2] = lo16(w.y); f[3] = hi16(w.y); f[4] = lo16(w.z); f[5] = hi16(w.z); f[6] = lo16(w.w); f[7] = hi16(w.w); }
__device__ void phase_shift(KP p, int s, int wid0) {
    KP_FRESH(p);
    int tid_ = hw_tid(wid0); asm volatile("" : "+v"(tid_));
    int tok0, nseq, T; slab_info(s, tok0, nseq, T);
    const bf16_t* SB = (const bf16_t*)(p->ws + WS_TMP); bf16_t* U = (bf16_t*)(p->ws + WS_U);
    const float* mu = p->in[I_MU];
    const int gt = blockIdx.x * 512 + tid_, nt = gridDim.x * 512;
    for (int unit = gt; unit < 416 * 512; unit += nt) {
        const int cg0 = unit % 416, cg = cg0 < 384 ? cg0 : cg0 + 128, be = unit / 416, blk = be >> 1, e = be & 1, c0 = cg * 8;
        const int r = blk * 64 + (e ? 63 : 0), t = r & (T - 1);
        const bool tanh_cols = (c0 >= 4096) && (c0 < 4096 + 128);
        const bf16_t* sb = SB + (size_t)blk * 4 * 4352 + c0;
        float prev[8], cur[8], nxt[8], m[8];
        { const f32x4 a = *(const f32x4*)(mu + c0), b = *(const f32x4*)(mu + c0 + 4); m[0] = a[0]; m[1] = a[1]; m[2] = a[2]; m[3] = a[3]; m[4] = b[0]; m[5] = b[1]; m[6] = b[2]; m[7] = b[3]; }
        if (e == 0) {
            if (t > 0) unpack8(*(const u32x4*)(sb - 4352), prev); else { for (int k = 0; k < 8; ++k) prev[k] = 0.f; }
            unpack8(*(const u32x4*)sb, cur); unpack8(*(const u32x4*)(sb + 4352), nxt);
        } else {
            unpack8(*(const u32x4*)(sb + 2 * 4352), prev); unpack8(*(const u32x4*)(sb + 3 * 4352), cur);
            if (t < T - 1) unpack8(*(const u32x4*)(sb + 4 * 4352), nxt); else { for (int k = 0; k < 8; ++k) nxt[k] = 0.f; }
        }
        float o[8];
#pragma unroll
        for (int k = 0; k < 8; ++k) {
            float v = cur[k] + m[k] * (0.5f * (prev[k] + nxt[k]) - cur[k]);
            if (tanh_cols) v = 1.f - 2.f * __builtin_amdgcn_rcpf(1.f + __expf(2.f * v));
            o[k] = v;
        }
        *(u32x4*)(U + (size_t)r * UW + URW + c0) = (u32x4){cvtpk(o[0], o[1]), cvtpk(o[2], o[3]), cvtpk(o[4], o[5]), cvtpk(o[6], o[7])};
    }
    const bf16_t* SB2 = (const bf16_t*)(p->ws + WS_SB2); bf16_t* ymix = (bf16_t*)(p->ws + WS_YMIX);
    const float* cw = p->in[I_CW]; const float* cb = p->in[I_CB];
    for (int unit = gt; unit < 128 * 512; unit += nt) {
        const int cg = unit & 127, be = unit >> 7, blk = be >> 1, e = be & 1, c0 = cg * 8;
        const int r = blk * 64 + (e ? 63 : 0), t = r & (T - 1);
        const bf16_t* sb = SB2 + (size_t)blk * 6 * 1024 + c0;
        float prev[8], cur[8], nxt[8], gg[8];
        if (e == 0) {
            if (t > 0) unpack8(*(const u32x4*)(sb - 3 * 1024), prev); else { for (int k = 0; k < 8; ++k) prev[k] = 0.f; }
            unpack8(*(const u32x4*)sb, cur); unpack8(*(const u32x4*)(sb + 1024), nxt); unpack8(*(const u32x4*)(sb + 4 * 1024), gg);
        } else {
            unpack8(*(const u32x4*)(sb + 2 * 1024), prev); unpack8(*(const u32x4*)(sb + 3 * 1024), cur); unpack8(*(const u32x4*)(sb + 5 * 1024), gg);
            if (t < T - 1) unpack8(*(const u32x4*)(sb + 6 * 1024), nxt); else { for (int k = 0; k < 8; ++k) nxt[k] = 0.f; }
        }
        float o[8];
#pragma unroll
        for (int k = 0; k < 8; ++k) o[k] = gg[k] * (cw[c0 + k] * prev[k] + cw[1024 + c0 + k] * cur[k] + cw[2048 + c0 + k] * nxt[k] + cb[c0 + k]);
        *(u32x4*)(ymix + (size_t)r * 2048 + c0) = (u32x4){cvtpk(o[0], o[1]), cvtpk(o[2], o[3]), cvtpk(o[4], o[5]), cvtpk(o[6], o[7])};
    }
}

__device__ void phase_post(KP p, int s, int wid0) {
    KP_FRESH(p);
    int tid_ = hw_tid(wid0); asm volatile("" : "+v"(tid_));
    const int lane = tid_ & 63, gw = blockIdx.x * 8 + (tid_ >> 6), nw = gridDim.x * 8;
    int tok0, nseq, T; slab_info(s, tok0, nseq, T);
    const bf16_t* U = (const bf16_t*)(p->ws + WS_U);
    const bf16_t* YS = (const bf16_t*)(p->ws + WS_YS); const float* BON = (const float*)(p->ws + WS_BON);
    bf16_t* ymix = (bf16_t*)(p->ws + WS_YMIX);
    for (int unit = gw; unit < (SLAB / 16) * 2; unit += nw) {
        const int half = unit & 1, r0 = (unit >> 1) * 16, c0 = half * 512 + lane * 8, h = c0 >> 6;
        float lg[8], lb[8], muz[8];
        {
            const float* g = p->in[I_LXG]; const float* b = p->in[I_LXB]; const float* mu = p->in[I_MU];
#pragma unroll
            for (int e = 0; e < 8; ++e) { lg[e] = g[c0 + e]; lb[e] = b[c0 + e]; muz[e] = mu[3072 + c0 + e]; }
        }
        const int t0 = r0 & (T - 1);
        const bf16_t* up = U + (size_t)r0 * UW + URW + c0;
        float zprev[8], zcur[8], znxt[8];
        if (t0 > 0) unpack8(*(const u32x4*)(up - UW + 3072), zprev); else { for (int e = 0; e < 8; ++e) zprev[e] = 0.f; }
        unpack8(*(const u32x4*)(up + 3072), zcur);
        for (int ib = 0; ib < 16; ib += 4) {
            u32x4 rv[4], rz[4], ry0[4], ry1[4]; float bonv[4];
#pragma unroll
            for (int r = 0; r < 4; ++r) {
                const int i = ib + r, row = r0 + i;
                const bf16_t* ur = up + (size_t)i * UW;
                rz[r] = (t0 + i < T - 1) ? *(const u32x4*)(ur + UW + 3072) : (u32x4){0u, 0u, 0u, 0u};
                rv[r] = *(const u32x4*)(ur + 2048);
                ry0[r] = *(const u32x4*)(YS + (size_t)row * DR + c0); ry1[r] = *(const u32x4*)(YS + ((size_t)SLAB + row) * DR + c0);
                bonv[r] = BON[(size_t)row * 16 + h] + BON[((size_t)SLAB + row) * 16 + h];
            }
#pragma unroll
            for (int r = 0; r < 4; ++r) {
                const int row = r0 + ib + r;
                float vv[8], zz[8], y[8], y1[8];
                unpack8(rv[r], vv); unpack8(rz[r], znxt); unpack8(ry0[r], y); unpack8(ry1[r], y1);
#pragma unroll
                for (int e = 0; e < 8; ++e) { zz[e] = zcur[e] + muz[e] * (0.5f * (zprev[e] + znxt[e]) - zcur[e]); zprev[e] = zcur[e]; zcur[e] = znxt[e]; }
                const float bon = bonv[r];
#pragma unroll
                for (int e = 0; e < 8; ++e) y[e] += y1[e];
                float sum = 0.f;
#pragma unroll
                for (int e = 0; e < 8; ++e) sum += y[e];
                sum += shx(sum, lane, 1); sum += shx(sum, lane, 2); sum += shx(sum, lane, 4);
                const float mean = sum * (1.f / 64.f);
                float sq = 0.f;
#pragma unroll
                for (int e = 0; e < 8; ++e) { const float dl = y[e] - mean; sq += dl * dl; }
                sq += shx(sq, lane, 1); sq += shx(sq, lane, 2); sq += shx(sq, lane, 4);
                const float rstd = rsqrtf(sq * (1.f / 64.f) + 64e-5f);
                float orw[8];
#pragma unroll
                for (int e = 0; e < 8; ++e) orw[e] = ((y[e] - mean) * rstd * lg[e] + lb[e] + bon * vv[e]) * (zz[e] * fsig(zz[e]));
                *(u32x4*)(ymix + (size_t)row * 2048 + 1024 + c0) = (u32x4){cvtpk(orw[0], orw[1]), cvtpk(orw[2], orw[3]), cvtpk(orw[4], orw[5]), cvtpk(orw[6], orw[7])};
            }
        }
    }
}

__device__ void phase_lnout(KP p, int s, int wid0) {
    KP_FRESH(p);
    int tid_ = hw_tid(wid0); asm volatile("" : "+v"(tid_)); int lane = tid_ & 63; const int gw = blockIdx.x * 8 + (tid_ >> 6), nw = gridDim.x * 8;
    float* out = p->out + (size_t)s * SLAB * D;
    const float4* g4 = (const float4*)p->in[I_LG]; const float4* b4 = (const float4*)p->in[I_LB];
    for (int r0 = gw; r0 < SLAB; r0 += 4 * nw) {
        asm volatile("" : "+v"(lane));
        float4 v[4][4];
#pragma unroll
        for (int k = 0; k < 4; ++k)
#pragma unroll
            for (int i = 0; i < 4; ++i) v[k][i] = ((const float4*)(out + (size_t)(r0 + k * nw) * D))[lane + 64 * i];
#pragma unroll
        for (int k = 0; k < 4; ++k) {
            float4* xp = (float4*)(out + (size_t)(r0 + k * nw) * D);
            float sum = 0.f;
#pragma unroll
            for (int i = 0; i < 4; ++i) sum += v[k][i].x + v[k][i].y + v[k][i].z + v[k][i].w;
            const float mean = wsum(sum, lane) * (1.f / 1024.f);
            float sq = 0.f;
#pragma unroll
            for (int i = 0; i < 4; ++i) { float a = v[k][i].x - mean, b = v[k][i].y - mean, c = v[k][i].z - mean, d = v[k][i].w - mean; sq += a * a + b * b + c * c + d * d; }
            const float rstd = rsqrtf(wsum(sq, lane) * (1.f / 1024.f) + 1e-5f);
#pragma unroll
            for (int i = 0; i < 4; ++i) {
                const float4 g = g4[lane + 64 * i], b = b4[lane + 64 * i];
                float4 o; o.x = (v[k][i].x - mean) * rstd * g.x + b.x; o.y = (v[k][i].y - mean) * rstd * g.y + b.y; o.z = (v[k][i].z - mean) * rstd * g.z + b.z; o.w = (v[k][i].w - mean) * rstd * g.w + b.w;
                xp[lane + 64 * i] = o;
            }
        }
    }
}

#define LAS __attribute__((address_space(3)))
#define XB_TMO      128
#define XB_XCNT(j)  (256  + 64 * (j))
#define XB_XSUB(j)  (1280 + 64 * (j))
#define XB_XGEN(j)  (2304 + 64 * (j))
#define XB_TOP      3328
#define XB_TOPGEN   3392
#define XCD_BAR_WORDS 3456
#define XB_SPIN_CAP (1u << 18)

__device__ __forceinline__ unsigned xb_ld(unsigned* p)              { return __hip_atomic_load(p, __ATOMIC_RELAXED, __HIP_MEMORY_SCOPE_AGENT); }
__device__ __forceinline__ unsigned xb_add(unsigned* p, unsigned v) { return __hip_atomic_fetch_add(p, v, __ATOMIC_RELAXED, __HIP_MEMORY_SCOPE_AGENT); }
__device__ __forceinline__ unsigned xb_xcc_id() { return (unsigned)__builtin_amdgcn_s_getreg((3 << 11) | 20) & 0xFu; }
#define XB_SPIN(cond, bar) do { unsigned _sp = 0; while (cond) { __builtin_amdgcn_s_sleep(1); \
    if ((++_sp & 255u) == 0u) { if (xb_ld(&(bar)[XB_TMO])) break; if (_sp > XB_SPIN_CAP) { atomicAdd(&(bar)[XB_TMO], 1u); break; } } } } while (0)

struct XcdBarrier {
    unsigned* bar; unsigned x;
    volatile LAS unsigned* st;
};

__device__ __forceinline__ XcdBarrier xcd_barrier_post(unsigned* bar, volatile LAS unsigned* st) {
    XcdBarrier b; b.bar = bar; b.x = xb_xcc_id(); b.st = st;
    if (threadIdx.x == 0) (void)xb_add(&bar[XB_XCNT(b.x)], 1u);
    return b;
}
__device__ __forceinline__ void xcd_barrier_complete(unsigned* bar, unsigned x, unsigned& nloc, unsigned& nx) {
    const unsigned G = gridDim.x * gridDim.y * gridDim.z;
    unsigned sum, cnt, mine, sp = 0u;
    for (;;) {
        sum = 0u; cnt = 0u; mine = 0u;
#pragma unroll
        for (unsigned j = 0; j < 16; ++j) { const unsigned c = xb_ld(&bar[XB_XCNT(j)]); sum += c; cnt += (c > 0u) ? 1u : 0u; mine = (j == x) ? c : mine; }
        if (sum == G) break;
        __builtin_amdgcn_s_sleep(1);
        if ((++sp & 255u) == 0u) { if (xb_ld(&bar[XB_TMO])) break; if (sp > XB_SPIN_CAP) { atomicAdd(&bar[XB_TMO], 1u); break; } }
    }
    nloc = mine > 0u ? mine : 1u; nx = cnt > 0u ? cnt : 1u;
}

__device__ __forceinline__ void xcd_barrier(const XcdBarrier& b) {
    asm volatile("s_waitcnt vmcnt(0)" ::: "memory");
    __syncthreads();
    if (threadIdx.x == 0) {
        unsigned* bar = b.bar;
        __builtin_amdgcn_s_waitcnt(0);
        unsigned nloc = b.st[0], nx = b.st[1];
        if (nloc == 0u) { xcd_barrier_complete(bar, b.x, nloc, nx); b.st[0] = nloc; b.st[1] = nx; }
        const unsigned old = xb_add(&bar[XB_XSUB(b.x)], 1u);
        const unsigned gen = old / nloc;
        if (old + 1u == (gen + 1u) * nloc) {
            __builtin_amdgcn_fence(__ATOMIC_RELEASE, "agent");
            asm volatile("s_waitcnt vmcnt(0)" ::: "memory");
            const unsigned og = xb_add(&bar[XB_TOP], 1u);
            const unsigned tg = og / nx;
            if (og + 1u == (tg + 1u) * nx) xb_add(&bar[XB_TOPGEN], 1u);
            else XB_SPIN(xb_ld(&bar[XB_TOPGEN]) == tg, bar);
            __builtin_amdgcn_fence(__ATOMIC_ACQUIRE, "agent");
            xb_add(&bar[XB_XGEN(b.x)], 1u);
            asm volatile("s_waitcnt vmcnt(0)" ::: "memory");
        } else {
            XB_SPIN(xb_ld(&bar[XB_XGEN(b.x)]) == gen, bar);
            __builtin_amdgcn_fence(__ATOMIC_ACQUIRE, "agent");
            asm volatile("s_waitcnt vmcnt(0)" ::: "memory");
        }
    }
    __syncthreads();
}

#ifndef REP_SHIFT
#define REP_SHIFT 1
#endif
#ifndef REP_G2
#define REP_G2 1
#endif
#ifndef REP_SCAN
#define REP_SCAN 1
#endif
#ifndef REP_POST
#define REP_POST 1
#endif
#ifndef REP_G1
#define REP_G1 1
#endif
#define GBAR() xcd_barrier(bar)
__global__ void __launch_bounds__(512, 2) fwd_megakernel(Params p_unused) {
    extern __shared__ __attribute__((aligned(16))) unsigned char lds_raw[];
    PG8_LAS unsigned char* lds = (PG8_LAS unsigned char*)lds_raw;
    cg::grid_group grid = cg::this_grid();
    KP p = (KP)__builtin_amdgcn_kernarg_segment_ptr();
    if (threadIdx.x < 2) ((volatile LAS unsigned*)(lds + LDS_BYTES - 64))[threadIdx.x] = 0u;
    __syncthreads();
    {
        unsigned* bw = (unsigned*)(((const Params __attribute__((address_space(4)))*)__builtin_amdgcn_kernarg_segment_ptr())->ws + WS_BAR);
        if (blockIdx.x == 0) { for (int w = threadIdx.x; w < XCD_BAR_WORDS; w += 512) __hip_atomic_store(bw + w, 0u, __ATOMIC_RELAXED, __HIP_MEMORY_SCOPE_AGENT); __threadfence(); }
        grid.sync();
    }
    XcdBarrier bar = xcd_barrier_post((unsigned*)(((const Params __attribute__((address_space(4)))*)__builtin_amdgcn_kernarg_segment_ptr())->ws + WS_BAR), (volatile LAS unsigned*)(lds + LDS_BYTES - 64));
    const int wid0 = __builtin_amdgcn_readfirstlane((int)threadIdx.x >> 6);
    phase_weights(p, wid0);
    for (int s = -1; s < 3; ++s) {
        if (s == 0) GBAR();
        if (s >= 0)
        for (int rep = 0; rep < REP_G1; ++rep) {
            if (rep) GBAR();
            KP_FRESH(p);
            pg8::Gemm g; g.A = xn_buf(p, s); g.Bt = (const bf16_t*)(p->ws + WS_WIN); g.M = SLAB; g.N = NIN; g.K = D;
            pg8::StaticOrder S; S.init(g.M, g.N, gridDim.x, blockIdx.x);
            EpiU E; E.U = (bf16_t*)(p->ws + WS_U); E.TMP = (bf16_t*)(p->ws + WS_TMP); E.mu = p->in[I_MU]; E.YM = (bf16_t*)(p->ws + WS_YMIX); E.SB2 = (bf16_t*)(p->ws + WS_SB2); E.cw = p->in[I_CW]; E.cb = p->in[I_CB];
            pg8::gemm_phase<EpiU, pg8::StaticOrder, true, true>(lds, g, S, E, wid0);
        }
        {
            const int wg0 = (s >= 0 && gridDim.x > 64) ? 64 : 0;
            if (s < 2 && (int)blockIdx.x >= wg0) phase_ln(p, s + 1, wid0, wg0);
        }
        if (s < 0) continue;
        GBAR();
        for (int rep = 0; rep < REP_SHIFT; ++rep) {
        phase_shift(p, s, wid0);
        GBAR();
        }
        for (int rep = 0; rep < REP_SCAN; ++rep) {
        phase_scan<1>(p, s, lds_raw, wid0);
        GBAR();
        if (s > 0 && gridDim.x >= 128) phase_combine_ring(p, s, wid0, lds_raw); else phase_combine(p, s, wid0);
        GBAR();
        phase_scan<2>(p, s, lds_raw, wid0);
        GBAR();
        }
        for (int rep = 0; rep < REP_POST; ++rep) {
        phase_post(p, s, wid0);
        GBAR();
        }
        for (int rep = 0; rep < REP_G2; ++rep) {
            if (rep) GBAR();
            KP_FRESH(p);
            pg8::Gemm g; g.A = (const bf16_t*)(p->ws + WS_YMIX); g.Bt = (const bf16_t*)(p->ws + WS_WOUT); g.M = SLAB; g.N = D; g.K = 2048;
            pg8::StaticOrder S; S.init(g.M, g.N, gridDim.x, blockIdx.x);
            EpiOut E; E.out = p->out + (size_t)s * SLAB * D; E.x = slab_x(p, s); E.stats = (const float*)(p->ws + WS_STATS) + (size_t)s * SLAB * 2; E.eg = p->in[I_EG]; E.eb = p->in[I_EB];
            pg8::gemm_phase<EpiOut, pg8::StaticOrder, true, true>(lds, g, S, E, wid0);
        }
        GBAR();
        phase_lnout(p, s, wid0);
    }
}

extern "C" void kernel_launch(void* const* d_in, const int* in_sizes, int n_in, void* d_out, int out_size, void* d_ws, size_t ws_size, hipStream_t stream) {
    static int grid_blocks = 0;
    if (!grid_blocks) {
        int dev = 0, cus = 0, per_cu = 0;
        hipGetDevice(&dev);
        hipDeviceGetAttribute(&cus, hipDeviceAttributeMultiprocessorCount, dev);
        hipFuncSetAttribute((const void*)fwd_megakernel, hipFuncAttributeMaxDynamicSharedMemorySize, LDS_BYTES);
        hipOccupancyMaxActiveBlocksPerMultiprocessor(&per_cu, (const void*)fwd_megakernel, 512, LDS_BYTES);
        if (per_cu < 1) per_cu = 1;
        if (per_cu > 1) per_cu = 1;
        grid_blocks = cus * per_cu;
    }
    Params p{};
    for (int i = 0; i < 20; ++i) p.in[i] = (const float*)d_in[i];
    p.out = (float*)d_out; p.ws = (unsigned char*)d_ws;
    void* args[] = {&p};
    hipError_t e = hipLaunchCooperativeKernel((const void*)fwd_megakernel, dim3(grid_blocks), dim3(512), args, LDS_BYTES, stream);
    if (e != hipSuccess) fprintf(stderr, "cooperative launch failed: %s (grid %d)\n", hipGetErrorString(e), grid_blocks);
}
```

```cpp
#include <hip/hip_runtime.h>
#include <hip/hip_cooperative_groups.h>
#include <cstdio>
#include <cstdint>
namespace cg = cooperative_groups;
namespace pg8 {
#define PG8_LAS __attribute__((address_space(3)))
typedef unsigned short bf16_t;
typedef short bf16x8 __attribute__((ext_vector_type(8)));
typedef float f32x4 __attribute__((ext_vector_type(4)));
typedef unsigned u32x4 __attribute__((ext_vector_type(4)));
constexpr int BM = 256, BK = 64, HALF = 128, HTB = HALF * BK * 2  , STAGE_BYTES = 8 * HTB, NXCD = 8, WGM = 4;

__host__ __device__ __forceinline__ int lds_byte(int r, int c) { const int st = (r >> 4) * 2 + (c >> 5), rr = r & 15, cc = c & 31, ob = rr * 64 + cc * 2; return st * 1024 + (ob ^ (((ob >> 9) & 1) << 5)); }
__host__ __device__ __forceinline__ void stage_rc(int b, int& R, int& C) { const int st = b / 1024, sb = b % 1024, swz = sb ^ (((sb >> 9) & 1) << 5); R = (st >> 1) * 16 + swz / 64; C = (st & 1) * 32 + (swz % 64) / 2; }
__host__ __device__ __forceinline__ int perm32(int rho) { const int n = rho >> 4, i = rho & 15; return 8 * (i >> 2) + 4 * n + (i & 3); }

struct Unit { int pm, pn; };
struct Gemm { const bf16_t* A; const bf16_t* Bt; int M, N, K; };

struct StaticOrder {
    int nM, nN, nwg, G, c;
    __host__ __device__ void init(int M, int N, int G_, int c_) { nM = M / BM; nN = N / BM; nwg = nM * nN; G = G_; c = c_; }
    __host__ __device__ bool next(int i, Unit& u) const {
        const long L = (long)i * G + c; if (L >= nwg) return false;
        int wgid = (int)L; { const int q = nwg / NXCD, r = nwg % NXCD, xcd = wgid % NXCD, off = wgid / NXCD; wgid = (xcd < r ? xcd * (q + 1) : r * (q + 1) + (xcd - r) * q) + off; }
        const int nig = WGM * nN, gid = wgid / nig, fm = gid * WGM, gsz = (nM - fm) < WGM ? (nM - fm) : WGM;
        u.pm = fm + ((wgid % nig) % gsz); u.pn = (wgid % nig) / gsz; return true;
    }
    __device__ __forceinline__ void a_ready(const Unit&) const {}
    __device__ __forceinline__ void done(const Unit&) const {}
};

template <class Epi, class Sched, bool ALIGN_EPI = false, bool SP2 = false>
__device__ __forceinline__ void gemm_phase(PG8_LAS unsigned char* lds, const Gemm g, const Sched& S, const Epi& E, int wid0) {
    int tid_; asm volatile("v_mbcnt_lo_u32_b32 %0, -1, 0\n\tv_mbcnt_hi_u32_b32 %0, -1, %0" : "=v"(tid_)); tid_ += wid0 * 64; const int tid = tid_, wid = __builtin_amdgcn_readfirstlane(tid >> 6), lane = tid & 63, wr = wid >> 2, wc = wid & 3, fr = lane & 15, fq = lane >> 4;
    const int K = g.K, nt = K / BK;
    unsigned voffA[2], voffB[2];
#pragma unroll
    for (int i = 0; i < 2; ++i) { int R, C; stage_rc(tid * 16 + i * 8192, R, C); const int Rb = Epi::PERM ? ((R & ~31) + perm32(R & 31)) : R;
        voffA[i] = (unsigned)(R * K + C) * 2u; voffB[i] = (unsigned)(Rb * K + C) * 2u; }
    const size_t kstep = (size_t)(BK * 2);
    const size_t hstep = (size_t)HALF * K * 2;
    const size_t tstep = 2 * hstep;
    const unsigned ldsw = (unsigned)wid * 1024u;
    const int aoff = lds_byte(wr * 64 + fr, fq * 8), boff = lds_byte(wc * 32 + fr, fq * 8);
#define PG8_SA(b, h) (((b) * 2 + (h)) * HTB)
#define PG8_SB(b, h) ((4 + (b) * 2 + (h)) * HTB)
#define PG8_STAGE(bufoff, gbase, voff) do { _Pragma("unroll") for (int _i = 0; _i < 2; ++_i) \
        __builtin_amdgcn_global_load_lds((const unsigned*)((const char*)(gbase) + (voff)[_i]), (PG8_LAS unsigned*)(lds + (bufoff) + ldsw + _i * 8192), 16, 0, 0); } while (0)
#define PG8_LDA(dst, b, h) do { _Pragma("unroll") for (int m = 0; m < 4; ++m) _Pragma("unroll") for (int k = 0; k < 2; ++k) dst[m][k] = *(const PG8_LAS bf16x8*)(lds + PG8_SA(b, h) + aoff + m * 2048 + k * 1024); } while (0)
#define PG8_LDB(dst, b, h) do { _Pragma("unroll") for (int n = 0; n < 2; ++n) _Pragma("unroll") for (int k = 0; k < 2; ++k) dst[n][k] = *(const PG8_LAS bf16x8*)(lds + PG8_SB(b, h) + boff + n * 2048 + k * 1024); } while (0)
#define PG8_MMA(ai, bj, At, Bt) do { __builtin_amdgcn_s_setprio(1); _Pragma("unroll") for (int m = 0; m < 4; ++m) _Pragma("unroll") for (int n = 0; n < 2; ++n) _Pragma("unroll") for (int k = 0; k < 2; ++k) \
        acc[ai][bj][m][n] = __builtin_amdgcn_mfma_f32_16x16x32_bf16(Bt[n][k], At[m][k], acc[ai][bj][m][n], 0, 0, 0); __builtin_amdgcn_s_setprio(0); } while (0)
#define PG8_WAIT_V(n) asm volatile("s_waitcnt vmcnt(" #n ")" ::: "memory")
#define PG8_WAIT_L(n) asm volatile("s_waitcnt lgkmcnt(" #n ")" ::: "memory")
#define PG8_BAR __builtin_amdgcn_s_barrier()
#define PG8_SCHED __builtin_amdgcn_sched_barrier(0)
    Unit cur, nxt; int ui = 0;
    if (!S.next(0, cur)) return;
    f32x4 acc[2][2][4][2];
#pragma unroll
    for (int a = 0; a < 2; ++a)
#pragma unroll
        for (int b = 0; b < 2; ++b)
#pragma unroll
            for (int m = 0; m < 4; ++m)
#pragma unroll
                for (int n = 0; n < 2; ++n) acc[a][b][m][n] = (f32x4){0.f, 0.f, 0.f, 0.f};
    bf16x8 At[4][2], B0[2][2], B1[2][2];
    const char* cA = (const char*)g.A + (size_t)cur.pm * tstep; const char* cB = (const char*)g.Bt + (size_t)cur.pn * tstep;
    S.a_ready(cur);
    if constexpr (SP2) {
        PG8_STAGE(PG8_SB(0, 0), cB, voffB); PG8_STAGE(PG8_SB(0, 1), cB + hstep, voffB); PG8_STAGE(PG8_SA(0, 0), cA, voffA); PG8_STAGE(PG8_SA(0, 1), cA + hstep, voffA);
        if (wr == 1) PG8_BAR;
        PG8_WAIT_V(2); PG8_BAR;
        PG8_STAGE(PG8_SB(1, 0), cB + kstep, voffB); PG8_STAGE(PG8_SA(1, 0), cA + kstep, voffA); PG8_STAGE(PG8_SB(1, 1), cB + hstep + kstep, voffB);
        PG8_WAIT_V(6); PG8_BAR;
    } else {
        PG8_STAGE(PG8_SB(0, 0), cB, voffB); PG8_STAGE(PG8_SA(0, 0), cA, voffA); PG8_STAGE(PG8_SB(0, 1), cB + hstep, voffB); PG8_STAGE(PG8_SA(0, 1), cA + hstep, voffA);
        if (wr == 1) PG8_BAR;
        PG8_WAIT_V(4); PG8_BAR;
        PG8_STAGE(PG8_SB(1, 0), cB + kstep, voffB); PG8_STAGE(PG8_SA(1, 0), cA + kstep, voffA); PG8_STAGE(PG8_SB(1, 1), cB + hstep + kstep, voffB);
        PG8_WAIT_V(6); PG8_BAR;
    }
    for (;;) {
        const bool has_next = S.next(ui + 1, nxt);
        const char* nA = has_next ? (const char*)g.A + (size_t)nxt.pm * tstep : cA; const char* nB = has_next ? (const char*)g.Bt + (size_t)nxt.pn * tstep : cB;
        for (int t = 0; t < nt; t += 2) {
            const bool last = (t == nt - 2);
            const char* a1 = cA + (size_t)(t + 1) * kstep;
            const char* a2 = last ? nA : cA + (size_t)(t + 2) * kstep; const char* b2 = last ? nB : cB + (size_t)(t + 2) * kstep;
            const char* a3 = a2 + kstep; const char* b3 = b2 + kstep;
            if (last && has_next) S.a_ready(nxt);
            if constexpr (SP2) {
            PG8_LDB(B0, 0, 0); PG8_LDB(B1, 0, 1); PG8_SCHED; PG8_LDA(At, 0, 0); PG8_STAGE(PG8_SA(1, 1), a1 + hstep, voffA);
            PG8_WAIT_V(8); PG8_WAIT_L(0); PG8_BAR; PG8_MMA(0, 0, At, B0); PG8_MMA(0, 1, At, B1); PG8_BAR; PG8_SCHED;
            PG8_LDA(At, 0, 1); PG8_STAGE(PG8_SB(0, 0), b2, voffB); PG8_STAGE(PG8_SB(0, 1), b2 + hstep, voffB); PG8_STAGE(PG8_SA(0, 0), a2, voffA);
            PG8_WAIT_V(8); PG8_WAIT_L(0); PG8_BAR; PG8_MMA(1, 0, At, B0); PG8_MMA(1, 1, At, B1); PG8_BAR; PG8_SCHED;
            PG8_LDB(B0, 1, 0); PG8_LDB(B1, 1, 1); PG8_SCHED; PG8_LDA(At, 1, 0); PG8_STAGE(PG8_SA(0, 1), a2 + hstep, voffA);
            PG8_WAIT_V(8); PG8_WAIT_L(0); PG8_BAR; PG8_MMA(0, 0, At, B0); PG8_MMA(0, 1, At, B1); PG8_BAR; PG8_SCHED;
            PG8_LDA(At, 1, 1); PG8_STAGE(PG8_SB(1, 0), b3, voffB); PG8_STAGE(PG8_SB(1, 1), b3 + hstep, voffB); PG8_STAGE(PG8_SA(1, 0), a3, voffA);
            PG8_WAIT_V(8); PG8_WAIT_L(0); PG8_BAR; PG8_MMA(1, 0, At, B0); PG8_MMA(1, 1, At, B1); PG8_BAR; PG8_SCHED;
            } else {
            PG8_LDB(B0, 0, 0); PG8_SCHED; PG8_LDA(At, 0, 0); PG8_STAGE(PG8_SA(1, 1), a1 + hstep, voffA);
            PG8_WAIT_L(8); PG8_BAR; PG8_WAIT_L(0); PG8_MMA(0, 0, At, B0); PG8_BAR; PG8_SCHED;
            PG8_LDB(B1, 0, 1); PG8_STAGE(PG8_SB(0, 0), b2, voffB);
            PG8_BAR; PG8_WAIT_L(0); PG8_MMA(0, 1, At, B1); PG8_BAR;
            PG8_LDA(At, 0, 1); PG8_STAGE(PG8_SA(0, 0), a2, voffA);
            PG8_BAR; PG8_WAIT_L(0); PG8_MMA(1, 0, At, B0); PG8_BAR; PG8_SCHED;
            PG8_STAGE(PG8_SB(0, 1), b2 + hstep, voffB);
            PG8_WAIT_V(6); PG8_BAR; PG8_MMA(1, 1, At, B1); PG8_BAR;
            PG8_LDB(B0, 1, 0); PG8_SCHED; PG8_LDA(At, 1, 0); PG8_STAGE(PG8_SA(0, 1), a2 + hstep, voffA);
            PG8_WAIT_L(8); PG8_BAR; PG8_WAIT_L(0); PG8_MMA(0, 0, At, B0); PG8_BAR; PG8_SCHED;
            PG8_LDB(B1, 1, 1); PG8_STAGE(PG8_SB(1, 0), b3, voffB);
            PG8_BAR; PG8_WAIT_L(0); PG8_MMA(0, 1, At, B1); PG8_BAR;
            PG8_LDA(At, 1, 1); PG8_STAGE(PG8_SA(1, 0), a3, voffA);
            PG8_BAR; PG8_WAIT_L(0); PG8_MMA(1, 0, At, B0); PG8_BAR; PG8_SCHED;
            PG8_STAGE(PG8_SB(1, 1), b3 + hstep, voffB);
            PG8_WAIT_V(6); PG8_BAR; PG8_MMA(1, 1, At, B1); PG8_BAR;
            }
        }
        if constexpr (ALIGN_EPI) { if (wr == 0) PG8_BAR; }
        if constexpr (!Epi::AFTER_DRAIN) { E(acc, cur, wr, wc, fr, fq); S.done(cur); }
        if (!has_next) break;
#pragma unroll
        for (int a = 0; a < 2; ++a)
#pragma unroll
            for (int b = 0; b < 2; ++b)
#pragma unroll
                for (int m = 0; m < 4; ++m)
#pragma unroll
                    for (int n = 0; n < 2; ++n) acc[a][b][m][n] = (f32x4){0.f, 0.f, 0.f, 0.f};
        cur = nxt; cA = nA; cB = nB; ++ui;
        if constexpr (ALIGN_EPI) { if (wr == 1) PG8_BAR; }
    }
    PG8_WAIT_V(0);
    if constexpr (!ALIGN_EPI) { if (wr == 0) PG8_BAR; }
    PG8_BAR;
    if constexpr (Epi::AFTER_DRAIN) { E.fused(acc, cur, wr, wc, fr, fq, lds, wid, lane); S.done(cur); }
#undef PG8_SA
#undef PG8_SB
#undef PG8_STAGE
#undef PG8_LDA
#undef PG8_LDB
#undef PG8_MMA
#undef PG8_WAIT_V
#undef PG8_WAIT_L
#undef PG8_BAR
#undef PG8_SCHED
}
}

typedef unsigned short bf16_t;
typedef float f32x4 __attribute__((ext_vector_type(4)));
typedef unsigned u32x4 __attribute__((ext_vector_type(4)));
typedef unsigned u32x2 __attribute__((ext_vector_type(2)));

constexpr int D = 1024, NIN = 8448, DR = 1024, UW = 6400  , URW = 2048  ;
constexpr int SLAB = 16384, NTOK = 49152;
constexpr float DN_ALPHA = 1.189207115002721f;
constexpr size_t WS_WIN = 0;
constexpr size_t WS_WOUT = WS_WIN + (size_t)NIN * D * 2;
constexpr size_t WS_STATS = WS_WOUT + (size_t)D * 2048 * 2;
constexpr size_t WS_XN = WS_STATS + (size_t)NTOK * 2 * 4;
constexpr size_t WS_U = WS_XN + (size_t)SLAB * D * 2;
constexpr size_t WS_YS = WS_U + (size_t)SLAB * UW * 2;
constexpr size_t WS_BON = WS_YS + (size_t)2 * SLAB * DR * 4;
constexpr size_t WS_YMIX = WS_YS + (size_t)2 * SLAB * DR * 2;
constexpr size_t WS_SB2 = WS_YS + (size_t)16 * 1024 * 1024;
constexpr size_t WS_TMP = WS_YS;
constexpr size_t WS_PQ = WS_BON + (size_t)2 * SLAB * 16 * 4;
constexpr size_t WS_SST = WS_PQ + (size_t)2048 * 8192 * 4;
constexpr size_t WS_BAR = WS_SST + (size_t)2048 * 4096 * 4;
constexpr size_t WS_END = WS_BAR + 16384;
static_assert(WS_END <= (size_t)512 * 1024 * 1024, "ws map");
constexpr int LDS_BYTES = 147456;

struct Params { const float* in[20]; float* out; unsigned char* ws; };
typedef const Params __attribute__((address_space(4)))* KP;
#define KP_FRESH(p) asm volatile("" : "+s"(p))
__device__ __forceinline__ int hw_tid(int wid0) { int l; asm volatile("v_mbcnt_lo_u32_b32 %0, -1, 0\n\tv_mbcnt_hi_u32_b32 %0, -1, %0" : "=v"(l)); return wid0 * 64 + l; }
enum { I_XP = 0, I_XS, I_EG, I_EB, I_WIN, I_CW, I_CB, I_MU, I_W0, I_WUP, I_A0, I_AUP, I_KK, I_KA, I_RK, I_LXG, I_LXB, I_WOUT, I_LG, I_LB };

__device__ __forceinline__ float bf2f(unsigned short h) { return __uint_as_float((unsigned)h << 16); }
__device__ __forceinline__ unsigned f2bf(float f) { unsigned u = __float_as_uint(f); return (u + 0x7fffu + ((u >> 16) & 1u)) >> 16; }
__device__ __forceinline__ unsigned pk2(float lo, float hi) { return f2bf(lo) | (f2bf(hi) << 16); }
typedef __bf16 bf16x2e_t __attribute__((ext_vector_type(2)));
typedef float f32x2e __attribute__((ext_vector_type(2)));
__device__ __forceinline__ unsigned cvtpk_(float lo, float hi) { f32x2e v = {lo, hi}; bf16x2e_t b = __builtin_convertvector(v, bf16x2e_t); return __builtin_bit_cast(unsigned, b); }
__device__ __forceinline__ float shx(float v, int lane, int o) { return __int_as_float(__builtin_amdgcn_ds_bpermute((lane ^ o) << 2, __float_as_int(v))); }
__device__ __forceinline__ float wsum(float v, int lane) {
#pragma unroll
    for (int o = 32; o; o >>= 1) v += shx(v, lane, o);
    return v;
}
__device__ __forceinline__ float sigmoidf_(float x) { return 1.f / (1.f + __expf(-x)); }
__device__ __forceinline__ float siluf_(float x) { return x * sigmoidf_(x); }
__device__ __forceinline__ float rl(float v, int l) { return __int_as_float(__builtin_amdgcn_readlane(__float_as_int(v), l)); }

__device__ __forceinline__ void slab_info(int s, int& tok0, int& nseq, int& T) { if (s == 0) { tok0 = 0; nseq = 8; T = 2048; } else { tok0 = SLAB * s; nseq = 1; T = 16384; } }
__device__ __forceinline__ const float* slab_x(KP p, int s) { return s == 0 ? p->in[I_XP] : p->in[I_XS] + (size_t)(s - 1) * SLAB * D; }

__device__ __forceinline__ int orig_col(int jv) {
    if (jv >= 4096) return jv;
    const int pn = jv >> 8, bj = (jv >> 7) & 1, wc = (jv >> 5) & 3, fq = (jv >> 3) & 3, n = (jv >> 2) & 1, j = jv & 3;
    return (2 * bj + n) * 1024 + 64 * pn + 16 * wc + 4 * fq + j;
}

__device__ void phase_weights(KP p, int wid0) {
    KP_FRESH(p);
    int gt = blockIdx.x * 512 + hw_tid(wid0); asm volatile("" : "+v"(gt)); const int nt = gridDim.x * 512;
    bf16_t* win = (bf16_t*)(p->ws + WS_WIN); bf16_t* wout = (bf16_t*)(p->ws + WS_WOUT);
    const float* w_in = p->in[I_WIN]; const float* w_out = p->in[I_WOUT];
    for (int idx = gt; idx < NIN * 128; idx += nt) {
        const int jv = idx % NIN, kg = idx / NIN, oc = orig_col(jv);
        float v[8];
#pragma unroll
        for (int i = 0; i < 8; ++i) v[i] = w_in[(size_t)(kg * 8 + i) * NIN + oc];
        u32x4 w; w.x = pk2(v[0], v[1]); w.y = pk2(v[2], v[3]); w.z = pk2(v[4], v[5]); w.w = pk2(v[6], v[7]);
        *(u32x4*)(win + (size_t)jv * D + kg * 8) = w;
    }
    for (int idx = gt; idx < D * 256; idx += nt) {
        const int n = idx % D, kg = idx / D;
        float v[8];
#pragma unroll
        for (int i = 0; i < 8; ++i) v[i] = w_out[(size_t)(kg * 8 + i) * D + n];
        u32x4 w; w.x = pk2(v[0], v[1]); w.y = pk2(v[2], v[3]); w.z = pk2(v[4], v[5]); w.w = pk2(v[6], v[7]);
        *(u32x4*)(wout + (size_t)n * 2048 + kg * 8) = w;
    }
}

__device__ __forceinline__ bf16_t* xn_buf(KP p, int s) { return s == 1 ? (bf16_t*)(p->out + (size_t)2 * SLAB * D) : (bf16_t*)(p->ws + WS_XN); }
__device__ __forceinline__ void phase_ln(KP p, int s, int wid0, int wg0) {
    KP_FRESH(p);
    int tid_ = hw_tid(wid0); asm volatile("" : "+v"(tid_)); int lane = tid_ & 63; const int gw = ((int)blockIdx.x - wg0) * 8 + (tid_ >> 6), nw = ((int)gridDim.x - wg0) * 8;
    const float* x = slab_x(p, s); bf16_t* xn = xn_buf(p, s); float* stats = (float*)(p->ws + WS_STATS) + (size_t)s * SLAB * 2;
    const float4* g4 = (const float4*)p->in[I_EG]; const float4* b4 = (const float4*)p->in[I_EB];
    for (int gi = gw; gi < SLAB / 4; gi += nw) {
        const int r0 = gi * 4;
        asm volatile("" : "+v"(lane));
        float4 v[4][4];
#pragma unroll
        for (int k = 0; k < 4; ++k)
#pragma unroll
            for (int i = 0; i < 4; ++i) v[k][i] = ((const float4*)(x + (size_t)(r0 + k) * D))[lane + 64 * i];
#pragma unroll
        for (int k = 0; k < 4; ++k) {
            const int r = r0 + k;
            float sum = 0.f;
#pragma unroll
            for (int i = 0; i < 4; ++i) sum += v[k][i].x + v[k][i].y + v[k][i].z + v[k][i].w;
            const float mean = wsum(sum, lane) * (1.f / 1024.f);
            float sq = 0.f;
#pragma unroll
            for (int i = 0; i < 4; ++i) { float a = v[k][i].x - mean, b = v[k][i].y - mean, c = v[k][i].z - mean, d = v[k][i].w - mean; sq += a * a + b * b + c * c + d * d; }
            const float rstd = rsqrtf(wsum(sq, lane) * (1.f / 1024.f) + 1e-5f);
            if (lane == 0) { stats[r * 2] = mean; stats[r * 2 + 1] = rstd; }
#pragma unroll
            for (int i = 0; i < 4; ++i) {
                const float4 g = g4[lane + 64 * i], b = b4[lane + 64 * i];
                u32x2 w; w.x = cvtpk_((v[k][i].x - mean) * rstd * g.x + b.x, (v[k][i].y - mean) * rstd * g.y + b.y);
                w.y = cvtpk_((v[k][i].z - mean) * rstd * g.z + b.z, (v[k][i].w - mean) * rstd * g.w + b.w);
                *(u32x2*)(xn + (size_t)r * D + (lane + 64 * i) * 4) = w;
            }
        }
    }
}

struct EpiU {
    static constexpr bool PERM = true, AFTER_DRAIN = false;
    bf16_t* U; bf16_t* TMP; const float* mu; bf16_t* YM; bf16_t* SB2; const float* cw; const float* cb;
    __device__ __forceinline__ void operator()(const f32x4 (&acc)[2][2][4][2], const pg8::Unit& u, int wr, int wc, int fr, int fq) const {
        const int row0 = u.pm * 256 + wr * 64 + fr;
        if (u.pn < 16) {
            const int ch0 = 64 * u.pn + 16 * wc + 4 * fq;
            const f32x4 cw0 = *(const f32x4*)(cw + ch0), cw1 = *(const f32x4*)(cw + 1024 + ch0), cw2 = *(const f32x4*)(cw + 2048 + ch0), cbv = *(const f32x4*)(cb + ch0);
#define EPI_DPP(old_, src_, ctrl_) __int_as_float(__builtin_amdgcn_update_dpp(__float_as_int(old_), __float_as_int(src_), ctrl_, 0xf, 0xf, false))
#pragma unroll
            for (int ai = 0; ai < 2; ++ai) {
                f32x4 pv_[4], gv_[4];
#pragma unroll
                for (int m = 0; m < 4; ++m) {
                    const f32x4 h = acc[ai][0][m][0], B = acc[ai][0][m][1], C = acc[ai][1][m][0], z = acc[ai][1][m][1];
                    pv_[m] = C * h;
#pragma unroll
                    for (int j = 0; j < 4; ++j) gv_[m][j] = B[j] * siluf_(z[j]);
                }
                const int blk = 4 * u.pm + 2 * ai + wr;
#pragma unroll
                for (int m = 0; m < 4; ++m) {
                    float y[4];
#pragma unroll
                    for (int j = 0; j < 4; ++j) {
                        const float po = (m > 0) ? EPI_DPP(0.f, pv_[m > 0 ? m - 1 : 0][j], 0x121) : 0.f, no = (m < 3) ? EPI_DPP(0.f, pv_[m < 3 ? m + 1 : 3][j], 0x12F) : 0.f;
                        const float pr = EPI_DPP(po, pv_[m][j], 0x111), nx = EPI_DPP(no, pv_[m][j], 0x101);
                        y[j] = gv_[m][j] * (cw0[j] * pr + cw1[j] * pv_[m][j] + cw2[j] * nx + cbv[j]);
                    }
                    u32x2 wy; wy.x = cvtpk_(y[0], y[1]); wy.y = cvtpk_(y[2], y[3]);
                    *(u32x2*)(YM + (size_t)(row0 + ai * 128 + m * 16) * 2048 + ch0) = wy;
                    if ((m == 0 && fr < 2) || (m == 3 && fr >= 14)) {
                        const int w4 = (m == 0) ? fr : fr - 12;
                        u32x2 wp; wp.x = cvtpk_(pv_[m][0], pv_[m][1]); wp.y = cvtpk_(pv_[m][2], pv_[m][3]);
                        *(u32x2*)(SB2 + ((size_t)blk * 6 + w4) * 1024 + ch0) = wp;
                        if (w4 == 0 || w4 == 3) {
                            u32x2 wg; wg.x = cvtpk_(gv_[m][0], gv_[m][1]); wg.y = cvtpk_(gv_[m][2], gv_[m][3]);
                            *(u32x2*)(SB2 + ((size_t)blk * 6 + (w4 == 0 ? 4 : 5)) * 1024 + ch0) = wg;
                        }
                    }
                }
            }
#undef EPI_DPP
        } else {
            const int col0 = 256 * (u.pn - 16) + 32 * wc + 8 * fq; const bool zt = (u.pn >= 28) && (u.pn < 32);
            if (zt) {
#pragma unroll
                for (int ai = 0; ai < 2; ++ai)
#pragma unroll
                    for (int m = 0; m < 4; ++m) {
                        bf16_t* rowp = U + (size_t)(row0 + ai * 128 + m * 16) * UW + URW + col0;
#pragma unroll
                        for (int bj = 0; bj < 2; ++bj) {
                            const f32x4 v0 = acc[ai][bj][m][0], v1 = acc[ai][bj][m][1];
                            u32x4 w; w.x = cvtpk_(v0[0], v0[1]); w.y = cvtpk_(v0[2], v0[3]); w.z = cvtpk_(v1[0], v1[1]); w.w = cvtpk_(v1[2], v1[3]);
                            *(u32x4*)(rowp + bj * 128) = w;
                        }
                    }
            } else {
#define EPI_DPP(old_, src_, ctrl_) __int_as_float(__builtin_amdgcn_update_dpp(__float_as_int(old_), __float_as_int(src_), ctrl_, 0xf, 0xf, false))
#pragma unroll
                for (int ai = 0; ai < 2; ++ai)
#pragma unroll
                    for (int bj = 0; bj < 2; ++bj) {
                        const int cb = col0 + bj * 128;
                        const f32x4 mu0 = *(const f32x4*)(mu + cb), mu1 = *(const f32x4*)(mu + cb + 4);
                        const bool th = (u.pn == 32) && (bj == 0);
                        const int blk = 4 * u.pm + 2 * ai + wr;
#pragma unroll
                        for (int m = 0; m < 4; ++m) {
                            u32x4 wv;
#pragma unroll
                            for (int n = 0; n < 2; ++n) {
                                const f32x4 cur = acc[ai][bj][m][n], mun = n ? mu1 : mu0;
                                f32x4 o;
#pragma unroll
                                for (int j = 0; j < 4; ++j) {
                                    const float po = (m > 0) ? EPI_DPP(0.f, acc[ai][bj][m > 0 ? m - 1 : 0][n][j], 0x121) : 0.f;
                                    const float no = (m < 3) ? EPI_DPP(0.f, acc[ai][bj][m < 3 ? m + 1 : 3][n][j], 0x12F) : 0.f;
                                    const float pv = EPI_DPP(po, cur[j], 0x111), nx = EPI_DPP(no, cur[j], 0x101);
                                    float v = cur[j] + mun[j] * (0.5f * (pv + nx) - cur[j]);
                                    if (th) v = 1.f - 2.f * __builtin_amdgcn_rcpf(1.f + __builtin_amdgcn_exp2f(2.88539008f * v));
                                    o[j] = v;
                                }
                                if (n == 0) { wv.x = cvtpk_(o[0], o[1]); wv.y = cvtpk_(o[2], o[3]); } else { wv.z = cvtpk_(o[0], o[1]); wv.w = cvtpk_(o[2], o[3]); }
                            }
                            *(u32x4*)(U + (size_t)(row0 + ai * 128 + m * 16) * UW + URW + cb) = wv;
                            if ((m == 0 && fr < 2) || (m == 3 && fr >= 14)) {
                                const int w4 = (m == 0) ? fr : fr - 12;
                                const f32x4 v0 = acc[ai][bj][m][0], v1 = acc[ai][bj][m][1];
                                u32x4 w; w.x = cvtpk_(v0[0], v0[1]); w.y = cvtpk_(v0[2], v0[3]); w.z = cvtpk_(v1[0], v1[1]); w.w = cvtpk_(v1[2], v1[3]);
                                *(u32x4*)(TMP + ((size_t)blk * 4 + w4) * 4352 + cb) = w;
                            }
                        }
                    }
#undef EPI_DPP
            }
        }
    }
};

struct EpiOut {
    static constexpr bool PERM = true, AFTER_DRAIN = false;
    float* out; const float* x; const float* stats; const float* eg; const float* eb;
    __device__ __forceinline__ void operator()(const f32x4 (&acc)[2][2][4][2], const pg8::Unit& u, int wr, int wc, int fr, int fq) const {
        const int row0 = u.pm * 256 + wr * 64 + fr, col0 = u.pn * 256 + wc * 32 + 8 * fq;
#pragma unroll
        for (int ai = 0; ai < 2; ++ai)
#pragma unroll
            for (int m = 0; m < 4; ++m) {
                const int row = row0 + ai * 128 + m * 16;
                const float mean = stats[row * 2], rstd = stats[row * 2 + 1];
#pragma unroll
                for (int bj = 0; bj < 2; ++bj)
#pragma unroll
                    for (int n = 0; n < 2; ++n) {
                        const int c = col0 + bj * 128 + 4 * n;
                        const float4 xv = *(const float4*)(x + (size_t)row * D + c), g = *(const float4*)(eg + c), b = *(const float4*)(eb + c);
                        const f32x4 a = acc[ai][bj][m][n];
                        float4 o;
                        o.x = DN_ALPHA * ((xv.x - mean) * rstd * g.x + b.x) + a[0]; o.y = DN_ALPHA * ((xv.y - mean) * rstd * g.y + b.y) + a[1];
                        o.z = DN_ALPHA * ((xv.z - mean) * rstd * g.z + b.z) + a[2]; o.w = DN_ALPHA * ((xv.w - mean) * rstd * g.w + b.w) + a[3];
                        *(float4*)(out + (size_t)row * D + c) = o;
                    }
            }
    }
};

typedef short bf16x8 __attribute__((ext_vector_type(8)));
typedef short s16x4 __attribute__((ext_vector_type(4)));
typedef __bf16 bf16x2_t __attribute__((ext_vector_type(2)));
typedef float f32x2 __attribute__((ext_vector_type(2)));
#define MFMA16(a, b, c) __builtin_amdgcn_mfma_f32_16x16x32_bf16((a), (b), (c), 0, 0, 0)
#define DI __device__ __forceinline__
constexpr int IMG_STRIDE = 144;
constexpr int WG_FRAG = 0;
constexpr int WG_CONST = 16384;
constexpr int WV_BASE = 16384 + 2560;
constexpr int WV_BYTES = 3 * 16 * IMG_STRIDE + 256;
static_assert(WV_BASE + 8 * WV_BYTES <= LDS_BYTES, "scan LDS map");

DI unsigned cvtpk(float lo, float hi) { f32x2 v = {lo, hi}; bf16x2_t b = __builtin_convertvector(v, bf16x2_t); return __builtin_bit_cast(unsigned, b); }
DI bf16x8 mkfrag(unsigned a, unsigned b, unsigned c, unsigned d) { u32x4 w = {a, b, c, d}; return __builtin_bit_cast(bf16x8, w); }
DI bf16x8 frag_f4(f32x4 a, f32x4 b) { return mkfrag(cvtpk(a[0], a[1]), cvtpk(a[2], a[3]), cvtpk(b[0], b[1]), cvtpk(b[2], b[3])); }
DI float bperm(float v, int srclane) { return __int_as_float(__builtin_amdgcn_ds_bpermute(srclane << 2, __float_as_int(v))); }
DI float lo16(unsigned w) { return __uint_as_float(w << 16); }
DI float hi16(unsigned w) { return __uint_as_float(w & 0xffff0000u); }
template <int CTRL> DI float dpp0(float x) { return __int_as_float(__builtin_amdgcn_update_dpp(0, __float_as_int(x), CTRL, 0xf, 0xf, true)); }
template <int CTRL> DI float dpp1(float x) { return __int_as_float(__builtin_amdgcn_update_dpp(0x3f800000, __float_as_int(x), CTRL, 0xf, 0xf, false)); }
DI float fsig(float x) { return __builtin_amdgcn_rcpf(1.f + __expf(-x)); }
DI f32x4 ld4(const bf16_t* ur) { const u32x2 c = *(const u32x2*)ur; return (f32x4){lo16(c.x), hi16(c.x), lo16(c.y), hi16(c.y)}; }

DI void split_frag(f32x4 a, f32x4 b, bf16x8& hi, bf16x8& lo) {
    f32x4 ah, bh;
    unsigned w[4] = {cvtpk(a[0], a[1]), cvtpk(a[2], a[3]), cvtpk(b[0], b[1]), cvtpk(b[2], b[3])};
    ah[0] = lo16(w[0]); ah[1] = hi16(w[0]); ah[2] = lo16(w[1]); ah[3] = hi16(w[1]); bh[0] = lo16(w[2]); bh[1] = hi16(w[2]); bh[2] = lo16(w[3]); bh[3] = hi16(w[3]);
    hi = mkfrag(w[0], w[1], w[2], w[3]); lo = frag_f4(a - ah, b - bh);
}
struct ChunkIn { u32x2 k[4], r[4], v[4]; bf16x8 tl[2], la[2]; };
template <int PASS> DI void chunk_load(ChunkIn& c, const bf16_t* ur, int h, int d, int q) {
#pragma unroll
    for (int n = 0; n < 4; ++n) {
        c.k[n] = *(const u32x2*)(ur + 1024 + h * 64 + 16 * n + 4 * q);
        if (PASS == 2) { c.v[n] = *(const u32x2*)(ur + 2048 + h * 64 + 16 * n + 4 * q); c.r[n] = *(const u32x2*)(ur + h * 64 + 16 * n + 4 * q); }
    }
#pragma unroll
    for (int ks = 0; ks < 2; ++ks) { const bf16_t* ul = ur + 4096 + d * 64 + 32 * ks + 8 * q; c.tl[ks] = *(const bf16x8*)ul; c.la[ks] = *(const bf16x8*)(ul + 128); }
}
DI f32x4 up4(u32x2 c) { return (f32x4){lo16(c.x), hi16(c.x), lo16(c.y), hi16(c.y)}; }
template <int PASS>
__device__ void phase_scan(KP p, int s, unsigned char* ldsg, int wid0) {
    KP_FRESH(p);
    const int wid = wid0;
    int tok0, nseq, T; slab_info(s, tok0, nseq, T);
    const int LS = 256, lgseg = (s == 0) ? 3 : 6, nseg = 1 << lgseg, nblk = (nseq * 32 << lgseg) >> 3;
    const bf16_t* U = (const bf16_t*)(p->ws + WS_U);
    bf16_t* YS = (bf16_t*)(p->ws + WS_YS); float* BON = (float*)(p->ws + WS_BON);
    float* PQ = (float*)(p->ws + WS_PQ); const float* SST = (const float*)(p->ws + WS_SST);
    float* cst = (float*)(ldsg + WG_CONST);
    const int wo = WV_BASE + wid * WV_BYTES;
    for (int ib = blockIdx.x; ib < nblk; ib += gridDim.x) {
        const int item = ib * 8 + wid, g = item & (nseg - 1), chain = item >> lgseg, h = chain & 15, d = (chain >> 4) & 1, b = chain >> 5;
        const int tid = hw_tid(wid0), lane = tid & 63, fr = lane & 15, q = lane >> 4;
        __syncthreads();
        if (tid < 64) {
            const float* mu = p->in[I_MU]; const int c = h * 64 + tid;
            cst[tid] = mu[c]; cst[64 + tid] = mu[1024 + c]; cst[128 + tid] = mu[2048 + c];
            cst[192 + tid] = -1.44269504f * p->in[I_W0][d * 1024 + c]; cst[256 + tid] = -1.44269504f * p->in[I_A0][d * 1024 + c];
            cst[320 + tid] = p->in[I_KK][c]; cst[384 + tid] = p->in[I_KA][c]; cst[448 + tid] = p->in[I_RK][c];
            cst[512 + tid] = mu[4096 + d * 64 + tid]; cst[576 + tid] = mu[4096 + 128 + d * 64 + tid];
        }
        for (int e = tid; e < 1024; e += 512) {
            const int l2 = e & 63, ks = (e >> 6) & 1, mt = (e >> 7) & 3, mat = e >> 9, fr2 = l2 & 15, q2 = l2 >> 4;
            const float* src = (mat ? p->in[I_AUP] : p->in[I_WUP]) + ((size_t)d * 64 + 32 * ks + 8 * q2) * 1024 + h * 64 + 16 * mt + fr2;
            float v8[8];
#pragma unroll
            for (int jj = 0; jj < 8; ++jj) v8[jj] = -1.44269504f * src[(size_t)jj * 1024];
            u32x4 w = {cvtpk(v8[0], v8[1]), cvtpk(v8[2], v8[3]), cvtpk(v8[4], v8[5]), cvtpk(v8[6], v8[7])};
            *(u32x4*)(ldsg + WG_FRAG + e * 16) = w;
        }
        __syncthreads();
        f32x4 St[4][4];
        f32x4 Pa[PASS == 1 ? 4 : 1][PASS == 1 ? 4 : 1];
        int l3 = lane; asm volatile("" : "+v"(l3));
        const float* sstl = SST + (size_t)item * 4096 + l3 * 4;
#pragma unroll
        for (int mt = 0; mt < 4; ++mt)
#pragma unroll
            for (int nt = 0; nt < 4; ++nt) {
                if (PASS == 1) {
#pragma unroll
                    for (int j = 0; j < 4; ++j) { St[mt][nt][j] = 0.f; Pa[PASS == 1 ? mt : 0][PASS == 1 ? nt : 0][j] = (16 * mt + 4 * q + j == 16 * nt + fr) ? 1.f : 0.f; }
                } else {
                    St[mt][nt] = *(const f32x4*)(sstl + (mt * 4 + nt) * 256);
                }
            }
        ChunkIn cin;
        { const int p0 = g * LS, t0 = d ? T - 1 - (p0 + fr) : p0 + fr; chunk_load<PASS>(cin, U + (size_t)(b * T + t0) * UW + URW, h, d, q); }
        for (int ck = 0; ck < LS / 16; ++ck) {
            const int pos0 = g * LS + ck * 16;
            const int lane_c = hw_tid(wid0) & 63;
            const int lane = lane_c, fr = lane_c & 15, q = lane_c >> 4;
            const int ti = d ? T - 1 - (pos0 + fr) : pos0 + fr, row = b * T + ti;
            ChunkIn cc = cin;
            if (PASS == 1) {
#pragma unroll
                for (int n = 0; n < 4; ++n) cc.v[n] = *(const u32x2*)(U + (size_t)row * UW + URW + 2048 + h * 64 + 16 * n + 4 * q);
            }
            {
                const int pn = g * LS + (ck + 1 < LS / 16 ? ck + 1 : ck) * 16, tn = d ? T - 1 - (pn + fr) : pn + fr;
                chunk_load<PASS>(cin, U + (size_t)(b * T + tn) * UW + URW, h, d, q);
            }
            const int lq16 = 16 * q, ll16 = 16 * lane, limg = fr * IMG_STRIDE + 8 * q, ltr = (4 * q + (fr >> 2)) * IMG_STRIDE + 8 * (fr & 3);
            f32x4 ow[4], oa[4];
            {
                const bf16x8 tlf[2] = {cc.tl[0], cc.tl[1]}, laf[2] = {cc.la[0], cc.la[1]};
#pragma unroll
                for (int mt = 0; mt < 4; ++mt) {
                    const bf16x8 w0f = *(const bf16x8*)(ldsg + WG_FRAG + ((0 * 4 + mt) * 2 + 0) * 1024 + ll16), w1f = *(const bf16x8*)(ldsg + WG_FRAG + ((0 * 4 + mt) * 2 + 1) * 1024 + ll16);
                    const bf16x8 a0f = *(const bf16x8*)(ldsg + WG_FRAG + ((1 * 4 + mt) * 2 + 0) * 1024 + ll16), a1f = *(const bf16x8*)(ldsg + WG_FRAG + ((1 * 4 + mt) * 2 + 1) * 1024 + ll16);
                    f32x4 z = {0.f, 0.f, 0.f, 0.f};
                    ow[mt] = MFMA16(w1f, tlf[1], MFMA16(w0f, tlf[0], z));
                    oa[mt] = MFMA16(a1f, laf[1], MFMA16(a0f, laf[0], z));
                }
            }
            f32x4 km[4]; f32x4 ss4 = {0.f, 0.f, 0.f, 0.f};
#pragma unroll
            for (int n = 0; n < 4; ++n) {
                km[n] = up4(cc.k[n]);
                const f32x4 kr = km[n] * *(const f32x4*)(ldsg + WG_CONST + (320 + 16 * n) * 4 + lq16);
                ss4 += kr * kr;
            }
            float ss = (ss4[0] + ss4[1]) + (ss4[2] + ss4[3]);
            ss += bperm(ss, lane ^ 16); ss += bperm(ss, lane ^ 32);
            const float kinv = 1.f / fmaxf(sqrtf(ss), 1e-12f);
            u32x2 kapP[4], ktP[4], btP[4], rtP[4]; f32x4 bon4 = {0.f, 0.f, 0.f, 0.f};
#pragma unroll
            for (int n = 0; n < 4; ++n) {
                const f32x4 w0v = *(const f32x4*)(ldsg + WG_CONST + (192 + 16 * n) * 4 + lq16), a0v = *(const f32x4*)(ldsg + WG_CONST + (256 + 16 * n) * 4 + lq16), kkw = *(const f32x4*)(ldsg + WG_CONST + (320 + 16 * n) * 4 + lq16), kav = *(const f32x4*)(ldsg + WG_CONST + (384 + 16 * n) * 4 + lq16);
                const f32x4 tw = w0v + ow[n], ta = a0v + oa[n];
                f32x4 ew, ea;
#pragma unroll
                for (int j = 0; j < 4; ++j) { ew[j] = __builtin_amdgcn_exp2f(tw[j]); ea[j] = __builtin_amdgcn_exp2f(ta[j]); }
                const f32x4 dw = ew + 1.f, da = ea + 1.f;
                f32x4 sw, av;
#pragma unroll
                for (int j = 0; j < 4; ++j) { sw[j] = __builtin_amdgcn_rcpf(dw[j]); av[j] = __builtin_amdgcn_rcpf(da[j]); }
                const f32x4 lw2 = sw * -0.87503877f;
                f32x4 L, Lm, gmv, emL;
#pragma unroll
                for (int j = 0; j < 4; ++j) {
                    float x = __builtin_amdgcn_exp2f(lw2[j]);
                    x *= dpp1<0x111>(x); x *= dpp1<0x112>(x); x *= dpp1<0x114>(x); x *= dpp1<0x118>(x);
                    L[j] = x; Lm[j] = dpp1<0x111>(x); gmv[j] = dpp0<0x121>(x);
                    emL[j] = __builtin_amdgcn_rcpf(x);
                }
                const f32x4 kk = km[n] * kkw * kinv;
                const f32x4 kd = km[n] * ((av - 1.f) * kav + 1.f);
                const f32x4 kap = kk * Lm, bt = kk * av * emL, kt = kd * emL;
                if (fr == 0) *(f32x4*)(ldsg + wo + 48 * IMG_STRIDE + 64 * n + lq16) = gmv;
                kapP[n] = (u32x2){cvtpk(kap[0], kap[1]), cvtpk(kap[2], kap[3])};
                ktP[n] = (u32x2){cvtpk(kt[0], kt[1]), cvtpk(kt[2], kt[3])};
                btP[n] = (u32x2){cvtpk(bt[0], bt[1]), cvtpk(bt[2], bt[3])};
                *(u32x2*)(ldsg + wo + 16 * IMG_STRIDE + 32 * n + limg) = ktP[n];
                *(u32x2*)(ldsg + wo + 32 * IMG_STRIDE + 32 * n + limg) = btP[n];
                if (PASS == 2) {
                    const f32x4 rm = up4(cc.r[n]), rk = *(const f32x4*)(ldsg + WG_CONST + (448 + 16 * n) * 4 + lq16);
                    const f32x4 rt = rm * L;
                    rtP[n] = (u32x2){cvtpk(rt[0], rt[1]), cvtpk(rt[2], rt[3])};
                    bon4 += rm * kd * rk;
                }
                *(u32x2*)(ldsg + wo + 32 * n + limg) = cc.v[n];
            }
            if (PASS == 2) {
                float bon = (bon4[0] + bon4[1]) + (bon4[2] + bon4[3]);
                bon += bperm(bon, lane ^ 16); bon += bperm(bon, lane ^ 32);
                if (q == 0) BON[((size_t)d * SLAB + row) * 16 + h] = 0.5f * bon;
            }
            const bf16x8 kapF0 = mkfrag(kapP[0].x, kapP[0].y, kapP[1].x, kapP[1].y), kapF1 = mkfrag(kapP[2].x, kapP[2].y, kapP[3].x, kapP[3].y);
            bf16x8 akkA, tA, aryA;
            {
                const bf16x8 ktF0 = mkfrag(ktP[0].x, ktP[0].y, ktP[1].x, ktP[1].y), ktF1 = mkfrag(ktP[2].x, ktP[2].y, ktP[3].x, ktP[3].y);
                const bf16x8 btF0 = mkfrag(btP[0].x, btP[0].y, btP[1].x, btP[1].y), btF1 = mkfrag(btP[2].x, btP[2].y, btP[3].x, btP[3].y);
                const f32x4 z = {0.f, 0.f, 0.f, 0.f};
                f32x4 akk = MFMA16(ktF1, kapF1, MFMA16(ktF0, kapF0, z));
                f32x4 nn = MFMA16(kapF1, btF1, MFMA16(kapF0, btF0, z));
                f32x4 na = MFMA16(btF1, kapF1, MFMA16(btF0, kapF0, z));
                f32x4 idv;
#pragma unroll
                for (int jj = 0; jj < 4; ++jj) {
                    akk[jj] = (4 * q + jj < fr) ? akk[jj] : 0.f; nn[jj] = (fr < 4 * q + jj) ? nn[jj] : 0.f; na[jj] = (4 * q + jj < fr) ? na[jj] : 0.f;
                    idv[jj] = (4 * q + jj == fr) ? 1.f : 0.f;
                }
                akkA = mkfrag(cvtpk(akk[0], akk[1]), cvtpk(akk[2], akk[3]), 0u, 0u);
                if (PASS == 2) {
                    const bf16x8 rtF0 = mkfrag(rtP[0].x, rtP[0].y, rtP[1].x, rtP[1].y), rtF1 = mkfrag(rtP[2].x, rtP[2].y, rtP[3].x, rtP[3].y);
                    f32x4 ark = MFMA16(ktF1, rtF1, MFMA16(ktF0, rtF0, z));
                    f32x4 arb = MFMA16(btF1, rtF1, MFMA16(btF0, rtF0, z));
#pragma unroll
                    for (int jj = 0; jj < 4; ++jj) { ark[jj] = (4 * q + jj <= fr) ? ark[jj] : 0.f; arb[jj] = (4 * q + jj <= fr) ? arb[jj] : 0.f; }
                    aryA = mkfrag(cvtpk(ark[0], ark[1]), cvtpk(ark[2], ark[3]), cvtpk(arb[0], arb[1]), cvtpk(arb[2], arb[3]));
                }
#define TF(x) mkfrag(cvtpk((x)[0], (x)[1]), cvtpk((x)[2], (x)[3]), 0u, 0u)
                const bf16x8 nF = TF(nn), aF = TF(na);
                const f32x4 n2 = MFMA16(aF, nF, z), a2 = MFMA16(nF, aF, z);
                const bf16x8 n2F = TF(n2), a2F = TF(a2);
                const f32x4 n4 = MFMA16(a2F, n2F, z), a4 = MFMA16(n2F, a2F, z);
                const bf16x8 n4F = TF(n4), a4F = TF(a4);
                const f32x4 n8 = MFMA16(a4F, n4F, z);
                const f32x4 t21 = MFMA16(n2F, aF, z);
                f32x4 R = idv - na + a2 - t21;
                R = MFMA16(n4F, TF(R), R);
                R = MFMA16(TF(n8), TF(R), R);
                tA = TF(R);
#undef TF
            }
            s16x4 Vc[4], Kc[4], Bc[4];
            {
                typedef s16x4 __attribute__((address_space(3)))* lp;
#pragma unroll
                for (int t4 = 0; t4 < 4; ++t4) {
                    Vc[t4] = __builtin_amdgcn_ds_read_tr16_b64_v4i16((lp)(ldsg + wo + ltr + 32 * t4));
                    Kc[t4] = __builtin_amdgcn_ds_read_tr16_b64_v4i16((lp)(ldsg + wo + 16 * IMG_STRIDE + ltr + 32 * t4));
                    Bc[t4] = __builtin_amdgcn_ds_read_tr16_b64_v4i16((lp)(ldsg + wo + 32 * IMG_STRIDE + ltr + 32 * t4));
                }
            }
            bf16x8 kbA[4];
#pragma unroll
            for (int mt = 0; mt < 4; ++mt) kbA[mt] = __builtin_shufflevector(Kc[mt], Bc[mt], 0, 1, 2, 3, 4, 5, 6, 7);
#pragma unroll
            for (int nt = 0; nt < 4; ++nt) {
                const f32x4 z = {0.f, 0.f, 0.f, 0.f};
                const bf16x8 stf0 = frag_f4(St[0][nt], St[1][nt]), stf1 = frag_f4(St[2][nt], St[3][nt]);
                const u32x2 vcu = __builtin_bit_cast(u32x2, Vc[nt]);
                f32x4 X = MFMA16(kapF1, stf1, MFMA16(kapF0, stf0, z));
                X = MFMA16(akkA, mkfrag(vcu.x, vcu.y, 0u, 0u), X);
                const f32x4 Uu = MFMA16(tA, mkfrag(cvtpk(X[0], X[1]), cvtpk(X[2], X[3]), 0u, 0u), z);
                const bf16x8 bvu = mkfrag(vcu.x, vcu.y, cvtpk(-Uu[0], -Uu[1]), cvtpk(-Uu[2], -Uu[3]));
                if (PASS == 2) {
                    const bf16x8 rtF0 = mkfrag(rtP[0].x, rtP[0].y, rtP[1].x, rtP[1].y), rtF1 = mkfrag(rtP[2].x, rtP[2].y, rtP[3].x, rtP[3].y);
                    f32x4 Y = MFMA16(rtF1, stf1, MFMA16(rtF0, stf0, z));
                    Y = MFMA16(aryA, bvu, Y);
#pragma unroll
                    for (int jj = 0; jj < 4; ++jj) {
                        const int i = 4 * q + jj, t2 = d ? T - 1 - (pos0 + i) : pos0 + i;
                        YS[((size_t)d * SLAB + b * T + t2) * DR + h * 64 + 16 * nt + fr] = (bf16_t)(cvtpk(Y[jj], 0.f) & 0xffffu);
                    }
                }
#pragma unroll
                for (int mt = 0; mt < 4; ++mt) St[mt][nt] = MFMA16(kbA[mt], bvu, St[mt][nt]) * *(const f32x4*)(ldsg + wo + 48 * IMG_STRIDE + 64 * mt + lq16);
            }
            if (PASS == 1) {
#pragma unroll
                for (int ct = 0; ct < 4; ++ct) {
                    const f32x4 z = {0.f, 0.f, 0.f, 0.f};
                    const bf16x8 pf0 = frag_f4(Pa[0][PASS == 1 ? ct : 0], Pa[PASS == 1 ? 1 : 0][PASS == 1 ? ct : 0]), pf1 = frag_f4(Pa[PASS == 1 ? 2 : 0][PASS == 1 ? ct : 0], Pa[PASS == 1 ? 3 : 0][PASS == 1 ? ct : 0]);
                    const f32x4 X = MFMA16(kapF1, pf1, MFMA16(kapF0, pf0, z));
                    const f32x4 Uu = MFMA16(tA, mkfrag(cvtpk(X[0], X[1]), cvtpk(X[2], X[3]), 0u, 0u), z);
                    const bf16x8 bvu = mkfrag(0u, 0u, cvtpk(-Uu[0], -Uu[1]), cvtpk(-Uu[2], -Uu[3]));
#pragma unroll
                    for (int mt = 0; mt < 4; ++mt) Pa[PASS == 1 ? mt : 0][PASS == 1 ? ct : 0] = MFMA16(kbA[mt], bvu, Pa[PASS == 1 ? mt : 0][PASS == 1 ? ct : 0]) * *(const f32x4*)(ldsg + wo + 48 * IMG_STRIDE + 64 * mt + lq16);
                }
            }
        }
        if (PASS == 1) {
            const int l2 = hw_tid(wid0) & 63, fr2 = l2 & 15, q2 = l2 >> 4;
            unsigned char* pqb = (unsigned char*)(PQ + (size_t)item * 8192);
            float* tl = (float*)(ldsg + wo);
#pragma unroll
            for (int mt = 0; mt < 4; ++mt)
#pragma unroll
                for (int ks = 0; ks < 2; ++ks) {
#pragma unroll
                    for (int e = 0; e < 2; ++e)
#pragma unroll
                        for (int j2 = 0; j2 < 4; ++j2) tl[e * 256 + (4 * q2 + j2) * 16 + fr2] = Pa[PASS == 1 ? mt : 0][PASS == 1 ? 2 * ks + e : 0][j2];
                    __builtin_amdgcn_wave_barrier();
                    const f32x4 pa = *(const f32x4*)(tl + fr2 * 16 + 4 * q2), pb = *(const f32x4*)(tl + 256 + fr2 * 16 + 4 * q2);
                    __builtin_amdgcn_wave_barrier();
                    bf16x8 ah, al; split_frag(pa, pb, ah, al);
                    *(bf16x8*)(pqb + (((mt * 2 + ks) * 2 + 0) * 64 + l2) * 16) = ah;
                }
            float* pq = PQ + (size_t)item * 8192 + 4096 + l2 * 4;
#pragma unroll
            for (int mt = 0; mt < 4; ++mt)
#pragma unroll
                for (int nt = 0; nt < 4; ++nt) *(f32x4*)(pq + (mt * 4 + nt) * 256) = St[mt][nt];
        }
    }
}

constexpr int CR_SLOTS = 10, CR_SLOT_BYTES = 12288, CR_FLAGS = CR_SLOTS * CR_SLOT_BYTES;
__device__ __forceinline__ void phase_combine_ring(KP p, int s, int wid0, unsigned char* ldsg) {
    KP_FRESH(p);
    int tid_ = hw_tid(wid0); asm volatile("" : "+v"(tid_));
    const int lane = tid_ & 63, wid = wid0;
    const int nseg = 64, nsteps = nseg - 1;
    const float* PQ = (const float*)(p->ws + WS_PQ); float* SST = (float*)(p->ws + WS_SST);
    volatile unsigned* flags = (volatile unsigned*)(ldsg + CR_FLAGS);
    __syncthreads();
    if (tid_ < CR_SLOTS) flags[tid_] = 0u;
    __syncthreads();
    if ((int)blockIdx.x >= 128) return;
    const int nt = blockIdx.x & 3, chain = blockIdx.x >> 2;
    if (wid != 0) {
        u32x4 ra[12], rb[12];
#define CR_ISSUE(r, gg) do { const unsigned char* b_ = (const unsigned char*)(PQ + ((size_t)chain * nseg + (gg)) * 8192); \
        _Pragma("unroll") for (int f = 0; f < 8; ++f) (r)[f] = *(const u32x4*)(b_ + ((f * 2 + 0) * 64 + lane) * 16); \
        _Pragma("unroll") for (int mt = 0; mt < 4; ++mt) (r)[8 + mt] = *(const u32x4*)(b_ + 16384 + ((mt * 4 + nt) * 64 + lane) * 16); } while (0)
#define CR_PUT(r, gg) do { const int slot_ = (gg) % CR_SLOTS; const unsigned gen_ = 2u * (unsigned)((gg) / CR_SLOTS); unsigned sp_ = 0;     \
        while (flags[slot_] != gen_ && ++sp_ < (1u << 20)) __builtin_amdgcn_s_sleep(1); \
        _Pragma("unroll") for (int f = 0; f < 12; ++f) *(u32x4*)(ldsg + slot_ * CR_SLOT_BYTES + f * 1024 + lane * 16) = (r)[f]; \
        asm volatile("s_waitcnt lgkmcnt(0)" ::: "memory"); __builtin_amdgcn_wave_barrier(); \
        if (lane == 0) flags[slot_] = gen_ + 1u; } while (0)
        int g = wid - 1;
        if (g < nsteps) CR_ISSUE(ra, g);
        for (; g < nsteps; g += 14) {
            if (g + 7 < nsteps) CR_ISSUE(rb, g + 7);
            CR_PUT(ra, g);
            if (g + 14 < nsteps) CR_ISSUE(ra, g + 14);
            if (g + 7 < nsteps) CR_PUT(rb, g + 7);
        }
#undef CR_ISSUE
#undef CR_PUT
    } else {
        f32x4 S[4];
#pragma unroll
        for (int mt = 0; mt < 4; ++mt) S[mt] = (f32x4){0.f, 0.f, 0.f, 0.f};
        for (int g = 0; g < nseg; ++g) {
            const size_t item = (size_t)chain * nseg + g;
#pragma unroll
            for (int mt = 0; mt < 4; ++mt) *(f32x4*)(SST + item * 4096 + ((mt * 4 + nt) * 64 + lane) * 4) = S[mt];
            if (g == nsteps) break;
            const int slot = g % CR_SLOTS; const unsigned gen = 2u * (unsigned)(g / CR_SLOTS); unsigned sp = 0;
            while (flags[slot] != gen + 1u && ++sp < (1u << 20)) __builtin_amdgcn_s_sleep(1);
            bf16x8 ah[4][2]; f32x4 qv[4];
#pragma unroll
            for (int mt = 0; mt < 4; ++mt) {
                qv[mt] = *(const f32x4*)(ldsg + slot * CR_SLOT_BYTES + (8 + mt) * 1024 + lane * 16);
#pragma unroll
                for (int ks = 0; ks < 2; ++ks) ah[mt][ks] = *(const bf16x8*)(ldsg + slot * CR_SLOT_BYTES + (mt * 2 + ks) * 1024 + lane * 16);
            }
            asm volatile("s_waitcnt lgkmcnt(0)" ::: "memory"); __builtin_amdgcn_wave_barrier();
            if (lane == 0) flags[slot] = gen + 2u;
            bf16x8 bh[2], bl[2];
            split_frag(S[0], S[1], bh[0], bl[0]); split_frag(S[2], S[3], bh[1], bl[1]);
#pragma unroll
            for (int mt = 0; mt < 4; ++mt) {
                f32x4 acc = qv[mt];
#pragma unroll
                for (int ks = 0; ks < 2; ++ks) { acc = MFMA16(ah[mt][ks], bh[ks], acc); acc = MFMA16(ah[mt][ks], bl[ks], acc); }
                S[mt] = acc;
            }
        }
    }
}

__device__ void phase_combine(KP p, int s, int wid0) {
    KP_FRESH(p);
    int tid_ = hw_tid(wid0); asm volatile("" : "+v"(tid_));
    const int lane = tid_ & 63, wid = tid_ >> 6, fr = lane & 15, q = lane >> 4;
    int tok0, nseq, T; slab_info(s, tok0, nseq, T);
    const int lgseg = (s == 0) ? 3 : 6, nseg = 1 << lgseg, nwork = nseq * 32 * 4;
    const float* PQ = (const float*)(p->ws + WS_PQ); float* SST = (float*)(p->ws + WS_SST);
    for (int wk = blockIdx.x * 8 + wid; wk < nwork; wk += gridDim.x * 8) {
        const int nt = wk & 3, chain = wk >> 2;
        f32x4 S[4];
#pragma unroll
        for (int mt = 0; mt < 4; ++mt) S[mt] = (f32x4){0.f, 0.f, 0.f, 0.f};
        struct CStep { bf16x8 ah[4][2]; f32x4 q[4]; };
#define CMB_LOAD(c, gg) do { const int g_ = (gg) < nseg - 1 ? (gg) : nseg - 2; const unsigned char* b_ = (const unsigned char*)(PQ + ((size_t)chain * nseg + g_) * 8192); \
        _Pragma("unroll") for (int mt = 0; mt < 4; ++mt) { (c).q[mt] = *(const f32x4*)(b_ + 16384 + ((mt * 4 + nt) * 64 + lane) * 16); \
            _Pragma("unroll") for (int ks = 0; ks < 2; ++ks) (c).ah[mt][ks] = *(const bf16x8*)(b_ + (((mt * 2 + ks) * 2 + 0) * 64 + lane) * 16); } } while (0)
        CStep c0, c1, c2;
        CMB_LOAD(c0, 0); CMB_LOAD(c1, 1); CMB_LOAD(c2, 2);
        for (int g = 0; g < nseg; ++g) {
            const size_t item = (size_t)chain * nseg + g;
#pragma unroll
            for (int mt = 0; mt < 4; ++mt) *(f32x4*)(SST + item * 4096 + ((mt * 4 + nt) * 64 + lane) * 4) = S[mt];
            if (g == nseg - 1) break;
            const CStep cc = c0; c0 = c1; c1 = c2;
            CMB_LOAD(c2, g + 3);
            bf16x8 bh[2], bl[2];
            split_frag(S[0], S[1], bh[0], bl[0]); split_frag(S[2], S[3], bh[1], bl[1]);
#pragma unroll
            for (int mt = 0; mt < 4; ++mt) {
                f32x4 acc = cc.q[mt];
#pragma unroll
                for (int ks = 0; ks < 2; ++ks) { acc = MFMA16(cc.ah[mt][ks], bh[ks], acc); acc = MFMA16(cc.ah[mt][ks], bl[ks], acc); }
                S[mt] = acc;
            }
        }
#undef CMB_LOAD
    }
}

DI void unpack8(u32x4 w, float (&f)[8]) { f[0] = lo16(w.x); f[1] = hi16(w.x); f[2] = lo16(w.y); f[3] = hi16(w.y); f[4] = lo16(w.z); f[5] = hi16(w.z); f[6] = lo16(w.w); f[7] = hi16(w.w); }
__device__ void phase_shift(KP p, int s, int wid0) {
    KP_FRESH(p);
    int tid_ = hw_tid(wid0); asm volatile("" : "+v"(tid_));
    int tok0, nseq, T; slab_info(s, tok0, nseq, T);
    const bf16_t* SB = (const bf16_t*)(p->ws + WS_TMP); bf16_t* U = (bf16_t*)(p->ws + WS_U);
    const float* mu = p->in[I_MU];
    const int gt = blockIdx.x * 512 + tid_, nt = gridDim.x * 512;
    for (int unit = gt; unit < 416 * 512; unit += nt) {
        const int cg0 = unit % 416, cg = cg0 < 384 ? cg0 : cg0 + 128, be = unit / 416, blk = be >> 1, e = be & 1, c0 = cg * 8;
        const int r = blk * 64 + (e ? 63 : 0), t = r & (T - 1);
        const bool tanh_cols = (c0 >= 4096) && (c0 < 4096 + 128);
        const bf16_t* sb = SB + (size_t)blk * 4 * 4352 + c0;
        float prev[8], cur[8], nxt[8], m[8];
        { const f32x4 a = *(const f32x4*)(mu + c0), b = *(const f32x4*)(mu + c0 + 4); m[0] = a[0]; m[1] = a[1]; m[2] = a[2]; m[3] = a[3]; m[4] = b[0]; m[5] = b[1]; m[6] = b[2]; m[7] = b[3]; }
        if (e == 0) {
            if (t > 0) unpack8(*(const u32x4*)(sb - 4352), prev); else { for (int k = 0; k < 8; ++k) prev[k] = 0.f; }
            unpack8(*(const u32x4*)sb, cur); unpack8(*(const u32x4*)(sb + 4352), nxt);
        } else {
            unpack8(*(const u32x4*)(sb + 2 * 4352), prev); unpack8(*(const u32x4*)(sb + 3 * 4352), cur);
            if (t < T - 1) unpack8(*(const u32x4*)(sb + 4 * 4352), nxt); else { for (int k = 0; k < 8; ++k) nxt[k] = 0.f; }
        }
        float o[8];
#pragma unroll
        for (int k = 0; k < 8; ++k) {
            float v = cur[k] + m[k] * (0.5f * (prev[k] + nxt[k]) - cur[k]);
            if (tanh_cols) v = 1.f - 2.f * __builtin_amdgcn_rcpf(1.f + __expf(2.f * v));
            o[k] = v;
        }
        *(u32x4*)(U + (size_t)r * UW + URW + c0) = (u32x4){cvtpk(o[0], o[1]), cvtpk(o[2], o[3]), cvtpk(o[4], o[5]), cvtpk(o[6], o[7])};
    }
    const bf16_t* SB2 = (const bf16_t*)(p->ws + WS_SB2); bf16_t* ymix = (bf16_t*)(p->ws + WS_YMIX);
    const float* cw = p->in[I_CW]; const float* cb = p->in[I_CB];
    for (int unit = gt; unit < 128 * 512; unit += nt) {
        const int cg = unit & 127, be = unit >> 7, blk = be >> 1, e = be & 1, c0 = cg * 8;
        const int r = blk * 64 + (e ? 63 : 0), t = r & (T - 1);
        const bf16_t* sb = SB2 + (size_t)blk * 6 * 1024 + c0;
        float prev[8], cur[8], nxt[8], gg[8];
        if (e == 0) {
            if (t > 0) unpack8(*(const u32x4*)(sb - 3 * 1024), prev); else { for (int k = 0; k < 8; ++k) prev[k] = 0.f; }
            unpack8(*(const u32x4*)sb, cur); unpack8(*(const u32x4*)(sb + 1024), nxt); unpack8(*(const u32x4*)(sb + 4 * 1024), gg);
        } else {
            unpack8(*(const u32x4*)(sb + 2 * 1024), prev); unpack8(*(const u32x4*)(sb + 3 * 1024), cur); unpack8(*(const u32x4*)(sb + 5 * 1024), gg);
            if (t < T - 1) unpack8(*(const u32x4*)(sb + 6 * 1024), nxt); else { for (int k = 0; k < 8; ++k) nxt[k] = 0.f; }
        }
        float o[8];
#pragma unroll
        for (int k = 0; k < 8; ++k) o[k] = gg[k] * (cw[c0 + k] * prev[k] + cw[1024 + c0 + k] * cur[k] + cw[2048 + c0 + k] * nxt[k] + cb[c0 + k]);
        *(u32x4*)(ymix + (size_t)r * 2048 + c0) = (u32x4){cvtpk(o[0], o[1]), cvtpk(o[2], o[3]), cvtpk(o[4], o[5]), cvtpk(o[6], o[7])};
    }
}

__device__ void phase_post(KP p, int s, int wid0) {
    KP_FRESH(p);
    int tid_ = hw_tid(wid0); asm volatile("" : "+v"(tid_));
    const int lane = tid_ & 63, gw = blockIdx.x * 8 + (tid_ >> 6), nw = gridDim.x * 8;
    int tok0, nseq, T; slab_info(s, tok0, nseq, T);
    const bf16_t* U = (const bf16_t*)(p->ws + WS_U);
    const bf16_t* YS = (const bf16_t*)(p->ws + WS_YS); const float* BON = (const float*)(p->ws + WS_BON);
    bf16_t* ymix = (bf16_t*)(p->ws + WS_YMIX);
    for (int unit = gw; unit < (SLAB / 16) * 2; unit += nw) {
        const int half = unit & 1, r0 = (unit >> 1) * 16, c0 = half * 512 + lane * 8, h = c0 >> 6;
        float lg[8], lb[8], muz[8];
        {
            const float* g = p->in[I_LXG]; const float* b = p->in[I_LXB]; const float* mu = p->in[I_MU];
#pragma unroll
            for (int e = 0; e < 8; ++e) { lg[e] = g[c0 + e]; lb[e] = b[c0 + e]; muz[e] = mu[3072 + c0 + e]; }
        }
        const int t0 = r0 & (T - 1);
        const bf16_t* up = U + (size_t)r0 * UW + URW + c0;
        float zprev[8], zcur[8], znxt[8];
        if (t0 > 0) unpack8(*(const u32x4*)(up - UW + 3072), zprev); else { for (int e = 0; e < 8; ++e) zprev[e] = 0.f; }
        unpack8(*(const u32x4*)(up + 3072), zcur);
        for (int ib = 0; ib < 16; ib += 4) {
            u32x4 rv[4], rz[4], ry0[4], ry1[4]; float bonv[4];
#pragma unroll
            for (int r = 0; r < 4; ++r) {
                const int i = ib + r, row = r0 + i;
                const bf16_t* ur = up + (size_t)i * UW;
                rz[r] = (t0 + i < T - 1) ? *(const u32x4*)(ur + UW + 3072) : (u32x4){0u, 0u, 0u, 0u};
                rv[r] = *(const u32x4*)(ur + 2048);
                ry0[r] = *(const u32x4*)(YS + (size_t)row * DR + c0); ry1[r] = *(const u32x4*)(YS + ((size_t)SLAB + row) * DR + c0);
                bonv[r] = BON[(size_t)row * 16 + h] + BON[((size_t)SLAB + row) * 16 + h];
            }
#pragma unroll
            for (int r = 0; r < 4; ++r) {
                const int row = r0 + ib + r;
                float vv[8], zz[8], y[8], y1[8];
                unpack8(rv[r], vv); unpack8(rz[r], znxt); unpack8(ry0[r], y); unpack8(ry1[r], y1);
#pragma unroll
                for (int e = 0; e < 8; ++e) { zz[e] = zcur[e] + muz[e] * (0.5f * (zprev[e] + znxt[e]) - zcur[e]); zprev[e] = zcur[e]; zcur[e] = znxt[e]; }
                const float bon = bonv[r];
#pragma unroll
                for (int e = 0; e < 8; ++e) y[e] += y1[e];
                float sum = 0.f;
#pragma unroll
                for (int e = 0; e < 8; ++e) sum += y[e];
                sum += shx(sum, lane, 1); sum += shx(sum, lane, 2); sum += shx(sum, lane, 4);
                const float mean = sum * (1.f / 64.f);
                float sq = 0.f;
#pragma unroll
                for (int e = 0; e < 8; ++e) { const float dl = y[e] - mean; sq += dl * dl; }
                sq += shx(sq, lane, 1); sq += shx(sq, lane, 2); sq += shx(sq, lane, 4);
                const float rstd = rsqrtf(sq * (1.f / 64.f) + 64e-5f);
                float orw[8];
#pragma unroll
                for (int e = 0; e < 8; ++e) orw[e] = ((y[e] - mean) * rstd * lg[e] + lb[e] + bon * vv[e]) * (zz[e] * fsig(zz[e]));
                *(u32x4*)(ymix + (size_t)row * 2048 + 1024 + c0) = (u32x4){cvtpk(orw[0], orw[1]), cvtpk(orw[2], orw[3]), cvtpk(orw[4], orw[5]), cvtpk(orw[6], orw[7])};
            }
        }
    }
}

__device__ void phase_lnout(KP p, int s, int wid0) {
    KP_FRESH(p);
    int tid_ = hw_tid(wid0); asm volatile("" : "+v"(tid_)); int lane = tid_ & 63; const int gw = blockIdx.x * 8 + (tid_ >> 6), nw = gridDim.x * 8;
    float* out = p->out + (size_t)s * SLAB * D;
    const float4* g4 = (const float4*)p->in[I_LG]; const float4* b4 = (const float4*)p->in[I_LB];
    for (int r0 = gw; r0 < SLAB; r0 += 4 * nw) {
        asm volatile("" : "+v"(lane));
        float4 v[4][4];
#pragma unroll
        for (int k = 0; k < 4; ++k)
#pragma unroll
            for (int i = 0; i < 4; ++i) v[k][i] = ((const float4*)(out + (size_t)(r0 + k * nw) * D))[lane + 64 * i];
#pragma unroll
        for (int k = 0; k < 4; ++k) {
            float4* xp = (float4*)(out + (size_t)(r0 + k * nw) * D);
            float sum = 0.f;
#pragma unroll
            for (int i = 0; i < 4; ++i) sum += v[k][i].x + v[k][i].y + v[k][i].z + v[k][i].w;
            const float mean = wsum(sum, lane) * (1.f / 1024.f);
            float sq = 0.f;
#pragma unroll
            for (int i = 0; i < 4; ++i) { float a = v[k][i].x - mean, b = v[k][i].y - mean, c = v[k][i].z - mean, d = v[k][i].w - mean; sq += a * a + b * b + c * c + d * d; }
            const float rstd = rsqrtf(wsum(sq, lane) * (1.f / 1024.f) + 1e-5f);
#pragma unroll
            for (int i = 0; i < 4; ++i) {
                const float4 g = g4[lane + 64 * i], b = b4[lane + 64 * i];
                float4 o; o.x = (v[k][i].x - mean) * rstd * g.x + b.x; o.y = (v[k][i].y - mean) * rstd * g.y + b.y; o.z = (v[k][i].z - mean) * rstd * g.z + b.z; o.w = (v[k][i].w - mean) * rstd * g.w + b.w;
                xp[lane + 64 * i] = o;
            }
        }
    }
}

#define LAS __attribute__((address_space(3)))
#define XB_TMO      128
#define XB_XCNT(j)  (256  + 64 * (j))
#define XB_XSUB(j)  (1280 + 64 * (j))
#define XB_XGEN(j)  (2304 + 64 * (j))
#define XB_TOP      3328
#define XB_TOPGEN   3392
#define XCD_BAR_WORDS 3456
#define XB_SPIN_CAP (1u << 18)

__device__ __forceinline__ unsigned xb_ld(unsigned* p)              { return __hip_atomic_load(p, __ATOMIC_RELAXED, __HIP_MEMORY_SCOPE_AGENT); }
__device__ __forceinline__ unsigned xb_add(unsigned* p, unsigned v) { return __hip_atomic_fetch_add(p, v, __ATOMIC_RELAXED, __HIP_MEMORY_SCOPE_AGENT); }
__device__ __forceinline__ unsigned xb_xcc_id() { return (unsigned)__builtin_amdgcn_s_getreg((3 << 11) | 20) & 0xFu; }
#define XB_SPIN(cond, bar) do { unsigned _sp = 0; while (cond) { __builtin_amdgcn_s_sleep(1); \
    if ((++_sp & 255u) == 0u) { if (xb_ld(&(bar)[XB_TMO])) break; if (_sp > XB_SPIN_CAP) { atomicAdd(&(bar)[XB_TMO], 1u); break; } } } } while (0)

struct XcdBarrier {
    unsigned* bar; unsigned x;
    volatile LAS unsigned* st;
};

__device__ __forceinline__ XcdBarrier xcd_barrier_post(unsigned* bar, volatile LAS unsigned* st) {
    XcdBarrier b; b.bar = bar; b.x = xb_xcc_id(); b.st = st;
    if (threadIdx.x == 0) (void)xb_add(&bar[XB_XCNT(b.x)], 1u);
    return b;
}
__device__ __forceinline__ void xcd_barrier_complete(unsigned* bar, unsigned x, unsigned& nloc, unsigned& nx) {
    const unsigned G = gridDim.x * gridDim.y * gridDim.z;
    unsigned sum, cnt, mine, sp = 0u;
    for (;;) {
        sum = 0u; cnt = 0u; mine = 0u;
#pragma unroll
        for (unsigned j = 0; j < 16; ++j) { const unsigned c = xb_ld(&bar[XB_XCNT(j)]); sum += c; cnt += (c > 0u) ? 1u : 0u; mine = (j == x) ? c : mine; }
        if (sum == G) break;
        __builtin_amdgcn_s_sleep(1);
        if ((++sp & 255u) == 0u) { if (xb_ld(&bar[XB_TMO])) break; if (sp > XB_SPIN_CAP) { atomicAdd(&bar[XB_TMO], 1u); break; } }
    }
    nloc = mine > 0u ? mine : 1u; nx = cnt > 0u ? cnt : 1u;
}

__device__ __forceinline__ void xcd_barrier(const XcdBarrier& b) {
    asm volatile("s_waitcnt vmcnt(0)" ::: "memory");
    __syncthreads();
    if (threadIdx.x == 0) {
        unsigned* bar = b.bar;
        __builtin_amdgcn_s_waitcnt(0);
        unsigned nloc = b.st[0], nx = b.st[1];
        if (nloc == 0u) { xcd_barrier_complete(bar, b.x, nloc, nx); b.st[0] = nloc; b.st[1] = nx; }
        const unsigned old = xb_add(&bar[XB_XSUB(b.x)], 1u);
        const unsigned gen = old / nloc;
        if (old + 1u == (gen + 1u) * nloc) {
            __builtin_amdgcn_fence(__ATOMIC_RELEASE, "agent");
            asm volatile("s_waitcnt vmcnt(0)" ::: "memory");
            const unsigned og = xb_add(&bar[XB_TOP], 1u);
            const unsigned tg = og / nx;
            if (og + 1u == (tg + 1u) * nx) xb_add(&bar[XB_TOPGEN], 1u);
            else XB_SPIN(xb_ld(&bar[XB_TOPGEN]) == tg, bar);
            __builtin_amdgcn_fence(__ATOMIC_ACQUIRE, "agent");
            xb_add(&bar[XB_XGEN(b.x)], 1u);
            asm volatile("s_waitcnt vmcnt(0)" ::: "memory");
        } else {
            XB_SPIN(xb_ld(&bar[XB_XGEN(b.x)]) == gen, bar);
            __builtin_amdgcn_fence(__ATOMIC_ACQUIRE, "agent");
            asm volatile("s_waitcnt vmcnt(0)" ::: "memory");
        }
    }
    __syncthreads();
}

#ifndef REP_SHIFT
#define REP_SHIFT 1
#endif
#ifndef REP_G2
#define REP_G2 1
#endif
#ifndef REP_SCAN
#define REP_SCAN 1
#endif
#ifndef REP_POST
#define REP_POST 1
#endif
#ifndef REP_G1
#define REP_G1 1
#endif
#define GBAR() xcd_barrier(bar)
__global__ void __launch_bounds__(512, 2) fwd_megakernel(Params p_unused) {
    extern __shared__ __attribute__((aligned(16))) unsigned char lds_raw[];
    PG8_LAS unsigned char* lds = (PG8_LAS unsigned char*)lds_raw;
    cg::grid_group grid = cg::this_grid();
    KP p = (KP)__builtin_amdgcn_kernarg_segment_ptr();
    if (threadIdx.x < 2) ((volatile LAS unsigned*)(lds + LDS_BYTES - 64))[threadIdx.x] = 0u;
    __syncthreads();
    {
        unsigned* bw = (unsigned*)(((const Params __attribute__((address_space(4)))*)__builtin_amdgcn_kernarg_segment_ptr())->ws + WS_BAR);
        if (blockIdx.x == 0) { for (int w = threadIdx.x; w < XCD_BAR_WORDS; w += 512) __hip_atomic_store(bw + w, 0u, __ATOMIC_RELAXED, __HIP_MEMORY_SCOPE_AGENT); __threadfence(); }
        grid.sync();
    }
    XcdBarrier bar = xcd_barrier_post((unsigned*)(((const Params __attribute__((address_space(4)))*)__builtin_amdgcn_kernarg_segment_ptr())->ws + WS_BAR), (volatile LAS unsigned*)(lds + LDS_BYTES - 64));
    const int wid0 = __builtin_amdgcn_readfirstlane((int)threadIdx.x >> 6);
    phase_weights(p, wid0);
    for (int s = -1; s < 3; ++s) {
        if (s == 0) GBAR();
        if (s >= 0)
        for (int rep = 0; rep < REP_G1; ++rep) {
            if (rep) GBAR();
            KP_FRESH(p);
            pg8::Gemm g; g.A = xn_buf(p, s); g.Bt = (const bf16_t*)(p->ws + WS_WIN); g.M = SLAB; g.N = NIN; g.K = D;
            pg8::StaticOrder S; S.init(g.M, g.N, gridDim.x, blockIdx.x);
            EpiU E; E.U = (bf16_t*)(p->ws + WS_U); E.TMP = (bf16_t*)(p->ws + WS_TMP); E.mu = p->in[I_MU]; E.YM = (bf16_t*)(p->ws + WS_YMIX); E.SB2 = (bf16_t*)(p->ws + WS_SB2); E.cw = p->in[I_CW]; E.cb = p->in[I_CB];
            pg8::gemm_phase<EpiU, pg8::StaticOrder, true, true>(lds, g, S, E, wid0);
        }
        {
            const int wg0 = (s >= 0 && gridDim.x > 64) ? 64 : 0;
            if (s < 2 && (int)blockIdx.x >= wg0) phase_ln(p, s + 1, wid0, wg0);
        }
        if (s < 0) continue;
        GBAR();
        for (int rep = 0; rep < REP_SHIFT; ++rep) {
        phase_shift(p, s, wid0);
        GBAR();
        }
        for (int rep = 0; rep < REP_SCAN; ++rep) {
        phase_scan<1>(p, s, lds_raw, wid0);
        GBAR();
        if (s > 0 && gridDim.x >= 128) phase_combine_ring(p, s, wid0, lds_raw); else phase_combine(p, s, wid0);
        GBAR();
        phase_scan<2>(p, s, lds_raw, wid0);
        GBAR();
        }
        for (int rep = 0; rep < REP_POST; ++rep) {
        phase_post(p, s, wid0);
        GBAR();
        }
        for (int rep = 0; rep < REP_G2; ++rep) {
            if (rep) GBAR();
            KP_FRESH(p);
            pg8::Gemm g; g.A = (const bf16_t*)(p->ws + WS_YMIX); g.Bt = (const bf16_t*)(p->ws + WS_WOUT); g.M = SLAB; g.N = D; g.K = 2048;
            pg8::StaticOrder S; S.init(g.M, g.N, gridDim.x, blockIdx.x);
            EpiOut E; E.out = p->out + (size_t)s * SLAB * D; E.x = slab_x(p, s); E.stats = (const float*)(p->ws + WS_STATS) + (size_t)s * SLAB * 2; E.eg = p->in[I_EG]; E.eb = p->in[I_EB];
            pg8::gemm_phase<EpiOut, pg8::StaticOrder, true, true>(lds, g, S, E, wid0);
        }
        GBAR();
        phase_lnout(p, s, wid0);
    }
}

extern "C" void kernel_launch(void* const* d_in, const int* in_sizes, int n_in, void* d_out, int out_size, void* d_ws, size_t ws_size, hipStream_t stream) {
    static int grid_blocks = 0;
    if (!grid_blocks) {
        int dev = 0, cus = 0, per_cu = 0;
        hipGetDevice(&dev);
        hipDeviceGetAttribute(&cus, hipDeviceAttributeMultiprocessorCount, dev);
        hipFuncSetAttribute((const void*)fwd_megakernel, hipFuncAttributeMaxDynamicSharedMemorySize, LDS_BYTES);
        hipOccupancyMaxActiveBlocksPerMultiprocessor(&per_cu, (const void*)fwd_megakernel, 512, LDS_BYTES);
        if (per_cu < 1) per_cu = 1;
        if (per_cu > 1) per_cu = 1;
        grid_blocks = cus * per_cu;
    }
    Params p{};
    for (int i = 0; i < 20; ++i) p.in[i] = (const float*)d_in[i];
    p.out = (float*)d_out; p.ws = (unsigned char*)d_ws;
    void* args[] = {&p};
    hipError_t e = hipLaunchCooperativeKernel((const void*)fwd_megakernel, dim3(grid_blocks), dim3(512), args, LDS_BYTES, stream);
    if (e != hipSuccess) fprintf(stderr, "cooperative launch failed: %s (grid %d)\n", hipGetErrorString(e), grid_blocks);
}
```

```cpp
#include <hip/hip_runtime.h>
#include <hip/hip_cooperative_groups.h>
#include <cstdio>
#include <cstdint>
namespace cg = cooperative_groups;
namespace pg8 {
#define PG8_LAS __attribute__((address_space(3)))
typedef unsigned short bf16_t;
typedef short bf16x8 __attribute__((ext_vector_type(8)));
typedef float f32x4 __attribute__((ext_vector_type(4)));
typedef unsigned u32x4 __attribute__((ext_vector_type(4)));
constexpr int BM = 256, BK = 64, HALF = 128, HTB = HALF * BK * 2  , STAGE_BYTES = 8 * HTB, NXCD = 8, WGM = 4;

__host__ __device__ __forceinline__ int lds_byte(int r, int c) { const int st = (r >> 4) * 2 + (c >> 5), rr = r & 15, cc = c & 31, ob = rr * 64 + cc * 2; return st * 1024 + (ob ^ (((ob >> 9) & 1) << 5)); }
__host__ __device__ __forceinline__ void stage_rc(int b, int& R, int& C) { const int st = b / 1024, sb = b % 1024, swz = sb ^ (((sb >> 9) & 1) << 5); R = (st >> 1) * 16 + swz / 64; C = (st & 1) * 32 + (swz % 64) / 2; }
__host__ __device__ __forceinline__ int perm32(int rho) { const int n = rho >> 4, i = rho & 15; return 8 * (i >> 2) + 4 * n + (i & 3); }

struct Unit { int pm, pn; };
struct Gemm { const bf16_t* A; const bf16_t* Bt; int M, N, K; };

struct StaticOrder {
    int nM, nN, nwg, G, c;
    __host__ __device__ void init(int M, int N, int G_, int c_) { nM = M / BM; nN = N / BM; nwg = nM * nN; G = G_; c = c_; }
    __host__ __device__ bool next(int i, Unit& u) const {
        const long L = (long)i * G + c; if (L >= nwg) return false;
        int wgid = (int)L; { const int q = nwg / NXCD, r = nwg % NXCD, xcd = wgid % NXCD, off = wgid / NXCD; wgid = (xcd < r ? xcd * (q + 1) : r * (q + 1) + (xcd - r) * q) + off; }
        const int nig = WGM * nN, gid = wgid / nig, fm = gid * WGM, gsz = (nM - fm) < WGM ? (nM - fm) : WGM;
        u.pm = fm + ((wgid % nig) % gsz); u.pn = (wgid % nig) / gsz; return true;
    }
    __device__ __forceinline__ void a_ready(const Unit&) const {}
    __device__ __forceinline__ void done(const Unit&) const {}
};

template <class Epi, class Sched, bool ALIGN_EPI = false, bool SP2 = false>
__device__ __forceinline__ void gemm_phase(PG8_LAS unsigned char* lds, const Gemm g, const Sched& S, const Epi& E, int wid0) {
    int tid_; asm volatile("v_mbcnt_lo_u32_b32 %0, -1, 0\n\tv_mbcnt_hi_u32_b32 %0, -1, %0" : "=v"(tid_)); tid_ += wid0 * 64; const int tid = tid_, wid = __builtin_amdgcn_readfirstlane(tid >> 6), lane = tid & 63, wr = wid >> 2, wc = wid & 3, fr = lane & 15, fq = lane >> 4;
    const int K = g.K, nt = K / BK;
    unsigned voffA[2], voffB[2];
#pragma unroll
    for (int i = 0; i < 2; ++i) { int R, C; stage_rc(tid * 16 + i * 8192, R, C); const int Rb = Epi::PERM ? ((R & ~31) + perm32(R & 31)) : R;
        voffA[i] = (unsigned)(R * K + C) * 2u; voffB[i] = (unsigned)(Rb * K + C) * 2u; }
    const size_t kstep = (size_t)(BK * 2);
    const size_t hstep = (size_t)HALF * K * 2;
    const size_t tstep = 2 * hstep;
    const unsigned ldsw = (unsigned)wid * 1024u;
    const int aoff = lds_byte(wr * 64 + fr, fq * 8), boff = lds_byte(wc * 32 + fr, fq * 8);
#define PG8_SA(b, h) (((b) * 2 + (h)) * HTB)
#define PG8_SB(b, h) ((4 + (b) * 2 + (h)) * HTB)
#define PG8_STAGE(bufoff, gbase, voff) do { _Pragma("unroll") for (int _i = 0; _i < 2; ++_i) \
        __builtin_amdgcn_global_load_lds((const unsigned*)((const char*)(gbase) + (voff)[_i]), (PG8_LAS unsigned*)(lds + (bufoff) + ldsw + _i * 8192), 16, 0, 0); } while (0)
#define PG8_LDA(dst, b, h) do { _Pragma("unroll") for (int m = 0; m < 4; ++m) _Pragma("unroll") for (int k = 0; k < 2; ++k) dst[m][k] = *(const PG8_LAS bf16x8*)(lds + PG8_SA(b, h) + aoff + m * 2048 + k * 1024); } while (0)
#define PG8_LDB(dst, b, h) do { _Pragma("unroll") for (int n = 0; n < 2; ++n) _Pragma("unroll") for (int k = 0; k < 2; ++k) dst[n][k] = *(const PG8_LAS bf16x8*)(lds + PG8_SB(b, h) + boff + n * 2048 + k * 1024); } while (0)
#define PG8_MMA(ai, bj, At, Bt) do { __builtin_amdgcn_s_setprio(1); _Pragma("unroll") for (int m = 0; m < 4; ++m) _Pragma("unroll") for (int n = 0; n < 2; ++n) _Pragma("unroll") for (int k = 0; k < 2; ++k) \
        acc[ai][bj][m][n] = __builtin_amdgcn_mfma_f32_16x16x32_bf16(Bt[n][k], At[m][k], acc[ai][bj][m][n], 0, 0, 0); __builtin_amdgcn_s_setprio(0); } while (0)
#define PG8_WAIT_V(n) asm volatile("s_waitcnt vmcnt(" #n ")" ::: "memory")
#define PG8_WAIT_L(n) asm volatile("s_waitcnt lgkmcnt(" #n ")" ::: "memory")
#define PG8_BAR __builtin_amdgcn_s_barrier()
#define PG8_SCHED __builtin_amdgcn_sched_barrier(0)
    Unit cur, nxt; int ui = 0;
    if (!S.next(0, cur)) return;
    f32x4 acc[2][2][4][2];
#pragma unroll
    for (int a = 0; a < 2; ++a)
#pragma unroll
        for (int b = 0; b < 2; ++b)
#pragma unroll
            for (int m = 0; m < 4; ++m)
#pragma unroll
                for (int n = 0; n < 2; ++n) acc[a][b][m][n] = (f32x4){0.f, 0.f, 0.f, 0.f};
    bf16x8 At[4][2], B0[2][2], B1[2][2];
    const char* cA = (const char*)g.A + (size_t)cur.pm * tstep; const char* cB = (const char*)g.Bt + (size_t)cur.pn * tstep;
    S.a_ready(cur);
    if constexpr (SP2) {
        PG8_STAGE(PG8_SB(0, 0), cB, voffB); PG8_STAGE(PG8_SB(0, 1), cB + hstep, voffB); PG8_STAGE(PG8_SA(0, 0), cA, voffA); PG8_STAGE(PG8_SA(0, 1), cA + hstep, voffA);
        if (wr == 1) PG8_BAR;
        PG8_WAIT_V(2); PG8_BAR;
        PG8_STAGE(PG8_SB(1, 0), cB + kstep, voffB); PG8_STAGE(PG8_SA(1, 0), cA + kstep, voffA); PG8_STAGE(PG8_SB(1, 1), cB + hstep + kstep, voffB);
        PG8_WAIT_V(6); PG8_BAR;
    } else {
        PG8_STAGE(PG8_SB(0, 0), cB, voffB); PG8_STAGE(PG8_SA(0, 0), cA, voffA); PG8_STAGE(PG8_SB(0, 1), cB + hstep, voffB); PG8_STAGE(PG8_SA(0, 1), cA + hstep, voffA);
        if (wr == 1) PG8_BAR;
        PG8_WAIT_V(4); PG8_BAR;
        PG8_STAGE(PG8_SB(1, 0), cB + kstep, voffB); PG8_STAGE(PG8_SA(1, 0), cA + kstep, voffA); PG8_STAGE(PG8_SB(1, 1), cB + hstep + kstep, voffB);
        PG8_WAIT_V(6); PG8_BAR;
    }
    for (;;) {
        const bool has_next = S.next(ui + 1, nxt);
        const char* nA = has_next ? (const char*)g.A + (size_t)nxt.pm * tstep : cA; const char* nB = has_next ? (const char*)g.Bt + (size_t)nxt.pn * tstep : cB;
        for (int t = 0; t < nt; t += 2) {
            const bool last = (t == nt - 2);
            const char* a1 = cA + (size_t)(t + 1) * kstep;
            const char* a2 = last ? nA : cA + (size_t)(t + 2) * kstep; const char* b2 = last ? nB : cB + (size_t)(t + 2) * kstep;
            const char* a3 = a2 + kstep; const char* b3 = b2 + kstep;
            if (last && has_next) S.a_ready(nxt);
            if constexpr (SP2) {
            PG8_LDB(B0, 0, 0); PG8_LDB(B1, 0, 1); PG8_SCHED; PG8_LDA(At, 0, 0); PG8_STAGE(PG8_SA(1, 1), a1 + hstep, voffA);
            PG8_WAIT_V(8); PG8_WAIT_L(0); PG8_BAR; PG8_MMA(0, 0, At, B0); PG8_MMA(0, 1, At, B1); PG8_BAR; PG8_SCHED;
            PG8_LDA(At, 0, 1); PG8_STAGE(PG8_SB(0, 0), b2, voffB); PG8_STAGE(PG8_SB(0, 1), b2 + hstep, voffB); PG8_STAGE(PG8_SA(0, 0), a2, voffA);
            PG8_WAIT_V(8); PG8_WAIT_L(0); PG8_BAR; PG8_MMA(1, 0, At, B0); PG8_MMA(1, 1, At, B1); PG8_BAR; PG8_SCHED;
            PG8_LDB(B0, 1, 0); PG8_LDB(B1, 1, 1); PG8_SCHED; PG8_LDA(At, 1, 0); PG8_STAGE(PG8_SA(0, 1), a2 + hstep, voffA);
            PG8_WAIT_V(8); PG8_WAIT_L(0); PG8_BAR; PG8_MMA(0, 0, At, B0); PG8_MMA(0, 1, At, B1); PG8_BAR; PG8_SCHED;
            PG8_LDA(At, 1, 1); PG8_STAGE(PG8_SB(1, 0), b3, voffB); PG8_STAGE(PG8_SB(1, 1), b3 + hstep, voffB); PG8_STAGE(PG8_SA(1, 0), a3, voffA);
            PG8_WAIT_V(8); PG8_WAIT_L(0); PG8_BAR; PG8_MMA(1, 0, At, B0); PG8_MMA(1, 1, At, B1); PG8_BAR; PG8_SCHED;
            } else {
            PG8_LDB(B0, 0, 0); PG8_SCHED; PG8_LDA(At, 0, 0); PG8_STAGE(PG8_SA(1, 1), a1 + hstep, voffA);
            PG8_WAIT_L(8); PG8_BAR; PG8_WAIT_L(0); PG8_MMA(0, 0, At, B0); PG8_BAR; PG8_SCHED;
            PG8_LDB(B1, 0, 1); PG8_STAGE(PG8_SB(0, 0), b2, voffB);
            PG8_BAR; PG8_WAIT_L(0); PG8_MMA(0, 1, At, B1); PG8_BAR;
            PG8_LDA(At, 0, 1); PG8_STAGE(PG8_SA(0, 0), a2, voffA);
            PG8_BAR; PG8_WAIT_L(0); PG8_MMA(1, 0, At, B0); PG8_BAR; PG8_SCHED;
            PG8_STAGE(PG8_SB(0, 1), b2 + hstep, voffB);
            PG8_WAIT_V(6); PG8_BAR; PG8_MMA(1, 1, At, B1); PG8_BAR;
            PG8_LDB(B0, 1, 0); PG8_SCHED; PG8_LDA(At, 1, 0); PG8_STAGE(PG8_SA(0, 1), a2 + hstep, voffA);
            PG8_WAIT_L(8); PG8_BAR; PG8_WAIT_L(0); PG8_MMA(0, 0, At, B0); PG8_BAR; PG8_SCHED;
            PG8_LDB(B1, 1, 1); PG8_STAGE(PG8_SB(1, 0), b3, voffB);
            PG8_BAR; PG8_WAIT_L(0); PG8_MMA(0, 1, At, B1); PG8_BAR;
            PG8_LDA(At, 1, 1); PG8_STAGE(PG8_SA(1, 0), a3, voffA);
            PG8_BAR; PG8_WAIT_L(0); PG8_MMA(1, 0, At, B0); PG8_BAR; PG8_SCHED;
            PG8_STAGE(PG8_SB(1, 1), b3 + hstep, voffB);
            PG8_WAIT_V(6); PG8_BAR; PG8_MMA(1, 1, At, B1); PG8_BAR;
            }
        }
        if constexpr (ALIGN_EPI) { if (wr == 0) PG8_BAR; }
        if constexpr (!Epi::AFTER_DRAIN) { E(acc, cur, wr, wc, fr, fq); S.done(cur); }
        if (!has_next) break;
#pragma unroll
        for (int a = 0; a < 2; ++a)
#pragma unroll
            for (int b = 0; b < 2; ++b)
#pragma unroll
                for (int m = 0; m < 4; ++m)
#pragma unroll
                    for (int n = 0; n < 2; ++n) acc[a][b][m][n] = (f32x4){0.f, 0.f, 0.f, 0.f};
        cur = nxt; cA = nA; cB = nB; ++ui;
        if constexpr (ALIGN_EPI) { if (wr == 1) PG8_BAR; }
    }
    PG8_WAIT_V(0);
    if constexpr (!ALIGN_EPI) { if (wr == 0) PG8_BAR; }
    PG8_BAR;
    if constexpr (Epi::AFTER_DRAIN) { E.fused(acc, cur, wr, wc, fr, fq, lds, wid, lane); S.done(cur); }
#undef PG8_SA
#undef PG8_SB
#undef PG8_STAGE
#undef PG8_LDA
#undef PG8_LDB
#undef PG8_MMA
#undef PG8_WAIT_V
#undef PG8_WAIT_L
#undef PG8_BAR
#undef PG8_SCHED
}
}

typedef unsigned short bf16_t;
typedef float f32x4 __attribute__((ext_vector_type(4)));
typedef unsigned u32x4 __attribute__((ext_vector_type(4)));
typedef unsigned u32x2 __attribute__((ext_vector_type(2)));

constexpr int D = 1024, NIN = 8448, DR = 1024, UW = 6400  , URW = 2048  ;
constexpr int SLAB = 16384, NTOK = 49152;
constexpr float DN_ALPHA = 1.189207115002721f;
constexpr size_t WS_WIN = 0;
constexpr size_t WS_WOUT = WS_WIN + (size_t)NIN * D * 2;
constexpr size_t WS_STATS = WS_WOUT + (size_t)D * 2048 * 2;
constexpr size_t WS_XN = WS_STATS + (size_t)NTOK * 2 * 4;
constexpr size_t WS_U = WS_XN + (size_t)SLAB * D * 2;
constexpr size_t WS_YS = WS_U + (size_t)SLAB * UW * 2;
constexpr size_t WS_BON = WS_YS + (size_t)2 * SLAB * DR * 4;
constexpr size_t WS_YMIX = WS_YS + (size_t)2 * SLAB * DR * 2;
constexpr size_t WS_SB2 = WS_YS + (size_t)16 * 1024 * 1024;
constexpr size_t WS_TMP = WS_YS;
constexpr size_t WS_PQ = WS_BON + (size_t)2 * SLAB * 16 * 4;
constexpr size_t WS_SST = WS_PQ + (size_t)2048 * 8192 * 4;
constexpr size_t WS_BAR = WS_SST + (size_t)2048 * 4096 * 4;
constexpr size_t WS_END = WS_BAR + 16384;
static_assert(WS_END <= (size_t)512 * 1024 * 1024, "ws map");
constexpr int LDS_BYTES = 147456;

struct Params { const float* in[20]; float* out; unsigned char* ws; };
typedef const Params __attribute__((address_space(4)))* KP;
#define KP_FRESH(p) asm volatile("" : "+s"(p))
__device__ __forceinline__ int hw_tid(int wid0) { int l; asm volatile("v_mbcnt_lo_u32_b32 %0, -1, 0\n\tv_mbcnt_hi_u32_b32 %0, -1, %0" : "=v"(l)); return wid0 * 64 + l; }
enum { I_XP = 0, I_XS, I_EG, I_EB, I_WIN, I_CW, I_CB, I_MU, I_W0, I_WUP, I_A0, I_AUP, I_KK, I_KA, I_RK, I_LXG, I_LXB, I_WOUT, I_LG, I_LB };

__device__ __forceinline__ float bf2f(unsigned short h) { return __uint_as_float((unsigned)h << 16); }
__device__ __forceinline__ unsigned f2bf(float f) { unsigned u = __float_as_uint(f); return (u + 0x7fffu + ((u >> 16) & 1u)) >> 16; }
__device__ __forceinline__ unsigned pk2(float lo, float hi) { return f2bf(lo) | (f2bf(hi) << 16); }
typedef __bf16 bf16x2e_t __attribute__((ext_vector_type(2)));
typedef float f32x2e __attribute__((ext_vector_type(2)));
__device__ __forceinline__ unsigned cvtpk_(float lo, float hi) { f32x2e v = {lo, hi}; bf16x2e_t b = __builtin_convertvector(v, bf16x2e_t); return __builtin_bit_cast(unsigned, b); }
__device__ __forceinline__ float shx(float v, int lane, int o) { return __int_as_float(__builtin_amdgcn_ds_bpermute((lane ^ o) << 2, __float_as_int(v))); }
__device__ __forceinline__ float wsum(float v, int lane) {
#pragma unroll
    for (int o = 32; o; o >>= 1) v += shx(v, lane, o);
    return v;
}
__device__ __forceinline__ float sigmoidf_(float x) { return __builtin_amdgcn_rcpf(1.f + __builtin_amdgcn_exp2f(-1.44269504f * x)); }
__device__ __forceinline__ float siluf_(float x) { return x * sigmoidf_(x); }
__device__ __forceinline__ float rl(float v, int l) { return __int_as_float(__builtin_amdgcn_readlane(__float_as_int(v), l)); }

__device__ __forceinline__ void slab_info(int s, int& tok0, int& nseq, int& T) { if (s == 0) { tok0 = 0; nseq = 8; T = 2048; } else { tok0 = SLAB * s; nseq = 1; T = 16384; } }
__device__ __forceinline__ const float* slab_x(KP p, int s) { return s == 0 ? p->in[I_XP] : p->in[I_XS] + (size_t)(s - 1) * SLAB * D; }

__device__ __forceinline__ int orig_col(int jv) {
    if (jv >= 4096) return jv;
    const int pn = jv >> 8, bj = (jv >> 7) & 1, wc = (jv >> 5) & 3, fq = (jv >> 3) & 3, n = (jv >> 2) & 1, j = jv & 3;
    return (2 * bj + n) * 1024 + 64 * pn + 16 * wc + 4 * fq + j;
}

__device__ void phase_weights(KP p, int wid0) {
    KP_FRESH(p);
    int gt = blockIdx.x * 512 + hw_tid(wid0); asm volatile("" : "+v"(gt)); const int nt = gridDim.x * 512;
    bf16_t* win = (bf16_t*)(p->ws + WS_WIN); bf16_t* wout = (bf16_t*)(p->ws + WS_WOUT);
    const float* w_in = p->in[I_WIN]; const float* w_out = p->in[I_WOUT];
    for (int idx = gt; idx < NIN * 128; idx += nt) {
        const int jv = idx % NIN, kg = idx / NIN, oc = orig_col(jv);
        float v[8];
#pragma unroll
        for (int i = 0; i < 8; ++i) v[i] = w_in[(size_t)(kg * 8 + i) * NIN + oc];
        u32x4 w; w.x = cvtpk_(v[0], v[1]); w.y = cvtpk_(v[2], v[3]); w.z = cvtpk_(v[4], v[5]); w.w = cvtpk_(v[6], v[7]);
        *(u32x4*)(win + (size_t)jv * D + kg * 8) = w;
    }
    for (int idx = gt; idx < D * 256; idx += nt) {
        const int n = idx % D, kg = idx / D;
        float v[8];
#pragma unroll
        for (int i = 0; i < 8; ++i) v[i] = w_out[(size_t)(kg * 8 + i) * D + n];
        u32x4 w; w.x = cvtpk_(v[0], v[1]); w.y = cvtpk_(v[2], v[3]); w.z = cvtpk_(v[4], v[5]); w.w = cvtpk_(v[6], v[7]);
        *(u32x4*)(wout + (size_t)n * 2048 + kg * 8) = w;
    }
}

__device__ __forceinline__ bf16_t* xn_buf(KP p, int s) { return s == 1 ? (bf16_t*)(p->out + (size_t)2 * SLAB * D) : (bf16_t*)(p->ws + WS_XN); }
__device__ __forceinline__ void phase_ln(KP p, int s, int wid0, int wg0) {
    KP_FRESH(p);
    int tid_ = hw_tid(wid0); asm volatile("" : "+v"(tid_)); int lane = tid_ & 63; const int gw = ((int)blockIdx.x - wg0) * 8 + (tid_ >> 6), nw = ((int)gridDim.x - wg0) * 8;
    const float* x = slab_x(p, s); bf16_t* xn = xn_buf(p, s); float* stats = (float*)(p->ws + WS_STATS) + (size_t)s * SLAB * 2;
    const float4* g4 = (const float4*)p->in[I_EG]; const float4* b4 = (const float4*)p->in[I_EB];
    for (int gi = gw; gi < SLAB / 4; gi += nw) {
        const int r0 = gi * 4;
        asm volatile("" : "+v"(lane));
        float4 v[4][4];
#pragma unroll
        for (int k = 0; k < 4; ++k)
#pragma unroll
            for (int i = 0; i < 4; ++i) v[k][i] = ((const float4*)(x + (size_t)(r0 + k) * D))[lane + 64 * i];
#pragma unroll
        for (int k = 0; k < 4; ++k) {
            const int r = r0 + k;
            float sum = 0.f;
#pragma unroll
            for (int i = 0; i < 4; ++i) sum += v[k][i].x + v[k][i].y + v[k][i].z + v[k][i].w;
            const float mean = wsum(sum, lane) * (1.f / 1024.f);
            float sq = 0.f;
#pragma unroll
            for (int i = 0; i < 4; ++i) { float a = v[k][i].x - mean, b = v[k][i].y - mean, c = v[k][i].z - mean, d = v[k][i].w - mean; sq += a * a + b * b + c * c + d * d; }
            const float rstd = rsqrtf(wsum(sq, lane) * (1.f / 1024.f) + 1e-5f);
            if (lane == 0) { stats[r * 2] = mean; stats[r * 2 + 1] = rstd; }
#pragma unroll
            for (int i = 0; i < 4; ++i) {
                const float4 g = g4[lane + 64 * i], b = b4[lane + 64 * i];
                u32x2 w; w.x = cvtpk_((v[k][i].x - mean) * rstd * g.x + b.x, (v[k][i].y - mean) * rstd * g.y + b.y);
                w.y = cvtpk_((v[k][i].z - mean) * rstd * g.z + b.z, (v[k][i].w - mean) * rstd * g.w + b.w);
                *(u32x2*)(xn + (size_t)r * D + (lane + 64 * i) * 4) = w;
            }
        }
    }
}

struct EpiU {
    static constexpr bool PERM = true, AFTER_DRAIN = false;
    bf16_t* U; bf16_t* TMP; const float* mu; bf16_t* YM; bf16_t* SB2; const float* cw; const float* cb;
    __device__ __forceinline__ void operator()(const f32x4 (&acc)[2][2][4][2], const pg8::Unit& u, int wr, int wc, int fr, int fq) const {
        const int row0 = u.pm * 256 + wr * 64 + fr;
        if (u.pn < 16) {
            const int ch0 = 64 * u.pn + 16 * wc + 4 * fq;
            const f32x4 cw0 = *(const f32x4*)(cw + ch0), cw1 = *(const f32x4*)(cw + 1024 + ch0), cw2 = *(const f32x4*)(cw + 2048 + ch0), cbv = *(const f32x4*)(cb + ch0);
#define EPI_DPP(old_, src_, ctrl_) __int_as_float(__builtin_amdgcn_update_dpp(__float_as_int(old_), __float_as_int(src_), ctrl_, 0xf, 0xf, false))
#pragma unroll
            for (int ai = 0; ai < 2; ++ai) {
                f32x4 pv_[4], gv_[4];
#pragma unroll
                for (int m = 0; m < 4; ++m) {
                    const f32x4 h = acc[ai][0][m][0], B = acc[ai][0][m][1], C = acc[ai][1][m][0], z = acc[ai][1][m][1];
                    pv_[m] = C * h;
#pragma unroll
                    for (int j = 0; j < 4; ++j) gv_[m][j] = B[j] * siluf_(z[j]);
                }
                const int blk = 4 * u.pm + 2 * ai + wr;
#pragma unroll
                for (int m = 0; m < 4; ++m) {
                    float y[4];
#pragma unroll
                    for (int j = 0; j < 4; ++j) {
                        const float po = (m > 0) ? EPI_DPP(0.f, pv_[m > 0 ? m - 1 : 0][j], 0x121) : 0.f, no = (m < 3) ? EPI_DPP(0.f, pv_[m < 3 ? m + 1 : 3][j], 0x12F) : 0.f;
                        const float pr = EPI_DPP(po, pv_[m][j], 0x111), nx = EPI_DPP(no, pv_[m][j], 0x101);
                        y[j] = gv_[m][j] * (cw0[j] * pr + cw1[j] * pv_[m][j] + cw2[j] * nx + cbv[j]);
                    }
                    u32x2 wy; wy.x = cvtpk_(y[0], y[1]); wy.y = cvtpk_(y[2], y[3]);
                    *(u32x2*)(YM + (size_t)(row0 + ai * 128 + m * 16) * 2048 + ch0) = wy;
                    if ((m == 0 && fr < 2) || (m == 3 && fr >= 14)) {
                        const int w4 = (m == 0) ? fr : fr - 12;
                        u32x2 wp; wp.x = cvtpk_(pv_[m][0], pv_[m][1]); wp.y = cvtpk_(pv_[m][2], pv_[m][3]);
                        *(u32x2*)(SB2 + ((size_t)blk * 6 + w4) * 1024 + ch0) = wp;
                        if (w4 == 0 || w4 == 3) {
                            u32x2 wg; wg.x = cvtpk_(gv_[m][0], gv_[m][1]); wg.y = cvtpk_(gv_[m][2], gv_[m][3]);
                            *(u32x2*)(SB2 + ((size_t)blk * 6 + (w4 == 0 ? 4 : 5)) * 1024 + ch0) = wg;
                        }
                    }
                }
            }
#undef EPI_DPP
        } else {
            const int col0 = 256 * (u.pn - 16) + 32 * wc + 8 * fq; const bool zt = (u.pn >= 28) && (u.pn < 32);
            if (zt) {
#pragma unroll
                for (int ai = 0; ai < 2; ++ai)
#pragma unroll
                    for (int m = 0; m < 4; ++m) {
                        bf16_t* rowp = U + (size_t)(row0 + ai * 128 + m * 16) * UW + URW + col0;
#pragma unroll
                        for (int bj = 0; bj < 2; ++bj) {
                            const f32x4 v0 = acc[ai][bj][m][0], v1 = acc[ai][bj][m][1];
                            u32x4 w; w.x = cvtpk_(v0[0], v0[1]); w.y = cvtpk_(v0[2], v0[3]); w.z = cvtpk_(v1[0], v1[1]); w.w = cvtpk_(v1[2], v1[3]);
                            *(u32x4*)(rowp + bj * 128) = w;
                        }
                    }
            } else {
#define EPI_DPP(old_, src_, ctrl_) __int_as_float(__builtin_amdgcn_update_dpp(__float_as_int(old_), __float_as_int(src_), ctrl_, 0xf, 0xf, false))
#pragma unroll
                for (int ai = 0; ai < 2; ++ai)
#pragma unroll
                    for (int bj = 0; bj < 2; ++bj) {
                        const int cb = col0 + bj * 128;
                        const f32x4 mu0 = *(const f32x4*)(mu + cb), mu1 = *(const f32x4*)(mu + cb + 4);
                        const bool th = (u.pn == 32) && (bj == 0);
                        const int blk = 4 * u.pm + 2 * ai + wr;
#pragma unroll
                        for (int m = 0; m < 4; ++m) {
                            u32x4 wv;
#pragma unroll
                            for (int n = 0; n < 2; ++n) {
                                const f32x4 cur = acc[ai][bj][m][n], mun = n ? mu1 : mu0;
                                f32x4 o;
#pragma unroll
                                for (int j = 0; j < 4; ++j) {
                                    const float po = (m > 0) ? EPI_DPP(0.f, acc[ai][bj][m > 0 ? m - 1 : 0][n][j], 0x121) : 0.f;
                                    const float no = (m < 3) ? EPI_DPP(0.f, acc[ai][bj][m < 3 ? m + 1 : 3][n][j], 0x12F) : 0.f;
                                    const float pv = EPI_DPP(po, cur[j], 0x111), nx = EPI_DPP(no, cur[j], 0x101);
                                    float v = cur[j] + mun[j] * (0.5f * (pv + nx) - cur[j]);
                                    if (th) v = 1.f - 2.f * __builtin_amdgcn_rcpf(1.f + __builtin_amdgcn_exp2f(2.88539008f * v));
                                    o[j] = v;
                                }
                                if (n == 0) { wv.x = cvtpk_(o[0], o[1]); wv.y = cvtpk_(o[2], o[3]); } else { wv.z = cvtpk_(o[0], o[1]); wv.w = cvtpk_(o[2], o[3]); }
                            }
                            *(u32x4*)(U + (size_t)(row0 + ai * 128 + m * 16) * UW + URW + cb) = wv;
                            if ((m == 0 && fr < 2) || (m == 3 && fr >= 14)) {
                                const int w4 = (m == 0) ? fr : fr - 12;
                                const f32x4 v0 = acc[ai][bj][m][0], v1 = acc[ai][bj][m][1];
                                u32x4 w; w.x = cvtpk_(v0[0], v0[1]); w.y = cvtpk_(v0[2], v0[3]); w.z = cvtpk_(v1[0], v1[1]); w.w = cvtpk_(v1[2], v1[3]);
                                *(u32x4*)(TMP + ((size_t)blk * 4 + w4) * 4352 + cb) = w;
                            }
                        }
                    }
#undef EPI_DPP
            }
        }
    }
};

struct EpiOut {
    static constexpr bool PERM = true, AFTER_DRAIN = false;
    float* out; const float* x; const float* stats; const float* eg; const float* eb;
    __device__ __forceinline__ void operator()(const f32x4 (&acc)[2][2][4][2], const pg8::Unit& u, int wr, int wc, int fr, int fq) const {
        const int row0 = u.pm * 256 + wr * 64 + fr, col0 = u.pn * 256 + wc * 32 + 8 * fq;
#pragma unroll
        for (int ai = 0; ai < 2; ++ai)
#pragma unroll
            for (int m = 0; m < 4; ++m) {
                const int row = row0 + ai * 128 + m * 16;
                const float mean = stats[row * 2], rstd = stats[row * 2 + 1];
#pragma unroll
                for (int bj = 0; bj < 2; ++bj)
#pragma unroll
                    for (int n = 0; n < 2; ++n) {
                        const int c = col0 + bj * 128 + 4 * n;
                        const float4 xv = *(const float4*)(x + (size_t)row * D + c), g = *(const float4*)(eg + c), b = *(const float4*)(eb + c);
                        const f32x4 a = acc[ai][bj][m][n];
                        float4 o;
                        o.x = DN_ALPHA * ((xv.x - mean) * rstd * g.x + b.x) + a[0]; o.y = DN_ALPHA * ((xv.y - mean) * rstd * g.y + b.y) + a[1];
                        o.z = DN_ALPHA * ((xv.z - mean) * rstd * g.z + b.z) + a[2]; o.w = DN_ALPHA * ((xv.w - mean) * rstd * g.w + b.w) + a[3];
                        *(float4*)(out + (size_t)row * D + c) = o;
                    }
            }
    }
};

typedef short bf16x8 __attribute__((ext_vector_type(8)));
typedef short s16x4 __attribute__((ext_vector_type(4)));
typedef __bf16 bf16x2_t __attribute__((ext_vector_type(2)));
typedef float f32x2 __attribute__((ext_vector_type(2)));
#define MFMA16(a, b, c) __builtin_amdgcn_mfma_f32_16x16x32_bf16((a), (b), (c), 0, 0, 0)
#define DI __device__ __forceinline__
constexpr int IMG_STRIDE = 144;
constexpr int WG_FRAG = 0;
constexpr int WG_CONST = 16384;
constexpr int WV_BASE = 16384 + 2560;
constexpr int WV_BYTES = 3 * 16 * IMG_STRIDE + 256;
static_assert(WV_BASE + 8 * WV_BYTES <= LDS_BYTES, "scan LDS map");

DI unsigned cvtpk(float lo, float hi) { f32x2 v = {lo, hi}; bf16x2_t b = __builtin_convertvector(v, bf16x2_t); return __builtin_bit_cast(unsigned, b); }
DI bf16x8 mkfrag(unsigned a, unsigned b, unsigned c, unsigned d) { u32x4 w = {a, b, c, d}; return __builtin_bit_cast(bf16x8, w); }
DI bf16x8 frag_f4(f32x4 a, f32x4 b) { return mkfrag(cvtpk(a[0], a[1]), cvtpk(a[2], a[3]), cvtpk(b[0], b[1]), cvtpk(b[2], b[3])); }
DI float bperm(float v, int srclane) { return __int_as_float(__builtin_amdgcn_ds_bpermute(srclane << 2, __float_as_int(v))); }
DI float lo16(unsigned w) { return __uint_as_float(w << 16); }
DI float hi16(unsigned w) { return __uint_as_float(w & 0xffff0000u); }
template <int CTRL> DI float dpp0(float x) { return __int_as_float(__builtin_amdgcn_update_dpp(0, __float_as_int(x), CTRL, 0xf, 0xf, true)); }
template <int CTRL> DI float dpp1(float x) { return __int_as_float(__builtin_amdgcn_update_dpp(0x3f800000, __float_as_int(x), CTRL, 0xf, 0xf, false)); }
DI float fsig(float x) { return __builtin_amdgcn_rcpf(1.f + __expf(-x)); }
DI f32x4 ld4(const bf16_t* ur) { const u32x2 c = *(const u32x2*)ur; return (f32x4){lo16(c.x), hi16(c.x), lo16(c.y), hi16(c.y)}; }

DI void split_frag(f32x4 a, f32x4 b, bf16x8& hi, bf16x8& lo) {
    f32x4 ah, bh;
    unsigned w[4] = {cvtpk(a[0], a[1]), cvtpk(a[2], a[3]), cvtpk(b[0], b[1]), cvtpk(b[2], b[3])};
    ah[0] = lo16(w[0]); ah[1] = hi16(w[0]); ah[2] = lo16(w[1]); ah[3] = hi16(w[1]); bh[0] = lo16(w[2]); bh[1] = hi16(w[2]); bh[2] = lo16(w[3]); bh[3] = hi16(w[3]);
    hi = mkfrag(w[0], w[1], w[2], w[3]); lo = frag_f4(a - ah, b - bh);
}
struct ChunkIn { u32x2 k[4], r[4], v[4]; bf16x8 tl[2], la[2]; };
template <int PASS> DI void chunk_load(ChunkIn& c, const bf16_t* ur, int h, int d, int q) {
#pragma unroll
    for (int n = 0; n < 4; ++n) {
        c.k[n] = *(const u32x2*)(ur + 1024 + h * 64 + 16 * n + 4 * q);
        if (PASS == 2) { c.v[n] = *(const u32x2*)(ur + 2048 + h * 64 + 16 * n + 4 * q); c.r[n] = *(const u32x2*)(ur + h * 64 + 16 * n + 4 * q); }
    }
#pragma unroll
    for (int ks = 0; ks < 2; ++ks) { const bf16_t* ul = ur + 4096 + d * 64 + 32 * ks + 8 * q; c.tl[ks] = *(const bf16x8*)ul; c.la[ks] = *(const bf16x8*)(ul + 128); }
}
DI f32x4 up4(u32x2 c) { return (f32x4){lo16(c.x), hi16(c.x), lo16(c.y), hi16(c.y)}; }
template <int PASS>
__device__ void phase_scan(KP p, int s, unsigned char* ldsg, int wid0) {
    KP_FRESH(p);
    const int wid = wid0;
    int tok0, nseq, T; slab_info(s, tok0, nseq, T);
    const int LS = 256, lgseg = (s == 0) ? 3 : 6, nseg = 1 << lgseg, nblk = (nseq * 32 << lgseg) >> 3;
    const bf16_t* U = (const bf16_t*)(p->ws + WS_U);
    bf16_t* YS = (bf16_t*)(p->ws + WS_YS); float* BON = (float*)(p->ws + WS_BON);
    float* PQ = (float*)(p->ws + WS_PQ); const float* SST = (const float*)(p->ws + WS_SST);
    float* cst = (float*)(ldsg + WG_CONST);
    const int wo = WV_BASE + wid * WV_BYTES;
    for (int ib = blockIdx.x; ib < nblk; ib += gridDim.x) {
        const int item = ib * 8 + wid, g = item & (nseg - 1), chain = item >> lgseg, h = chain & 15, d = (chain >> 4) & 1, b = chain >> 5;
        const int tid = hw_tid(wid0), lane = tid & 63, fr = lane & 15, q = lane >> 4;
        __syncthreads();
        if (tid < 64) {
            const float* mu = p->in[I_MU]; const int c = h * 64 + tid;
            cst[tid] = mu[c]; cst[64 + tid] = mu[1024 + c]; cst[128 + tid] = mu[2048 + c];
            cst[192 + tid] = -1.44269504f * p->in[I_W0][d * 1024 + c]; cst[256 + tid] = -1.44269504f * p->in[I_A0][d * 1024 + c];
            cst[320 + tid] = p->in[I_KK][c]; cst[384 + tid] = p->in[I_KA][c]; cst[448 + tid] = p->in[I_RK][c];
            cst[512 + tid] = mu[4096 + d * 64 + tid]; cst[576 + tid] = mu[4096 + 128 + d * 64 + tid];
        }
        for (int e = tid; e < 1024; e += 512) {
            const int l2 = e & 63, ks = (e >> 6) & 1, mt = (e >> 7) & 3, mat = e >> 9, fr2 = l2 & 15, q2 = l2 >> 4;
            const float* src = (mat ? p->in[I_AUP] : p->in[I_WUP]) + ((size_t)d * 64 + 32 * ks + 8 * q2) * 1024 + h * 64 + 16 * mt + fr2;
            float v8[8];
#pragma unroll
            for (int jj = 0; jj < 8; ++jj) v8[jj] = -1.44269504f * src[(size_t)jj * 1024];
            u32x4 w = {cvtpk(v8[0], v8[1]), cvtpk(v8[2], v8[3]), cvtpk(v8[4], v8[5]), cvtpk(v8[6], v8[7])};
            *(u32x4*)(ldsg + WG_FRAG + e * 16) = w;
        }
        __syncthreads();
        f32x4 St[4][4];
        f32x4 Pa[PASS == 1 ? 4 : 1][PASS == 1 ? 4 : 1];
        int l3 = lane; asm volatile("" : "+v"(l3));
        const float* sstl = SST + (size_t)item * 4096 + l3 * 4;
#pragma unroll
        for (int mt = 0; mt < 4; ++mt)
#pragma unroll
            for (int nt = 0; nt < 4; ++nt) {
                if (PASS == 1) {
#pragma unroll
                    for (int j = 0; j < 4; ++j) { St[mt][nt][j] = 0.f; Pa[PASS == 1 ? mt : 0][PASS == 1 ? nt : 0][j] = (16 * mt + 4 * q + j == 16 * nt + fr) ? 1.f : 0.f; }
                } else {
                    St[mt][nt] = *(const f32x4*)(sstl + (mt * 4 + nt) * 256);
                }
            }
        ChunkIn cin;
        { const int p0 = g * LS, t0 = d ? T - 1 - (p0 + fr) : p0 + fr; chunk_load<PASS>(cin, U + (size_t)(b * T + t0) * UW + URW, h, d, q); }
        for (int ck = 0; ck < LS / 16; ++ck) {
            const int pos0 = g * LS + ck * 16;
            const int lane_c = hw_tid(wid0) & 63;
            const int lane = lane_c, fr = lane_c & 15, q = lane_c >> 4;
            const int ti = d ? T - 1 - (pos0 + fr) : pos0 + fr, row = b * T + ti;
            ChunkIn cc = cin;
            if (PASS == 1) {
#pragma unroll
                for (int n = 0; n < 4; ++n) cc.v[n] = *(const u32x2*)(U + (size_t)row * UW + URW + 2048 + h * 64 + 16 * n + 4 * q);
            }
            {
                const int pn = g * LS + (ck + 1 < LS / 16 ? ck + 1 : ck) * 16, tn = d ? T - 1 - (pn + fr) : pn + fr;
                chunk_load<PASS>(cin, U + (size_t)(b * T + tn) * UW + URW, h, d, q);
            }
            const int lq16 = 16 * q, ll16 = 16 * lane, limg = fr * IMG_STRIDE + 8 * q, ltr = (4 * q + (fr >> 2)) * IMG_STRIDE + 8 * (fr & 3);
            f32x4 ow[4], oa[4];
            {
                const bf16x8 tlf[2] = {cc.tl[0], cc.tl[1]}, laf[2] = {cc.la[0], cc.la[1]};
#pragma unroll
                for (int mt = 0; mt < 4; ++mt) {
                    const bf16x8 w0f = *(const bf16x8*)(ldsg + WG_FRAG + ((0 * 4 + mt) * 2 + 0) * 1024 + ll16), w1f = *(const bf16x8*)(ldsg + WG_FRAG + ((0 * 4 + mt) * 2 + 1) * 1024 + ll16);
                    const bf16x8 a0f = *(const bf16x8*)(ldsg + WG_FRAG + ((1 * 4 + mt) * 2 + 0) * 1024 + ll16), a1f = *(const bf16x8*)(ldsg + WG_FRAG + ((1 * 4 + mt) * 2 + 1) * 1024 + ll16);
                    f32x4 z = {0.f, 0.f, 0.f, 0.f};
                    ow[mt] = MFMA16(w1f, tlf[1], MFMA16(w0f, tlf[0], z));
                    oa[mt] = MFMA16(a1f, laf[1], MFMA16(a0f, laf[0], z));
                }
            }
            f32x4 km[4]; f32x4 ss4 = {0.f, 0.f, 0.f, 0.f};
#pragma unroll
            for (int n = 0; n < 4; ++n) {
                km[n] = up4(cc.k[n]);
                const f32x4 kr = km[n] * *(const f32x4*)(ldsg + WG_CONST + (320 + 16 * n) * 4 + lq16);
                ss4 += kr * kr;
            }
            float ss = (ss4[0] + ss4[1]) + (ss4[2] + ss4[3]);
            ss += bperm(ss, lane ^ 16); ss += bperm(ss, lane ^ 32);
            const float kinv = 1.f / fmaxf(sqrtf(ss), 1e-12f);
            u32x2 kapP[4], ktP[4], btP[4], rtP[4]; f32x4 bon4 = {0.f, 0.f, 0.f, 0.f};
#pragma unroll
            for (int n = 0; n < 4; ++n) {
                const f32x4 w0v = *(const f32x4*)(ldsg + WG_CONST + (192 + 16 * n) * 4 + lq16), a0v = *(const f32x4*)(ldsg + WG_CONST + (256 + 16 * n) * 4 + lq16), kkw = *(const f32x4*)(ldsg + WG_CONST + (320 + 16 * n) * 4 + lq16), kav = *(const f32x4*)(ldsg + WG_CONST + (384 + 16 * n) * 4 + lq16);
                const f32x4 tw = w0v + ow[n], ta = a0v + oa[n];
                f32x4 ew, ea;
#pragma unroll
                for (int j = 0; j < 4; ++j) { ew[j] = __builtin_amdgcn_exp2f(tw[j]); ea[j] = __builtin_amdgcn_exp2f(ta[j]); }
                const f32x4 dw = ew + 1.f, da = ea + 1.f;
                f32x4 sw, av;
#pragma unroll
                for (int j = 0; j < 4; ++j) { sw[j] = __builtin_amdgcn_rcpf(dw[j]); av[j] = __builtin_amdgcn_rcpf(da[j]); }
                const f32x4 lw2 = sw * -0.87503877f;
                f32x4 L, Lm, gmv, emL;
#pragma unroll
                for (int j = 0; j < 4; ++j) {
                    float x = __builtin_amdgcn_exp2f(lw2[j]);
                    x *= dpp1<0x111>(x); x *= dpp1<0x112>(x); x *= dpp1<0x114>(x); x *= dpp1<0x118>(x);
                    L[j] = x; Lm[j] = dpp1<0x111>(x); gmv[j] = dpp0<0x121>(x);
                    emL[j] = __builtin_amdgcn_rcpf(x);
                }
                const f32x4 kk = km[n] * kkw * kinv;
                const f32x4 kd = km[n] * ((av - 1.f) * kav + 1.f);
                const f32x4 kap = kk * Lm, bt = kk * av * emL, kt = kd * emL;
                if (fr == 0) *(f32x4*)(ldsg + wo + 48 * IMG_STRIDE + 64 * n + lq16) = gmv;
                kapP[n] = (u32x2){cvtpk(kap[0], kap[1]), cvtpk(kap[2], kap[3])};
                ktP[n] = (u32x2){cvtpk(kt[0], kt[1]), cvtpk(kt[2], kt[3])};
                btP[n] = (u32x2){cvtpk(bt[0], bt[1]), cvtpk(bt[2], bt[3])};
                *(u32x2*)(ldsg + wo + 16 * IMG_STRIDE + 32 * n + limg) = ktP[n];
                *(u32x2*)(ldsg + wo + 32 * IMG_STRIDE + 32 * n + limg) = btP[n];
                if (PASS == 2) {
                    const f32x4 rm = up4(cc.r[n]), rk = *(const f32x4*)(ldsg + WG_CONST + (448 + 16 * n) * 4 + lq16);
                    const f32x4 rt = rm * L;
                    rtP[n] = (u32x2){cvtpk(rt[0], rt[1]), cvtpk(rt[2], rt[3])};
                    bon4 += rm * kd * rk;
                }
                *(u32x2*)(ldsg + wo + 32 * n + limg) = cc.v[n];
            }
            if (PASS == 2) {
                float bon = (bon4[0] + bon4[1]) + (bon4[2] + bon4[3]);
                bon += bperm(bon, lane ^ 16); bon += bperm(bon, lane ^ 32);
                if (q == 0) BON[((size_t)d * SLAB + row) * 16 + h] = 0.5f * bon;
            }
            const bf16x8 kapF0 = mkfrag(kapP[0].x, kapP[0].y, kapP[1].x, kapP[1].y), kapF1 = mkfrag(kapP[2].x, kapP[2].y, kapP[3].x, kapP[3].y);
            bf16x8 akkA, tA, aryA;
            {
                const bf16x8 ktF0 = mkfrag(ktP[0].x, ktP[0].y, ktP[1].x, ktP[1].y), ktF1 = mkfrag(ktP[2].x, ktP[2].y, ktP[3].x, ktP[3].y);
                const bf16x8 btF0 = mkfrag(btP[0].x, btP[0].y, btP[1].x, btP[1].y), btF1 = mkfrag(btP[2].x, btP[2].y, btP[3].x, btP[3].y);
                const f32x4 z = {0.f, 0.f, 0.f, 0.f};
                f32x4 akk = MFMA16(ktF1, kapF1, MFMA16(ktF0, kapF0, z));
                f32x4 nn = MFMA16(kapF1, btF1, MFMA16(kapF0, btF0, z));
                f32x4 na = MFMA16(btF1, kapF1, MFMA16(btF0, kapF0, z));
                f32x4 idv;
#pragma unroll
                for (int jj = 0; jj < 4; ++jj) {
                    akk[jj] = (4 * q + jj < fr) ? akk[jj] : 0.f; nn[jj] = (fr < 4 * q + jj) ? nn[jj] : 0.f; na[jj] = (4 * q + jj < fr) ? na[jj] : 0.f;
                    idv[jj] = (4 * q + jj == fr) ? 1.f : 0.f;
                }
                akkA = mkfrag(cvtpk(akk[0], akk[1]), cvtpk(akk[2], akk[3]), 0u, 0u);
                if (PASS == 2) {
                    const bf16x8 rtF0 = mkfrag(rtP[0].x, rtP[0].y, rtP[1].x, rtP[1].y), rtF1 = mkfrag(rtP[2].x, rtP[2].y, rtP[3].x, rtP[3].y);
                    f32x4 ark = MFMA16(ktF1, rtF1, MFMA16(ktF0, rtF0, z));
                    f32x4 arb = MFMA16(btF1, rtF1, MFMA16(btF0, rtF0, z));
#pragma unroll
                    for (int jj = 0; jj < 4; ++jj) { ark[jj] = (4 * q + jj <= fr) ? ark[jj] : 0.f; arb[jj] = (4 * q + jj <= fr) ? arb[jj] : 0.f; }
                    aryA = mkfrag(cvtpk(ark[0], ark[1]), cvtpk(ark[2], ark[3]), cvtpk(arb[0], arb[1]), cvtpk(arb[2], arb[3]));
                }
#define TF(x) mkfrag(cvtpk((x)[0], (x)[1]), cvtpk((x)[2], (x)[3]), 0u, 0u)
                const bf16x8 nF = TF(nn), aF = TF(na);
                const f32x4 n2 = MFMA16(aF, nF, z), a2 = MFMA16(nF, aF, z);
                const bf16x8 n2F = TF(n2), a2F = TF(a2);
                const f32x4 n4 = MFMA16(a2F, n2F, z), a4 = MFMA16(n2F, a2F, z);
                const bf16x8 n4F = TF(n4), a4F = TF(a4);
                const f32x4 n8 = MFMA16(a4F, n4F, z);
                const f32x4 t21 = MFMA16(n2F, aF, z);
                f32x4 R = idv - na + a2 - t21;
                R = MFMA16(n4F, TF(R), R);
                R = MFMA16(TF(n8), TF(R), R);
                tA = TF(R);
#undef TF
            }
            s16x4 Vc[4], Kc[4], Bc[4];
            {
                typedef s16x4 __attribute__((address_space(3)))* lp;
#pragma unroll
                for (int t4 = 0; t4 < 4; ++t4) {
                    Vc[t4] = __builtin_amdgcn_ds_read_tr16_b64_v4i16((lp)(ldsg + wo + ltr + 32 * t4));
                    Kc[t4] = __builtin_amdgcn_ds_read_tr16_b64_v4i16((lp)(ldsg + wo + 16 * IMG_STRIDE + ltr + 32 * t4));
                    Bc[t4] = __builtin_amdgcn_ds_read_tr16_b64_v4i16((lp)(ldsg + wo + 32 * IMG_STRIDE + ltr + 32 * t4));
                }
            }
            bf16x8 kbA[4];
#pragma unroll
            for (int mt = 0; mt < 4; ++mt) kbA[mt] = __builtin_shufflevector(Kc[mt], Bc[mt], 0, 1, 2, 3, 4, 5, 6, 7);
#pragma unroll
            for (int nt = 0; nt < 4; ++nt) {
                const f32x4 z = {0.f, 0.f, 0.f, 0.f};
                const bf16x8 stf0 = frag_f4(St[0][nt], St[1][nt]), stf1 = frag_f4(St[2][nt], St[3][nt]);
                const u32x2 vcu = __builtin_bit_cast(u32x2, Vc[nt]);
                f32x4 X = MFMA16(kapF1, stf1, MFMA16(kapF0, stf0, z));
                X = MFMA16(akkA, mkfrag(vcu.x, vcu.y, 0u, 0u), X);
                const f32x4 Uu = MFMA16(tA, mkfrag(cvtpk(X[0], X[1]), cvtpk(X[2], X[3]), 0u, 0u), z);
                const bf16x8 bvu = mkfrag(vcu.x, vcu.y, cvtpk(-Uu[0], -Uu[1]), cvtpk(-Uu[2], -Uu[3]));
                if (PASS == 2) {
                    const bf16x8 rtF0 = mkfrag(rtP[0].x, rtP[0].y, rtP[1].x, rtP[1].y), rtF1 = mkfrag(rtP[2].x, rtP[2].y, rtP[3].x, rtP[3].y);
                    f32x4 Y = MFMA16(rtF1, stf1, MFMA16(rtF0, stf0, z));
                    Y = MFMA16(aryA, bvu, Y);
#pragma unroll
                    for (int jj = 0; jj < 4; ++jj) {
                        const int i = 4 * q + jj, t2 = d ? T - 1 - (pos0 + i) : pos0 + i;
                        YS[((size_t)d * SLAB + b * T + t2) * DR + h * 64 + 16 * nt + fr] = (bf16_t)(cvtpk(Y[jj], 0.f) & 0xffffu);
                    }
                }
#pragma unroll
                for (int mt = 0; mt < 4; ++mt) St[mt][nt] = MFMA16(kbA[mt], bvu, St[mt][nt]) * *(const f32x4*)(ldsg + wo + 48 * IMG_STRIDE + 64 * mt + lq16);
            }
            if (PASS == 1) {
#pragma unroll
                for (int ct = 0; ct < 4; ++ct) {
                    const f32x4 z = {0.f, 0.f, 0.f, 0.f};
                    const bf16x8 pf0 = frag_f4(Pa[0][PASS == 1 ? ct : 0], Pa[PASS == 1 ? 1 : 0][PASS == 1 ? ct : 0]), pf1 = frag_f4(Pa[PASS == 1 ? 2 : 0][PASS == 1 ? ct : 0], Pa[PASS == 1 ? 3 : 0][PASS == 1 ? ct : 0]);
                    const f32x4 X = MFMA16(kapF1, pf1, MFMA16(kapF0, pf0, z));
                    const f32x4 Uu = MFMA16(tA, mkfrag(cvtpk(X[0], X[1]), cvtpk(X[2], X[3]), 0u, 0u), z);
                    const bf16x8 bvu = mkfrag(0u, 0u, cvtpk(-Uu[0], -Uu[1]), cvtpk(-Uu[2], -Uu[3]));
#pragma unroll
                    for (int mt = 0; mt < 4; ++mt) Pa[PASS == 1 ? mt : 0][PASS == 1 ? ct : 0] = MFMA16(kbA[mt], bvu, Pa[PASS == 1 ? mt : 0][PASS == 1 ? ct : 0]) * *(const f32x4*)(ldsg + wo + 48 * IMG_STRIDE + 64 * mt + lq16);
                }
            }
        }
        if (PASS == 1) {
            const int l2 = hw_tid(wid0) & 63, fr2 = l2 & 15, q2 = l2 >> 4;
            unsigned char* pqb = (unsigned char*)(PQ + (size_t)item * 8192);
            float* tl = (float*)(ldsg + wo);
#pragma unroll
            for (int mt = 0; mt < 4; ++mt)
#pragma unroll
                for (int ks = 0; ks < 2; ++ks) {
#pragma unroll
                    for (int e = 0; e < 2; ++e)
#pragma unroll
                        for (int j2 = 0; j2 < 4; ++j2) tl[e * 256 + (4 * q2 + j2) * 16 + fr2] = Pa[PASS == 1 ? mt : 0][PASS == 1 ? 2 * ks + e : 0][j2];
                    __builtin_amdgcn_wave_barrier();
                    const f32x4 pa = *(const f32x4*)(tl + fr2 * 16 + 4 * q2), pb = *(const f32x4*)(tl + 256 + fr2 * 16 + 4 * q2);
                    __builtin_amdgcn_wave_barrier();
                    bf16x8 ah, al; split_frag(pa, pb, ah, al);
                    *(bf16x8*)(pqb + (((mt * 2 + ks) * 2 + 0) * 64 + l2) * 16) = ah;
                }
            float* pq = PQ + (size_t)item * 8192 + 4096 + l2 * 4;
#pragma unroll
            for (int mt = 0; mt < 4; ++mt)
#pragma unroll
                for (int nt = 0; nt < 4; ++nt) *(f32x4*)(pq + (mt * 4 + nt) * 256) = St[mt][nt];
        }
    }
}

constexpr int CR_SLOTS = 10, CR_SLOT_BYTES = 12288, CR_FLAGS = CR_SLOTS * CR_SLOT_BYTES;
__device__ __forceinline__ void phase_combine_ring(KP p, int s, int wid0, unsigned char* ldsg) {
    KP_FRESH(p);
    int tid_ = hw_tid(wid0); asm volatile("" : "+v"(tid_));
    const int lane = tid_ & 63, wid = wid0;
    const int nseg = 64, nsteps = nseg - 1;
    const float* PQ = (const float*)(p->ws + WS_PQ); float* SST = (float*)(p->ws + WS_SST);
    volatile unsigned* flags = (volatile unsigned*)(ldsg + CR_FLAGS);
    __syncthreads();
    if (tid_ < CR_SLOTS) flags[tid_] = 0u;
    __syncthreads();
    if ((int)blockIdx.x >= 128) return;
    const int nt = blockIdx.x & 3, chain = blockIdx.x >> 2;
    if (wid != 0) {
        u32x4 ra[12], rb[12];
#define CR_ISSUE(r, gg) do { const unsigned char* b_ = (const unsigned char*)(PQ + ((size_t)chain * nseg + (gg)) * 8192); \
        _Pragma("unroll") for (int f = 0; f < 8; ++f) (r)[f] = *(const u32x4*)(b_ + ((f * 2 + 0) * 64 + lane) * 16); \
        _Pragma("unroll") for (int mt = 0; mt < 4; ++mt) (r)[8 + mt] = *(const u32x4*)(b_ + 16384 + ((mt * 4 + nt) * 64 + lane) * 16); } while (0)
#define CR_PUT(r, gg) do { const int slot_ = (gg) % CR_SLOTS; const unsigned gen_ = 2u * (unsigned)((gg) / CR_SLOTS); unsigned sp_ = 0;     \
        while (flags[slot_] != gen_ && ++sp_ < (1u << 20)) __builtin_amdgcn_s_sleep(1); \
        _Pragma("unroll") for (int f = 0; f < 12; ++f) *(u32x4*)(ldsg + slot_ * CR_SLOT_BYTES + f * 1024 + lane * 16) = (r)[f]; \
        asm volatile("s_waitcnt lgkmcnt(0)" ::: "memory"); __builtin_amdgcn_wave_barrier(); \
        if (lane == 0) flags[slot_] = gen_ + 1u; } while (0)
        int g = wid - 1;
        if (g < nsteps) CR_ISSUE(ra, g);
        for (; g < nsteps; g += 14) {
            if (g + 7 < nsteps) CR_ISSUE(rb, g + 7);
            CR_PUT(ra, g);
            if (g + 14 < nsteps) CR_ISSUE(ra, g + 14);
            if (g + 7 < nsteps) CR_PUT(rb, g + 7);
        }
#undef CR_ISSUE
#undef CR_PUT
    } else {
        f32x4 S[4];
#pragma unroll
        for (int mt = 0; mt < 4; ++mt) S[mt] = (f32x4){0.f, 0.f, 0.f, 0.f};
        for (int g = 0; g < nseg; ++g) {
            const size_t item = (size_t)chain * nseg + g;
#pragma unroll
            for (int mt = 0; mt < 4; ++mt) *(f32x4*)(SST + item * 4096 + ((mt * 4 + nt) * 64 + lane) * 4) = S[mt];
            if (g == nsteps) break;
            const int slot = g % CR_SLOTS; const unsigned gen = 2u * (unsigned)(g / CR_SLOTS); unsigned sp = 0;
            while (flags[slot] != gen + 1u && ++sp < (1u << 20)) __builtin_amdgcn_s_sleep(1);
            bf16x8 ah[4][2]; f32x4 qv[4];
#pragma unroll
            for (int mt = 0; mt < 4; ++mt) {
                qv[mt] = *(const f32x4*)(ldsg + slot * CR_SLOT_BYTES + (8 + mt) * 1024 + lane * 16);
#pragma unroll
                for (int ks = 0; ks < 2; ++ks) ah[mt][ks] = *(const bf16x8*)(ldsg + slot * CR_SLOT_BYTES + (mt * 2 + ks) * 1024 + lane * 16);
            }
            asm volatile("s_waitcnt lgkmcnt(0)" ::: "memory"); __builtin_amdgcn_wave_barrier();
            if (lane == 0) flags[slot] = gen + 2u;
            bf16x8 bh[2], bl[2];
            split_frag(S[0], S[1], bh[0], bl[0]); split_frag(S[2], S[3], bh[1], bl[1]);
#pragma unroll
            for (int mt = 0; mt < 4; ++mt) {
                f32x4 acc = qv[mt];
#pragma unroll
                for (int ks = 0; ks < 2; ++ks) { acc = MFMA16(ah[mt][ks], bh[ks], acc); acc = MFMA16(ah[mt][ks], bl[ks], acc); }
                S[mt] = acc;
            }
        }
    }
}

__device__ void phase_combine(KP p, int s, int wid0) {
    KP_FRESH(p);
    int tid_ = hw_tid(wid0); asm volatile("" : "+v"(tid_));
    const int lane = tid_ & 63, wid = tid_ >> 6, fr = lane & 15, q = lane >> 4;
    int tok0, nseq, T; slab_info(s, tok0, nseq, T);
    const int lgseg = (s == 0) ? 3 : 6, nseg = 1 << lgseg, nwork = nseq * 32 * 4;
    const float* PQ = (const float*)(p->ws + WS_PQ); float* SST = (float*)(p->ws + WS_SST);
    for (int wk = blockIdx.x * 8 + wid; wk < nwork; wk += gridDim.x * 8) {
        const int nt = wk & 3, chain = wk >> 2;
        f32x4 S[4];
#pragma unroll
        for (int mt = 0; mt < 4; ++mt) S[mt] = (f32x4){0.f, 0.f, 0.f, 0.f};
        struct CStep { bf16x8 ah[4][2]; f32x4 q[4]; };
#define CMB_LOAD(c, gg) do { const int g_ = (gg) < nseg - 1 ? (gg) : nseg - 2; const unsigned char* b_ = (const unsigned char*)(PQ + ((size_t)chain * nseg + g_) * 8192); \
        _Pragma("unroll") for (int mt = 0; mt < 4; ++mt) { (c).q[mt] = *(const f32x4*)(b_ + 16384 + ((mt * 4 + nt) * 64 + lane) * 16); \
            _Pragma("unroll") for (int ks = 0; ks < 2; ++ks) (c).ah[mt][ks] = *(const bf16x8*)(b_ + (((mt * 2 + ks) * 2 + 0) * 64 + lane) * 16); } } while (0)
        CStep c0, c1, c2;
        CMB_LOAD(c0, 0); CMB_LOAD(c1, 1); CMB_LOAD(c2, 2);
        for (int g = 0; g < nseg; ++g) {
            const size_t item = (size_t)chain * nseg + g;
#pragma unroll
            for (int mt = 0; mt < 4; ++mt) *(f32x4*)(SST + item * 4096 + ((mt * 4 + nt) * 64 + lane) * 4) = S[mt];
            if (g == nseg - 1) break;
            const CStep cc = c0; c0 = c1; c1 = c2;
            CMB_LOAD(c2, g + 3);
            bf16x8 bh[2], bl[2];
            split_frag(S[0], S[1], bh[0], bl[0]); split_frag(S[2], S[3], bh[1], bl[1]);
#pragma unroll
            for (int mt = 0; mt < 4; ++mt) {
                f32x4 acc = cc.q[mt];
#pragma unroll
                for (int ks = 0; ks < 2; ++ks) { acc = MFMA16(cc.ah[mt][ks], bh[ks], acc); acc = MFMA16(cc.ah[mt][ks], bl[ks], acc); }
                S[mt] = acc;
            }
        }
#undef CMB_LOAD
    }
}

DI void unpack8(u32x4 w, float (&f)[8]) { f[0] = lo16(w.x); f[1] = hi16(w.x); f[2] = lo16(w.y); f[3] = hi16(w.y); f[4] = lo16(w.z); f[5] = hi16(w.z); f[6] = lo16(w.w); f[7] = hi16(w.w); }
__device__ void phase_shift(KP p, int s, int wid0) {
    KP_FRESH(p);
    int tid_ = hw_tid(wid0); asm volatile("" : "+v"(tid_));
    int tok0, nseq, T; slab_info(s, tok0, nseq, T);
    const bf16_t* SB = (const bf16_t*)(p->ws + WS_TMP); bf16_t* U = (bf16_t*)(p->ws + WS_U);
    const float* mu = p->in[I_MU];
    const int gt = blockIdx.x * 512 + tid_, nt = gridDim.x * 512;
    for (int unit = gt; unit < 416 * 512; unit += nt) {
        const int cg0 = unit % 416, cg = cg0 < 384 ? cg0 : cg0 + 128, be = unit / 416, blk = be >> 1, e = be & 1, c0 = cg * 8;
        const int r = blk * 64 + (e ? 63 : 0), t = r & (T - 1);
        const bool tanh_cols = (c0 >= 4096) && (c0 < 4096 + 128);
        const bf16_t* sb = SB + (size_t)blk * 4 * 4352 + c0;
        float prev[8], cur[8], nxt[8], m[8];
        { const f32x4 a = *(const f32x4*)(mu + c0), b = *(const f32x4*)(mu + c0 + 4); m[0] = a[0]; m[1] = a[1]; m[2] = a[2]; m[3] = a[3]; m[4] = b[0]; m[5] = b[1]; m[6] = b[2]; m[7] = b[3]; }
        if (e == 0) {
            if (t > 0) unpack8(*(const u32x4*)(sb - 4352), prev); else { for (int k = 0; k < 8; ++k) prev[k] = 0.f; }
            unpack8(*(const u32x4*)sb, cur); unpack8(*(const u32x4*)(sb + 4352), nxt);
        } else {
            unpack8(*(const u32x4*)(sb + 2 * 4352), prev); unpack8(*(const u32x4*)(sb + 3 * 4352), cur);
            if (t < T - 1) unpack8(*(const u32x4*)(sb + 4 * 4352), nxt); else { for (int k = 0; k < 8; ++k) nxt[k] = 0.f; }
        }
        float o[8];
#pragma unroll
        for (int k = 0; k < 8; ++k) {
            float v = cur[k] + m[k] * (0.5f * (prev[k] + nxt[k]) - cur[k]);
            if (tanh_cols) v = 1.f - 2.f * __builtin_amdgcn_rcpf(1.f + __expf(2.f * v));
            o[k] = v;
        }
        *(u32x4*)(U + (size_t)r * UW + URW + c0) = (u32x4){cvtpk(o[0], o[1]), cvtpk(o[2], o[3]), cvtpk(o[4], o[5]), cvtpk(o[6], o[7])};
    }
    const bf16_t* SB2 = (const bf16_t*)(p->ws + WS_SB2); bf16_t* ymix = (bf16_t*)(p->ws + WS_YMIX);
    const float* cw = p->in[I_CW]; const float* cb = p->in[I_CB];
    for (int unit = gt; unit < 128 * 512; unit += nt) {
        const int cg = unit & 127, be = unit >> 7, blk = be >> 1, e = be & 1, c0 = cg * 8;
        const int r = blk * 64 + (e ? 63 : 0), t = r & (T - 1);
        const bf16_t* sb = SB2 + (size_t)blk * 6 * 1024 + c0;
        float prev[8], cur[8], nxt[8], gg[8];
        if (e == 0) {
            if (t > 0) unpack8(*(const u32x4*)(sb - 3 * 1024), prev); else { for (int k = 0; k < 8; ++k) prev[k] = 0.f; }
            unpack8(*(const u32x4*)sb, cur); unpack8(*(const u32x4*)(sb + 1024), nxt); unpack8(*(const u32x4*)(sb + 4 * 1024), gg);
        } else {
            unpack8(*(const u32x4*)(sb + 2 * 1024), prev); unpack8(*(const u32x4*)(sb + 3 * 1024), cur); unpack8(*(const u32x4*)(sb + 5 * 1024), gg);
            if (t < T - 1) unpack8(*(const u32x4*)(sb + 6 * 1024), nxt); else { for (int k = 0; k < 8; ++k) nxt[k] = 0.f; }
        }
        float o[8];
#pragma unroll
        for (int k = 0; k < 8; ++k) o[k] = gg[k] * (cw[c0 + k] * prev[k] + cw[1024 + c0 + k] * cur[k] + cw[2048 + c0 + k] * nxt[k] + cb[c0 + k]);
        *(u32x4*)(ymix + (size_t)r * 2048 + c0) = (u32x4){cvtpk(o[0], o[1]), cvtpk(o[2], o[3]), cvtpk(o[4], o[5]), cvtpk(o[6], o[7])};
    }
}

__device__ void phase_post(KP p, int s, int wid0) {
    KP_FRESH(p);
    int tid_ = hw_tid(wid0); asm volatile("" : "+v"(tid_));
    const int lane = tid_ & 63, gw = blockIdx.x * 8 + (tid_ >> 6), nw = gridDim.x * 8;
    int tok0, nseq, T; slab_info(s, tok0, nseq, T);
    const bf16_t* U = (const bf16_t*)(p->ws + WS_U);
    const bf16_t* YS = (const bf16_t*)(p->ws + WS_YS); const float* BON = (const float*)(p->ws + WS_BON);
    bf16_t* ymix = (bf16_t*)(p->ws + WS_YMIX);
    for (int unit = gw; unit < (SLAB / 16) * 2; unit += nw) {
        const int half = unit & 1, r0 = (unit >> 1) * 16, c0 = half * 512 + lane * 8, h = c0 >> 6;
        float lg[8], lb[8], muz[8];
        {
            const float* g = p->in[I_LXG]; const float* b = p->in[I_LXB]; const float* mu = p->in[I_MU];
#pragma unroll
            for (int e = 0; e < 8; ++e) { lg[e] = g[c0 + e]; lb[e] = b[c0 + e]; muz[e] = mu[3072 + c0 + e]; }
        }
        const int t0 = r0 & (T - 1);
        const bf16_t* up = U + (size_t)r0 * UW + URW + c0;
        float zprev[8], zcur[8], znxt[8];
        if (t0 > 0) unpack8(*(const u32x4*)(up - UW + 3072), zprev); else { for (int e = 0; e < 8; ++e) zprev[e] = 0.f; }
        unpack8(*(const u32x4*)(up + 3072), zcur);
        for (int ib = 0; ib < 16; ib += 4) {
            u32x4 rv[4], rz[4], ry0[4], ry1[4]; float bonv[4];
#pragma unroll
            for (int r = 0; r < 4; ++r) {
                const int i = ib + r, row = r0 + i;
                const bf16_t* ur = up + (size_t)i * UW;
                rz[r] = (t0 + i < T - 1) ? *(const u32x4*)(ur + UW + 3072) : (u32x4){0u, 0u, 0u, 0u};
                rv[r] = *(const u32x4*)(ur + 2048);
                ry0[r] = *(const u32x4*)(YS + (size_t)row * DR + c0); ry1[r] = *(const u32x4*)(YS + ((size_t)SLAB + row) * DR + c0);
                bonv[r] = BON[(size_t)row * 16 + h] + BON[((size_t)SLAB + row) * 16 + h];
            }
#pragma unroll
            for (int r = 0; r < 4; ++r) {
                const int row = r0 + ib + r;
                float vv[8], zz[8], y[8], y1[8];
                unpack8(rv[r], vv); unpack8(rz[r], znxt); unpack8(ry0[r], y); unpack8(ry1[r], y1);
#pragma unroll
                for (int e = 0; e < 8; ++e) { zz[e] = zcur[e] + muz[e] * (0.5f * (zprev[e] + znxt[e]) - zcur[e]); zprev[e] = zcur[e]; zcur[e] = znxt[e]; }
                const float bon = bonv[r];
#pragma unroll
                for (int e = 0; e < 8; ++e) y[e] += y1[e];
                float sum = 0.f;
#pragma unroll
                for (int e = 0; e < 8; ++e) sum += y[e];
                sum += shx(sum, lane, 1); sum += shx(sum, lane, 2); sum += shx(sum, lane, 4);
                const float mean = sum * (1.f / 64.f);
                float sq = 0.f;
#pragma unroll
                for (int e = 0; e < 8; ++e) { const float dl = y[e] - mean; sq += dl * dl; }
                sq += shx(sq, lane, 1); sq += shx(sq, lane, 2); sq += shx(sq, lane, 4);
                const float rstd = rsqrtf(sq * (1.f / 64.f) + 64e-5f);
                float orw[8];
#pragma unroll
                for (int e = 0; e < 8; ++e) orw[e] = ((y[e] - mean) * rstd * lg[e] + lb[e] + bon * vv[e]) * (zz[e] * fsig(zz[e]));
                *(u32x4*)(ymix + (size_t)row * 2048 + 1024 + c0) = (u32x4){cvtpk(orw[0], orw[1]), cvtpk(orw[2], orw[3]), cvtpk(orw[4], orw[5]), cvtpk(orw[6], orw[7])};
            }
        }
    }
}

__device__ void phase_lnout(KP p, int s, int wid0) {
    KP_FRESH(p);
    int tid_ = hw_tid(wid0); asm volatile("" : "+v"(tid_)); int lane = tid_ & 63; const int gw = blockIdx.x * 8 + (tid_ >> 6), nw = gridDim.x * 8;
    float* out = p->out + (size_t)s * SLAB * D;
    const float4* g4 = (const float4*)p->in[I_LG]; const float4* b4 = (const float4*)p->in[I_LB];
    for (int r0 = gw; r0 < SLAB; r0 += 4 * nw) {
        asm volatile("" : "+v"(lane));
        float4 v[4][4];
#pragma unroll
        for (int k = 0; k < 4; ++k)
#pragma unroll
            for (int i = 0; i < 4; ++i) v[k][i] = ((const float4*)(out + (size_t)(r0 + k * nw) * D))[lane + 64 * i];
#pragma unroll
        for (int k = 0; k < 4; ++k) {
            float4* xp = (float4*)(out + (size_t)(r0 + k * nw) * D);
            float sum = 0.f;
#pragma unroll
            for (int i = 0; i < 4; ++i) sum += v[k][i].x + v[k][i].y + v[k][i].z + v[k][i].w;
            const float mean = wsum(sum, lane) * (1.f / 1024.f);
            float sq = 0.f;
#pragma unroll
            for (int i = 0; i < 4; ++i) { float a = v[k][i].x - mean, b = v[k][i].y - mean, c = v[k][i].z - mean, d = v[k][i].w - mean; sq += a * a + b * b + c * c + d * d; }
            const float rstd = rsqrtf(wsum(sq, lane) * (1.f / 1024.f) + 1e-5f);
#pragma unroll
            for (int i = 0; i < 4; ++i) {
                const float4 g = g4[lane + 64 * i], b = b4[lane + 64 * i];
                float4 o; o.x = (v[k][i].x - mean) * rstd * g.x + b.x; o.y = (v[k][i].y - mean) * rstd * g.y + b.y; o.z = (v[k][i].z - mean) * rstd * g.z + b.z; o.w = (v[k][i].w - mean) * rstd * g.w + b.w;
                xp[lane + 64 * i] = o;
            }
        }
    }
}

#define LAS __attribute__((address_space(3)))
#define XB_TMO      128
#define XB_XCNT(j)  (256  + 64 * (j))
#define XB_XSUB(j)  (1280 + 64 * (j))
#define XB_XGEN(j)  (2304 + 64 * (j))
#define XB_TOP      3328
#define XB_TOPGEN   3392
#define XCD_BAR_WORDS 3456
#define XB_SPIN_CAP (1u << 18)

__device__ __forceinline__ unsigned xb_ld(unsigned* p)              { return __hip_atomic_load(p, __ATOMIC_RELAXED, __HIP_MEMORY_SCOPE_AGENT); }
__device__ __forceinline__ unsigned xb_add(unsigned* p, unsigned v) { return __hip_atomic_fetch_add(p, v, __ATOMIC_RELAXED, __HIP_MEMORY_SCOPE_AGENT); }
__device__ __forceinline__ unsigned xb_xcc_id() { return (unsigned)__builtin_amdgcn_s_getreg((3 << 11) | 20) & 0xFu; }
#define XB_SPIN(cond, bar) do { unsigned _sp = 0; while (cond) { __builtin_amdgcn_s_sleep(1); \
    if ((++_sp & 255u) == 0u) { if (xb_ld(&(bar)[XB_TMO])) break; if (_sp > XB_SPIN_CAP) { atomicAdd(&(bar)[XB_TMO], 1u); break; } } } } while (0)

struct XcdBarrier {
    unsigned* bar; unsigned x;
    volatile LAS unsigned* st;
};

__device__ __forceinline__ XcdBarrier xcd_barrier_post(unsigned* bar, volatile LAS unsigned* st) {
    XcdBarrier b; b.bar = bar; b.x = xb_xcc_id(); b.st = st;
    if (threadIdx.x == 0) (void)xb_add(&bar[XB_XCNT(b.x)], 1u);
    return b;
}
__device__ __forceinline__ void xcd_barrier_complete(unsigned* bar, unsigned x, unsigned& nloc, unsigned& nx) {
    const unsigned G = gridDim.x * gridDim.y * gridDim.z;
    unsigned sum, cnt, mine, sp = 0u;
    for (;;) {
        sum = 0u; cnt = 0u; mine = 0u;
#pragma unroll
        for (unsigned j = 0; j < 16; ++j) { const unsigned c = xb_ld(&bar[XB_XCNT(j)]); sum += c; cnt += (c > 0u) ? 1u : 0u; mine = (j == x) ? c : mine; }
        if (sum == G) break;
        __builtin_amdgcn_s_sleep(1);
        if ((++sp & 255u) == 0u) { if (xb_ld(&bar[XB_TMO])) break; if (sp > XB_SPIN_CAP) { atomicAdd(&bar[XB_TMO], 1u); break; } }
    }
    nloc = mine > 0u ? mine : 1u; nx = cnt > 0u ? cnt : 1u;
}

__device__ __forceinline__ void xcd_barrier(const XcdBarrier& b) {
    asm volatile("s_waitcnt vmcnt(0)" ::: "memory");
    __syncthreads();
    if (threadIdx.x == 0) {
        unsigned* bar = b.bar;
        __builtin_amdgcn_s_waitcnt(0);
        unsigned nloc = b.st[0], nx = b.st[1];
        if (nloc == 0u) { xcd_barrier_complete(bar, b.x, nloc, nx); b.st[0] = nloc; b.st[1] = nx; }
        const unsigned old = xb_add(&bar[XB_XSUB(b.x)], 1u);
        const unsigned gen = old / nloc;
        if (old + 1u == (gen + 1u) * nloc) {
            __builtin_amdgcn_fence(__ATOMIC_RELEASE, "agent");
            asm volatile("s_waitcnt vmcnt(0)" ::: "memory");
            const unsigned og = xb_add(&bar[XB_TOP], 1u);
            const unsigned tg = og / nx;
            if (og + 1u == (tg + 1u) * nx) xb_add(&bar[XB_TOPGEN], 1u);
            else XB_SPIN(xb_ld(&bar[XB_TOPGEN]) == tg, bar);
            __builtin_amdgcn_fence(__ATOMIC_ACQUIRE, "agent");
            xb_add(&bar[XB_XGEN(b.x)], 1u);
            asm volatile("s_waitcnt vmcnt(0)" ::: "memory");
        } else {
            XB_SPIN(xb_ld(&bar[XB_XGEN(b.x)]) == gen, bar);
            __builtin_amdgcn_fence(__ATOMIC_ACQUIRE, "agent");
            asm volatile("s_waitcnt vmcnt(0)" ::: "memory");
        }
    }
    __syncthreads();
}

#ifndef REP_SHIFT
#define REP_SHIFT 1
#endif
#ifndef REP_G2
#define REP_G2 1
#endif
#ifndef REP_SCAN
#define REP_SCAN 1
#endif
#ifndef REP_POST
#define REP_POST 1
#endif
#ifndef REP_G1
#define REP_G1 1
#endif
#define GBAR() xcd_barrier(bar)
__global__ void __launch_bounds__(512, 2) fwd_megakernel(Params p_unused) {
    extern __shared__ __attribute__((aligned(16))) unsigned char lds_raw[];
    PG8_LAS unsigned char* lds = (PG8_LAS unsigned char*)lds_raw;
    cg::grid_group grid = cg::this_grid();
    KP p = (KP)__builtin_amdgcn_kernarg_segment_ptr();
    if (threadIdx.x < 2) ((volatile LAS unsigned*)(lds + LDS_BYTES - 64))[threadIdx.x] = 0u;
    __syncthreads();
    {
        unsigned* bw = (unsigned*)(((const Params __attribute__((address_space(4)))*)__builtin_amdgcn_kernarg_segment_ptr())->ws + WS_BAR);
        if (blockIdx.x == 0) { for (int w = threadIdx.x; w < XCD_BAR_WORDS; w += 512) __hip_atomic_store(bw + w, 0u, __ATOMIC_RELAXED, __HIP_MEMORY_SCOPE_AGENT); __threadfence(); }
        grid.sync();
    }
    XcdBarrier bar = xcd_barrier_post((unsigned*)(((const Params __attribute__((address_space(4)))*)__builtin_amdgcn_kernarg_segment_ptr())->ws + WS_BAR), (volatile LAS unsigned*)(lds + LDS_BYTES - 64));
    const int wid0 = __builtin_amdgcn_readfirstlane((int)threadIdx.x >> 6);
    phase_weights(p, wid0);
    for (int s = -1; s < 3; ++s) {
        if (s == 0) GBAR();
        if (s >= 0)
        for (int rep = 0; rep < REP_G1; ++rep) {
            if (rep) GBAR();
            KP_FRESH(p);
            pg8::Gemm g; g.A = xn_buf(p, s); g.Bt = (const bf16_t*)(p->ws + WS_WIN); g.M = SLAB; g.N = NIN; g.K = D;
            pg8::StaticOrder S; S.init(g.M, g.N, gridDim.x, blockIdx.x);
            EpiU E; E.U = (bf16_t*)(p->ws + WS_U); E.TMP = (bf16_t*)(p->ws + WS_TMP); E.mu = p->in[I_MU]; E.YM = (bf16_t*)(p->ws + WS_YMIX); E.SB2 = (bf16_t*)(p->ws + WS_SB2); E.cw = p->in[I_CW]; E.cb = p->in[I_CB];
            pg8::gemm_phase<EpiU, pg8::StaticOrder, true, true>(lds, g, S, E, wid0);
        }
        {
            const int wg0 = (s >= 0 && gridDim.x > 64) ? 64 : 0;
            if (s < 2 && (int)blockIdx.x >= wg0) phase_ln(p, s + 1, wid0, wg0);
        }
        if (s < 0) continue;
        GBAR();
        for (int rep = 0; rep < REP_SHIFT; ++rep) {
        phase_shift(p, s, wid0);
        GBAR();
        }
        for (int rep = 0; rep < REP_SCAN; ++rep) {
        phase_scan<1>(p, s, lds_raw, wid0);
        GBAR();
        if (s > 0 && gridDim.x >= 128) phase_combine_ring(p, s, wid0, lds_raw); else phase_combine(p, s, wid0);
        GBAR();
        phase_scan<2>(p, s, lds_raw, wid0);
        GBAR();
        }
        for (int rep = 0; rep < REP_POST; ++rep) {
        phase_post(p, s, wid0);
        GBAR();
        }
        for (int rep = 0; rep < REP_G2; ++rep) {
            if (rep) GBAR();
            KP_FRESH(p);
            pg8::Gemm g; g.A = (const bf16_t*)(p->ws + WS_YMIX); g.Bt = (const bf16_t*)(p->ws + WS_WOUT); g.M = SLAB; g.N = D; g.K = 2048;
            pg8::StaticOrder S; S.init(g.M, g.N, gridDim.x, blockIdx.x);
            EpiOut E; E.out = p->out + (size_t)s * SLAB * D; E.x = slab_x(p, s); E.stats = (const float*)(p->ws + WS_STATS) + (size_t)s * SLAB * 2; E.eg = p->in[I_EG]; E.eb = p->in[I_EB];
            pg8::gemm_phase<EpiOut, pg8::StaticOrder, true, true>(lds, g, S, E, wid0);
        }
        GBAR();
        phase_lnout(p, s, wid0);
    }
}

extern "C" void kernel_launch(void* const* d_in, const int* in_sizes, int n_in, void* d_out, int out_size, void* d_ws, size_t ws_size, hipStream_t stream) {
    static int grid_blocks = 0;
    if (!grid_blocks) {
        int dev = 0, cus = 0, per_cu = 0;
        hipGetDevice(&dev);
        hipDeviceGetAttribute(&cus, hipDeviceAttributeMultiprocessorCount, dev);
        hipFuncSetAttribute((const void*)fwd_megakernel, hipFuncAttributeMaxDynamicSharedMemorySize, LDS_BYTES);
        hipOccupancyMaxActiveBlocksPerMultiprocessor(&per_cu, (const void*)fwd_megakernel, 512, LDS_BYTES);
        if (per_cu < 1) per_cu = 1;
        if (per_cu > 1) per_cu = 1;
        grid_blocks = cus * per_cu;
    }
    Params p{};
    for (int i = 0; i < 20; ++i) p.in[i] = (const float*)d_in[i];
    p.out = (float*)d_out; p.ws = (unsigned char*)d_ws;
    void* args[] = {&p};
    hipError_t e = hipLaunchCooperativeKernel((const void*)fwd_megakernel, dim3(grid_blocks), dim3(512), args, LDS_BYTES, stream);
    if (e != hipSuccess) fprintf(stderr, "cooperative launch failed: %s (grid %d)\n", hipGetErrorString(e), grid_blocks);
}
```

```cpp
#include <hip/hip_runtime.h>
#include <hip/hip_cooperative_groups.h>
#include <cstdio>
#include <cstdint>
namespace cg = cooperative_groups;
namespace pg8 {
#define PG8_LAS __attribute__((address_space(3)))
typedef unsigned short bf16_t;
typedef short bf16x8 __attribute__((ext_vector_type(8)));
typedef float f32x4 __attribute__((ext_vector_type(4)));
typedef unsigned u32x4 __attribute__((ext_vector_type(4)));
constexpr int BM = 256, BK = 64, HALF = 128, HTB = HALF * BK * 2  , STAGE_BYTES = 8 * HTB, NXCD = 8, WGM = 4;

__host__ __device__ __forceinline__ int lds_byte(int r, int c) { const int st = (r >> 4) * 2 + (c >> 5), rr = r & 15, cc = c & 31, ob = rr * 64 + cc * 2; return st * 1024 + (ob ^ (((ob >> 9) & 1) << 5)); }
__host__ __device__ __forceinline__ void stage_rc(int b, int& R, int& C) { const int st = b / 1024, sb = b % 1024, swz = sb ^ (((sb >> 9) & 1) << 5); R = (st >> 1) * 16 + swz / 64; C = (st & 1) * 32 + (swz % 64) / 2; }
__host__ __device__ __forceinline__ int perm32(int rho) { const int n = rho >> 4, i = rho & 15; return 8 * (i >> 2) + 4 * n + (i & 3); }

struct Unit { int pm, pn; };
struct Gemm { const bf16_t* A; const bf16_t* Bt; int M, N, K; };

struct StaticOrder {
    int nM, nN, nwg, G, c;
    __host__ __device__ void init(int M, int N, int G_, int c_) { nM = M / BM; nN = N / BM; nwg = nM * nN; G = G_; c = c_; }
    __host__ __device__ bool next(int i, Unit& u) const {
        const long L = (long)i * G + c; if (L >= nwg) return false;
        int wgid = (int)L; { const int q = nwg / NXCD, r = nwg % NXCD, xcd = wgid % NXCD, off = wgid / NXCD; wgid = (xcd < r ? xcd * (q + 1) : r * (q + 1) + (xcd - r) * q) + off; }
        const int nig = WGM * nN, gid = wgid / nig, fm = gid * WGM, gsz = (nM - fm) < WGM ? (nM - fm) : WGM;
        u.pm = fm + ((wgid % nig) % gsz); u.pn = (wgid % nig) / gsz; return true;
    }
    __device__ __forceinline__ void a_ready(const Unit&) const {}
    __device__ __forceinline__ void done(const Unit&) const {}
};

template <class Epi, class Sched, bool ALIGN_EPI = false, bool SP2 = false>
__device__ __forceinline__ void gemm_phase(PG8_LAS unsigned char* lds, const Gemm g, const Sched& S, const Epi& E, int wid0) {
    int tid_; asm volatile("v_mbcnt_lo_u32_b32 %0, -1, 0\n\tv_mbcnt_hi_u32_b32 %0, -1, %0" : "=v"(tid_)); tid_ += wid0 * 64; const int tid = tid_, wid = __builtin_amdgcn_readfirstlane(tid >> 6), lane = tid & 63, wr = wid >> 2, wc = wid & 3, fr = lane & 15, fq = lane >> 4;
    const int K = g.K, nt = K / BK;
    unsigned voffA[2], voffB[2];
#pragma unroll
    for (int i = 0; i < 2; ++i) { int R, C; stage_rc(tid * 16 + i * 8192, R, C); const int Rb = Epi::PERM ? ((R & ~31) + perm32(R & 31)) : R;
        voffA[i] = (unsigned)(R * K + C) * 2u; voffB[i] = (unsigned)(Rb * K + C) * 2u; }
    const size_t kstep = (size_t)(BK * 2);
    const size_t hstep = (size_t)HALF * K * 2;
    const size_t tstep = 2 * hstep;
    const unsigned ldsw = (unsigned)wid * 1024u;
    const int aoff = lds_byte(wr * 64 + fr, fq * 8), boff = lds_byte(wc * 32 + fr, fq * 8);
#define PG8_SA(b, h) (((b) * 2 + (h)) * HTB)
#define PG8_SB(b, h) ((4 + (b) * 2 + (h)) * HTB)
#define PG8_STAGE(bufoff, gbase, voff) do { _Pragma("unroll") for (int _i = 0; _i < 2; ++_i) \
        __builtin_amdgcn_global_load_lds((const unsigned*)((const char*)(gbase) + (voff)[_i]), (PG8_LAS unsigned*)(lds + (bufoff) + ldsw + _i * 8192), 16, 0, 0); } while (0)
#define PG8_LDA(dst, b, h) do { _Pragma("unroll") for (int m = 0; m < 4; ++m) _Pragma("unroll") for (int k = 0; k < 2; ++k) dst[m][k] = *(const PG8_LAS bf16x8*)(lds + PG8_SA(b, h) + aoff + m * 2048 + k * 1024); } while (0)
#define PG8_LDB(dst, b, h) do { _Pragma("unroll") for (int n = 0; n < 2; ++n) _Pragma("unroll") for (int k = 0; k < 2; ++k) dst[n][k] = *(const PG8_LAS bf16x8*)(lds + PG8_SB(b, h) + boff + n * 2048 + k * 1024); } while (0)
#define PG8_MMA(ai, bj, At, Bt) do { __builtin_amdgcn_s_setprio(1); _Pragma("unroll") for (int m = 0; m < 4; ++m) _Pragma("unroll") for (int n = 0; n < 2; ++n) _Pragma("unroll") for (int k = 0; k < 2; ++k) \
        acc[ai][bj][m][n] = __builtin_amdgcn_mfma_f32_16x16x32_bf16(Bt[n][k], At[m][k], acc[ai][bj][m][n], 0, 0, 0); __builtin_amdgcn_s_setprio(0); } while (0)
#define PG8_WAIT_V(n) asm volatile("s_waitcnt vmcnt(" #n ")" ::: "memory")
#define PG8_WAIT_L(n) asm volatile("s_waitcnt lgkmcnt(" #n ")" ::: "memory")
#define PG8_BAR __builtin_amdgcn_s_barrier()
#define PG8_SCHED __builtin_amdgcn_sched_barrier(0)
    Unit cur, nxt; int ui = 0;
    if (!S.next(0, cur)) return;
    f32x4 acc[2][2][4][2];
#pragma unroll
    for (int a = 0; a < 2; ++a)
#pragma unroll
        for (int b = 0; b < 2; ++b)
#pragma unroll
            for (int m = 0; m < 4; ++m)
#pragma unroll
                for (int n = 0; n < 2; ++n) acc[a][b][m][n] = (f32x4){0.f, 0.f, 0.f, 0.f};
    bf16x8 At[4][2], B0[2][2], B1[2][2];
    const char* cA = (const char*)g.A + (size_t)cur.pm * tstep; const char* cB = (const char*)g.Bt + (size_t)cur.pn * tstep;
    S.a_ready(cur);
    if constexpr (SP2) {
        PG8_STAGE(PG8_SB(0, 0), cB, voffB); PG8_STAGE(PG8_SB(0, 1), cB + hstep, voffB); PG8_STAGE(PG8_SA(0, 0), cA, voffA); PG8_STAGE(PG8_SA(0, 1), cA + hstep, voffA);
        if (wr == 1) PG8_BAR;
        PG8_WAIT_V(2); PG8_BAR;
        PG8_STAGE(PG8_SB(1, 0), cB + kstep, voffB); PG8_STAGE(PG8_SA(1, 0), cA + kstep, voffA); PG8_STAGE(PG8_SB(1, 1), cB + hstep + kstep, voffB);
        PG8_WAIT_V(6); PG8_BAR;
    } else {
        PG8_STAGE(PG8_SB(0, 0), cB, voffB); PG8_STAGE(PG8_SA(0, 0), cA, voffA); PG8_STAGE(PG8_SB(0, 1), cB + hstep, voffB); PG8_STAGE(PG8_SA(0, 1), cA + hstep, voffA);
        if (wr == 1) PG8_BAR;
        PG8_WAIT_V(4); PG8_BAR;
        PG8_STAGE(PG8_SB(1, 0), cB + kstep, voffB); PG8_STAGE(PG8_SA(1, 0), cA + kstep, voffA); PG8_STAGE(PG8_SB(1, 1), cB + hstep + kstep, voffB);
        PG8_WAIT_V(6); PG8_BAR;
    }
    for (;;) {
        const bool has_next = S.next(ui + 1, nxt);
        const char* nA = has_next ? (const char*)g.A + (size_t)nxt.pm * tstep : cA; const char* nB = has_next ? (const char*)g.Bt + (size_t)nxt.pn * tstep : cB;
        for (int t = 0; t < nt; t += 2) {
            const bool last = (t == nt - 2);
            const char* a1 = cA + (size_t)(t + 1) * kstep;
            const char* a2 = last ? nA : cA + (size_t)(t + 2) * kstep; const char* b2 = last ? nB : cB + (size_t)(t + 2) * kstep;
            const char* a3 = a2 + kstep; const char* b3 = b2 + kstep;
            if (last && has_next) S.a_ready(nxt);
            if constexpr (SP2) {
            PG8_LDB(B0, 0, 0); PG8_LDB(B1, 0, 1); PG8_SCHED; PG8_LDA(At, 0, 0); PG8_STAGE(PG8_SA(1, 1), a1 + hstep, voffA);
            PG8_WAIT_V(8); PG8_WAIT_L(0); PG8_BAR; PG8_MMA(0, 0, At, B0); PG8_MMA(0, 1, At, B1); PG8_BAR; PG8_SCHED;
            PG8_LDA(At, 0, 1); PG8_STAGE(PG8_SB(0, 0), b2, voffB); PG8_STAGE(PG8_SB(0, 1), b2 + hstep, voffB); PG8_STAGE(PG8_SA(0, 0), a2, voffA);
            PG8_WAIT_V(8); PG8_WAIT_L(0); PG8_BAR; PG8_MMA(1, 0, At, B0); PG8_MMA(1, 1, At, B1); PG8_BAR; PG8_SCHED;
            PG8_LDB(B0, 1, 0); PG8_LDB(B1, 1, 1); PG8_SCHED; PG8_LDA(At, 1, 0); PG8_STAGE(PG8_SA(0, 1), a2 + hstep, voffA);
            PG8_WAIT_V(8); PG8_WAIT_L(0); PG8_BAR; PG8_MMA(0, 0, At, B0); PG8_MMA(0, 1, At, B1); PG8_BAR; PG8_SCHED;
            PG8_LDA(At, 1, 1); PG8_STAGE(PG8_SB(1, 0), b3, voffB); PG8_STAGE(PG8_SB(1, 1), b3 + hstep, voffB); PG8_STAGE(PG8_SA(1, 0), a3, voffA);
            PG8_WAIT_V(8); PG8_WAIT_L(0); PG8_BAR; PG8_MMA(1, 0, At, B0); PG8_MMA(1, 1, At, B1); PG8_BAR; PG8_SCHED;
            } else {
            PG8_LDB(B0, 0, 0); PG8_SCHED; PG8_LDA(At, 0, 0); PG8_STAGE(PG8_SA(1, 1), a1 + hstep, voffA);
            PG8_WAIT_L(8); PG8_BAR; PG8_WAIT_L(0); PG8_MMA(0, 0, At, B0); PG8_BAR; PG8_SCHED;
            PG8_LDB(B1, 0, 1); PG8_STAGE(PG8_SB(0, 0), b2, voffB);
            PG8_BAR; PG8_WAIT_L(0); PG8_MMA(0, 1, At, B1); PG8_BAR;
            PG8_LDA(At, 0, 1); PG8_STAGE(PG8_SA(0, 0), a2, voffA);
            PG8_BAR; PG8_WAIT_L(0); PG8_MMA(1, 0, At, B0); PG8_BAR; PG8_SCHED;
            PG8_STAGE(PG8_SB(0, 1), b2 + hstep, voffB);
            PG8_WAIT_V(6); PG8_BAR; PG8_MMA(1, 1, At, B1); PG8_BAR;
            PG8_LDB(B0, 1, 0); PG8_SCHED; PG8_LDA(At, 1, 0); PG8_STAGE(PG8_SA(0, 1), a2 + hstep, voffA);
            PG8_WAIT_L(8); PG8_BAR; PG8_WAIT_L(0); PG8_MMA(0, 0, At, B0); PG8_BAR; PG8_SCHED;
            PG8_LDB(B1, 1, 1); PG8_STAGE(PG8_SB(1, 0), b3, voffB);
            PG8_BAR; PG8_WAIT_L(0); PG8_MMA(0, 1, At, B1); PG8_BAR;
            PG8_LDA(At, 1, 1); PG8_STAGE(PG8_SA(1, 0), a3, voffA);
            PG8_BAR; PG8_WAIT_L(0); PG8_MMA(1, 0, At, B0); PG8_BAR; PG8_SCHED;
            PG8_STAGE(PG8_SB(1, 1), b3 + hstep, voffB);
            PG8_WAIT_V(6); PG8_BAR; PG8_MMA(1, 1, At, B1); PG8_BAR;
            }
        }
        if constexpr (ALIGN_EPI) { if (wr == 0) PG8_BAR; }
        if constexpr (!Epi::AFTER_DRAIN) { E(acc, cur, wr, wc, fr, fq); S.done(cur); }
        if (!has_next) break;
#pragma unroll
        for (int a = 0; a < 2; ++a)
#pragma unroll
            for (int b = 0; b < 2; ++b)
#pragma unroll
                for (int m = 0; m < 4; ++m)
#pragma unroll
                    for (int n = 0; n < 2; ++n) acc[a][b][m][n] = (f32x4){0.f, 0.f, 0.f, 0.f};
        cur = nxt; cA = nA; cB = nB; ++ui;
        if constexpr (ALIGN_EPI) { if (wr == 1) PG8_BAR; }
    }
    PG8_WAIT_V(0);
    if constexpr (!ALIGN_EPI) { if (wr == 0) PG8_BAR; }
    PG8_BAR;
    if constexpr (Epi::AFTER_DRAIN) { E.fused(acc, cur, wr, wc, fr, fq, lds, wid, lane); S.done(cur); }
#undef PG8_SA
#undef PG8_SB
#undef PG8_STAGE
#undef PG8_LDA
#undef PG8_LDB
#undef PG8_MMA
#undef PG8_WAIT_V
#undef PG8_WAIT_L
#undef PG8_BAR
#undef PG8_SCHED
}
}

typedef unsigned short bf16_t;
typedef float f32x4 __attribute__((ext_vector_type(4)));
typedef unsigned u32x4 __attribute__((ext_vector_type(4)));
typedef unsigned u32x2 __attribute__((ext_vector_type(2)));

constexpr int D = 1024, NIN = 8448, DR = 1024, UW = 6400  , URW = 2048  ;
constexpr int SLAB = 16384, NTOK = 49152;
constexpr float DN_ALPHA = 1.189207115002721f;
constexpr size_t WS_WIN = 0;
constexpr size_t WS_WOUT = WS_WIN + (size_t)NIN * D * 2;
constexpr size_t WS_STATS = WS_WOUT + (size_t)D * 2048 * 2;
constexpr size_t WS_XN = WS_STATS + (size_t)NTOK * 2 * 4;
constexpr size_t WS_U = WS_XN + (size_t)SLAB * D * 2;
constexpr size_t WS_YS = WS_U + (size_t)SLAB * UW * 2;
constexpr size_t WS_BON = WS_YS + (size_t)2 * SLAB * DR * 4;
constexpr size_t WS_YMIX = WS_YS + (size_t)2 * SLAB * DR * 2;
constexpr size_t WS_SB2 = WS_YS + (size_t)16 * 1024 * 1024;
constexpr size_t WS_TMP = WS_YS;
constexpr size_t WS_PQ = WS_BON + (size_t)2 * SLAB * 16 * 4;
constexpr size_t WS_SST = WS_PQ + (size_t)2048 * 8192 * 4;
constexpr size_t WS_BAR = WS_SST + (size_t)2048 * 4096 * 4;
constexpr size_t WS_END = WS_BAR + 16384;
static_assert(WS_END <= (size_t)512 * 1024 * 1024, "ws map");
constexpr int LDS_BYTES = 147456;

struct Params { const float* in[20]; float* out; unsigned char* ws; };
typedef const Params __attribute__((address_space(4)))* KP;
#define KP_FRESH(p) asm volatile("" : "+s"(p))
__device__ __forceinline__ int hw_tid(int wid0) { int l; asm volatile("v_mbcnt_lo_u32_b32 %0, -1, 0\n\tv_mbcnt_hi_u32_b32 %0, -1, %0" : "=v"(l)); return wid0 * 64 + l; }
enum { I_XP = 0, I_XS, I_EG, I_EB, I_WIN, I_CW, I_CB, I_MU, I_W0, I_WUP, I_A0, I_AUP, I_KK, I_KA, I_RK, I_LXG, I_LXB, I_WOUT, I_LG, I_LB };

__device__ __forceinline__ float bf2f(unsigned short h) { return __uint_as_float((unsigned)h << 16); }
__device__ __forceinline__ unsigned f2bf(float f) { unsigned u = __float_as_uint(f); return (u + 0x7fffu + ((u >> 16) & 1u)) >> 16; }
__device__ __forceinline__ unsigned pk2(float lo, float hi) { return f2bf(lo) | (f2bf(hi) << 16); }
typedef __bf16 bf16x2e_t __attribute__((ext_vector_type(2)));
typedef float f32x2e __attribute__((ext_vector_type(2)));
__device__ __forceinline__ unsigned cvtpk_(float lo, float hi) { f32x2e v = {lo, hi}; bf16x2e_t b = __builtin_convertvector(v, bf16x2e_t); return __builtin_bit_cast(unsigned, b); }
__device__ __forceinline__ float shx(float v, int lane, int o) { return __int_as_float(__builtin_amdgcn_ds_bpermute((lane ^ o) << 2, __float_as_int(v))); }
__device__ __forceinline__ float wsum(float v, int lane) {
#pragma unroll
    for (int o = 32; o; o >>= 1) v += shx(v, lane, o);
    return v;
}
__device__ __forceinline__ float sigmoidf_(float x) { return __builtin_amdgcn_rcpf(1.f + __builtin_amdgcn_exp2f(-1.44269504f * x)); }
__device__ __forceinline__ float siluf_(float x) { return x * sigmoidf_(x); }
__device__ __forceinline__ float rl(float v, int l) { return __int_as_float(__builtin_amdgcn_readlane(__float_as_int(v), l)); }

__device__ __forceinline__ void slab_info(int s, int& tok0, int& nseq, int& T) { if (s == 0) { tok0 = 0; nseq = 8; T = 2048; } else { tok0 = SLAB * s; nseq = 1; T = 16384; } }
__device__ __forceinline__ const float* slab_x(KP p, int s) { return s == 0 ? p->in[I_XP] : p->in[I_XS] + (size_t)(s - 1) * SLAB * D; }

__device__ __forceinline__ int orig_col(int jv) {
    if (jv >= 4096) return jv;
    const int pn = jv >> 8, bj = (jv >> 7) & 1, wc = (jv >> 5) & 3, fq = (jv >> 3) & 3, n = (jv >> 2) & 1, j = jv & 3;
    return (2 * bj + n) * 1024 + 64 * pn + 16 * wc + 4 * fq + j;
}

__device__ void phase_weights(KP p, int wid0) {
    KP_FRESH(p);
    int gt = blockIdx.x * 512 + hw_tid(wid0); asm volatile("" : "+v"(gt)); const int nt = gridDim.x * 512;
    bf16_t* win = (bf16_t*)(p->ws + WS_WIN); bf16_t* wout = (bf16_t*)(p->ws + WS_WOUT);
    const float* w_in = p->in[I_WIN]; const float* w_out = p->in[I_WOUT];
    for (int idx = gt; idx < NIN * 128; idx += nt) {
        const int jv = idx % NIN, kg = idx / NIN, oc = orig_col(jv);
        float v[8];
#pragma unroll
        for (int i = 0; i < 8; ++i) v[i] = w_in[(size_t)(kg * 8 + i) * NIN + oc];
        u32x4 w; w.x = cvtpk_(v[0], v[1]); w.y = cvtpk_(v[2], v[3]); w.z = cvtpk_(v[4], v[5]); w.w = cvtpk_(v[6], v[7]);
        *(u32x4*)(win + (size_t)jv * D + kg * 8) = w;
    }
    for (int idx = gt; idx < D * 256; idx += nt) {
        const int n = idx % D, kg = idx / D;
        float v[8];
#pragma unroll
        for (int i = 0; i < 8; ++i) v[i] = w_out[(size_t)(kg * 8 + i) * D + n];
        u32x4 w; w.x = cvtpk_(v[0], v[1]); w.y = cvtpk_(v[2], v[3]); w.z = cvtpk_(v[4], v[5]); w.w = cvtpk_(v[6], v[7]);
        *(u32x4*)(wout + (size_t)n * 2048 + kg * 8) = w;
    }
}

__device__ __forceinline__ bf16_t* xn_buf(KP p, int s) { return s == 1 ? (bf16_t*)(p->out + (size_t)2 * SLAB * D) : (bf16_t*)(p->ws + WS_XN); }
__device__ __forceinline__ void phase_ln(KP p, int s, int wid0, int wg0) {
    KP_FRESH(p);
    int tid_ = hw_tid(wid0); asm volatile("" : "+v"(tid_)); int lane = tid_ & 63; const int gw = ((int)blockIdx.x - wg0) * 8 + (tid_ >> 6), nw = ((int)gridDim.x - wg0) * 8;
    const float* x = slab_x(p, s); bf16_t* xn = xn_buf(p, s); float* stats = (float*)(p->ws + WS_STATS) + (size_t)s * SLAB * 2;
    const float4* g4 = (const float4*)p->in[I_EG]; const float4* b4 = (const float4*)p->in[I_EB];
    for (int gi = gw; gi < SLAB / 4; gi += nw) {
        const int r0 = gi * 4;
        asm volatile("" : "+v"(lane));
        float4 v[4][4];
#pragma unroll
        for (int k = 0; k < 4; ++k)
#pragma unroll
            for (int i = 0; i < 4; ++i) v[k][i] = ((const float4*)(x + (size_t)(r0 + k) * D))[lane + 64 * i];
#pragma unroll
        for (int k = 0; k < 4; ++k) {
            const int r = r0 + k;
            float sum = 0.f;
#pragma unroll
            for (int i = 0; i < 4; ++i) sum += v[k][i].x + v[k][i].y + v[k][i].z + v[k][i].w;
            const float mean = wsum(sum, lane) * (1.f / 1024.f);
            float sq = 0.f;
#pragma unroll
            for (int i = 0; i < 4; ++i) { float a = v[k][i].x - mean, b = v[k][i].y - mean, c = v[k][i].z - mean, d = v[k][i].w - mean; sq += a * a + b * b + c * c + d * d; }
            const float rstd = rsqrtf(wsum(sq, lane) * (1.f / 1024.f) + 1e-5f);
            if (lane == 0) { stats[r * 2] = mean; stats[r * 2 + 1] = rstd; }
#pragma unroll
            for (int i = 0; i < 4; ++i) {
                const float4 g = g4[lane + 64 * i], b = b4[lane + 64 * i];
                u32x2 w; w.x = cvtpk_((v[k][i].x - mean) * rstd * g.x + b.x, (v[k][i].y - mean) * rstd * g.y + b.y);
                w.y = cvtpk_((v[k][i].z - mean) * rstd * g.z + b.z, (v[k][i].w - mean) * rstd * g.w + b.w);
                *(u32x2*)(xn + (size_t)r * D + (lane + 64 * i) * 4) = w;
            }
        }
    }
}

struct EpiU {
    static constexpr bool PERM = true, AFTER_DRAIN = false;
    bf16_t* U; bf16_t* TMP; const float* mu; bf16_t* YM; bf16_t* SB2; const float* cw; const float* cb;
    __device__ __forceinline__ void operator()(const f32x4 (&acc)[2][2][4][2], const pg8::Unit& u, int wr, int wc, int fr, int fq) const {
        const int row0 = u.pm * 256 + wr * 64 + fr;
        if (u.pn < 16) {
            const int ch0 = 64 * u.pn + 16 * wc + 4 * fq;
            const f32x4 cw0 = *(const f32x4*)(cw + ch0), cw1 = *(const f32x4*)(cw + 1024 + ch0), cw2 = *(const f32x4*)(cw + 2048 + ch0), cbv = *(const f32x4*)(cb + ch0);
#define EPI_DPP(old_, src_, ctrl_) __int_as_float(__builtin_amdgcn_update_dpp(__float_as_int(old_), __float_as_int(src_), ctrl_, 0xf, 0xf, false))
#pragma unroll
            for (int ai = 0; ai < 2; ++ai) {
                f32x4 pv_[4], gv_[4];
#pragma unroll
                for (int m = 0; m < 4; ++m) {
                    const f32x4 h = acc[ai][0][m][0], B = acc[ai][0][m][1], C = acc[ai][1][m][0], z = acc[ai][1][m][1];
                    pv_[m] = C * h;
#pragma unroll
                    for (int j = 0; j < 4; ++j) gv_[m][j] = B[j] * siluf_(z[j]);
                }
                const int blk = 4 * u.pm + 2 * ai + wr;
#pragma unroll
                for (int m = 0; m < 4; ++m) {
                    f32x4 pr, nx;
#pragma unroll
                    for (int j = 0; j < 4; ++j) {
                        const float po = (m > 0) ? EPI_DPP(0.f, pv_[m > 0 ? m - 1 : 0][j], 0x121) : 0.f, no = (m < 3) ? EPI_DPP(0.f, pv_[m < 3 ? m + 1 : 3][j], 0x12F) : 0.f;
                        pr[j] = EPI_DPP(po, pv_[m][j], 0x111); nx[j] = EPI_DPP(no, pv_[m][j], 0x101);
                    }
                    const f32x4 y = gv_[m] * (cw0 * pr + cw1 * pv_[m] + cw2 * nx + cbv);
                    u32x2 wy; wy.x = cvtpk_(y[0], y[1]); wy.y = cvtpk_(y[2], y[3]);
                    *(u32x2*)(YM + (size_t)(row0 + ai * 128 + m * 16) * 2048 + ch0) = wy;
                    if ((m == 0 && fr < 2) || (m == 3 && fr >= 14)) {
                        const int w4 = (m == 0) ? fr : fr - 12;
                        u32x2 wp; wp.x = cvtpk_(pv_[m][0], pv_[m][1]); wp.y = cvtpk_(pv_[m][2], pv_[m][3]);
                        *(u32x2*)(SB2 + ((size_t)blk * 6 + w4) * 1024 + ch0) = wp;
                        if (w4 == 0 || w4 == 3) {
                            u32x2 wg; wg.x = cvtpk_(gv_[m][0], gv_[m][1]); wg.y = cvtpk_(gv_[m][2], gv_[m][3]);
                            *(u32x2*)(SB2 + ((size_t)blk * 6 + (w4 == 0 ? 4 : 5)) * 1024 + ch0) = wg;
                        }
                    }
                }
            }
#undef EPI_DPP
        } else {
            const int col0 = 256 * (u.pn - 16) + 32 * wc + 8 * fq; const bool zt = (u.pn >= 28) && (u.pn < 32);
            if (zt) {
#pragma unroll
                for (int ai = 0; ai < 2; ++ai)
#pragma unroll
                    for (int m = 0; m < 4; ++m) {
                        bf16_t* rowp = U + (size_t)(row0 + ai * 128 + m * 16) * UW + URW + col0;
#pragma unroll
                        for (int bj = 0; bj < 2; ++bj) {
                            const f32x4 v0 = acc[ai][bj][m][0], v1 = acc[ai][bj][m][1];
                            u32x4 w; w.x = cvtpk_(v0[0], v0[1]); w.y = cvtpk_(v0[2], v0[3]); w.z = cvtpk_(v1[0], v1[1]); w.w = cvtpk_(v1[2], v1[3]);
                            *(u32x4*)(rowp + bj * 128) = w;
                        }
                    }
            } else {
#define EPI_DPP(old_, src_, ctrl_) __int_as_float(__builtin_amdgcn_update_dpp(__float_as_int(old_), __float_as_int(src_), ctrl_, 0xf, 0xf, false))
#pragma unroll
                for (int ai = 0; ai < 2; ++ai)
#pragma unroll
                    for (int bj = 0; bj < 2; ++bj) {
                        const int cb = col0 + bj * 128;
                        const f32x4 mu0 = *(const f32x4*)(mu + cb), mu1 = *(const f32x4*)(mu + cb + 4);
                        const bool th = (u.pn == 32) && (bj == 0);
                        const int blk = 4 * u.pm + 2 * ai + wr;
#pragma unroll
                        for (int m = 0; m < 4; ++m) {
                            u32x4 wv;
#pragma unroll
                            for (int n = 0; n < 2; ++n) {
                                const f32x4 cur = acc[ai][bj][m][n], mun = n ? mu1 : mu0;
                                f32x4 pv, nx;
#pragma unroll
                                for (int j = 0; j < 4; ++j) {
                                    const float po = (m > 0) ? EPI_DPP(0.f, acc[ai][bj][m > 0 ? m - 1 : 0][n][j], 0x121) : 0.f;
                                    const float no = (m < 3) ? EPI_DPP(0.f, acc[ai][bj][m < 3 ? m + 1 : 3][n][j], 0x12F) : 0.f;
                                    pv[j] = EPI_DPP(po, cur[j], 0x111); nx[j] = EPI_DPP(no, cur[j], 0x101);
                                }
                                f32x4 o = cur * (1.f - mun) + (0.5f * mun) * (pv + nx);
                                if (th) {
#pragma unroll
                                    for (int j = 0; j < 4; ++j) o[j] = 1.f - 2.f * __builtin_amdgcn_rcpf(1.f + __builtin_amdgcn_exp2f(2.88539008f * o[j]));
                                }
                                if (n == 0) { wv.x = cvtpk_(o[0], o[1]); wv.y = cvtpk_(o[2], o[3]); } else { wv.z = cvtpk_(o[0], o[1]); wv.w = cvtpk_(o[2], o[3]); }
                            }
                            *(u32x4*)(U + (size_t)(row0 + ai * 128 + m * 16) * UW + URW + cb) = wv;
                            if ((m == 0 && fr < 2) || (m == 3 && fr >= 14)) {
                                const int w4 = (m == 0) ? fr : fr - 12;
                                const f32x4 v0 = acc[ai][bj][m][0], v1 = acc[ai][bj][m][1];
                                u32x4 w; w.x = cvtpk_(v0[0], v0[1]); w.y = cvtpk_(v0[2], v0[3]); w.z = cvtpk_(v1[0], v1[1]); w.w = cvtpk_(v1[2], v1[3]);
                                *(u32x4*)(TMP + ((size_t)blk * 4 + w4) * 4352 + cb) = w;
                            }
                        }
                    }
#undef EPI_DPP
            }
        }
    }
};

struct EpiOut {
    static constexpr bool PERM = true, AFTER_DRAIN = false;
    float* out; const float* x; const float* stats; const float* eg; const float* eb;
    __device__ __forceinline__ void operator()(const f32x4 (&acc)[2][2][4][2], const pg8::Unit& u, int wr, int wc, int fr, int fq) const {
        const int row0 = u.pm * 256 + wr * 64 + fr, col0 = u.pn * 256 + wc * 32 + 8 * fq;
#pragma unroll
        for (int ai = 0; ai < 2; ++ai)
#pragma unroll
            for (int m = 0; m < 4; ++m) {
                const int row = row0 + ai * 128 + m * 16;
                const float mean = stats[row * 2], rstd = stats[row * 2 + 1];
#pragma unroll
                for (int bj = 0; bj < 2; ++bj)
#pragma unroll
                    for (int n = 0; n < 2; ++n) {
                        const int c = col0 + bj * 128 + 4 * n;
                        const float4 xv = *(const float4*)(x + (size_t)row * D + c), g = *(const float4*)(eg + c), b = *(const float4*)(eb + c);
                        const f32x4 a = acc[ai][bj][m][n];
                        float4 o;
                        o.x = DN_ALPHA * ((xv.x - mean) * rstd * g.x + b.x) + a[0]; o.y = DN_ALPHA * ((xv.y - mean) * rstd * g.y + b.y) + a[1];
                        o.z = DN_ALPHA * ((xv.z - mean) * rstd * g.z + b.z) + a[2]; o.w = DN_ALPHA * ((xv.w - mean) * rstd * g.w + b.w) + a[3];
                        *(float4*)(out + (size_t)row * D + c) = o;
                    }
            }
    }
};

typedef short bf16x8 __attribute__((ext_vector_type(8)));
typedef short s16x4 __attribute__((ext_vector_type(4)));
typedef __bf16 bf16x2_t __attribute__((ext_vector_type(2)));
typedef float f32x2 __attribute__((ext_vector_type(2)));
#define MFMA16(a, b, c) __builtin_amdgcn_mfma_f32_16x16x32_bf16((a), (b), (c), 0, 0, 0)
#define DI __device__ __forceinline__
constexpr int IMG_STRIDE = 144;
constexpr int WG_FRAG = 0;
constexpr int WG_CONST = 16384;
constexpr int WV_BASE = 16384 + 2560;
constexpr int WV_BYTES = 3 * 16 * IMG_STRIDE + 256;
static_assert(WV_BASE + 8 * WV_BYTES <= LDS_BYTES, "scan LDS map");

DI unsigned cvtpk(float lo, float hi) { f32x2 v = {lo, hi}; bf16x2_t b = __builtin_convertvector(v, bf16x2_t); return __builtin_bit_cast(unsigned, b); }
DI bf16x8 mkfrag(unsigned a, unsigned b, unsigned c, unsigned d) { u32x4 w = {a, b, c, d}; return __builtin_bit_cast(bf16x8, w); }
DI bf16x8 frag_f4(f32x4 a, f32x4 b) { return mkfrag(cvtpk(a[0], a[1]), cvtpk(a[2], a[3]), cvtpk(b[0], b[1]), cvtpk(b[2], b[3])); }
DI float bperm(float v, int srclane) { return __int_as_float(__builtin_amdgcn_ds_bpermute(srclane << 2, __float_as_int(v))); }
DI float lo16(unsigned w) { return __uint_as_float(w << 16); }
DI float hi16(unsigned w) { return __uint_as_float(w & 0xffff0000u); }
template <int CTRL> DI float dpp0(float x) { return __int_as_float(__builtin_amdgcn_update_dpp(0, __float_as_int(x), CTRL, 0xf, 0xf, true)); }
template <int CTRL> DI float dpp1(float x) { return __int_as_float(__builtin_amdgcn_update_dpp(0x3f800000, __float_as_int(x), CTRL, 0xf, 0xf, false)); }
DI float fsig(float x) { return __builtin_amdgcn_rcpf(1.f + __expf(-x)); }
DI f32x4 ld4(const bf16_t* ur) { const u32x2 c = *(const u32x2*)ur; return (f32x4){lo16(c.x), hi16(c.x), lo16(c.y), hi16(c.y)}; }

DI void split_frag(f32x4 a, f32x4 b, bf16x8& hi, bf16x8& lo) {
    f32x4 ah, bh;
    unsigned w[4] = {cvtpk(a[0], a[1]), cvtpk(a[2], a[3]), cvtpk(b[0], b[1]), cvtpk(b[2], b[3])};
    ah[0] = lo16(w[0]); ah[1] = hi16(w[0]); ah[2] = lo16(w[1]); ah[3] = hi16(w[1]); bh[0] = lo16(w[2]); bh[1] = hi16(w[2]); bh[2] = lo16(w[3]); bh[3] = hi16(w[3]);
    hi = mkfrag(w[0], w[1], w[2], w[3]); lo = frag_f4(a - ah, b - bh);
}
struct ChunkIn { u32x2 k[4], r[4], v[4]; bf16x8 tl[2], la[2]; };
template <int PASS> DI void chunk_load(ChunkIn& c, const bf16_t* ur, int h, int d, int q) {
#pragma unroll
    for (int n = 0; n < 4; ++n) {
        c.k[n] = *(const u32x2*)(ur + 1024 + h * 64 + 16 * n + 4 * q);
        if (PASS == 2) { c.v[n] = *(const u32x2*)(ur + 2048 + h * 64 + 16 * n + 4 * q); c.r[n] = *(const u32x2*)(ur + h * 64 + 16 * n + 4 * q); }
    }
#pragma unroll
    for (int ks = 0; ks < 2; ++ks) { const bf16_t* ul = ur + 4096 + d * 64 + 32 * ks + 8 * q; c.tl[ks] = *(const bf16x8*)ul; c.la[ks] = *(const bf16x8*)(ul + 128); }
}
DI f32x4 up4(u32x2 c) { return (f32x4){lo16(c.x), hi16(c.x), lo16(c.y), hi16(c.y)}; }
template <int PASS>
__device__ void phase_scan(KP p, int s, unsigned char* ldsg, int wid0) {
    KP_FRESH(p);
    const int wid = wid0;
    int tok0, nseq, T; slab_info(s, tok0, nseq, T);
    const int LS = 256, lgseg = (s == 0) ? 3 : 6, nseg = 1 << lgseg, nblk = (nseq * 32 << lgseg) >> 3;
    const bf16_t* U = (const bf16_t*)(p->ws + WS_U);
    bf16_t* YS = (bf16_t*)(p->ws + WS_YS); float* BON = (float*)(p->ws + WS_BON);
    float* PQ = (float*)(p->ws + WS_PQ); const float* SST = (const float*)(p->ws + WS_SST);
    float* cst = (float*)(ldsg + WG_CONST);
    const int wo = WV_BASE + wid * WV_BYTES;
    for (int ib = blockIdx.x; ib < nblk; ib += gridDim.x) {
        const int item = ib * 8 + wid, g = item & (nseg - 1), chain = item >> lgseg, h = chain & 15, d = (chain >> 4) & 1, b = chain >> 5;
        const int tid = hw_tid(wid0), lane = tid & 63, fr = lane & 15, q = lane >> 4;
        __syncthreads();
        if (tid < 64) {
            const float* mu = p->in[I_MU]; const int c = h * 64 + tid;
            cst[tid] = mu[c]; cst[64 + tid] = mu[1024 + c]; cst[128 + tid] = mu[2048 + c];
            cst[192 + tid] = -1.44269504f * p->in[I_W0][d * 1024 + c]; cst[256 + tid] = -1.44269504f * p->in[I_A0][d * 1024 + c];
            cst[320 + tid] = p->in[I_KK][c]; cst[384 + tid] = p->in[I_KA][c]; cst[448 + tid] = p->in[I_RK][c];
            cst[512 + tid] = mu[4096 + d * 64 + tid]; cst[576 + tid] = mu[4096 + 128 + d * 64 + tid];
        }
        for (int e = tid; e < 1024; e += 512) {
            const int l2 = e & 63, ks = (e >> 6) & 1, mt = (e >> 7) & 3, mat = e >> 9, fr2 = l2 & 15, q2 = l2 >> 4;
            const float* src = (mat ? p->in[I_AUP] : p->in[I_WUP]) + ((size_t)d * 64 + 32 * ks + 8 * q2) * 1024 + h * 64 + 16 * mt + fr2;
            float v8[8];
#pragma unroll
            for (int jj = 0; jj < 8; ++jj) v8[jj] = -1.44269504f * src[(size_t)jj * 1024];
            u32x4 w = {cvtpk(v8[0], v8[1]), cvtpk(v8[2], v8[3]), cvtpk(v8[4], v8[5]), cvtpk(v8[6], v8[7])};
            *(u32x4*)(ldsg + WG_FRAG + e * 16) = w;
        }
        __syncthreads();
        f32x4 St[4][4];
        f32x4 Pa[PASS == 1 ? 4 : 1][PASS == 1 ? 4 : 1];
        int l3 = lane; asm volatile("" : "+v"(l3));
        const float* sstl = SST + (size_t)item * 4096 + l3 * 4;
#pragma unroll
        for (int mt = 0; mt < 4; ++mt)
#pragma unroll
            for (int nt = 0; nt < 4; ++nt) {
                if (PASS == 1) {
#pragma unroll
                    for (int j = 0; j < 4; ++j) { St[mt][nt][j] = 0.f; Pa[PASS == 1 ? mt : 0][PASS == 1 ? nt : 0][j] = (16 * mt + 4 * q + j == 16 * nt + fr) ? 1.f : 0.f; }
                } else {
                    St[mt][nt] = *(const f32x4*)(sstl + (mt * 4 + nt) * 256);
                }
            }
        ChunkIn cin;
        { const int p0 = g * LS, t0 = d ? T - 1 - (p0 + fr) : p0 + fr; chunk_load<PASS>(cin, U + (size_t)(b * T + t0) * UW + URW, h, d, q); }
        for (int ck = 0; ck < LS / 16; ++ck) {
            const int pos0 = g * LS + ck * 16;
            const int lane_c = hw_tid(wid0) & 63;
            const int lane = lane_c, fr = lane_c & 15, q = lane_c >> 4;
            const int ti = d ? T - 1 - (pos0 + fr) : pos0 + fr, row = b * T + ti;
            ChunkIn cc = cin;
            if (PASS == 1) {
#pragma unroll
                for (int n = 0; n < 4; ++n) cc.v[n] = *(const u32x2*)(U + (size_t)row * UW + URW + 2048 + h * 64 + 16 * n + 4 * q);
            }
            {
                const int pn = g * LS + (ck + 1 < LS / 16 ? ck + 1 : ck) * 16, tn = d ? T - 1 - (pn + fr) : pn + fr;
                chunk_load<PASS>(cin, U + (size_t)(b * T + tn) * UW + URW, h, d, q);
            }
            const int lq16 = 16 * q, ll16 = 16 * lane, limg = fr * IMG_STRIDE + 8 * q, ltr = (4 * q + (fr >> 2)) * IMG_STRIDE + 8 * (fr & 3);
            f32x4 ow[4], oa[4];
            {
                const bf16x8 tlf[2] = {cc.tl[0], cc.tl[1]}, laf[2] = {cc.la[0], cc.la[1]};
#pragma unroll
                for (int mt = 0; mt < 4; ++mt) {
                    const bf16x8 w0f = *(const bf16x8*)(ldsg + WG_FRAG + ((0 * 4 + mt) * 2 + 0) * 1024 + ll16), w1f = *(const bf16x8*)(ldsg + WG_FRAG + ((0 * 4 + mt) * 2 + 1) * 1024 + ll16);
                    const bf16x8 a0f = *(const bf16x8*)(ldsg + WG_FRAG + ((1 * 4 + mt) * 2 + 0) * 1024 + ll16), a1f = *(const bf16x8*)(ldsg + WG_FRAG + ((1 * 4 + mt) * 2 + 1) * 1024 + ll16);
                    f32x4 z = {0.f, 0.f, 0.f, 0.f};
                    ow[mt] = MFMA16(w1f, tlf[1], MFMA16(w0f, tlf[0], z));
                    oa[mt] = MFMA16(a1f, laf[1], MFMA16(a0f, laf[0], z));
                }
            }
            f32x4 km[4]; f32x4 ss4 = {0.f, 0.f, 0.f, 0.f};
#pragma unroll
            for (int n = 0; n < 4; ++n) {
                km[n] = up4(cc.k[n]);
                const f32x4 kr = km[n] * *(const f32x4*)(ldsg + WG_CONST + (320 + 16 * n) * 4 + lq16);
                ss4 += kr * kr;
            }
            float ss = (ss4[0] + ss4[1]) + (ss4[2] + ss4[3]);
            ss += bperm(ss, lane ^ 16); ss += bperm(ss, lane ^ 32);
            const float kinv = 1.f / fmaxf(sqrtf(ss), 1e-12f);
            u32x2 kapP[4], ktP[4], btP[4], rtP[4]; f32x4 bon4 = {0.f, 0.f, 0.f, 0.f};
#pragma unroll
            for (int n = 0; n < 4; ++n) {
                const f32x4 w0v = *(const f32x4*)(ldsg + WG_CONST + (192 + 16 * n) * 4 + lq16), a0v = *(const f32x4*)(ldsg + WG_CONST + (256 + 16 * n) * 4 + lq16), kkw = *(const f32x4*)(ldsg + WG_CONST + (320 + 16 * n) * 4 + lq16), kav = *(const f32x4*)(ldsg + WG_CONST + (384 + 16 * n) * 4 + lq16);
                const f32x4 tw = w0v + ow[n], ta = a0v + oa[n];
                f32x4 ew, ea;
#pragma unroll
                for (int j = 0; j < 4; ++j) { ew[j] = __builtin_amdgcn_exp2f(tw[j]); ea[j] = __builtin_amdgcn_exp2f(ta[j]); }
                const f32x4 dw = ew + 1.f, da = ea + 1.f;
                f32x4 sw, av;
#pragma unroll
                for (int j = 0; j < 4; ++j) { sw[j] = __builtin_amdgcn_rcpf(dw[j]); av[j] = __builtin_amdgcn_rcpf(da[j]); }
                const f32x4 lw2 = sw * -0.87503877f;
                f32x4 L, Lm, gmv, emL;
#pragma unroll
                for (int j = 0; j < 4; ++j) {
                    float x = __builtin_amdgcn_exp2f(lw2[j]);
                    x *= dpp1<0x111>(x); x *= dpp1<0x112>(x); x *= dpp1<0x114>(x); x *= dpp1<0x118>(x);
                    L[j] = x; Lm[j] = dpp1<0x111>(x); gmv[j] = dpp0<0x121>(x);
                    emL[j] = __builtin_amdgcn_rcpf(x);
                }
                const f32x4 kk = km[n] * kkw * kinv;
                const f32x4 kd = km[n] * ((av - 1.f) * kav + 1.f);
                const f32x4 kap = kk * Lm, bt = kk * av * emL, kt = kd * emL;
                if (fr == 0) *(f32x4*)(ldsg + wo + 48 * IMG_STRIDE + 64 * n + lq16) = gmv;
                kapP[n] = (u32x2){cvtpk(kap[0], kap[1]), cvtpk(kap[2], kap[3])};
                ktP[n] = (u32x2){cvtpk(kt[0], kt[1]), cvtpk(kt[2], kt[3])};
                btP[n] = (u32x2){cvtpk(bt[0], bt[1]), cvtpk(bt[2], bt[3])};
                *(u32x2*)(ldsg + wo + 16 * IMG_STRIDE + 32 * n + limg) = ktP[n];
                *(u32x2*)(ldsg + wo + 32 * IMG_STRIDE + 32 * n + limg) = btP[n];
                if (PASS == 2) {
                    const f32x4 rm = up4(cc.r[n]), rk = *(const f32x4*)(ldsg + WG_CONST + (448 + 16 * n) * 4 + lq16);
                    const f32x4 rt = rm * L;
                    rtP[n] = (u32x2){cvtpk(rt[0], rt[1]), cvtpk(rt[2], rt[3])};
                    bon4 += rm * kd * rk;
                }
                *(u32x2*)(ldsg + wo + 32 * n + limg) = cc.v[n];
            }
            if (PASS == 2) {
                float bon = (bon4[0] + bon4[1]) + (bon4[2] + bon4[3]);
                bon += bperm(bon, lane ^ 16); bon += bperm(bon, lane ^ 32);
                if (q == 0) BON[((size_t)d * SLAB + row) * 16 + h] = 0.5f * bon;
            }
            const bf16x8 kapF0 = mkfrag(kapP[0].x, kapP[0].y, kapP[1].x, kapP[1].y), kapF1 = mkfrag(kapP[2].x, kapP[2].y, kapP[3].x, kapP[3].y);
            bf16x8 akkA, tA, aryA;
            {
                const bf16x8 ktF0 = mkfrag(ktP[0].x, ktP[0].y, ktP[1].x, ktP[1].y), ktF1 = mkfrag(ktP[2].x, ktP[2].y, ktP[3].x, ktP[3].y);
                const bf16x8 btF0 = mkfrag(btP[0].x, btP[0].y, btP[1].x, btP[1].y), btF1 = mkfrag(btP[2].x, btP[2].y, btP[3].x, btP[3].y);
                const f32x4 z = {0.f, 0.f, 0.f, 0.f};
                f32x4 akk = MFMA16(ktF1, kapF1, MFMA16(ktF0, kapF0, z));
                f32x4 nn = MFMA16(kapF1, btF1, MFMA16(kapF0, btF0, z));
                f32x4 na = MFMA16(btF1, kapF1, MFMA16(btF0, kapF0, z));
                f32x4 idv;
#pragma unroll
                for (int jj = 0; jj < 4; ++jj) {
                    akk[jj] = (4 * q + jj < fr) ? akk[jj] : 0.f; nn[jj] = (fr < 4 * q + jj) ? nn[jj] : 0.f; na[jj] = (4 * q + jj < fr) ? na[jj] : 0.f;
                    idv[jj] = (4 * q + jj == fr) ? 1.f : 0.f;
                }
                akkA = mkfrag(cvtpk(akk[0], akk[1]), cvtpk(akk[2], akk[3]), 0u, 0u);
                if (PASS == 2) {
                    const bf16x8 rtF0 = mkfrag(rtP[0].x, rtP[0].y, rtP[1].x, rtP[1].y), rtF1 = mkfrag(rtP[2].x, rtP[2].y, rtP[3].x, rtP[3].y);
                    f32x4 ark = MFMA16(ktF1, rtF1, MFMA16(ktF0, rtF0, z));
                    f32x4 arb = MFMA16(btF1, rtF1, MFMA16(btF0, rtF0, z));
#pragma unroll
                    for (int jj = 0; jj < 4; ++jj) { ark[jj] = (4 * q + jj <= fr) ? ark[jj] : 0.f; arb[jj] = (4 * q + jj <= fr) ? arb[jj] : 0.f; }
                    aryA = mkfrag(cvtpk(ark[0], ark[1]), cvtpk(ark[2], ark[3]), cvtpk(arb[0], arb[1]), cvtpk(arb[2], arb[3]));
                }
#define TF(x) mkfrag(cvtpk((x)[0], (x)[1]), cvtpk((x)[2], (x)[3]), 0u, 0u)
                const bf16x8 nF = TF(nn), aF = TF(na);
                const f32x4 n2 = MFMA16(aF, nF, z), a2 = MFMA16(nF, aF, z);
                const bf16x8 n2F = TF(n2), a2F = TF(a2);
                const f32x4 n4 = MFMA16(a2F, n2F, z), a4 = MFMA16(n2F, a2F, z);
                const bf16x8 n4F = TF(n4), a4F = TF(a4);
                const f32x4 n8 = MFMA16(a4F, n4F, z);
                const f32x4 t21 = MFMA16(n2F, aF, z);
                f32x4 R = idv - na + a2 - t21;
                R = MFMA16(n4F, TF(R), R);
                R = MFMA16(TF(n8), TF(R), R);
                tA = TF(R);
#undef TF
            }
            s16x4 Vc[4], Kc[4], Bc[4];
            {
                typedef s16x4 __attribute__((address_space(3)))* lp;
#pragma unroll
                for (int t4 = 0; t4 < 4; ++t4) {
                    Vc[t4] = __builtin_amdgcn_ds_read_tr16_b64_v4i16((lp)(ldsg + wo + ltr + 32 * t4));
                    Kc[t4] = __builtin_amdgcn_ds_read_tr16_b64_v4i16((lp)(ldsg + wo + 16 * IMG_STRIDE + ltr + 32 * t4));
                    Bc[t4] = __builtin_amdgcn_ds_read_tr16_b64_v4i16((lp)(ldsg + wo + 32 * IMG_STRIDE + ltr + 32 * t4));
                }
            }
            bf16x8 kbA[4];
#pragma unroll
            for (int mt = 0; mt < 4; ++mt) kbA[mt] = __builtin_shufflevector(Kc[mt], Bc[mt], 0, 1, 2, 3, 4, 5, 6, 7);
#pragma unroll
            for (int nt = 0; nt < 4; ++nt) {
                const f32x4 z = {0.f, 0.f, 0.f, 0.f};
                const bf16x8 stf0 = frag_f4(St[0][nt], St[1][nt]), stf1 = frag_f4(St[2][nt], St[3][nt]);
                const u32x2 vcu = __builtin_bit_cast(u32x2, Vc[nt]);
                f32x4 X = MFMA16(kapF1, stf1, MFMA16(kapF0, stf0, z));
                X = MFMA16(akkA, mkfrag(vcu.x, vcu.y, 0u, 0u), X);
                const f32x4 Uu = MFMA16(tA, mkfrag(cvtpk(X[0], X[1]), cvtpk(X[2], X[3]), 0u, 0u), z);
                const bf16x8 bvu = mkfrag(vcu.x, vcu.y, cvtpk(-Uu[0], -Uu[1]), cvtpk(-Uu[2], -Uu[3]));
                if (PASS == 2) {
                    const bf16x8 rtF0 = mkfrag(rtP[0].x, rtP[0].y, rtP[1].x, rtP[1].y), rtF1 = mkfrag(rtP[2].x, rtP[2].y, rtP[3].x, rtP[3].y);
                    f32x4 Y = MFMA16(rtF1, stf1, MFMA16(rtF0, stf0, z));
                    Y = MFMA16(aryA, bvu, Y);
#pragma unroll
                    for (int jj = 0; jj < 4; ++jj) {
                        const int i = 4 * q + jj, t2 = d ? T - 1 - (pos0 + i) : pos0 + i;
                        YS[((size_t)d * SLAB + b * T + t2) * DR + h * 64 + 16 * nt + fr] = (bf16_t)(cvtpk(Y[jj], 0.f) & 0xffffu);
                    }
                }
#pragma unroll
                for (int mt = 0; mt < 4; ++mt) St[mt][nt] = MFMA16(kbA[mt], bvu, St[mt][nt]) * *(const f32x4*)(ldsg + wo + 48 * IMG_STRIDE + 64 * mt + lq16);
            }
            if (PASS == 1) {
#pragma unroll
                for (int ct = 0; ct < 4; ++ct) {
                    const f32x4 z = {0.f, 0.f, 0.f, 0.f};
                    const bf16x8 pf0 = frag_f4(Pa[0][PASS == 1 ? ct : 0], Pa[PASS == 1 ? 1 : 0][PASS == 1 ? ct : 0]), pf1 = frag_f4(Pa[PASS == 1 ? 2 : 0][PASS == 1 ? ct : 0], Pa[PASS == 1 ? 3 : 0][PASS == 1 ? ct : 0]);
                    const f32x4 X = MFMA16(kapF1, pf1, MFMA16(kapF0, pf0, z));
                    const f32x4 Uu = MFMA16(tA, mkfrag(cvtpk(X[0], X[1]), cvtpk(X[2], X[3]), 0u, 0u), z);
                    const bf16x8 bvu = mkfrag(0u, 0u, cvtpk(-Uu[0], -Uu[1]), cvtpk(-Uu[2], -Uu[3]));
#pragma unroll
                    for (int mt = 0; mt < 4; ++mt) Pa[PASS == 1 ? mt : 0][PASS == 1 ? ct : 0] = MFMA16(kbA[mt], bvu, Pa[PASS == 1 ? mt : 0][PASS == 1 ? ct : 0]) * *(const f32x4*)(ldsg + wo + 48 * IMG_STRIDE + 64 * mt + lq16);
                }
            }
        }
        if (PASS == 1) {
            const int l2 = hw_tid(wid0) & 63, fr2 = l2 & 15, q2 = l2 >> 4;
            unsigned char* pqb = (unsigned char*)(PQ + (size_t)item * 8192);
            float* tl = (float*)(ldsg + wo);
#pragma unroll
            for (int mt = 0; mt < 4; ++mt)
#pragma unroll
                for (int ks = 0; ks < 2; ++ks) {
#pragma unroll
                    for (int e = 0; e < 2; ++e)
#pragma unroll
                        for (int j2 = 0; j2 < 4; ++j2) tl[e * 256 + (4 * q2 + j2) * 16 + fr2] = Pa[PASS == 1 ? mt : 0][PASS == 1 ? 2 * ks + e : 0][j2];
                    __builtin_amdgcn_wave_barrier();
                    const f32x4 pa = *(const f32x4*)(tl + fr2 * 16 + 4 * q2), pb = *(const f32x4*)(tl + 256 + fr2 * 16 + 4 * q2);
                    __builtin_amdgcn_wave_barrier();
                    bf16x8 ah, al; split_frag(pa, pb, ah, al);
                    *(bf16x8*)(pqb + (((mt * 2 + ks) * 2 + 0) * 64 + l2) * 16) = ah;
                }
            float* pq = PQ + (size_t)item * 8192 + 4096 + l2 * 4;
#pragma unroll
            for (int mt = 0; mt < 4; ++mt)
#pragma unroll
                for (int nt = 0; nt < 4; ++nt) *(f32x4*)(pq + (mt * 4 + nt) * 256) = St[mt][nt];
        }
    }
}

constexpr int CR_SLOTS = 10, CR_SLOT_BYTES = 12288, CR_FLAGS = CR_SLOTS * CR_SLOT_BYTES;
__device__ __forceinline__ void phase_combine_ring(KP p, int s, int wid0, unsigned char* ldsg) {
    KP_FRESH(p);
    int tid_ = hw_tid(wid0); asm volatile("" : "+v"(tid_));
    const int lane = tid_ & 63, wid = wid0;
    const int nseg = 64, nsteps = nseg - 1;
    const float* PQ = (const float*)(p->ws + WS_PQ); float* SST = (float*)(p->ws + WS_SST);
    volatile unsigned* flags = (volatile unsigned*)(ldsg + CR_FLAGS);
    __syncthreads();
    if (tid_ < CR_SLOTS) flags[tid_] = 0u;
    __syncthreads();
    if ((int)blockIdx.x >= 128) return;
    const int nt = blockIdx.x & 3, chain = blockIdx.x >> 2;
    if (wid != 0) {
        u32x4 ra[12], rb[12];
#define CR_ISSUE(r, gg) do { const unsigned char* b_ = (const unsigned char*)(PQ + ((size_t)chain * nseg + (gg)) * 8192); \
        _Pragma("unroll") for (int f = 0; f < 8; ++f) (r)[f] = *(const u32x4*)(b_ + ((f * 2 + 0) * 64 + lane) * 16); \
        _Pragma("unroll") for (int mt = 0; mt < 4; ++mt) (r)[8 + mt] = *(const u32x4*)(b_ + 16384 + ((mt * 4 + nt) * 64 + lane) * 16); } while (0)
#define CR_PUT(r, gg) do { const int slot_ = (gg) % CR_SLOTS; const unsigned gen_ = 2u * (unsigned)((gg) / CR_SLOTS); unsigned sp_ = 0;     \
        while (flags[slot_] != gen_ && ++sp_ < (1u << 20)) __builtin_amdgcn_s_sleep(1); \
        _Pragma("unroll") for (int f = 0; f < 12; ++f) *(u32x4*)(ldsg + slot_ * CR_SLOT_BYTES + f * 1024 + lane * 16) = (r)[f]; \
        asm volatile("s_waitcnt lgkmcnt(0)" ::: "memory"); __builtin_amdgcn_wave_barrier(); \
        if (lane == 0) flags[slot_] = gen_ + 1u; } while (0)
        int g = wid - 1;
        if (g < nsteps) CR_ISSUE(ra, g);
        for (; g < nsteps; g += 14) {
            if (g + 7 < nsteps) CR_ISSUE(rb, g + 7);
            CR_PUT(ra, g);
            if (g + 14 < nsteps) CR_ISSUE(ra, g + 14);
            if (g + 7 < nsteps) CR_PUT(rb, g + 7);
        }
#undef CR_ISSUE
#undef CR_PUT
    } else {
        f32x4 S[4];
#pragma unroll
        for (int mt = 0; mt < 4; ++mt) S[mt] = (f32x4){0.f, 0.f, 0.f, 0.f};
        for (int g = 0; g < nseg; ++g) {
            const size_t item = (size_t)chain * nseg + g;
#pragma unroll
            for (int mt = 0; mt < 4; ++mt) *(f32x4*)(SST + item * 4096 + ((mt * 4 + nt) * 64 + lane) * 4) = S[mt];
            if (g == nsteps) break;
            const int slot = g % CR_SLOTS; const unsigned gen = 2u * (unsigned)(g / CR_SLOTS); unsigned sp = 0;
            while (flags[slot] != gen + 1u && ++sp < (1u << 20)) __builtin_amdgcn_s_sleep(1);
            bf16x8 ah[4][2]; f32x4 qv[4];
#pragma unroll
            for (int mt = 0; mt < 4; ++mt) {
                qv[mt] = *(const f32x4*)(ldsg + slot * CR_SLOT_BYTES + (8 + mt) * 1024 + lane * 16);
#pragma unroll
                for (int ks = 0; ks < 2; ++ks) ah[mt][ks] = *(const bf16x8*)(ldsg + slot * CR_SLOT_BYTES + (mt * 2 + ks) * 1024 + lane * 16);
            }
            asm volatile("s_waitcnt lgkmcnt(0)" ::: "memory"); __builtin_amdgcn_wave_barrier();
            if (lane == 0) flags[slot] = gen + 2u;
            bf16x8 bh[2], bl[2];
            split_frag(S[0], S[1], bh[0], bl[0]); split_frag(S[2], S[3], bh[1], bl[1]);
#pragma unroll
            for (int mt = 0; mt < 4; ++mt) {
                f32x4 acc = qv[mt];
#pragma unroll
                for (int ks = 0; ks < 2; ++ks) { acc = MFMA16(ah[mt][ks], bh[ks], acc); acc = MFMA16(ah[mt][ks], bl[ks], acc); }
                S[mt] = acc;
            }
        }
    }
}

__device__ void phase_combine(KP p, int s, int wid0) {
    KP_FRESH(p);
    int tid_ = hw_tid(wid0); asm volatile("" : "+v"(tid_));
    const int lane = tid_ & 63, wid = tid_ >> 6, fr = lane & 15, q = lane >> 4;
    int tok0, nseq, T; slab_info(s, tok0, nseq, T);
    const int lgseg = (s == 0) ? 3 : 6, nseg = 1 << lgseg, nwork = nseq * 32 * 4;
    const float* PQ = (const float*)(p->ws + WS_PQ); float* SST = (float*)(p->ws + WS_SST);
    for (int wk = blockIdx.x * 8 + wid; wk < nwork; wk += gridDim.x * 8) {
        const int nt = wk & 3, chain = wk >> 2;
        f32x4 S[4];
#pragma unroll
        for (int mt = 0; mt < 4; ++mt) S[mt] = (f32x4){0.f, 0.f, 0.f, 0.f};
        struct CStep { bf16x8 ah[4][2]; f32x4 q[4]; };
#define CMB_LOAD(c, gg) do { const int g_ = (gg) < nseg - 1 ? (gg) : nseg - 2; const unsigned char* b_ = (const unsigned char*)(PQ + ((size_t)chain * nseg + g_) * 8192); \
        _Pragma("unroll") for (int mt = 0; mt < 4; ++mt) { (c).q[mt] = *(const f32x4*)(b_ + 16384 + ((mt * 4 + nt) * 64 + lane) * 16); \
            _Pragma("unroll") for (int ks = 0; ks < 2; ++ks) (c).ah[mt][ks] = *(const bf16x8*)(b_ + (((mt * 2 + ks) * 2 + 0) * 64 + lane) * 16); } } while (0)
        CStep c0, c1, c2;
        CMB_LOAD(c0, 0); CMB_LOAD(c1, 1); CMB_LOAD(c2, 2);
        for (int g = 0; g < nseg; ++g) {
            const size_t item = (size_t)chain * nseg + g;
#pragma unroll
            for (int mt = 0; mt < 4; ++mt) *(f32x4*)(SST + item * 4096 + ((mt * 4 + nt) * 64 + lane) * 4) = S[mt];
            if (g == nseg - 1) break;
            const CStep cc = c0; c0 = c1; c1 = c2;
            CMB_LOAD(c2, g + 3);
            bf16x8 bh[2], bl[2];
            split_frag(S[0], S[1], bh[0], bl[0]); split_frag(S[2], S[3], bh[1], bl[1]);
#pragma unroll
            for (int mt = 0; mt < 4; ++mt) {
                f32x4 acc = cc.q[mt];
#pragma unroll
                for (int ks = 0; ks < 2; ++ks) { acc = MFMA16(cc.ah[mt][ks], bh[ks], acc); acc = MFMA16(cc.ah[mt][ks], bl[ks], acc); }
                S[mt] = acc;
            }
        }
#undef CMB_LOAD
    }
}

DI void unpack8(u32x4 w, float (&f)[8]) { f[0] = lo16(w.x); f[1] = hi16(w.x); f[2] = lo16(w.y); f[3] = hi16(w.y); f[4] = lo16(w.z); f[5] = hi16(w.z); f[6] = lo16(w.w); f[7] = hi16(w.w); }
__device__ void phase_shift(KP p, int s, int wid0) {
    KP_FRESH(p);
    int tid_ = hw_tid(wid0); asm volatile("" : "+v"(tid_));
    int tok0, nseq, T; slab_info(s, tok0, nseq, T);
    const bf16_t* SB = (const bf16_t*)(p->ws + WS_TMP); bf16_t* U = (bf16_t*)(p->ws + WS_U);
    const float* mu = p->in[I_MU];
    const int gt = blockIdx.x * 512 + tid_, nt = gridDim.x * 512;
    for (int unit = gt; unit < 416 * 512; unit += nt) {
        const int cg0 = unit % 416, cg = cg0 < 384 ? cg0 : cg0 + 128, be = unit / 416, blk = be >> 1, e = be & 1, c0 = cg * 8;
        const int r = blk * 64 + (e ? 63 : 0), t = r & (T - 1);
        const bool tanh_cols = (c0 >= 4096) && (c0 < 4096 + 128);
        const bf16_t* sb = SB + (size_t)blk * 4 * 4352 + c0;
        float prev[8], cur[8], nxt[8], m[8];
        { const f32x4 a = *(const f32x4*)(mu + c0), b = *(const f32x4*)(mu + c0 + 4); m[0] = a[0]; m[1] = a[1]; m[2] = a[2]; m[3] = a[3]; m[4] = b[0]; m[5] = b[1]; m[6] = b[2]; m[7] = b[3]; }
        if (e == 0) {
            if (t > 0) unpack8(*(const u32x4*)(sb - 4352), prev); else { for (int k = 0; k < 8; ++k) prev[k] = 0.f; }
            unpack8(*(const u32x4*)sb, cur); unpack8(*(const u32x4*)(sb + 4352), nxt);
        } else {
            unpack8(*(const u32x4*)(sb + 2 * 4352), prev); unpack8(*(const u32x4*)(sb + 3 * 4352), cur);
            if (t < T - 1) unpack8(*(const u32x4*)(sb + 4 * 4352), nxt); else { for (int k = 0; k < 8; ++k) nxt[k] = 0.f; }
        }
        float o[8];
#pragma unroll
        for (int k = 0; k < 8; ++k) {
            float v = cur[k] + m[k] * (0.5f * (prev[k] + nxt[k]) - cur[k]);
            if (tanh_cols) v = 1.f - 2.f * __builtin_amdgcn_rcpf(1.f + __expf(2.f * v));
            o[k] = v;
        }
        *(u32x4*)(U + (size_t)r * UW + URW + c0) = (u32x4){cvtpk(o[0], o[1]), cvtpk(o[2], o[3]), cvtpk(o[4], o[5]), cvtpk(o[6], o[7])};
    }
    const bf16_t* SB2 = (const bf16_t*)(p->ws + WS_SB2); bf16_t* ymix = (bf16_t*)(p->ws + WS_YMIX);
    const float* cw = p->in[I_CW]; const float* cb = p->in[I_CB];
    for (int unit = gt; unit < 128 * 512; unit += nt) {
        const int cg = unit & 127, be = unit >> 7, blk = be >> 1, e = be & 1, c0 = cg * 8;
        const int r = blk * 64 + (e ? 63 : 0), t = r & (T - 1);
        const bf16_t* sb = SB2 + (size_t)blk * 6 * 1024 + c0;
        float prev[8], cur[8], nxt[8], gg[8];
        if (e == 0) {
            if (t > 0) unpack8(*(const u32x4*)(sb - 3 * 1024), prev); else { for (int k = 0; k < 8; ++k) prev[k] = 0.f; }
            unpack8(*(const u32x4*)sb, cur); unpack8(*(const u32x4*)(sb + 1024), nxt); unpack8(*(const u32x4*)(sb + 4 * 1024), gg);
        } else {
            unpack8(*(const u32x4*)(sb + 2 * 1024), prev); unpack8(*(const u32x4*)(sb + 3 * 1024), cur); unpack8(*(const u32x4*)(sb + 5 * 1024), gg);
            if (t < T - 1) unpack8(*(const u32x4*)(sb + 6 * 1024), nxt); else { for (int k = 0; k < 8; ++k) nxt[k] = 0.f; }
        }
        float o[8];
#pragma unroll
        for (int k = 0; k < 8; ++k) o[k] = gg[k] * (cw[c0 + k] * prev[k] + cw[1024 + c0 + k] * cur[k] + cw[2048 + c0 + k] * nxt[k] + cb[c0 + k]);
        *(u32x4*)(ymix + (size_t)r * 2048 + c0) = (u32x4){cvtpk(o[0], o[1]), cvtpk(o[2], o[3]), cvtpk(o[4], o[5]), cvtpk(o[6], o[7])};
    }
}

__device__ void phase_post(KP p, int s, int wid0) {
    KP_FRESH(p);
    int tid_ = hw_tid(wid0); asm volatile("" : "+v"(tid_));
    const int lane = tid_ & 63, gw = blockIdx.x * 8 + (tid_ >> 6), nw = gridDim.x * 8;
    int tok0, nseq, T; slab_info(s, tok0, nseq, T);
    const bf16_t* U = (const bf16_t*)(p->ws + WS_U);
    const bf16_t* YS = (const bf16_t*)(p->ws + WS_YS); const float* BON = (const float*)(p->ws + WS_BON);
    bf16_t* ymix = (bf16_t*)(p->ws + WS_YMIX);
    for (int unit = gw; unit < (SLAB / 16) * 2; unit += nw) {
        const int half = unit & 1, r0 = (unit >> 1) * 16, c0 = half * 512 + lane * 8, h = c0 >> 6;
        float lg[8], lb[8], muz[8];
        {
            const float* g = p->in[I_LXG]; const float* b = p->in[I_LXB]; const float* mu = p->in[I_MU];
#pragma unroll
            for (int e = 0; e < 8; ++e) { lg[e] = g[c0 + e]; lb[e] = b[c0 + e]; muz[e] = mu[3072 + c0 + e]; }
        }
        const int t0 = r0 & (T - 1);
        const bf16_t* up = U + (size_t)r0 * UW + URW + c0;
        float zprev[8], zcur[8], znxt[8];
        if (t0 > 0) unpack8(*(const u32x4*)(up - UW + 3072), zprev); else { for (int e = 0; e < 8; ++e) zprev[e] = 0.f; }
        unpack8(*(const u32x4*)(up + 3072), zcur);
        for (int ib = 0; ib < 16; ib += 4) {
            u32x4 rv[4], rz[4], ry0[4], ry1[4]; float bonv[4];
#pragma unroll
            for (int r = 0; r < 4; ++r) {
                const int i = ib + r, row = r0 + i;
                const bf16_t* ur = up + (size_t)i * UW;
                rz[r] = (t0 + i < T - 1) ? *(const u32x4*)(ur + UW + 3072) : (u32x4){0u, 0u, 0u, 0u};
                rv[r] = *(const u32x4*)(ur + 2048);
                ry0[r] = *(const u32x4*)(YS + (size_t)row * DR + c0); ry1[r] = *(const u32x4*)(YS + ((size_t)SLAB + row) * DR + c0);
                bonv[r] = BON[(size_t)row * 16 + h] + BON[((size_t)SLAB + row) * 16 + h];
            }
#pragma unroll
            for (int r = 0; r < 4; ++r) {
                const int row = r0 + ib + r;
                float vv[8], zz[8], y[8], y1[8];
                unpack8(rv[r], vv); unpack8(rz[r], znxt); unpack8(ry0[r], y); unpack8(ry1[r], y1);
#pragma unroll
                for (int e = 0; e < 8; ++e) { zz[e] = zcur[e] + muz[e] * (0.5f * (zprev[e] + znxt[e]) - zcur[e]); zprev[e] = zcur[e]; zcur[e] = znxt[e]; }
                const float bon = bonv[r];
#pragma unroll
                for (int e = 0; e < 8; ++e) y[e] += y1[e];
                float sum = 0.f;
#pragma unroll
                for (int e = 0; e < 8; ++e) sum += y[e];
                sum += shx(sum, lane, 1); sum += shx(sum, lane, 2); sum += shx(sum, lane, 4);
                const float mean = sum * (1.f / 64.f);
                float sq = 0.f;
#pragma unroll
                for (int e = 0; e < 8; ++e) { const float dl = y[e] - mean; sq += dl * dl; }
                sq += shx(sq, lane, 1); sq += shx(sq, lane, 2); sq += shx(sq, lane, 4);
                const float rstd = rsqrtf(sq * (1.f / 64.f) + 64e-5f);
                float orw[8];
#pragma unroll
                for (int e = 0; e < 8; ++e) orw[e] = ((y[e] - mean) * rstd * lg[e] + lb[e] + bon * vv[e]) * (zz[e] * fsig(zz[e]));
                *(u32x4*)(ymix + (size_t)row * 2048 + 1024 + c0) = (u32x4){cvtpk(orw[0], orw[1]), cvtpk(orw[2], orw[3]), cvtpk(orw[4], orw[5]), cvtpk(orw[6], orw[7])};
            }
        }
    }
}

__device__ void phase_lnout(KP p, int s, int wid0) {
    KP_FRESH(p);
    int tid_ = hw_tid(wid0); asm volatile("" : "+v"(tid_)); int lane = tid_ & 63; const int gw = blockIdx.x * 8 + (tid_ >> 6), nw = gridDim.x * 8;
    float* out = p->out + (size_t)s * SLAB * D;
    const float4* g4 = (const float4*)p->in[I_LG]; const float4* b4 = (const float4*)p->in[I_LB];
    for (int r0 = gw; r0 < SLAB; r0 += 4 * nw) {
        asm volatile("" : "+v"(lane));
        float4 v[4][4];
#pragma unroll
        for (int k = 0; k < 4; ++k)
#pragma unroll
            for (int i = 0; i < 4; ++i) v[k][i] = ((const float4*)(out + (size_t)(r0 + k * nw) * D))[lane + 64 * i];
#pragma unroll
        for (int k = 0; k < 4; ++k) {
            float4* xp = (float4*)(out + (size_t)(r0 + k * nw) * D);
            float sum = 0.f;
#pragma unroll
            for (int i = 0; i < 4; ++i) sum += v[k][i].x + v[k][i].y + v[k][i].z + v[k][i].w;
            const float mean = wsum(sum, lane) * (1.f / 1024.f);
            float sq = 0.f;
#pragma unroll
            for (int i = 0; i < 4; ++i) { float a = v[k][i].x - mean, b = v[k][i].y - mean, c = v[k][i].z - mean, d = v[k][i].w - mean; sq += a * a + b * b + c * c + d * d; }
            const float rstd = rsqrtf(wsum(sq, lane) * (1.f / 1024.f) + 1e-5f);
#pragma unroll
            for (int i = 0; i < 4; ++i) {
                const float4 g = g4[lane + 64 * i], b = b4[lane + 64 * i];
                float4 o; o.x = (v[k][i].x - mean) * rstd * g.x + b.x; o.y = (v[k][i].y - mean) * rstd * g.y + b.y; o.z = (v[k][i].z - mean) * rstd * g.z + b.z; o.w = (v[k][i].w - mean) * rstd * g.w + b.w;
                xp[lane + 64 * i] = o;
            }
        }
    }
}

#define LAS __attribute__((address_space(3)))
#define XB_TMO      128
#define XB_XCNT(j)  (256  + 64 * (j))
#define XB_XSUB(j)  (1280 + 64 * (j))
#define XB_XGEN(j)  (2304 + 64 * (j))
#define XB_TOP      3328
#define XB_TOPGEN   3392
#define XCD_BAR_WORDS 3456
#define XB_SPIN_CAP (1u << 18)

__device__ __forceinline__ unsigned xb_ld(unsigned* p)              { return __hip_atomic_load(p, __ATOMIC_RELAXED, __HIP_MEMORY_SCOPE_AGENT); }
__device__ __forceinline__ unsigned xb_add(unsigned* p, unsigned v) { return __hip_atomic_fetch_add(p, v, __ATOMIC_RELAXED, __HIP_MEMORY_SCOPE_AGENT); }
__device__ __forceinline__ unsigned xb_xcc_id() { return (unsigned)__builtin_amdgcn_s_getreg((3 << 11) | 20) & 0xFu; }
#define XB_SPIN(cond, bar) do { unsigned _sp = 0; while (cond) { __builtin_amdgcn_s_sleep(1); \
    if ((++_sp & 255u) == 0u) { if (xb_ld(&(bar)[XB_TMO])) break; if (_sp > XB_SPIN_CAP) { atomicAdd(&(bar)[XB_TMO], 1u); break; } } } } while (0)

struct XcdBarrier {
    unsigned* bar; unsigned x;
    volatile LAS unsigned* st;
};

__device__ __forceinline__ XcdBarrier xcd_barrier_post(unsigned* bar, volatile LAS unsigned* st) {
    XcdBarrier b; b.bar = bar; b.x = xb_xcc_id(); b.st = st;
    if (threadIdx.x == 0) (void)xb_add(&bar[XB_XCNT(b.x)], 1u);
    return b;
}
__device__ __forceinline__ void xcd_barrier_complete(unsigned* bar, unsigned x, unsigned& nloc, unsigned& nx) {
    const unsigned G = gridDim.x * gridDim.y * gridDim.z;
    unsigned sum, cnt, mine, sp = 0u;
    for (;;) {
        sum = 0u; cnt = 0u; mine = 0u;
#pragma unroll
        for (unsigned j = 0; j < 16; ++j) { const unsigned c = xb_ld(&bar[XB_XCNT(j)]); sum += c; cnt += (c > 0u) ? 1u : 0u; mine = (j == x) ? c : mine; }
        if (sum == G) break;
        __builtin_amdgcn_s_sleep(1);
        if ((++sp & 255u) == 0u) { if (xb_ld(&bar[XB_TMO])) break; if (sp > XB_SPIN_CAP) { atomicAdd(&bar[XB_TMO], 1u); break; } }
    }
    nloc = mine > 0u ? mine : 1u; nx = cnt > 0u ? cnt : 1u;
}

__device__ __forceinline__ void xcd_barrier(const XcdBarrier& b) {
    asm volatile("s_waitcnt vmcnt(0)" ::: "memory");
    __syncthreads();
    if (threadIdx.x == 0) {
        unsigned* bar = b.bar;
        __builtin_amdgcn_s_waitcnt(0);
        unsigned nloc = b.st[0], nx = b.st[1];
        if (nloc == 0u) { xcd_barrier_complete(bar, b.x, nloc, nx); b.st[0] = nloc; b.st[1] = nx; }
        const unsigned old = xb_add(&bar[XB_XSUB(b.x)], 1u);
        const unsigned gen = old / nloc;
        if (old + 1u == (gen + 1u) * nloc) {
            __builtin_amdgcn_fence(__ATOMIC_RELEASE, "agent");
            asm volatile("s_waitcnt vmcnt(0)" ::: "memory");
            const unsigned og = xb_add(&bar[XB_TOP], 1u);
            const unsigned tg = og / nx;
            if (og + 1u == (tg + 1u) * nx) xb_add(&bar[XB_TOPGEN], 1u);
            else XB_SPIN(xb_ld(&bar[XB_TOPGEN]) == tg, bar);
            __builtin_amdgcn_fence(__ATOMIC_ACQUIRE, "agent");
            xb_add(&bar[XB_XGEN(b.x)], 1u);
            asm volatile("s_waitcnt vmcnt(0)" ::: "memory");
        } else {
            XB_SPIN(xb_ld(&bar[XB_XGEN(b.x)]) == gen, bar);
            __builtin_amdgcn_fence(__ATOMIC_ACQUIRE, "agent");
            asm volatile("s_waitcnt vmcnt(0)" ::: "memory");
        }
    }
    __syncthreads();
}

#ifndef REP_SHIFT
#define REP_SHIFT 1
#endif
#ifndef REP_G2
#define REP_G2 1
#endif
#ifndef REP_SCAN
#define REP_SCAN 1
#endif
#ifndef REP_POST
#define REP_POST 1
#endif
#ifndef REP_G1
#define REP_G1 1
#endif
#define GBAR() xcd_barrier(bar)
__global__ void __launch_bounds__(512, 2) fwd_megakernel(Params p_unused) {
    extern __shared__ __attribute__((aligned(16))) unsigned char lds_raw[];
    PG8_LAS unsigned char* lds = (PG8_LAS unsigned char*)lds_raw;
    cg::grid_group grid = cg::this_grid();
    KP p = (KP)__builtin_amdgcn_kernarg_segment_ptr();
    if (threadIdx.x < 2) ((volatile LAS unsigned*)(lds + LDS_BYTES - 64))[threadIdx.x] = 0u;
    __syncthreads();
    {
        unsigned* bw = (unsigned*)(((const Params __attribute__((address_space(4)))*)__builtin_amdgcn_kernarg_segment_ptr())->ws + WS_BAR);
        if (blockIdx.x == 0) { for (int w = threadIdx.x; w < XCD_BAR_WORDS; w += 512) __hip_atomic_store(bw + w, 0u, __ATOMIC_RELAXED, __HIP_MEMORY_SCOPE_AGENT); __threadfence(); }
        grid.sync();
    }
    XcdBarrier bar = xcd_barrier_post((unsigned*)(((const Params __attribute__((address_space(4)))*)__builtin_amdgcn_kernarg_segment_ptr())->ws + WS_BAR), (volatile LAS unsigned*)(lds + LDS_BYTES - 64));
    const int wid0 = __builtin_amdgcn_readfirstlane((int)threadIdx.x >> 6);
    phase_weights(p, wid0);
    for (int s = -1; s < 3; ++s) {
        if (s == 0) GBAR();
        if (s >= 0)
        for (int rep = 0; rep < REP_G1; ++rep) {
            if (rep) GBAR();
            KP_FRESH(p);
            pg8::Gemm g; g.A = xn_buf(p, s); g.Bt = (const bf16_t*)(p->ws + WS_WIN); g.M = SLAB; g.N = NIN; g.K = D;
            pg8::StaticOrder S; S.init(g.M, g.N, gridDim.x, blockIdx.x);
            EpiU E; E.U = (bf16_t*)(p->ws + WS_U); E.TMP = (bf16_t*)(p->ws + WS_TMP); E.mu = p->in[I_MU]; E.YM = (bf16_t*)(p->ws + WS_YMIX); E.SB2 = (bf16_t*)(p->ws + WS_SB2); E.cw = p->in[I_CW]; E.cb = p->in[I_CB];
            pg8::gemm_phase<EpiU, pg8::StaticOrder, true, true>(lds, g, S, E, wid0);
        }
        {
            const int wg0 = (s >= 0 && gridDim.x > 64) ? 64 : 0;
            if (s < 2 && (int)blockIdx.x >= wg0) phase_ln(p, s + 1, wid0, wg0);
        }
        if (s < 0) continue;
        GBAR();
        for (int rep = 0; rep < REP_SHIFT; ++rep) {
        phase_shift(p, s, wid0);
        GBAR();
        }
        for (int rep = 0; rep < REP_SCAN; ++rep) {
        phase_scan<1>(p, s, lds_raw, wid0);
        GBAR();
        if (s > 0 && gridDim.x >= 128) phase_combine_ring(p, s, wid0, lds_raw); else phase_combine(p, s, wid0);
        GBAR();
        phase_scan<2>(p, s, lds_raw, wid0);
        GBAR();
        }
        for (int rep = 0; rep < REP_POST; ++rep) {
        phase_post(p, s, wid0);
        GBAR();
        }
        for (int rep = 0; rep < REP_G2; ++rep) {
            if (rep) GBAR();
            KP_FRESH(p);
            pg8::Gemm g; g.A = (const bf16_t*)(p->ws + WS_YMIX); g.Bt = (const bf16_t*)(p->ws + WS_WOUT); g.M = SLAB; g.N = D; g.K = 2048;
            pg8::StaticOrder S; S.init(g.M, g.N, gridDim.x, blockIdx.x);
            EpiOut E; E.out = p->out + (size_t)s * SLAB * D; E.x = slab_x(p, s); E.stats = (const float*)(p->ws + WS_STATS) + (size_t)s * SLAB * 2; E.eg = p->in[I_EG]; E.eb = p->in[I_EB];
            pg8::gemm_phase<EpiOut, pg8::StaticOrder, true, true>(lds, g, S, E, wid0);
        }
        GBAR();
        phase_lnout(p, s, wid0);
    }
}

extern "C" void kernel_launch(void* const* d_in, const int* in_sizes, int n_in, void* d_out, int out_size, void* d_ws, size_t ws_size, hipStream_t stream) {
    static int grid_blocks = 0;
    if (!grid_blocks) {
        int dev = 0, cus = 0, per_cu = 0;
        hipGetDevice(&dev);
        hipDeviceGetAttribute(&cus, hipDeviceAttributeMultiprocessorCount, dev);
        hipFuncSetAttribute((const void*)fwd_megakernel, hipFuncAttributeMaxDynamicSharedMemorySize, LDS_BYTES);
        hipOccupancyMaxActiveBlocksPerMultiprocessor(&per_cu, (const void*)fwd_megakernel, 512, LDS_BYTES);
        if (per_cu < 1) per_cu = 1;
        if (per_cu > 1) per_cu = 1;
        grid_blocks = cus * per_cu;
    }
    Params p{};
    for (int i = 0; i < 20; ++i) p.in[i] = (const float*)d_in[i];
    p.out = (float*)d_out; p.ws = (unsigned char*)d_ws;
    void* args[] = {&p};
    hipError_t e = hipLaunchCooperativeKernel((const void*)fwd_megakernel, dim3(grid_blocks), dim3(512), args, LDS_BYTES, stream);
    if (e != hipSuccess) fprintf(stderr, "cooperative launch failed: %s (grid %d)\n", hipGetErrorString(e), grid_blocks);
}
```
